# Optimizing an MI355X kernel written in HIP

```python
import jax, jax.numpy as jnp
from jax import lax
import numpy as np

D_MODEL = 1024
BATCH = 4
SEQ = 4096
DEPTH = 2

D_MIX = D_MODEL
HEAD_DIM = 64
W_CONV = D_MIX // 4
W_SGU = D_MIX // 4
W_LRU = D_MIX // 2
H_CONV = W_CONV // HEAD_DIM
H_SGU = W_SGU // HEAD_DIM
H_LRU = W_LRU // HEAD_DIM
D_IN = 3 * W_CONV + 2 * W_SGU + 2 * W_LRU
CONV_A_WIDTH = 3
CONV_C_WIDTH = 4
CHUNK = 128
RGLRU_C = 8.0
N_EXPERTS = 32
TOP_K = 4
D_FF_EXPERT = D_MODEL
SWIGLU_LIMIT = 7.0
SWIGLU_ALPHA = 1.702
MOE_BLOCK = 128
N_MOD = 6
EPS = 1e-6

kernel_name = 'hybrid_conv_sgu_rglru_moe_adaln'


def rms_normalize(x):
    xf = x.astype(jnp.float32)
    return xf * lax.rsqrt(jnp.mean(xf * xf, axis=-1, keepdims=True) + EPS)


def rms_norm(x, g):
    return (rms_normalize(x) * g.astype(jnp.float32)).astype(x.dtype)


def layer_norm(x, g, b):
    xf = x.astype(jnp.float32)
    xc = xf - jnp.mean(xf, axis=-1, keepdims=True)
    y = xc * lax.rsqrt(jnp.mean(xc * xc, axis=-1, keepdims=True) + EPS)
    return (y * g.astype(jnp.float32) + b.astype(jnp.float32)).astype(x.dtype)


def causal_depthwise_conv(z, w):
    k_width = w.shape[0]
    seq = z.shape[1]
    zp = jnp.pad(z, ((0, 0), (k_width - 1, 0), (0, 0)))
    y = zp[:, 0:seq] * w[0]
    for k in range(1, k_width):
        y = y + zp[:, k:k + seq] * w[k]
    return y


def short_conv_mixer(b_gate, c_gate, v, conv_w):
    return b_gate * causal_depthwise_conv(c_gate * v, conv_w)


def chunked_spatial_gating(z, sgu_w, sgu_b, ln_g, ln_b):
    bsz, seq, _ = z.shape
    z = jax.nn.gelu(z)
    u, v = jnp.split(z, 2, axis=-1)
    v = layer_norm(v, ln_g, ln_b).reshape(bsz, seq // CHUNK, CHUNK, H_SGU, HEAD_DIM)
    causal = jnp.tril(jnp.ones((CHUNK, CHUNK), dtype=bool))
    w = jnp.where(causal[None], sgu_w, jnp.zeros((), sgu_w.dtype))
    mixed = jnp.einsum('hts,bnshd->bnthd', w, v) + jnp.transpose(sgu_b)[:, :, None]
    return u * mixed.reshape(bsz, seq, W_SGU)


def rg_lru(x, gate_w, gate_b, lam):
    bsz, seq, _ = x.shape
    xh = x.reshape(bsz, seq, H_LRU, HEAD_DIM)
    gates = jnp.einsum('bshi,ghij->gbshj', xh, gate_w) + gate_b[:, None, None]
    gates = jax.nn.sigmoid(gates.astype(jnp.float32)).reshape(2, bsz, seq, W_LRU)
    r, i = gates[0], gates[1]
    log_a = -RGLRU_C * r * jax.nn.softplus(-lam.astype(jnp.float32))
    a = jnp.exp(log_a)
    b = x.astype(jnp.float32) * i * jnp.sqrt(-jnp.expm1(2.0 * log_a))

    def combine(left, right):
        a_l, b_l = left
        a_r, b_r = right
        return a_l * a_r, a_r * b_l + b_r

    _, h = lax.associative_scan(combine, (a, b), axis=1)
    return h.astype(x.dtype)


def recurrent_branch(gate_in, x_in, conv_w, conv_b, gate_w, gate_b, lam):
    xr = causal_depthwise_conv(x_in, conv_w) + conv_b
    return jax.nn.gelu(gate_in) * rg_lru(xr, gate_w, gate_b, lam)


def hybrid_mixer(h, w_in, conv_a_w, sgu_w, sgu_b, sgu_ln_g, sgu_ln_b, conv_c_w, conv_c_b,
                 rglru_gate_w, rglru_gate_b, rglru_lambda, mix_norm_g, w_out):
    z = jnp.einsum('bsd,dp->bsp', h, w_in)
    cuts = [W_CONV, 2 * W_CONV, 3 * W_CONV, 3 * W_CONV + 2 * W_SGU, 3 * W_CONV + 2 * W_SGU + W_LRU]
    z_b, z_c, z_v, z_s, z_g, z_x = jnp.split(z, cuts, axis=-1)
    y_conv = short_conv_mixer(z_b, z_c, z_v, conv_a_w)
    y_sgu = chunked_spatial_gating(z_s, sgu_w, sgu_b, sgu_ln_g, sgu_ln_b)
    y_lru = recurrent_branch(z_g, z_x, conv_c_w, conv_c_b, rglru_gate_w, rglru_gate_b, rglru_lambda)
    y = jnp.concatenate([rms_normalize(y_conv), rms_normalize(y_sgu), rms_normalize(y_lru)], axis=-1)
    y = (y * mix_norm_g.astype(jnp.float32)).astype(h.dtype)
    return jnp.einsum('bsm,md->bsd', y, w_out)


def clamped_swiglu_expert(xb, w1, b1, w2, b2):
    hgu = xb @ w1 + b1
    g, u = jnp.split(hgu, 2, axis=-1)
    g = jnp.minimum(g, SWIGLU_LIMIT)
    u = jnp.clip(u, -SWIGLU_LIMIT, SWIGLU_LIMIT)
    return ((u + 1.0) * (g * jax.nn.sigmoid(SWIGLU_ALPHA * g))) @ w2 + b2


def moe_ffn(h, router_w, router_b, w1, b1, w2, b2):
    bsz, seq, d = h.shape
    n_tok = bsz * seq
    xt = h.reshape(n_tok, d)
    logits = xt.astype(jnp.float32) @ router_w.astype(jnp.float32) + router_b.astype(jnp.float32)
    top_logits, top_idx = lax.top_k(logits, TOP_K)
    top_w = jax.nn.softmax(top_logits, axis=-1)
    n_assign = n_tok * TOP_K
    flat_e = top_idx.reshape(n_assign)
    order = jnp.argsort(flat_e)
    sorted_e = flat_e[order]
    sorted_tok = (order // TOP_K).astype(jnp.int32)
    sorted_w = top_w.reshape(n_assign)[order]
    counts = jnp.bincount(flat_e, length=N_EXPERTS)
    padded = (counts + MOE_BLOCK - 1) // MOE_BLOCK * MOE_BLOCK
    pad_end = jnp.cumsum(padded)
    pad_start = pad_end - padded
    grp_start = jnp.cumsum(counts) - counts
    rank = jnp.arange(n_assign) - grp_start[sorted_e]
    slot = pad_start[sorted_e] + rank
    n_blocks = (n_assign + MOE_BLOCK - 1) // MOE_BLOCK + N_EXPERTS
    n_slots = n_blocks * MOE_BLOCK
    slot_tok = jnp.full((n_slots,), n_tok, jnp.int32).at[slot].set(sorted_tok)
    slot_w = jnp.zeros((n_slots,), jnp.float32).at[slot].set(sorted_w)
    x_pad = jnp.concatenate([xt, jnp.zeros((1, d), xt.dtype)], axis=0)
    x_blocks = x_pad[slot_tok].reshape(n_blocks, MOE_BLOCK, d)
    block_e = jnp.minimum(
        jnp.searchsorted(pad_end, jnp.arange(n_blocks) * MOE_BLOCK, side='right'), N_EXPERTS - 1)

    def run_block(args):
        xb, e = args
        return clamped_swiglu_expert(xb, w1[e], b1[e], w2[e], b2[e])

    y = lax.map(run_block, (x_blocks, block_e)).reshape(n_slots, d)
    y = y * slot_w[:, None].astype(y.dtype)
    out = jnp.zeros((n_tok + 1, d), y.dtype).at[slot_tok].add(y)[:n_tok]
    return out.reshape(bsz, seq, d)


def decoder_layer(x, c, norm1_g, norm2_g, w_ada, b_ada, w_in, conv_a_w, sgu_w, sgu_b, sgu_ln_g,
                  sgu_ln_b, conv_c_w, conv_c_b, rglru_gate_w, rglru_gate_b, rglru_lambda,
                  mix_norm_g, w_out, router_w, router_b, expert_w1, expert_b1, expert_w2, expert_b2):
    mod = (c @ w_ada + b_ada)[:, None, :]
    shift1, scale1, gate1, shift2, scale2, gate2 = jnp.split(mod, N_MOD, axis=-1)
    h = rms_norm(x, norm1_g) * (1.0 + scale1) + shift1
    x = x + gate1 * hybrid_mixer(h, w_in, conv_a_w, sgu_w, sgu_b, sgu_ln_g, sgu_ln_b, conv_c_w,
                                 conv_c_b, rglru_gate_w, rglru_gate_b, rglru_lambda, mix_norm_g, w_out)
    h = rms_norm(x, norm2_g) * (1.0 + scale2) + shift2
    x = x + gate2 * moe_ffn(h, router_w, router_b, expert_w1, expert_b1, expert_w2, expert_b2)
    return x


def setup_inputs(seed: int = 0) -> dict:
    key = jax.random.key(seed)
    ks = jax.random.split(key, 32)

    def nrm(k, shape, scale):
        return scale * jax.random.normal(k, shape, jnp.float32)

    u = jax.random.uniform(ks[16], (DEPTH, W_LRU), jnp.float32, minval=0.9, maxval=0.999)
    a0 = u ** (1.0 / RGLRU_C)
    rglru_lambda = jnp.log(a0) - jnp.log1p(-a0)
    return {
        'x': nrm(ks[0], (BATCH, SEQ, D_MODEL), 1.0),
        'c': nrm(ks[1], (BATCH, D_MODEL), 1.0),
        'norm1_g': 1.0 + nrm(ks[2], (DEPTH, D_MODEL), 0.02),
        'norm2_g': 1.0 + nrm(ks[3], (DEPTH, D_MODEL), 0.02),
        'w_ada': nrm(ks[4], (DEPTH, D_MODEL, N_MOD * D_MODEL), 0.2 * D_MODEL ** -0.5),
        'b_ada': nrm(ks[5], (DEPTH, N_MOD * D_MODEL), 0.02),
        'w_in': nrm(ks[6], (DEPTH, D_MODEL, D_IN), D_MODEL ** -0.5),
        'conv_a_w': nrm(ks[7], (DEPTH, CONV_A_WIDTH, W_CONV), CONV_A_WIDTH ** -0.5),
        'sgu_w': nrm(ks[8], (DEPTH, H_SGU, CHUNK, CHUNK), CHUNK ** -0.5),
        'sgu_b': 1.0 + nrm(ks[9], (DEPTH, H_SGU, CHUNK), 0.1),
        'sgu_ln_g': 1.0 + nrm(ks[10], (DEPTH, W_SGU), 0.02),
        'sgu_ln_b': nrm(ks[11], (DEPTH, W_SGU), 0.02),
        'conv_c_w': nrm(ks[12], (DEPTH, CONV_C_WIDTH, W_LRU), CONV_C_WIDTH ** -0.5),
        'conv_c_b': nrm(ks[13], (DEPTH, W_LRU), 0.02),
        'rglru_gate_w': nrm(ks[14], (DEPTH, 2, H_LRU, HEAD_DIM, HEAD_DIM), HEAD_DIM ** -0.5),
        'rglru_gate_b': nrm(ks[15], (DEPTH, 2, H_LRU, HEAD_DIM), 0.02),
        'rglru_lambda': rglru_lambda,
        'mix_norm_g': 1.0 + nrm(ks[17], (DEPTH, D_MIX), 0.02),
        'w_out': nrm(ks[18], (DEPTH, D_MIX, D_MODEL), D_MIX ** -0.5),
        'router_w': nrm(ks[19], (DEPTH, D_MODEL, N_EXPERTS), D_MODEL ** -0.5),
        'router_b': nrm(ks[20], (DEPTH, N_EXPERTS), 0.01),
        'expert_w1': nrm(ks[21], (DEPTH, N_EXPERTS, D_MODEL, 2 * D_FF_EXPERT), D_MODEL ** -0.5),
        'expert_b1': nrm(ks[22], (DEPTH, N_EXPERTS, 2 * D_FF_EXPERT), 0.01),
        'expert_w2': nrm(ks[23], (DEPTH, N_EXPERTS, D_FF_EXPERT, D_MODEL), D_FF_EXPERT ** -0.5),
        'expert_b2': nrm(ks[24], (DEPTH, N_EXPERTS, D_MODEL), 0.01),
        'final_norm_g': 1.0 + nrm(ks[25], (D_MODEL,), 0.02),
    }


def reference(x, c, norm1_g, norm2_g, w_ada, b_ada, w_in, conv_a_w, sgu_w, sgu_b, sgu_ln_g,
              sgu_ln_b, conv_c_w, conv_c_b, rglru_gate_w, rglru_gate_b, rglru_lambda, mix_norm_g,
              w_out, router_w, router_b, expert_w1, expert_b1, expert_w2, expert_b2, final_norm_g):
    for l in range(DEPTH):
        x = decoder_layer(x, c, norm1_g[l], norm2_g[l], w_ada[l], b_ada[l], w_in[l], conv_a_w[l],
                          sgu_w[l], sgu_b[l], sgu_ln_g[l], sgu_ln_b[l], conv_c_w[l], conv_c_b[l],
                          rglru_gate_w[l], rglru_gate_b[l], rglru_lambda[l], mix_norm_g[l], w_out[l],
                          router_w[l], router_b[l], expert_w1[l], expert_b1[l], expert_w2[l],
                          expert_b2[l])
    return rms_norm(x, final_norm_g)
```

```cpp
#include <hip/hip_runtime.h>
#include <cstdio>
#include <cstdint>

#ifndef RUN_MASK
#define RUN_MASK 15
#endif
#ifndef PH_ENABLE
#define PH_ENABLE 0x7ff
#endif
#define PH(k) ((PH_ENABLE >> (k)) & 1)
#ifndef MIX_MASK
#define MIX_MASK 7
#endif

namespace pg8 {
#define PG8_LAS __attribute__((address_space(3)))
typedef unsigned short bf16_t;
typedef short bf16x8 __attribute__((ext_vector_type(8)));
typedef float f32x4 __attribute__((ext_vector_type(4)));
typedef unsigned u32x4 __attribute__((ext_vector_type(4)));
constexpr int BM = 256, BK = 64, HALF = 128, HTB = HALF * BK * 2, STAGE_BYTES = 8 * HTB, NXCD = 8, WGM = 8;

__host__ __device__ __forceinline__ int lds_byte(int r, int c) { const int st = (r >> 4) * 2 + (c >> 5), rr = r & 15, cc = c & 31, ob = rr * 64 + cc * 2; return st * 1024 + (ob ^ (((ob >> 9) & 1) << 5)); }
__host__ __device__ __forceinline__ void stage_rc(int b, int& R, int& C) { const int st = b / 1024, sb = b % 1024, swz = sb ^ (((sb >> 9) & 1) << 5); R = (st >> 1) * 16 + swz / 64; C = (st & 1) * 32 + (swz % 64) / 2; }
__host__ __device__ __forceinline__ int perm32(int rho) { const int n = rho >> 4, i = rho & 15; return 8 * (i >> 2) + 4 * n + (i & 3); }

struct Unit { int pm, pn, pb, e; };
struct Gemm { const bf16_t* A; const bf16_t* Bt; int K; };

struct StaticOrder {
    int nM, nN, nwg, G, c;
    __device__ void init(int nM_, int nN_, int G_, int c_) { nM = nM_; nN = nN_; nwg = nM * nN; G = G_; c = c_; }
    __device__ __forceinline__ bool map(int i, Unit& u) const {
        const long L = (long)i * G + c; if (L >= nwg) return false;
        int wgid = (int)L; { const int q = nwg / NXCD, r = nwg % NXCD, xcd = wgid % NXCD, off = wgid / NXCD; wgid = (xcd < r ? xcd * (q + 1) : r * (q + 1) + (xcd - r) * q) + off; }
        const int nig = WGM * nN, gid = wgid / nig, fm = gid * WGM, gsz = (nM - fm) < WGM ? (nM - fm) : WGM;
        u.pm = fm + ((wgid % nig) % gsz); u.pn = (wgid % nig) / gsz; return true;
    }
    __device__ __forceinline__ bool next(int i, Unit& u) const { if (!map(i, u)) return false; u.pb = u.pn; u.e = 0; return true; }
};
struct MoeOrder : StaticOrder {
    const PG8_LAS int* tile_e;
    __device__ __forceinline__ bool next(int i, Unit& u) const { if (!map(i, u)) return false; u.e = tile_e[u.pm]; u.pb = u.e * nN + u.pn; return true; }
};

__device__ __forceinline__ unsigned cvt_pk_bf16(float lo, float hi) { unsigned r; asm volatile("v_cvt_pk_bf16_f32 %0, %1, %2" : "=v"(r) : "v"(lo), "v"(hi)); return r; }

struct EpiBf16 {
    static constexpr bool PERM = true;
    bf16_t* O; int ldc; const float* bias; int bstride;
    __device__ __forceinline__ void operator()(const f32x4 (&acc)[2][2][4][2], const Unit& u, int wr, int wc, int fr, int fq) const {
        const int row0 = u.pm * BM + wr * 64 + fr; const int col0 = u.pn * BM + wc * 32 + 8 * fq;
        f32x4 bv[2][2];
#pragma unroll
        for (int bj = 0; bj < 2; ++bj)
#pragma unroll
            for (int n = 0; n < 2; ++n) bv[bj][n] = bias ? *(const f32x4*)(bias + (size_t)u.e * bstride + col0 + bj * HALF + 4 * n) : (f32x4){0.f, 0.f, 0.f, 0.f};
#pragma unroll
        for (int ai = 0; ai < 2; ++ai)
#pragma unroll
            for (int m = 0; m < 4; ++m) { bf16_t* rowp = O + (size_t)(row0 + ai * HALF + m * 16) * ldc + col0;
#pragma unroll
                for (int bj = 0; bj < 2; ++bj) { const f32x4 v0 = acc[ai][bj][m][0] + bv[bj][0], v1 = acc[ai][bj][m][1] + bv[bj][1];
                    u32x4 w; w.x = cvt_pk_bf16(v0[0], v0[1]); w.y = cvt_pk_bf16(v0[2], v0[3]); w.z = cvt_pk_bf16(v1[0], v1[1]); w.w = cvt_pk_bf16(v1[2], v1[3]);
                    *(u32x4*)(rowp + bj * HALF) = w; } }
    }
};
struct EpiSwiglu {
    static constexpr bool PERM = true;
    bf16_t* O; const float* b1;
    __device__ __forceinline__ void operator()(const f32x4 (&acc)[2][2][4][2], const Unit& u, int wr, int wc, int fr, int fq) const {
        const int row0 = u.pm * BM + wr * 64 + fr; const int cg = u.pn * HALF + wc * 32 + 8 * fq;
        const float* bg = b1 + (size_t)u.e * 2048 + cg;
        const f32x4 bg0 = *(const f32x4*)(bg), bg1 = *(const f32x4*)(bg + 4), bu0 = *(const f32x4*)(bg + 1024), bu1 = *(const f32x4*)(bg + 1028);
#pragma unroll
        for (int ai = 0; ai < 2; ++ai)
#pragma unroll
            for (int m = 0; m < 4; ++m) {
                const f32x4 g0 = acc[ai][0][m][0] + bg0, g1 = acc[ai][0][m][1] + bg1, u0 = acc[ai][1][m][0] + bu0, u1 = acc[ai][1][m][1] + bu1;
                float o[8];
#pragma unroll
                for (int j = 0; j < 8; ++j) { float g = j < 4 ? g0[j & 3] : g1[j & 3], uu = j < 4 ? u0[j & 3] : u1[j & 3];
                    g = fminf(g, 7.0f); uu = fminf(fmaxf(uu, -7.0f), 7.0f);
                    const float sg = __builtin_amdgcn_rcpf(1.0f + __builtin_amdgcn_exp2f(g * (-1.702f * 1.4426950408889634f)));
                    o[j] = (uu + 1.0f) * (g * sg); }
                u32x4 w; w.x = cvt_pk_bf16(o[0], o[1]); w.y = cvt_pk_bf16(o[2], o[3]); w.z = cvt_pk_bf16(o[4], o[5]); w.w = cvt_pk_bf16(o[6], o[7]);
                *(u32x4*)(O + (size_t)(row0 + ai * HALF + m * 16) * 1024 + cg) = w; }
    }
};
struct EpiResGate {
    static constexpr bool PERM = false;
    const float* X; float* O; const float* gate;
    __device__ __forceinline__ void operator()(const f32x4 (&acc)[2][2][4][2], const Unit& u, int wr, int wc, int fr, int fq) const {
        const int row0 = u.pm * BM + wr * 64 + fr, col0 = u.pn * BM + wc * 32 + 4 * fq; const int b = (u.pm * BM) >> 12;
        f32x4 gv[2][2];
#pragma unroll
        for (int bj = 0; bj < 2; ++bj)
#pragma unroll
            for (int n = 0; n < 2; ++n) gv[bj][n] = *(const f32x4*)(gate + b * 6144 + col0 + bj * HALF + n * 16);
#pragma unroll
        for (int ai = 0; ai < 2; ++ai)
#pragma unroll
            for (int m = 0; m < 4; ++m) { const size_t off = (size_t)(row0 + ai * HALF + m * 16) * 1024 + col0;
#pragma unroll
                for (int bj = 0; bj < 2; ++bj)
#pragma unroll
                    for (int n = 0; n < 2; ++n) { const f32x4 xv = *(const f32x4*)(X + off + bj * HALF + n * 16); *(f32x4*)(O + off + bj * HALF + n * 16) = xv + gv[bj][n] * acc[ai][bj][m][n]; }
                asm volatile("" ::: "memory"); }
    }
};

template <class Epi, class Sched>
__device__ __forceinline__ void gemm_phase(PG8_LAS unsigned char* lds, const Gemm g, const Sched& S, const Epi& E) {
    int tid_ = threadIdx.x; asm volatile("" : "+v"(tid_));
    const int tid = tid_, wid = __builtin_amdgcn_readfirstlane(tid >> 6), lane = tid & 63, wr = wid >> 2, wc = wid & 3, fr = lane & 15, fq = lane >> 4;
    const int K = g.K, nt = K / BK;
    unsigned voffA[2], voffB[2];
#pragma unroll
    for (int i = 0; i < 2; ++i) { int R, C; stage_rc(tid * 16 + i * 8192, R, C); const int Rb = Epi::PERM ? ((R & ~31) + perm32(R & 31)) : R;
        voffA[i] = (unsigned)(R * K + C) * 2u; voffB[i] = (unsigned)(Rb * K + C) * 2u; }
    const size_t kstep = (size_t)(BK * 2);
    const size_t hstep = (size_t)HALF * K * 2;
    const size_t tstep = 2 * hstep;
    const unsigned ldsw = (unsigned)wid * 1024u;
    const int aoff = lds_byte(wr * 64 + fr, fq * 8), boff = lds_byte(wc * 32 + fr, fq * 8);
#define PG8_SA(b, h) (((b) * 2 + (h)) * HTB)
#define PG8_SB(b, h) ((4 + (b) * 2 + (h)) * HTB)
#define PG8_STAGE(bufoff, gbase, voff) do { _Pragma("unroll") for (int _i = 0; _i < 2; ++_i) \
        __builtin_amdgcn_global_load_lds((const unsigned*)((const char*)(gbase) + (voff)[_i]), (PG8_LAS unsigned*)(lds + (bufoff) + ldsw + _i * 8192), 16, 0, 0); } while (0)
#define PG8_LDA(dst, b, h) do { _Pragma("unroll") for (int m = 0; m < 4; ++m) _Pragma("unroll") for (int k = 0; k < 2; ++k) dst[m][k] = *(const PG8_LAS bf16x8*)(lds + PG8_SA(b, h) + aoff + m * 2048 + k * 1024); } while (0)
#define PG8_LDB(dst, b, h) do { _Pragma("unroll") for (int n = 0; n < 2; ++n) _Pragma("unroll") for (int k = 0; k < 2; ++k) dst[n][k] = *(const PG8_LAS bf16x8*)(lds + PG8_SB(b, h) + boff + n * 2048 + k * 1024); } while (0)
#define PG8_MMA(ai, bj, At, Bt) do { __builtin_amdgcn_s_setprio(1); _Pragma("unroll") for (int m = 0; m < 4; ++m) _Pragma("unroll") for (int n = 0; n < 2; ++n) _Pragma("unroll") for (int k = 0; k < 2; ++k) \
        acc[ai][bj][m][n] = __builtin_amdgcn_mfma_f32_16x16x32_bf16(Bt[n][k], At[m][k], acc[ai][bj][m][n], 0, 0, 0); __builtin_amdgcn_s_setprio(0); } while (0)
#define PG8_WAIT_V(n) asm volatile("s_waitcnt vmcnt(" #n ")" ::: "memory")
#define PG8_WAIT_L(n) asm volatile("s_waitcnt lgkmcnt(" #n ")" ::: "memory")
#define PG8_BAR __builtin_amdgcn_s_barrier()
#define PG8_SCHED __builtin_amdgcn_sched_barrier(0)
    Unit cur, nxt; int ui = 0;
    if (!S.next(0, cur)) return;
    f32x4 acc[2][2][4][2];
#pragma unroll
    for (int a = 0; a < 2; ++a)
#pragma unroll
        for (int b = 0; b < 2; ++b)
#pragma unroll
            for (int m = 0; m < 4; ++m)
#pragma unroll
                for (int n = 0; n < 2; ++n) acc[a][b][m][n] = (f32x4){0.f, 0.f, 0.f, 0.f};
    bf16x8 At[4][2], B0[2][2], B1[2][2];
    const char* cA = (const char*)g.A + (size_t)cur.pm * tstep; const char* cB = (const char*)g.Bt + (size_t)cur.pb * tstep;
    PG8_STAGE(PG8_SB(0, 0), cB, voffB); PG8_STAGE(PG8_SB(0, 1), cB + hstep, voffB); PG8_STAGE(PG8_SA(0, 0), cA, voffA); PG8_STAGE(PG8_SA(0, 1), cA + hstep, voffA);
    if (wr == 1) PG8_BAR;
    PG8_WAIT_V(2); PG8_BAR;
    PG8_STAGE(PG8_SB(1, 0), cB + kstep, voffB); PG8_STAGE(PG8_SA(1, 0), cA + kstep, voffA); PG8_STAGE(PG8_SB(1, 1), cB + hstep + kstep, voffB);
    PG8_WAIT_V(6); PG8_BAR;
    for (;;) {
        const bool has_next = S.next(ui + 1, nxt);
        const char* nA = has_next ? (const char*)g.A + (size_t)nxt.pm * tstep : cA; const char* nB = has_next ? (const char*)g.Bt + (size_t)nxt.pb * tstep : cB;
        for (int t = 0; t < nt; t += 2) {
            const bool last = (t == nt - 2);
            const char* a1 = cA + (size_t)(t + 1) * kstep;
            const char* a2 = last ? nA : cA + (size_t)(t + 2) * kstep; const char* b2 = last ? nB : cB + (size_t)(t + 2) * kstep;
            const char* a3 = a2 + kstep; const char* b3 = b2 + kstep;
            PG8_LDB(B0, 0, 0); PG8_LDB(B1, 0, 1); PG8_SCHED; PG8_LDA(At, 0, 0); PG8_STAGE(PG8_SA(1, 1), a1 + hstep, voffA);
            PG8_WAIT_V(8); PG8_WAIT_L(0); PG8_BAR; PG8_MMA(0, 0, At, B0); PG8_MMA(0, 1, At, B1); PG8_BAR; PG8_SCHED;
            PG8_LDA(At, 0, 1); PG8_STAGE(PG8_SB(0, 0), b2, voffB); PG8_STAGE(PG8_SB(0, 1), b2 + hstep, voffB); PG8_STAGE(PG8_SA(0, 0), a2, voffA);
            PG8_WAIT_V(8); PG8_WAIT_L(0); PG8_BAR; PG8_MMA(1, 0, At, B0); PG8_MMA(1, 1, At, B1); PG8_BAR; PG8_SCHED;
            PG8_LDB(B0, 1, 0); PG8_LDB(B1, 1, 1); PG8_SCHED; PG8_LDA(At, 1, 0); PG8_STAGE(PG8_SA(0, 1), a2 + hstep, voffA);
            PG8_WAIT_V(8); PG8_WAIT_L(0); PG8_BAR; PG8_MMA(0, 0, At, B0); PG8_MMA(0, 1, At, B1); PG8_BAR; PG8_SCHED;
            PG8_LDA(At, 1, 1); PG8_STAGE(PG8_SB(1, 0), b3, voffB); PG8_STAGE(PG8_SB(1, 1), b3 + hstep, voffB); PG8_STAGE(PG8_SA(1, 0), a3, voffA);
            PG8_WAIT_V(8); PG8_WAIT_L(0); PG8_BAR; PG8_MMA(1, 0, At, B0); PG8_MMA(1, 1, At, B1); PG8_BAR; PG8_SCHED;
        }
        if (wr == 0) PG8_BAR;
        E(acc, cur, wr, wc, fr, fq);
        if (!has_next) break;
#pragma unroll
        for (int a = 0; a < 2; ++a)
#pragma unroll
            for (int b = 0; b < 2; ++b)
#pragma unroll
                for (int m = 0; m < 4; ++m)
#pragma unroll
                    for (int n = 0; n < 2; ++n) acc[a][b][m][n] = (f32x4){0.f, 0.f, 0.f, 0.f};
        cur = nxt; cA = nA; cB = nB; ++ui;
        if (wr == 1) PG8_BAR;
    }
    PG8_WAIT_V(0);
    PG8_BAR;
#undef PG8_SA
#undef PG8_SB
#undef PG8_STAGE
#undef PG8_LDA
#undef PG8_LDB
#undef PG8_MMA
#undef PG8_WAIT_V
#undef PG8_WAIT_L
#undef PG8_BAR
#undef PG8_SCHED
}
}

constexpr int NWAVES = 8, NTHR = 512;
constexpr int NB = 4, SEQ = 4096, D = 1024, T = NB * SEQ, DIN = 2304, NE = 32, TOPK = 4, DEPTH = 2, FF = 1024;
constexpr int OFF_ZB = 0, OFF_ZC = 256, OFF_ZV = 512, OFF_ZU = 768, OFF_ZSV = 1024, OFF_ZG = 1280, OFF_ZX = 1792;
constexpr int NBLK = SEQ / 64;
constexpr int NRT = T / 64;
constexpr int MAXTILES = T * TOPK / 256 + NE;
constexpr int MAXSLOTS = MAXTILES * 256;
constexpr float EPS = 1e-6f;

constexpr size_t al(size_t x) { return (x + 4095) & ~(size_t)4095; }
constexpr size_t WS_CTL = 0, CTL_ZERO_BYTES = 65536;
constexpr size_t WS_MOD = 65536;
constexpr size_t WS_GWT = al(WS_MOD + (size_t)DEPTH * NB * 6144 * 4);
constexpr size_t WS_SGW = al(WS_GWT + (size_t)DEPTH * 2 * 8 * 4096 * 2);
constexpr size_t WS_RWH = al(WS_SGW + (size_t)DEPTH * 4 * 16384 * 2);
constexpr size_t WS_RWL = al(WS_RWH + (size_t)DEPTH * NE * D * 2);
constexpr size_t WS_WIN = al(WS_RWL + (size_t)DEPTH * NE * D * 2);
constexpr size_t WS_WOUT = al(WS_WIN + (size_t)DEPTH * DIN * D * 2);
constexpr size_t WS_W1 = al(WS_WOUT + (size_t)DEPTH * D * D * 2);
constexpr size_t WS_W2 = al(WS_W1 + (size_t)DEPTH * NE * 2048 * D * 2);
constexpr size_t WS_H = al(WS_W2 + (size_t)DEPTH * NE * D * FF * 2);
constexpr size_t WS_Z = al(WS_H + (size_t)T * D * 2);
constexpr size_t WS_Y = al(WS_Z + (size_t)T * DIN * 2);
constexpr size_t WS_XA = al(WS_Y + (size_t)T * D * 2);
constexpr size_t WS_XB = al(WS_XA + (size_t)T * D * 4);
constexpr size_t WS_AGA = al(WS_XB + (size_t)T * D * 4);
constexpr size_t WS_AGH = al(WS_AGA + (size_t)NB * NBLK * 512 * 4);
constexpr size_t WS_TOPE = al(WS_AGH + (size_t)NB * NBLK * 512 * 4);
constexpr size_t WS_TOPW = al(WS_TOPE + (size_t)T * 4 * 4);
constexpr size_t WS_RANK = al(WS_TOPW + (size_t)T * 4 * 4);
constexpr size_t WS_SLOT = al(WS_RANK + (size_t)T * 4 * 4);
constexpr size_t WS_CNT = al(WS_SLOT + (size_t)T * 4 * 4);
constexpr size_t WS_XG = al(WS_CNT + (size_t)NRT * NE * 4);
constexpr size_t WS_ACT = al(WS_XG + (size_t)MAXSLOTS * D * 2);
constexpr size_t WS_END = al(WS_ACT + (size_t)MAXSLOTS * D * 2);
constexpr int CW_BAR = 1024;

constexpr int RING_BYTES = 131072;
constexpr int SCR_BYTES = 147456;
constexpr int LDSCTL_OFF = SCR_BYTES;
constexpr int L_MISC = LDSCTL_OFF;
constexpr int L_TILEE = LDSCTL_OFF + 256;
constexpr int L_NM = L_TILEE + MAXTILES * 4;
constexpr int LDS_BYTES = LDSCTL_OFF + 2048;
static_assert(L_NM + 4 <= LDS_BYTES, "LDS map");

#define GAS __attribute__((address_space(1)))
#define LAS __attribute__((address_space(3)))
typedef unsigned short bf16;
typedef unsigned v4u __attribute__((ext_vector_type(4)));
typedef unsigned v2u __attribute__((ext_vector_type(2)));
typedef float f32x4 __attribute__((ext_vector_type(4)));
typedef short bf16x8 __attribute__((ext_vector_type(8)));
#define LDS_WAIT() asm volatile("s_waitcnt lgkmcnt(0)" ::: "memory")
#define FRESH_TID() int tid_ = threadIdx.x; asm volatile("" : "+v"(tid_)); const int tid = tid_, lane = tid & 63, wave = __builtin_amdgcn_readfirstlane(tid >> 6); (void)tid; (void)lane; (void)wave
__device__ __forceinline__ unsigned f2bf(float f) { unsigned u = __builtin_bit_cast(unsigned, f); return (u + 0x7fffu + ((u >> 16) & 1u)) >> 16; }
__device__ __forceinline__ unsigned pk2(float lo, float hi) { return pg8::cvt_pk_bf16(lo, hi); }
__device__ __forceinline__ float bflo(unsigned w) { return __builtin_bit_cast(float, w << 16); }
__device__ __forceinline__ float bfhi(unsigned w) { return __builtin_bit_cast(float, w & 0xffff0000u); }
__device__ __forceinline__ float sigmoidf_(float x) { return __builtin_amdgcn_rcpf(1.0f + __builtin_amdgcn_exp2f(-1.4426950408889634f * x)); }
__device__ __forceinline__ float gelu_tanh(float x) { const float u2 = 1.5957691216057308f * (x + 0.044715f * x * x * x); return x * __builtin_amdgcn_rcpf(1.0f + __builtin_amdgcn_exp2f(-1.4426950408889634f * u2)); }
__device__ __forceinline__ float wave_sum(float v) {
#pragma unroll
    for (int o = 1; o < 64; o <<= 1) v += __shfl_xor(v, o);
    return v;
}
template <int CTRL> __device__ __forceinline__ float dpp_f(float old, float src) { return __builtin_bit_cast(float, __builtin_amdgcn_update_dpp(__builtin_bit_cast(int, old), __builtin_bit_cast(int, src), CTRL, 0xF, 0xF, false)); }
__device__ __forceinline__ float bcast15(float v, int lane) { return __builtin_bit_cast(float, __builtin_amdgcn_ds_bpermute((lane | 15) << 2, __builtin_bit_cast(int, v))); }

#define XB_TMO      128
#define XB_XCNT(j)  (256  + 64 * (j))
#define XB_XSUB(j)  (1280 + 64 * (j))
#define XB_XGEN(j)  (2304 + 64 * (j))
#define XB_TOP      3328
#define XB_TOPGEN   3392
#define XCD_BAR_WORDS 3456
#define XB_SPIN_CAP (1u << 18)
__device__ __forceinline__ unsigned xb_ld(unsigned* p)              { return __hip_atomic_load(p, __ATOMIC_RELAXED, __HIP_MEMORY_SCOPE_AGENT); }
__device__ __forceinline__ unsigned xb_add(unsigned* p, unsigned v) { return __hip_atomic_fetch_add(p, v, __ATOMIC_RELAXED, __HIP_MEMORY_SCOPE_AGENT); }
__device__ __forceinline__ unsigned xb_xcc_id() { return (unsigned)__builtin_amdgcn_s_getreg((3 << 11) | 20) & 0xFu; }
#define XB_SPIN(cond, bar) do { unsigned _sp = 0; while (cond) { __builtin_amdgcn_s_sleep(1); \
    if ((++_sp & 255u) == 0u) { if (xb_ld(&(bar)[XB_TMO])) break; if (_sp > XB_SPIN_CAP) { atomicAdd(&(bar)[XB_TMO], 1u); break; } } } } while (0)
struct XcdBarrier { unsigned* bar; unsigned x; volatile LAS unsigned* st; };
__device__ __forceinline__ XcdBarrier xcd_barrier_post(unsigned* bar, volatile LAS unsigned* st) {
    XcdBarrier b; b.bar = bar; b.x = xb_xcc_id(); b.st = st;
    if (threadIdx.x == 0) (void)xb_add(&bar[XB_XCNT(b.x)], 1u);
    return b;
}
__device__ __forceinline__ void xcd_barrier_complete(unsigned* bar, unsigned x, unsigned& nloc, unsigned& nx) {
    const unsigned G = gridDim.x * gridDim.y * gridDim.z;
    unsigned sum, cnt, mine, sp = 0u;
    for (;;) {
        sum = 0u; cnt = 0u; mine = 0u;
#pragma unroll
        for (unsigned j = 0; j < 16; ++j) { const unsigned c = xb_ld(&bar[XB_XCNT(j)]); sum += c; cnt += (c > 0u) ? 1u : 0u; mine = (j == x) ? c : mine; }
        if (sum == G) break;
        __builtin_amdgcn_s_sleep(1);
        if ((++sp & 255u) == 0u) { if (xb_ld(&bar[XB_TMO])) break; if (sp > XB_SPIN_CAP) { atomicAdd(&bar[XB_TMO], 1u); break; } }
    }
    nloc = mine > 0u ? mine : 1u; nx = cnt > 0u ? cnt : 1u;
}
__device__ __forceinline__ void xcd_barrier(const XcdBarrier& b) {
    asm volatile("s_waitcnt vmcnt(0)" ::: "memory");
    __syncthreads();
    if (threadIdx.x == 0) {
        unsigned* bar = b.bar;
        __builtin_amdgcn_s_waitcnt(0);
        unsigned nloc = b.st[0], nx = b.st[1];
        if (nloc == 0u) { xcd_barrier_complete(bar, b.x, nloc, nx); b.st[0] = nloc; b.st[1] = nx; }
        const unsigned old = xb_add(&bar[XB_XSUB(b.x)], 1u);
        const unsigned gen = old / nloc;
        if (old + 1u == (gen + 1u) * nloc) {
            __builtin_amdgcn_fence(__ATOMIC_RELEASE, "agent");
            asm volatile("s_waitcnt vmcnt(0)" ::: "memory");
            const unsigned og = xb_add(&bar[XB_TOP], 1u);
            const unsigned tg = og / nx;
            if (og + 1u == (tg + 1u) * nx) xb_add(&bar[XB_TOPGEN], 1u);
            else XB_SPIN(xb_ld(&bar[XB_TOPGEN]) == tg, bar);
            __builtin_amdgcn_fence(__ATOMIC_ACQUIRE, "agent");
            xb_add(&bar[XB_XGEN(b.x)], 1u);
            asm volatile("s_waitcnt vmcnt(0)" ::: "memory");
        } else {
            XB_SPIN(xb_ld(&bar[XB_XGEN(b.x)]) == gen, bar);
            __builtin_amdgcn_fence(__ATOMIC_ACQUIRE, "agent");
            asm volatile("s_waitcnt vmcnt(0)" ::: "memory");
        }
    }
    __syncthreads();
}

__device__ __forceinline__ void transpose_item(const float* W, int K, int N, bf16* WT, int k0, int n0, int rowbase, LAS float* scr, int lane) {
    f32x4 v[16];
#pragma unroll
    for (int i = 0; i < 16; ++i) v[i] = *(const f32x4*)(W + (size_t)(k0 + 4 * i + (lane >> 4)) * N + n0 + 4 * (lane & 15));
#pragma unroll
    for (int i = 0; i < 16; ++i) { LAS float* s = scr + (4 * i + (lane >> 4)) * 65 + 4 * (lane & 15); s[0] = v[i][0]; s[1] = v[i][1]; s[2] = v[i][2]; s[3] = v[i][3]; }
    LDS_WAIT(); asm volatile("" ::: "memory");
    const int c = lane & 7;
#pragma unroll
    for (int j = 0; j < 8; ++j) { const int n = (lane >> 3) + 8 * j; const LAS float* s = scr + (8 * c) * 65 + n;
        v4u o; o.x = pk2(s[0 * 65], s[1 * 65]); o.y = pk2(s[2 * 65], s[3 * 65]); o.z = pk2(s[4 * 65], s[5 * 65]); o.w = pk2(s[6 * 65], s[7 * 65]);
        *(v4u*)(WT + (size_t)(rowbase + n) * K + k0 + 8 * c) = o; }
    LDS_WAIT(); asm volatile("" ::: "memory");
}

struct Args { const float* in[26]; float* out; unsigned char* ws; int ph_lo, ph_hi; };

__device__ __forceinline__ void pro_phase(const Args& args, LAS unsigned char* lds, int vcu, int G) {
    FRESH_TID();
    unsigned char* ws = args.ws;
    for (int u = vcu; u < DEPTH * 96; u += G) {
        const int l = u / 96, cbk = u % 96, col = cbk * 64 + lane;
        const float* wa = args.in[4] + (size_t)l * D * 6144; const float* cc = args.in[1];
        float a0 = 0.f, a1 = 0.f, a2 = 0.f, a3 = 0.f;
#pragma unroll 8
        for (int k = wave * 128; k < wave * 128 + 128; ++k) { const float w = wa[(size_t)k * 6144 + col]; a0 += cc[k] * w; a1 += cc[D + k] * w; a2 += cc[2 * D + k] * w; a3 += cc[3 * D + k] * w; }
        LAS float* red = (LAS float*)lds;
        red[(wave * 4 + 0) * 64 + lane] = a0; red[(wave * 4 + 1) * 64 + lane] = a1; red[(wave * 4 + 2) * 64 + lane] = a2; red[(wave * 4 + 3) * 64 + lane] = a3;
        __syncthreads();
        if (tid < 256) { const int b = tid >> 6, cl = tid & 63; float s = args.in[5][(size_t)l * 6144 + cbk * 64 + cl];
#pragma unroll
            for (int w = 0; w < 8; ++w) s += red[(w * 4 + b) * 64 + cl];
            ((float*)(ws + WS_MOD))[(size_t)(l * NB + b) * 6144 + cbk * 64 + cl] = s; }
        __syncthreads();
    }
    const int gt = vcu * NTHR + tid, NGT = G * NTHR;
    for (int i = gt; i < DEPTH * 2 * 8 * 4096; i += NGT) {
        const int ii = i & 63, j = (i >> 6) & 63, lgh = i >> 12;
        ((bf16*)(ws + WS_GWT))[i] = (bf16)f2bf(args.in[14][(size_t)lgh * 4096 + ii * 64 + j]); }
    for (int i = gt; i < DEPTH * 4 * 16384; i += NGT) {
        const int s = i & 127, t = (i >> 7) & 127;
        ((bf16*)(ws + WS_SGW))[i] = (bf16)(s <= t ? f2bf(args.in[8][i]) : 0u); }
    for (int i = gt; i < DEPTH * NE * D; i += NGT) {
        const int k = i & 1023, e = (i >> 10) & 31, l = i >> 15;
        const float w = args.in[19][((size_t)l * D + k) * NE + e]; const unsigned hi = f2bf(w); const float r = w - __builtin_bit_cast(float, hi << 16);
        ((bf16*)(ws + WS_RWH))[i] = (bf16)hi; ((bf16*)(ws + WS_RWL))[i] = (bf16)f2bf(r); }
    LAS float* scr = (LAS float*)(lds + wave * 16640);
    const int gw = vcu * NWAVES + wave, NGW = G * NWAVES;
    constexpr int I_IN = 16 * 36, I_OUT = 16 * 16, I_W1 = NE * 16 * 32, I_W2 = NE * 16 * 16, I_L = I_IN + I_OUT + I_W1 + I_W2;
    for (int it = gw; it < DEPTH * I_L; it += NGW) {
        const int l = it / I_L; int r = it % I_L;
        if (r < I_IN) { const int kb = r / 36, nb = r % 36; transpose_item(args.in[6] + (size_t)l * D * DIN, D, DIN, (bf16*)(ws + WS_WIN) + (size_t)l * DIN * D, kb * 64, nb * 64, nb * 64, scr, lane); continue; } r -= I_IN;
        if (r < I_OUT) { const int kb = r / 16, nb = r % 16; transpose_item(args.in[18] + (size_t)l * D * D, D, D, (bf16*)(ws + WS_WOUT) + (size_t)l * D * D, kb * 64, nb * 64, nb * 64, scr, lane); continue; } r -= I_OUT;
        if (r < I_W1) { const int e = r / 512, q = r % 512, kb = q / 32, nb = q % 32, n0 = nb * 64;
            const int rowbase = (n0 < 1024) ? (n0 >> 7) * 256 + (n0 & 127) : ((n0 - 1024) >> 7) * 256 + 128 + ((n0 - 1024) & 127);
            transpose_item(args.in[21] + ((size_t)l * NE + e) * D * 2048, D, 2048, (bf16*)(ws + WS_W1) + ((size_t)l * NE + e) * 2048 * D, kb * 64, n0, rowbase, scr, lane); continue; } r -= I_W1;
        { const int e = r / 256, q = r % 256, kb = q / 16, nb = q % 16;
            transpose_item(args.in[23] + ((size_t)l * NE + e) * FF * D, FF, D, (bf16*)(ws + WS_W2) + ((size_t)l * NE + e) * D * FF, kb * 64, nb * 64, nb * 64, scr, lane); }
    }
}

__device__ __forceinline__ void adaln_rows(const float* X, bf16* H, const float* g, const float* mod_shift, const float* mod_scale, int vcu, int G) {
    FRESH_TID(); const int gw = vcu * NWAVES + wave, NGW = G * NWAVES;
    for (int row = gw; row < T; row += NGW) {
        const int b = row >> 12; const float* xr = X + (size_t)row * D + 4 * lane;
        f32x4 v[4]; float s = 0.f;
#pragma unroll
        for (int j = 0; j < 4; ++j) { v[j] = *(const f32x4*)(xr + 256 * j); s += (v[j][0] * v[j][0] + v[j][1] * v[j][1]) + (v[j][2] * v[j][2] + v[j][3] * v[j][3]); }
        const float rstd = 1.0f / sqrtf(wave_sum(s) * (1.0f / D) + EPS);
#pragma unroll
        for (int j = 0; j < 4; ++j) { const int c = 4 * lane + 256 * j;
            const f32x4 gv = *(const f32x4*)(g + c), sc = *(const f32x4*)(mod_scale + b * 6144 + c), sh = *(const f32x4*)(mod_shift + b * 6144 + c);
            const f32x4 o = v[j] * rstd * gv * (sc + 1.0f) + sh;
            v2u w; w.x = pk2(o[0], o[1]); w.y = pk2(o[2], o[3]); *(v2u*)(H + (size_t)row * D + c) = w; }
    }
}

constexpr int L3_CARRY = 139264, L3_SS = 141312, L3_SS2 = 143360, L3_SPL = 144384;
template <bool FULL>
__device__ __forceinline__ void mixer_unit(const Args& args, int l, int b, int j, LAS unsigned char* lds) {
    FRESH_TID();
    unsigned char* ws = args.ws;
    const bf16* Z = (const bf16*)(ws + WS_Z); bf16* Y = (bf16*)(ws + WS_Y);
    float* aggA = (float*)(ws + WS_AGA); float* aggH = (float*)(ws + WS_AGH);
    const float* mixg = args.in[17] + (size_t)l * D;
    const int fr = lane & 15, fq = lane >> 4;
    const size_t rowb = (size_t)b * SEQ;
    const int t0 = 64 * j;
    LAS float* CARRY = (LAS float*)(lds + L3_CARRY); LAS float* SS = (LAS float*)(lds + L3_SS); LAS float* SS2 = (LAS float*)(lds + L3_SS2); LAS float* SPL = (LAS float*)(lds + L3_SPL);
    if ((MIX_MASK & 4) || !FULL) {
        {
            const float y = -args.in[16][(size_t)l * 512 + tid];
            SPL[tid] = fmaxf(y, 0.f) + log1pf(expf(-fabsf(y)));
            if (FULL) { float c = 0.f; const float* pa = aggA + (size_t)b * NBLK * 512 + tid; const float* ph = aggH + (size_t)b * NBLK * 512 + tid;
                for (int jj = 0; jj < j; ++jj) c = pa[(size_t)jj * 512] * c + ph[(size_t)jj * 512];
                CARRY[tid] = c; }
        }
        __syncthreads();
        const int hd = wave;
        LAS float* XR = (LAS float*)(lds + wave * 17408);
        const float* cw = args.in[12] + (size_t)l * 4 * 512; const float* cbp = args.in[13] + (size_t)l * 512;
        bf16x8 Xa[4][2];
#pragma unroll
        for (int ks = 0; ks < 2; ++ks) {
            const int c8 = 64 * hd + 32 * ks + 8 * fq;
            float wv[4][8], bv[8];
#pragma unroll
            for (int k = 0; k < 4; ++k) { const f32x4 w0 = *(const f32x4*)(cw + k * 512 + c8), w1 = *(const f32x4*)(cw + k * 512 + c8 + 4);
#pragma unroll
                for (int e = 0; e < 4; ++e) { wv[k][e] = w0[e]; wv[k][4 + e] = w1[e]; } }
            { const f32x4 b0 = *(const f32x4*)(cbp + c8), b1 = *(const f32x4*)(cbp + c8 + 4);
#pragma unroll
                for (int e = 0; e < 4; ++e) { bv[e] = b0[e]; bv[4 + e] = b1[e]; } }
#pragma unroll
            for (int m = 0; m < 4; ++m) {
                const int t = t0 + 16 * m + fr;
                float a8[8];
#pragma unroll
                for (int e = 0; e < 8; ++e) a8[e] = bv[e];
#pragma unroll
                for (int k = 0; k < 4; ++k) { const int tt = t - 3 + k; const int tc = tt < 0 ? 0 : tt;
                    const v4u z = *(const v4u*)(Z + (rowb + tc) * DIN + OFF_ZX + c8); const float msk = tt < 0 ? 0.f : 1.f;
                    const unsigned zw[4] = {z.x, z.y, z.z, z.w};
#pragma unroll
                    for (int q = 0; q < 4; ++q) { a8[2 * q] += wv[k][2 * q] * (msk * bflo(zw[q])); a8[2 * q + 1] += wv[k][2 * q + 1] * (msk * bfhi(zw[q])); } }
                v4u pk; pk.x = pk2(a8[0], a8[1]); pk.y = pk2(a8[2], a8[3]); pk.z = pk2(a8[4], a8[5]); pk.w = pk2(a8[6], a8[7]);
                Xa[m][ks] = __builtin_bit_cast(bf16x8, pk);
                LAS float* xp = XR + (16 * m + fr) * 68 + 32 * ks + 8 * fq;
                *(LAS f32x4*)(xp) = (f32x4){a8[0], a8[1], a8[2], a8[3]}; *(LAS f32x4*)(xp + 4) = (f32x4){a8[4], a8[5], a8[6], a8[7]};
            }
        }
        LDS_WAIT(); asm volatile("" ::: "memory");
        const bf16* GwT = (const bf16*)(ws + WS_GWT) + (size_t)l * 2 * 8 * 4096;
        const float* gbp = args.in[15] + (size_t)l * 2 * 512;
        float ss[4] = {0.f, 0.f, 0.f, 0.f};
#pragma unroll 1
        for (int n = 0; n < 4; ++n) {
            const int cc = 16 * n + 4 * fq, c = 64 * hd + cc;
            f32x4 acc[2][4];
#pragma unroll
            for (int g = 0; g < 2; ++g) {
                bf16x8 Wg[2];
#pragma unroll
                for (int ks = 0; ks < 2; ++ks) Wg[ks] = __builtin_bit_cast(bf16x8, *(const v4u*)(GwT + ((size_t)(g * 8 + hd) * 64 + 16 * n + fr) * 64 + 32 * ks + 8 * fq));
#pragma unroll
                for (int m = 0; m < 4; ++m) { acc[g][m] = (f32x4){0.f, 0.f, 0.f, 0.f};
#pragma unroll
                    for (int ks = 0; ks < 2; ++ks) acc[g][m] = __builtin_amdgcn_mfma_f32_16x16x32_bf16(Wg[ks], Xa[m][ks], acc[g][m], 0, 0, 0); }
            }
            const f32x4 gbr = *(const f32x4*)(gbp + hd * 64 + cc), gbi = *(const f32x4*)(gbp + 512 + hd * 64 + cc);
            const f32x4 sp = *(const LAS f32x4*)(SPL + c);
            float A[4][4], Bv[4][4];
#pragma unroll
            for (int m = 0; m < 4; ++m) { const f32x4 xr = *(const LAS f32x4*)(XR + (16 * m + fr) * 68 + cc);
#pragma unroll
                for (int e = 0; e < 4; ++e) { const float r = sigmoidf_(acc[0][m][e] + gbr[e]), ig = sigmoidf_(acc[1][m][e] + gbi[e]);
                    const float la = -8.0f * r * sp[e]; const float a = __builtin_amdgcn_exp2f(la * 1.4426950408889634f);
                    A[m][e] = a; Bv[m][e] = xr[e] * ig * sqrtf(fmaxf(fmaf(-a, a, 1.0f), 0.f)); } }
#pragma unroll
            for (int m = 0; m < 4; ++m)
#pragma unroll
                for (int e = 0; e < 4; ++e) { float a = A[m][e], bb = Bv[m][e];
                    { const float ap = dpp_f<0x111>(1.0f, a), bp = dpp_f<0x111>(0.0f, bb); bb = fmaf(a, bp, bb); a *= ap; }
                    { const float ap = dpp_f<0x112>(1.0f, a), bp = dpp_f<0x112>(0.0f, bb); bb = fmaf(a, bp, bb); a *= ap; }
                    { const float ap = dpp_f<0x114>(1.0f, a), bp = dpp_f<0x114>(0.0f, bb); bb = fmaf(a, bp, bb); a *= ap; }
                    { const float ap = dpp_f<0x118>(1.0f, a), bp = dpp_f<0x118>(0.0f, bb); bb = fmaf(a, bp, bb); a *= ap; }
                    A[m][e] = a; Bv[m][e] = bb; }
            float hc[4], ac[4];
            if (FULL) { const f32x4 cv = *(const LAS f32x4*)(CARRY + c); hc[0] = cv[0]; hc[1] = cv[1]; hc[2] = cv[2]; hc[3] = cv[3]; }
            else { hc[0] = hc[1] = hc[2] = hc[3] = 0.f; }
            ac[0] = ac[1] = ac[2] = ac[3] = 1.f;
#pragma unroll
            for (int m = 0; m < 4; ++m) {
                float hcur[4];
#pragma unroll
                for (int e = 0; e < 4; ++e) { hcur[e] = fmaf(A[m][e], hc[e], Bv[m][e]); hc[e] = bcast15(hcur[e], lane);
                    if (!FULL) ac[e] = bcast15(A[m][e] * ac[e], lane); }
                if (FULL) { const v2u zg = *(const v2u*)(Z + (rowb + t0 + 16 * m + fr) * DIN + OFF_ZG + c);
                    const float g4[4] = {bflo(zg.x), bfhi(zg.x), bflo(zg.y), bfhi(zg.y)};
                    f32x4 yq;
#pragma unroll
                    for (int e = 0; e < 4; ++e) { const float y = gelu_tanh(g4[e]) * hcur[e]; yq[e] = y; ss[m] = fmaf(y, y, ss[m]); }
                    *(LAS f32x4*)(XR + (16 * m + fr) * 68 + cc) = yq; }
            }
            if (!FULL && fr == 0) { const size_t o = ((size_t)b * NBLK + j) * 512 + c; *(f32x4*)(aggA + o) = (f32x4){ac[0], ac[1], ac[2], ac[3]}; *(f32x4*)(aggH + o) = (f32x4){hc[0], hc[1], hc[2], hc[3]}; }
        }
        if (FULL) {
#pragma unroll
            for (int m = 0; m < 4; ++m) { float s = ss[m]; s += __shfl_xor(s, 16); s += __shfl_xor(s, 32); if (fq == 0) SS[wave * 64 + 16 * m + fr] = s; }
            __syncthreads();
#pragma unroll
            for (int m = 0; m < 4; ++m) { float tot = 0.f;
#pragma unroll
                for (int w = 0; w < 8; ++w) tot += SS[w * 64 + 16 * m + fr];
                const float rstd = 1.0f / sqrtf(tot * (1.0f / 512.0f) + EPS);
#pragma unroll
                for (int n = 0; n < 4; ++n) { const int c = 512 + 64 * hd + 16 * n + 4 * fq; const f32x4 mg = *(const f32x4*)(mixg + c);
                    const f32x4 yq = *(const LAS f32x4*)(XR + (16 * m + fr) * 68 + 16 * n + 4 * fq);
                    v2u w; w.x = pk2(yq[0] * rstd * mg[0], yq[1] * rstd * mg[1]); w.y = pk2(yq[2] * rstd * mg[2], yq[3] * rstd * mg[3]);
                    *(v2u*)(Y + (rowb + t0 + 16 * m + fr) * D + c) = w; } }
        }
    } else if (FULL) {
        for (int i = tid; i < 64 * 64; i += NTHR) { const int r = i >> 6, c8 = (i & 63) * 8; *(v4u*)(Y + (rowb + t0 + r) * D + 512 + c8) = (v4u){0u, 0u, 0u, 0u}; }
    }
    if (!FULL) return;
    asm volatile("" ::: "memory");
    if (MIX_MASK & 1) {
        const int tg = tid >> 5, s8 = (tid & 31) * 8; const int tb = t0 + 4 * tg;
        const float* caw = args.in[7] + (size_t)l * 3 * 256;
        float w3[3][8];
#pragma unroll
        for (int k = 0; k < 3; ++k) { const f32x4 w0 = *(const f32x4*)(caw + k * 256 + s8), w1 = *(const f32x4*)(caw + k * 256 + s8 + 4);
#pragma unroll
            for (int e = 0; e < 4; ++e) { w3[k][e] = w0[e]; w3[k][4 + e] = w1[e]; } }
        float cv[6][8];
#pragma unroll
        for (int i = 0; i < 6; ++i) { const int tt = tb - 2 + i; const int tc = tt < 0 ? 0 : tt; const float msk = tt < 0 ? 0.f : 1.f;
            const v4u zc = *(const v4u*)(Z + (rowb + tc) * DIN + OFF_ZC + s8), zv = *(const v4u*)(Z + (rowb + tc) * DIN + OFF_ZV + s8);
            const unsigned a[4] = {zc.x, zc.y, zc.z, zc.w}, bq[4] = {zv.x, zv.y, zv.z, zv.w};
#pragma unroll
            for (int q = 0; q < 4; ++q) { cv[i][2 * q] = msk * bflo(a[q]) * bflo(bq[q]); cv[i][2 * q + 1] = msk * bfhi(a[q]) * bfhi(bq[q]); } }
        const f32x4 mg0 = *(const f32x4*)(mixg + s8), mg1 = *(const f32x4*)(mixg + s8 + 4);
#pragma unroll
        for (int i = 0; i < 4; ++i) {
            const v4u zb = *(const v4u*)(Z + (rowb + tb + i) * DIN + OFF_ZB + s8); const unsigned a[4] = {zb.x, zb.y, zb.z, zb.w};
            float y[8], s = 0.f;
#pragma unroll
            for (int e = 0; e < 8; ++e) { const float zbe = (e & 1) ? bfhi(a[e >> 1]) : bflo(a[e >> 1]);
                y[e] = zbe * (w3[0][e] * cv[i][e] + w3[1][e] * cv[i + 1][e] + w3[2][e] * cv[i + 2][e]); s = fmaf(y[e], y[e], s); }
#pragma unroll
            for (int o = 1; o < 32; o <<= 1) s += __shfl_xor(s, o);
            const float rstd = 1.0f / sqrtf(s * (1.0f / 256.0f) + EPS);
            v4u w; w.x = pk2(y[0] * rstd * mg0[0], y[1] * rstd * mg0[1]); w.y = pk2(y[2] * rstd * mg0[2], y[3] * rstd * mg0[3]);
            w.z = pk2(y[4] * rstd * mg1[0], y[5] * rstd * mg1[1]); w.w = pk2(y[6] * rstd * mg1[2], y[7] * rstd * mg1[3]);
            *(v4u*)(Y + (rowb + tb + i) * D + s8) = w; }
    } else {
        for (int i = tid; i < 64 * 32; i += NTHR) { const int r = i >> 5, c8 = (i & 31) * 8; *(v4u*)(Y + (rowb + t0 + r) * D + c8) = (v4u){0u, 0u, 0u, 0u}; }
    }
    asm volatile("" ::: "memory");
    if (MIX_MASK & 2) {
        __syncthreads();
        const int hf = j & 1, tcs = t0 - 64 * hf, slen = 64 * (hf + 1);
        LAS bf16* Vt = (LAS bf16*)lds;
        const float* lng = args.in[10] + (size_t)l * 256; const float* lnb = args.in[11] + (size_t)l * 256;
        { const f32x4 gq = *(const f32x4*)(lng + 4 * lane), bq = *(const f32x4*)(lnb + 4 * lane);
            for (int s = wave; s < slen; s += NWAVES) {
                const v2u zz = *(const v2u*)(Z + (rowb + tcs + s) * DIN + OFF_ZSV + 4 * lane);
                float v[4] = {gelu_tanh(bflo(zz.x)), gelu_tanh(bfhi(zz.x)), gelu_tanh(bflo(zz.y)), gelu_tanh(bfhi(zz.y))};
                const float mean = wave_sum((v[0] + v[1]) + (v[2] + v[3])) * (1.0f / 256.0f);
#pragma unroll
                for (int e = 0; e < 4; ++e) v[e] -= mean;
                const float var = wave_sum((v[0] * v[0] + v[1] * v[1]) + (v[2] * v[2] + v[3] * v[3])) * (1.0f / 256.0f);
                const float rstd = 1.0f / sqrtf(var + EPS);
#pragma unroll
                for (int e = 0; e < 4; ++e) Vt[(4 * lane + e) * 136 + s] = (bf16)f2bf(v[e] * rstd * gq[e] + bq[e]);
            } }
        __syncthreads();
        const int h = wave >> 1, th = wave & 1;
        const bf16* SGW = (const bf16*)(ws + WS_SGW) + ((size_t)l * 4 + h) * 16384;
        f32x4 acc[2][4];
#pragma unroll
        for (int m = 0; m < 2; ++m)
#pragma unroll
            for (int n = 0; n < 4; ++n) acc[m][n] = (f32x4){0.f, 0.f, 0.f, 0.f};
#pragma unroll
        for (int ks = 0; ks < 4; ++ks) {
            if (ks * 32 < slen) {
                bf16x8 Wq[2];
#pragma unroll
                for (int m = 0; m < 2; ++m) Wq[m] = __builtin_bit_cast(bf16x8, *(const v4u*)(SGW + (size_t)(64 * hf + 32 * th + 16 * m + fr) * 128 + 32 * ks + 8 * fq));
#pragma unroll
                for (int n = 0; n < 4; ++n) { const bf16x8 Vp = *(const LAS bf16x8*)(Vt + (64 * h + 16 * n + fr) * 136 + 32 * ks + 8 * fq);
#pragma unroll
                    for (int m = 0; m < 2; ++m) acc[m][n] = __builtin_amdgcn_mfma_f32_16x16x32_bf16(Vp, Wq[m], acc[m][n], 0, 0, 0); }
            }
        }
        const float* sgb = args.in[9] + ((size_t)l * 4 + h) * 128;
        float ys[2][4][4], s2[2];
#pragma unroll
        for (int m = 0; m < 2; ++m) { const int tl = 32 * th + 16 * m + fr; const float bias = sgb[64 * hf + tl]; float s = 0.f;
#pragma unroll
            for (int n = 0; n < 4; ++n) { const v2u zu = *(const v2u*)(Z + (rowb + t0 + tl) * DIN + OFF_ZU + 64 * h + 16 * n + 4 * fq);
                const float u4[4] = {bflo(zu.x), bfhi(zu.x), bflo(zu.y), bfhi(zu.y)};
#pragma unroll
                for (int e = 0; e < 4; ++e) { const float y = gelu_tanh(u4[e]) * (acc[m][n][e] + bias); ys[m][n][e] = y; s = fmaf(y, y, s); } }
            s += __shfl_xor(s, 16); s += __shfl_xor(s, 32); s2[m] = s; if (fq == 0) SS2[h * 64 + tl] = s; }
        __syncthreads();
#pragma unroll
        for (int m = 0; m < 2; ++m) { const int tl = 32 * th + 16 * m + fr; const float tot = (SS2[tl] + SS2[64 + tl]) + (SS2[128 + tl] + SS2[192 + tl]);
            const float rstd = 1.0f / sqrtf(tot * (1.0f / 256.0f) + EPS);
#pragma unroll
            for (int n = 0; n < 4; ++n) { const int c = 256 + 64 * h + 16 * n + 4 * fq; const f32x4 mg = *(const f32x4*)(mixg + c);
                v2u w; w.x = pk2(ys[m][n][0] * rstd * mg[0], ys[m][n][1] * rstd * mg[1]); w.y = pk2(ys[m][n][2] * rstd * mg[2], ys[m][n][3] * rstd * mg[3]);
                *(v2u*)(Y + (rowb + t0 + tl) * D + c) = w; } }
        (void)s2;
    } else {
        for (int i = tid; i < 64 * 32; i += NTHR) { const int r = i >> 5, c8 = (i & 31) * 8; *(v4u*)(Y + (rowb + t0 + r) * D + 256 + c8) = (v4u){0u, 0u, 0u, 0u}; }
    }
}

__device__ __forceinline__ void route_tile(const Args& args, int l, int tile, const float* X1, LAS unsigned char* lds) {
    FRESH_TID();
    unsigned char* ws = args.ws;
    LAS float* GS = (LAS float*)lds; LAS float* SH = (LAS float*)(lds + 4096); LAS float* SHW = (LAS float*)(lds + 8192); LAS float* RED = (LAS float*)(lds + 8448);
    LAS float* PL = (LAS float*)(lds + 16384); LAS float* PSS = (LAS float*)(lds + 32768); LAS float* RSTD = (LAS float*)(lds + 33280); LAS int* HIST = (LAS int*)(lds + 33792);
    const int row0 = tile * 64, b = row0 >> 12; const int fr = lane & 15, fq = lane >> 4;
    const float* mod = (const float*)(ws + WS_MOD) + (size_t)(l * NB + b) * 6144;
    const float* g2 = args.in[3] + (size_t)l * D;
    for (int k = tid; k < D; k += NTHR) { GS[k] = g2[k] * (1.0f + mod[4 * D + k]); SH[k] = mod[3 * D + k]; }
    if (tid < 32) HIST[tid] = 0;
    __syncthreads();
    { const int e = tid & 31, part = tid >> 5; const float* rw = args.in[19] + (size_t)l * D * NE; float s = 0.f;
        for (int k = part * 64; k < part * 64 + 64; ++k) s = fmaf(SH[k], rw[(size_t)k * NE + e], s);
        RED[part * 32 + e] = s; }
    __syncthreads();
    if (tid < 32) { float s = args.in[20][(size_t)l * NE + tid];
#pragma unroll
        for (int p = 0; p < 16; ++p) s += RED[p * 32 + tid];
        SHW[tid] = s; }
    const int st = wave >> 1, kh = wave & 1;
    const bf16* RWH = (const bf16*)(ws + WS_RWH) + (size_t)l * NE * D; const bf16* RWL = (const bf16*)(ws + WS_RWL) + (size_t)l * NE * D;
    f32x4 acc[2] = {(f32x4){0.f, 0.f, 0.f, 0.f}, (f32x4){0.f, 0.f, 0.f, 0.f}}; float ssq = 0.f;
    const float* xrow = X1 + (size_t)(row0 + 16 * st + fr) * D;
#pragma unroll 2
    for (int kb = 0; kb < 16; ++kb) {
        const int k = 512 * kh + 32 * kb + 8 * fq;
        const f32x4 x0 = *(const f32x4*)(xrow + k), x1 = *(const f32x4*)(xrow + k + 4);
        const f32x4 g0 = *(const LAS f32x4*)(GS + k), g1 = *(const LAS f32x4*)(GS + k + 4);
        float xs[8], hi[8], lo[8];
#pragma unroll
        for (int e = 0; e < 4; ++e) { xs[e] = x0[e] * g0[e]; xs[4 + e] = x1[e] * g1[e]; ssq = fmaf(x0[e], x0[e], ssq); ssq = fmaf(x1[e], x1[e], ssq); }
        v4u qh, ql; unsigned hh[8], ll[8];
#pragma unroll
        for (int e = 0; e < 8; ++e) { hh[e] = f2bf(xs[e]); hi[e] = __builtin_bit_cast(float, hh[e] << 16); lo[e] = xs[e] - hi[e]; ll[e] = f2bf(lo[e]); }
        qh.x = hh[0] | (hh[1] << 16); qh.y = hh[2] | (hh[3] << 16); qh.z = hh[4] | (hh[5] << 16); qh.w = hh[6] | (hh[7] << 16);
        ql.x = ll[0] | (ll[1] << 16); ql.y = ll[2] | (ll[3] << 16); ql.z = ll[4] | (ll[5] << 16); ql.w = ll[6] | (ll[7] << 16);
        const bf16x8 Qh = __builtin_bit_cast(bf16x8, qh), Ql = __builtin_bit_cast(bf16x8, ql);
#pragma unroll
        for (int n = 0; n < 2; ++n) { const bf16x8 Ph = __builtin_bit_cast(bf16x8, *(const v4u*)(RWH + (size_t)(16 * n + fr) * D + k)), Pl = __builtin_bit_cast(bf16x8, *(const v4u*)(RWL + (size_t)(16 * n + fr) * D + k));
            acc[n] = __builtin_amdgcn_mfma_f32_16x16x32_bf16(Ph, Qh, acc[n], 0, 0, 0);
            acc[n] = __builtin_amdgcn_mfma_f32_16x16x32_bf16(Ph, Ql, acc[n], 0, 0, 0);
            acc[n] = __builtin_amdgcn_mfma_f32_16x16x32_bf16(Pl, Qh, acc[n], 0, 0, 0); }
    }
    ssq += __shfl_xor(ssq, 16); ssq += __shfl_xor(ssq, 32);
#pragma unroll
    for (int n = 0; n < 2; ++n) *(LAS f32x4*)(PL + (wave * 16 + fr) * 32 + 16 * n + 4 * fq) = acc[n];
    if (fq == 0) PSS[wave * 16 + fr] = ssq;
    __syncthreads();
    if (kh == 0) {
        const float tot = PSS[wave * 16 + fr] + PSS[(wave + 1) * 16 + fr]; const float rstd = 1.0f / sqrtf(tot * (1.0f / D) + EPS);
        if (fq == 0) RSTD[16 * st + fr] = rstd;
        float v[8]; int taken = 0;
#pragma unroll
        for (int n = 0; n < 2; ++n) { const f32x4 o = *(const LAS f32x4*)(PL + ((wave + 1) * 16 + fr) * 32 + 16 * n + 4 * fq); const f32x4 sw = *(const LAS f32x4*)(SHW + 16 * n + 4 * fq);
#pragma unroll
            for (int e = 0; e < 4; ++e) v[4 * n + e] = rstd * (acc[n][e] + o[e]) + sw[e]; }
        float selv[4]; int seli[4];
#pragma unroll
        for (int r = 0; r < 4; ++r) {
            float bv = -3.0e38f; int bi = 1 << 20;
#pragma unroll
            for (int q = 0; q < 8; ++q) { const int idx = 16 * (q >> 2) + 4 * fq + (q & 3); const bool ok = !((taken >> q) & 1) && (v[q] > bv); bv = ok ? v[q] : bv; bi = ok ? idx : bi; }
#pragma unroll
            for (int msk = 16; msk <= 32; msk <<= 1) { const float ov = __shfl_xor(bv, msk); const int oi = __shfl_xor(bi, msk); const bool tk = (ov > bv) || (ov == bv && oi < bi); bv = tk ? ov : bv; bi = tk ? oi : bi; }
            selv[r] = bv; seli[r] = bi;
            if (((bi >> 2) & 3) == fq) taken |= 1 << (4 * (bi >> 4) + (bi & 3));
        }
        const float e1 = __expf(selv[1] - selv[0]), e2 = __expf(selv[2] - selv[0]), e3 = __expf(selv[3] - selv[0]); const float inv = 1.0f / (1.0f + e1 + e2 + e3);
        const float wk = (fq == 0 ? 1.0f : fq == 1 ? e1 : fq == 2 ? e2 : e3) * inv; const int ek = fq == 0 ? seli[0] : fq == 1 ? seli[1] : fq == 2 ? seli[2] : seli[3];
        const int rank = __hip_atomic_fetch_add(HIST + ek, 1, __ATOMIC_RELAXED, __HIP_MEMORY_SCOPE_WORKGROUP);
        const size_t ai = (size_t)(row0 + 16 * st + fr) * 4 + fq;
        ((int*)(ws + WS_TOPE))[ai] = ek; ((float*)(ws + WS_TOPW))[ai] = wk; ((int*)(ws + WS_RANK))[ai] = rank;
    }
    __syncthreads();
    bf16* H = (bf16*)(ws + WS_H);
    for (int r = wave * 8; r < wave * 8 + 8; ++r) { const float rstd = RSTD[r]; const float* xr = X1 + (size_t)(row0 + r) * D;
#pragma unroll
        for (int jj = 0; jj < 4; ++jj) { const int c = 4 * lane + 256 * jj; const f32x4 x = *(const f32x4*)(xr + c); const f32x4 gs = *(const LAS f32x4*)(GS + c), sh = *(const LAS f32x4*)(SH + c);
            const f32x4 o = x * rstd * gs + sh; v2u w; w.x = pk2(o[0], o[1]); w.y = pk2(o[2], o[3]); *(v2u*)(H + (size_t)(row0 + r) * D + c) = w; } }
    if (tid < 32) ((int*)(ws + WS_CNT))[tile * 32 + tid] = HIST[tid];
    __syncthreads();
}

__device__ __forceinline__ void gather_phase(const Args& args, LAS unsigned char* lds, int vcu, int G) {
    FRESH_TID();
    unsigned char* ws = args.ws;
    LAS int* PART = (LAS int*)lds; LAS int* SEGS = (LAS int*)(lds + 2048); LAS int* BASE = (LAS int*)(lds + 2304); LAS int* SL = (LAS int*)(lds + 2560);
    LAS int* TILEE = (LAS int*)(lds + L_TILEE); LAS int* NMp = (LAS int*)(lds + L_NM);
    const int* CNT = (const int*)(ws + WS_CNT);
    { const int e = tid & 31, q = tid >> 5; int s = 0;
#pragma unroll
        for (int t = 0; t < 16; ++t) s += CNT[(16 * q + t) * 32 + e];
        PART[q * 32 + e] = s; }
    __syncthreads();
    if (tid == 0) { int run = 0;
        for (int e = 0; e < NE; ++e) { int tot = 0;
            for (int q = 0; q < 16; ++q) tot += PART[q * 32 + e];
            const int nt = (tot + 255) >> 8; SEGS[e] = run * 256;
            for (int t = 0; t < nt; ++t) TILEE[run + t] = e;
            run += nt; }
        NMp[0] = run; }
    __syncthreads();
    const bf16* H = (const bf16*)(ws + WS_H); bf16* XG = (bf16*)(ws + WS_XG);
    for (int tile = vcu; tile < NRT; tile += G) {
        if (tid < 32) { const int qt = tile >> 4; int s = SEGS[tid];
            for (int q = 0; q < qt; ++q) s += PART[q * 32 + tid];
            for (int t = 16 * qt; t < tile; ++t) s += CNT[t * 32 + tid];
            BASE[tid] = s; }
        __syncthreads();
        if (tid < 256) { const size_t ai = (size_t)tile * 256 + tid; const int e = ((const int*)(ws + WS_TOPE))[ai]; const int slot = BASE[e] + ((const int*)(ws + WS_RANK))[ai];
            ((int*)(ws + WS_SLOT))[ai] = slot; SL[tid] = slot; }
        __syncthreads();
        for (int a = wave * 32; a < wave * 32 + 32; ++a) { const int slot = SL[a]; const int tok = tile * 64 + (a >> 2);
            const v4u* src = (const v4u*)(H + (size_t)tok * D); v4u* dst = (v4u*)(XG + (size_t)slot * D);
            const v4u x0 = src[lane], x1 = src[64 + lane]; dst[lane] = x0; dst[64 + lane] = x1; }
        __syncthreads();
    }
}

template <bool MOE, bool LAST>
__device__ __forceinline__ void combine_rows(const Args& args, int l, const float* X1, float* XN, int vcu, int G) {
    FRESH_TID(); const int gw = vcu * NWAVES + wave, NGW = G * NWAVES;
    unsigned char* ws = args.ws;
    const bf16* YE = (const bf16*)(ws + WS_XG); bf16* H = (bf16*)(ws + WS_H);
    const float* modl = (const float*)(ws + WS_MOD) + (size_t)l * NB * 6144;
    for (int row = gw; row < T; row += NGW) {
        const int b = row >> 12; const float* xr = X1 + (size_t)row * D + 4 * lane;
        f32x4 v[4];
#pragma unroll
        for (int j = 0; j < 4; ++j) v[j] = *(const f32x4*)(xr + 256 * j);
        if (MOE) {
            f32x4 a[4] = {(f32x4){0.f, 0.f, 0.f, 0.f}, (f32x4){0.f, 0.f, 0.f, 0.f}, (f32x4){0.f, 0.f, 0.f, 0.f}, (f32x4){0.f, 0.f, 0.f, 0.f}};
#pragma unroll
            for (int k = 0; k < 4; ++k) { const int slot = __builtin_amdgcn_readfirstlane(((const int*)(ws + WS_SLOT))[(size_t)row * 4 + k]); const float w = ((const float*)(ws + WS_TOPW))[(size_t)row * 4 + k];
                const bf16* yr = YE + (size_t)slot * D + 4 * lane;
#pragma unroll
                for (int j = 0; j < 4; ++j) { const v2u y = *(const v2u*)(yr + 256 * j); a[j] += w * (f32x4){bflo(y.x), bfhi(y.x), bflo(y.y), bfhi(y.y)}; } }
#pragma unroll
            for (int j = 0; j < 4; ++j) { const f32x4 g = *(const f32x4*)(modl + b * 6144 + 5 * D + 4 * lane + 256 * j); v[j] += g * a[j]; }
        }
        float s = 0.f;
#pragma unroll
        for (int j = 0; j < 4; ++j) s += (v[j][0] * v[j][0] + v[j][1] * v[j][1]) + (v[j][2] * v[j][2] + v[j][3] * v[j][3]);
        const float rstd = 1.0f / sqrtf(wave_sum(s) * (1.0f / D) + EPS);
        if (LAST) {
#pragma unroll
            for (int j = 0; j < 4; ++j) { const int c = 4 * lane + 256 * j; const f32x4 g = *(const f32x4*)(args.in[25] + c); *(f32x4*)(args.out + (size_t)row * D + c) = v[j] * rstd * g; }
        } else {
            const float* modn = (const float*)(ws + WS_MOD) + (size_t)((l + 1) * NB + b) * 6144; const float* g1 = args.in[2] + (size_t)(l + 1) * D;
#pragma unroll
            for (int j = 0; j < 4; ++j) { const int c = 4 * lane + 256 * j; *(f32x4*)(XN + (size_t)row * D + c) = v[j];
                const f32x4 g = *(const f32x4*)(g1 + c), sc = *(const f32x4*)(modn + D + c), sh = *(const f32x4*)(modn + c);
                const f32x4 o = v[j] * rstd * g * (sc + 1.0f) + sh; v2u w; w.x = pk2(o[0], o[1]); w.y = pk2(o[2], o[3]); *(v2u*)(H + (size_t)row * D + c) = w; }
        }
    }
}

template <int L> __device__ __forceinline__ void layer_body(const Args& args, LAS unsigned char* lds, const XcdBarrier& bar, int vcu, int G, const float* xin, float* xnext) {
    unsigned char* ws = args.ws;
    constexpr bool MIX = (RUN_MASK >> (2 * L)) & 1, MOE = (RUN_MASK >> (2 * L + 1)) & 1, LAST = (L == DEPTH - 1);
    const float* modl = (const float*)(ws + WS_MOD) + (size_t)L * NB * 6144;
    float* XA = (float*)(ws + WS_XA);
    const float* x1 = xin;
    if (MIX) {
        if (PH(2)) { asm volatile("; PHASE_MARK P2" ::: "memory");
            pg8::Gemm g{(const bf16*)(ws + WS_H), (const bf16*)(ws + WS_WIN) + (size_t)L * DIN * D, D}; pg8::StaticOrder S; S.init(T / 256, DIN / 256, G, (int)blockIdx.x);
            pg8::EpiBf16 E{(bf16*)(ws + WS_Z), DIN, nullptr, 0};
            pg8::gemm_phase<pg8::EpiBf16, pg8::StaticOrder>(lds, g, S, E);
            xcd_barrier(bar);
        }
        if (PH(3) & ((MIX_MASK >> 2) & 1)) { asm volatile("; PHASE_MARK P3a" ::: "memory");
            for (int u = vcu; u < NB * NBLK; u += G) { mixer_unit<false>(args, L, u >> 6, u & 63, lds); __syncthreads(); }
            xcd_barrier(bar);
        }
        if (PH(4)) { asm volatile("; PHASE_MARK P3b" ::: "memory");
            for (int u = vcu; u < NB * NBLK; u += G) { mixer_unit<true>(args, L, u >> 6, u & 63, lds); __syncthreads(); }
            xcd_barrier(bar);
        }
        if (PH(5)) { asm volatile("; PHASE_MARK P4" ::: "memory");
            pg8::Gemm g{(const bf16*)(ws + WS_Y), (const bf16*)(ws + WS_WOUT) + (size_t)L * D * D, D}; pg8::StaticOrder S; S.init(T / 256, D / 256, G, (int)blockIdx.x);
            pg8::EpiResGate E{xin, XA, modl + 2 * D};
            pg8::gemm_phase<pg8::EpiResGate, pg8::StaticOrder>(lds, g, S, E);
            xcd_barrier(bar);
        }
        x1 = XA;
    }
    if (MOE) {
        if (PH(6)) { asm volatile("; PHASE_MARK P5" ::: "memory");
            for (int tile = vcu; tile < NRT; tile += G) route_tile(args, L, tile, x1, lds);
            xcd_barrier(bar);
        }
        if (PH(7)) { asm volatile("; PHASE_MARK P6" ::: "memory");
            gather_phase(args, lds, vcu, G);
            xcd_barrier(bar);
        }
        const int nM = *(const LAS int*)(lds + L_NM);
        if (PH(8)) { asm volatile("; PHASE_MARK P7" ::: "memory");
            pg8::Gemm g{(const bf16*)(ws + WS_XG), (const bf16*)(ws + WS_W1) + (size_t)L * NE * 2048 * D, D}; pg8::MoeOrder S; S.init(nM, 8, G, (int)blockIdx.x); S.tile_e = (const LAS int*)(lds + L_TILEE);
            pg8::EpiSwiglu E{(bf16*)(ws + WS_ACT), args.in[22] + (size_t)L * NE * 2048};
            pg8::gemm_phase<pg8::EpiSwiglu, pg8::MoeOrder>(lds, g, S, E);
            xcd_barrier(bar);
        }
        if (PH(9)) { asm volatile("; PHASE_MARK P8" ::: "memory");
            pg8::Gemm g{(const bf16*)(ws + WS_ACT), (const bf16*)(ws + WS_W2) + (size_t)L * NE * D * FF, FF}; pg8::MoeOrder S; S.init(nM, 4, G, (int)blockIdx.x); S.tile_e = (const LAS int*)(lds + L_TILEE);
            pg8::EpiBf16 E{(bf16*)(ws + WS_XG), D, args.in[24] + (size_t)L * NE * D, D};
            pg8::gemm_phase<pg8::EpiBf16, pg8::MoeOrder>(lds, g, S, E);
            xcd_barrier(bar);
        }
    }
    asm volatile("; PHASE_MARK P9" ::: "memory");
    if (PH(10)) combine_rows<MOE, LAST>(args, L, x1, xnext, vcu, G);
    if (!LAST) xcd_barrier(bar);
}

__global__ void __launch_bounds__(NTHR, 2) fwd_kernel(Args args) {
    extern __shared__ __attribute__((aligned(16))) unsigned char lds_raw[];
    LAS unsigned char* lds = (LAS unsigned char*)lds_raw;
    const int tid = threadIdx.x;
    const int G = gridDim.x; const int bx = blockIdx.x; const int vcu = (G % 8 == 0) ? (bx % 8) * (G / 8) + bx / 8 : bx;
    unsigned char* ws = args.ws;
    for (int u = tid; u < (LDS_BYTES - LDSCTL_OFF) / 4; u += NTHR) ((LAS unsigned*)(lds + LDSCTL_OFF))[u] = 0u;
    __syncthreads();
    XcdBarrier bar = xcd_barrier_post((unsigned*)(ws + WS_CTL) + CW_BAR, (volatile LAS unsigned*)(lds + L_MISC) + 8);
    asm volatile("; PHASE_MARK P0" ::: "memory");
    if (PH(0)) pro_phase(args, lds, vcu, G);
    xcd_barrier(bar);
    if (PH(1) & (RUN_MASK & 1)) { const float* mod0 = (const float*)(ws + WS_MOD); adaln_rows(args.in[0], (bf16*)(ws + WS_H), args.in[2], mod0, mod0 + D, vcu, G); xcd_barrier(bar); }
    layer_body<0>(args, lds, bar, vcu, G, args.in[0], (float*)(ws + WS_XB));
    layer_body<1>(args, lds, bar, vcu, G, (const float*)(ws + WS_XB), nullptr);
}

extern "C" void kernel_launch(void* const* d_in, const int* in_sizes, int n_in, void* d_out, int out_size, void* d_ws, size_t ws_size, hipStream_t stream) {
    static int grid = 0;
    if (grid == 0) {
        if (n_in != 26 || in_sizes[0] != T * D || out_size != T * D || ws_size < WS_END) { fprintf(stderr, "kernel_launch: unexpected shapes (n_in %d, in0 %d, out %d, ws %zu < %zu); nothing launched\n", n_in, n_in > 0 ? in_sizes[0] : -1, out_size, ws_size, (size_t)WS_END); grid = -1; return; }
        int dev = 0, cus = 0, per_cu = 0;
        if (hipGetDevice(&dev) != hipSuccess || hipDeviceGetAttribute(&cus, hipDeviceAttributeMultiprocessorCount, dev) != hipSuccess) { grid = -1; return; }
        if (hipFuncSetAttribute((const void*)fwd_kernel, hipFuncAttributeMaxDynamicSharedMemorySize, LDS_BYTES) != hipSuccess) { fprintf(stderr, "kernel_launch: hipFuncSetAttribute failed\n"); grid = -1; return; }
        if (hipOccupancyMaxActiveBlocksPerMultiprocessor(&per_cu, (const void*)fwd_kernel, NTHR, LDS_BYTES) != hipSuccess || per_cu < 1) { fprintf(stderr, "kernel_launch: occupancy query says %d blocks per CU\n", per_cu); }
        (void)hipGetLastError();
        grid = cus;
    }
    if (grid < 0) return;
    if (hipMemsetAsync((char*)d_ws + WS_CTL, 0, CTL_ZERO_BYTES, stream) != hipSuccess) return;
    Args a{};
    for (int i = 0; i < 26; ++i) a.in[i] = (const float*)d_in[i];
    a.out = (float*)d_out; a.ws = (unsigned char*)d_ws; a.ph_lo = 0; a.ph_hi = 0;
    hipLaunchKernelGGL(fwd_kernel, dim3(grid), dim3(NTHR), LDS_BYTES, stream, a);
}
```

```cpp
#include <hip/hip_runtime.h>
#include <cstdio>
#include <cstdint>

#ifndef RUN_MASK
#define RUN_MASK 15
#endif
#ifndef PH_ENABLE
#define PH_ENABLE 0x7ff
#endif
#define PH(k) ((PH_ENABLE >> (k)) & 1)
#ifndef DUP_MASK
#define DUP_MASK 0
#endif
#define NREP(k) (1 + ((DUP_MASK >> (k)) & 1))
#ifndef MIX_MASK
#define MIX_MASK 7
#endif

namespace pg8 {
#define PG8_LAS __attribute__((address_space(3)))
typedef unsigned short bf16_t;
typedef short bf16x8 __attribute__((ext_vector_type(8)));
typedef float f32x4 __attribute__((ext_vector_type(4)));
typedef unsigned u32x4 __attribute__((ext_vector_type(4)));
constexpr int BM = 256, BK = 64, HALF = 128, HTB = HALF * BK * 2, STAGE_BYTES = 8 * HTB, NXCD = 8, WGM = 8;

__host__ __device__ __forceinline__ int lds_byte(int r, int c) { const int st = (r >> 4) * 2 + (c >> 5), rr = r & 15, cc = c & 31, ob = rr * 64 + cc * 2; return st * 1024 + (ob ^ (((ob >> 9) & 1) << 5)); }
__host__ __device__ __forceinline__ void stage_rc(int b, int& R, int& C) { const int st = b / 1024, sb = b % 1024, swz = sb ^ (((sb >> 9) & 1) << 5); R = (st >> 1) * 16 + swz / 64; C = (st & 1) * 32 + (swz % 64) / 2; }
__host__ __device__ __forceinline__ int perm32(int rho) { const int n = rho >> 4, i = rho & 15; return 8 * (i >> 2) + 4 * n + (i & 3); }

struct Unit { int pm, pn, pb, e; };
struct Gemm { const bf16_t* A; const bf16_t* Bt; int K; };

struct StaticOrder {
    int nM, nN, nwg, G, c;
    __device__ void init(int nM_, int nN_, int G_, int c_) { nM = nM_; nN = nN_; nwg = nM * nN; G = G_; c = c_; }
    __device__ __forceinline__ bool map(int i, Unit& u) const {
        const long L = (long)i * G + c; if (L >= nwg) return false;
        int wgid = (int)L; { const int q = nwg / NXCD, r = nwg % NXCD, xcd = wgid % NXCD, off = wgid / NXCD; wgid = (xcd < r ? xcd * (q + 1) : r * (q + 1) + (xcd - r) * q) + off; }
        const int nig = WGM * nN, gid = wgid / nig, fm = gid * WGM, gsz = (nM - fm) < WGM ? (nM - fm) : WGM;
        u.pm = fm + ((wgid % nig) % gsz); u.pn = (wgid % nig) / gsz; return true;
    }
    __device__ __forceinline__ bool next(int i, Unit& u) const { if (!map(i, u)) return false; u.pb = u.pn; u.e = 0; return true; }
};
struct MoeOrder : StaticOrder {
    const PG8_LAS int* tile_e;
    __device__ __forceinline__ bool next(int i, Unit& u) const { if (!map(i, u)) return false; u.e = tile_e[u.pm]; u.pb = u.e * nN + u.pn; return true; }
};

__device__ __forceinline__ unsigned cvt_pk_bf16(float lo, float hi) { unsigned r; asm volatile("v_cvt_pk_bf16_f32 %0, %1, %2" : "=v"(r) : "v"(lo), "v"(hi)); return r; }

struct EpiBf16 {
    static constexpr bool PERM = true;
    bf16_t* O; int ldc; const float* bias; int bstride;
    __device__ __forceinline__ void operator()(const f32x4 (&acc)[2][2][4][2], const Unit& u, int wr, int wc, int fr, int fq) const {
        const int row0 = u.pm * BM + wr * 64 + fr; const int col0 = u.pn * BM + wc * 32 + 8 * fq;
        f32x4 bv[2][2];
#pragma unroll
        for (int bj = 0; bj < 2; ++bj)
#pragma unroll
            for (int n = 0; n < 2; ++n) bv[bj][n] = bias ? *(const f32x4*)(bias + (size_t)u.e * bstride + col0 + bj * HALF + 4 * n) : (f32x4){0.f, 0.f, 0.f, 0.f};
#pragma unroll
        for (int ai = 0; ai < 2; ++ai)
#pragma unroll
            for (int m = 0; m < 4; ++m) { bf16_t* rowp = O + (size_t)(row0 + ai * HALF + m * 16) * ldc + col0;
#pragma unroll
                for (int bj = 0; bj < 2; ++bj) { const f32x4 v0 = acc[ai][bj][m][0] + bv[bj][0], v1 = acc[ai][bj][m][1] + bv[bj][1];
                    u32x4 w; w.x = cvt_pk_bf16(v0[0], v0[1]); w.y = cvt_pk_bf16(v0[2], v0[3]); w.z = cvt_pk_bf16(v1[0], v1[1]); w.w = cvt_pk_bf16(v1[2], v1[3]);
                    *(u32x4*)(rowp + bj * HALF) = w; } }
    }
};
struct EpiSwiglu {
    static constexpr bool PERM = true;
    bf16_t* O; const float* b1;
    __device__ __forceinline__ void operator()(const f32x4 (&acc)[2][2][4][2], const Unit& u, int wr, int wc, int fr, int fq) const {
        const int row0 = u.pm * BM + wr * 64 + fr; const int cg = u.pn * HALF + wc * 32 + 8 * fq;
        const float* bg = b1 + (size_t)u.e * 2048 + cg;
        const f32x4 bg0 = *(const f32x4*)(bg), bg1 = *(const f32x4*)(bg + 4), bu0 = *(const f32x4*)(bg + 1024), bu1 = *(const f32x4*)(bg + 1028);
#pragma unroll
        for (int ai = 0; ai < 2; ++ai)
#pragma unroll
            for (int m = 0; m < 4; ++m) {
                const f32x4 g0 = acc[ai][0][m][0] + bg0, g1 = acc[ai][0][m][1] + bg1, u0 = acc[ai][1][m][0] + bu0, u1 = acc[ai][1][m][1] + bu1;
                float o[8];
#pragma unroll
                for (int j = 0; j < 8; ++j) { float g = j < 4 ? g0[j & 3] : g1[j & 3], uu = j < 4 ? u0[j & 3] : u1[j & 3];
                    g = fminf(g, 7.0f); uu = fminf(fmaxf(uu, -7.0f), 7.0f);
                    const float sg = __builtin_amdgcn_rcpf(1.0f + __builtin_amdgcn_exp2f(g * (-1.702f * 1.4426950408889634f)));
                    o[j] = (uu + 1.0f) * (g * sg); }
                u32x4 w; w.x = cvt_pk_bf16(o[0], o[1]); w.y = cvt_pk_bf16(o[2], o[3]); w.z = cvt_pk_bf16(o[4], o[5]); w.w = cvt_pk_bf16(o[6], o[7]);
                *(u32x4*)(O + (size_t)(row0 + ai * HALF + m * 16) * 1024 + cg) = w; }
    }
};
struct EpiResGate {
    static constexpr bool PERM = false;
    const float* X; float* O; const float* gate;
    __device__ __forceinline__ void operator()(const f32x4 (&acc)[2][2][4][2], const Unit& u, int wr, int wc, int fr, int fq) const {
        const int row0 = u.pm * BM + wr * 64 + fr, col0 = u.pn * BM + wc * 32 + 4 * fq; const int b = (u.pm * BM) >> 12;
        f32x4 gv[2][2];
#pragma unroll
        for (int bj = 0; bj < 2; ++bj)
#pragma unroll
            for (int n = 0; n < 2; ++n) gv[bj][n] = *(const f32x4*)(gate + b * 6144 + col0 + bj * HALF + n * 16);
#pragma unroll
        for (int ai = 0; ai < 2; ++ai)
#pragma unroll
            for (int m = 0; m < 4; ++m) { const size_t off = (size_t)(row0 + ai * HALF + m * 16) * 1024 + col0;
#pragma unroll
                for (int bj = 0; bj < 2; ++bj)
#pragma unroll
                    for (int n = 0; n < 2; ++n) { const f32x4 xv = *(const f32x4*)(X + off + bj * HALF + n * 16); *(f32x4*)(O + off + bj * HALF + n * 16) = xv + gv[bj][n] * acc[ai][bj][m][n]; }
                asm volatile("" ::: "memory"); }
    }
};

template <class Epi, class Sched>
__device__ __forceinline__ void gemm_phase(PG8_LAS unsigned char* lds, const Gemm g, const Sched& S, const Epi& E) {
    int tid_ = threadIdx.x; asm volatile("" : "+v"(tid_));
    const int tid = tid_, wid = __builtin_amdgcn_readfirstlane(tid >> 6), lane = tid & 63, wr = wid >> 2, wc = wid & 3, fr = lane & 15, fq = lane >> 4;
    const int K = g.K, nt = K / BK;
    unsigned voffA[2], voffB[2];
#pragma unroll
    for (int i = 0; i < 2; ++i) { int R, C; stage_rc(tid * 16 + i * 8192, R, C); const int Rb = Epi::PERM ? ((R & ~31) + perm32(R & 31)) : R;
        voffA[i] = (unsigned)(R * K + C) * 2u; voffB[i] = (unsigned)(Rb * K + C) * 2u; }
    const size_t kstep = (size_t)(BK * 2);
    const size_t hstep = (size_t)HALF * K * 2;
    const size_t tstep = 2 * hstep;
    const unsigned ldsw = (unsigned)wid * 1024u;
    const int aoff = lds_byte(wr * 64 + fr, fq * 8), boff = lds_byte(wc * 32 + fr, fq * 8);
#define PG8_SA(b, h) (((b) * 2 + (h)) * HTB)
#define PG8_SB(b, h) ((4 + (b) * 2 + (h)) * HTB)
#define PG8_STAGE(bufoff, gbase, voff) do { _Pragma("unroll") for (int _i = 0; _i < 2; ++_i) \
        __builtin_amdgcn_global_load_lds((const unsigned*)((const char*)(gbase) + (voff)[_i]), (PG8_LAS unsigned*)(lds + (bufoff) + ldsw + _i * 8192), 16, 0, 0); } while (0)
#define PG8_LDA(dst, b, h) do { _Pragma("unroll") for (int m = 0; m < 4; ++m) _Pragma("unroll") for (int k = 0; k < 2; ++k) dst[m][k] = *(const PG8_LAS bf16x8*)(lds + PG8_SA(b, h) + aoff + m * 2048 + k * 1024); } while (0)
#define PG8_LDB(dst, b, h) do { _Pragma("unroll") for (int n = 0; n < 2; ++n) _Pragma("unroll") for (int k = 0; k < 2; ++k) dst[n][k] = *(const PG8_LAS bf16x8*)(lds + PG8_SB(b, h) + boff + n * 2048 + k * 1024); } while (0)
#define PG8_MMA(ai, bj, At, Bt) do { __builtin_amdgcn_s_setprio(1); _Pragma("unroll") for (int m = 0; m < 4; ++m) _Pragma("unroll") for (int n = 0; n < 2; ++n) _Pragma("unroll") for (int k = 0; k < 2; ++k) \
        acc[ai][bj][m][n] = __builtin_amdgcn_mfma_f32_16x16x32_bf16(Bt[n][k], At[m][k], acc[ai][bj][m][n], 0, 0, 0); __builtin_amdgcn_s_setprio(0); } while (0)
#define PG8_WAIT_V(n) asm volatile("s_waitcnt vmcnt(" #n ")" ::: "memory")
#define PG8_WAIT_L(n) asm volatile("s_waitcnt lgkmcnt(" #n ")" ::: "memory")
#define PG8_BAR __builtin_amdgcn_s_barrier()
#define PG8_SCHED __builtin_amdgcn_sched_barrier(0)
    Unit cur, nxt; int ui = 0;
    if (!S.next(0, cur)) return;
    f32x4 acc[2][2][4][2];
#pragma unroll
    for (int a = 0; a < 2; ++a)
#pragma unroll
        for (int b = 0; b < 2; ++b)
#pragma unroll
            for (int m = 0; m < 4; ++m)
#pragma unroll
                for (int n = 0; n < 2; ++n) acc[a][b][m][n] = (f32x4){0.f, 0.f, 0.f, 0.f};
    bf16x8 At[4][2], B0[2][2], B1[2][2];
    const char* cA = (const char*)g.A + (size_t)cur.pm * tstep; const char* cB = (const char*)g.Bt + (size_t)cur.pb * tstep;
    PG8_STAGE(PG8_SB(0, 0), cB, voffB); PG8_STAGE(PG8_SB(0, 1), cB + hstep, voffB); PG8_STAGE(PG8_SA(0, 0), cA, voffA); PG8_STAGE(PG8_SA(0, 1), cA + hstep, voffA);
    if (wr == 1) PG8_BAR;
    PG8_WAIT_V(2); PG8_BAR;
    PG8_STAGE(PG8_SB(1, 0), cB + kstep, voffB); PG8_STAGE(PG8_SA(1, 0), cA + kstep, voffA); PG8_STAGE(PG8_SB(1, 1), cB + hstep + kstep, voffB);
    PG8_WAIT_V(6); PG8_BAR;
    for (;;) {
        const bool has_next = S.next(ui + 1, nxt);
        const char* nA = has_next ? (const char*)g.A + (size_t)nxt.pm * tstep : cA; const char* nB = has_next ? (const char*)g.Bt + (size_t)nxt.pb * tstep : cB;
        for (int t = 0; t < nt; t += 2) {
            const bool last = (t == nt - 2);
            const char* a1 = cA + (size_t)(t + 1) * kstep;
            const char* a2 = last ? nA : cA + (size_t)(t + 2) * kstep; const char* b2 = last ? nB : cB + (size_t)(t + 2) * kstep;
            const char* a3 = a2 + kstep; const char* b3 = b2 + kstep;
            PG8_LDB(B0, 0, 0); PG8_LDB(B1, 0, 1); PG8_SCHED; PG8_LDA(At, 0, 0); PG8_STAGE(PG8_SA(1, 1), a1 + hstep, voffA);
            PG8_WAIT_V(8); PG8_WAIT_L(0); PG8_BAR; PG8_MMA(0, 0, At, B0); PG8_MMA(0, 1, At, B1); PG8_BAR; PG8_SCHED;
            PG8_LDA(At, 0, 1); PG8_STAGE(PG8_SB(0, 0), b2, voffB); PG8_STAGE(PG8_SB(0, 1), b2 + hstep, voffB); PG8_STAGE(PG8_SA(0, 0), a2, voffA);
            PG8_WAIT_V(8); PG8_WAIT_L(0); PG8_BAR; PG8_MMA(1, 0, At, B0); PG8_MMA(1, 1, At, B1); PG8_BAR; PG8_SCHED;
            PG8_LDB(B0, 1, 0); PG8_LDB(B1, 1, 1); PG8_SCHED; PG8_LDA(At, 1, 0); PG8_STAGE(PG8_SA(0, 1), a2 + hstep, voffA);
            PG8_WAIT_V(8); PG8_WAIT_L(0); PG8_BAR; PG8_MMA(0, 0, At, B0); PG8_MMA(0, 1, At, B1); PG8_BAR; PG8_SCHED;
            PG8_LDA(At, 1, 1); PG8_STAGE(PG8_SB(1, 0), b3, voffB); PG8_STAGE(PG8_SB(1, 1), b3 + hstep, voffB); PG8_STAGE(PG8_SA(1, 0), a3, voffA);
            PG8_WAIT_V(8); PG8_WAIT_L(0); PG8_BAR; PG8_MMA(1, 0, At, B0); PG8_MMA(1, 1, At, B1); PG8_BAR; PG8_SCHED;
        }
        if (wr == 0) PG8_BAR;
        E(acc, cur, wr, wc, fr, fq);
        if (!has_next) break;
#pragma unroll
        for (int a = 0; a < 2; ++a)
#pragma unroll
            for (int b = 0; b < 2; ++b)
#pragma unroll
                for (int m = 0; m < 4; ++m)
#pragma unroll
                    for (int n = 0; n < 2; ++n) acc[a][b][m][n] = (f32x4){0.f, 0.f, 0.f, 0.f};
        cur = nxt; cA = nA; cB = nB; ++ui;
        if (wr == 1) PG8_BAR;
    }
    PG8_WAIT_V(0);
    PG8_BAR;
#undef PG8_SA
#undef PG8_SB
#undef PG8_STAGE
#undef PG8_LDA
#undef PG8_LDB
#undef PG8_MMA
#undef PG8_WAIT_V
#undef PG8_WAIT_L
#undef PG8_BAR
#undef PG8_SCHED
}
}

constexpr int NWAVES = 8, NTHR = 512;
constexpr int NB = 4, SEQ = 4096, D = 1024, T = NB * SEQ, DIN = 2304, NE = 32, TOPK = 4, DEPTH = 2, FF = 1024;
constexpr int OFF_ZB = 0, OFF_ZC = 256, OFF_ZV = 512, OFF_ZU = 768, OFF_ZSV = 1024, OFF_ZG = 1280, OFF_ZX = 1792;
constexpr int NBLK = SEQ / 64;
constexpr int NRT = T / 64;
constexpr int MAXTILES = T * TOPK / 256 + NE;
constexpr int MAXSLOTS = MAXTILES * 256;
constexpr float EPS = 1e-6f;

constexpr size_t al(size_t x) { return (x + 4095) & ~(size_t)4095; }
constexpr size_t WS_CTL = 0, CTL_ZERO_BYTES = 65536;
constexpr size_t WS_MOD = 65536;
constexpr size_t WS_GWT = al(WS_MOD + (size_t)DEPTH * NB * 6144 * 4);
constexpr size_t WS_SGW = al(WS_GWT + (size_t)DEPTH * 2 * 8 * 4096 * 2);
constexpr size_t WS_RWH = al(WS_SGW + (size_t)DEPTH * 4 * 16384 * 2);
constexpr size_t WS_RWL = al(WS_RWH + (size_t)DEPTH * NE * D * 2);
constexpr size_t WS_WIN = al(WS_RWL + (size_t)DEPTH * NE * D * 2);
constexpr size_t WS_WOUT = al(WS_WIN + (size_t)DEPTH * DIN * D * 2);
constexpr size_t WS_W1 = al(WS_WOUT + (size_t)DEPTH * D * D * 2);
constexpr size_t WS_W2 = al(WS_W1 + (size_t)DEPTH * NE * 2048 * D * 2);
constexpr size_t WS_H = al(WS_W2 + (size_t)DEPTH * NE * D * FF * 2);
constexpr size_t WS_Z = al(WS_H + (size_t)T * D * 2);
constexpr size_t WS_Y = al(WS_Z + (size_t)T * DIN * 2);
constexpr size_t WS_XA = al(WS_Y + (size_t)T * D * 2);
constexpr size_t WS_XB = al(WS_XA + (size_t)T * D * 4);
constexpr size_t WS_AGA = al(WS_XB + (size_t)T * D * 4);
constexpr size_t WS_AGH = al(WS_AGA + (size_t)NB * NBLK * 512 * 4);
constexpr size_t WS_TOPE = al(WS_AGH + (size_t)NB * NBLK * 512 * 4);
constexpr size_t WS_TOPW = al(WS_TOPE + (size_t)T * 4 * 4);
constexpr size_t WS_RANK = al(WS_TOPW + (size_t)T * 4 * 4);
constexpr size_t WS_SLOT = al(WS_RANK + (size_t)T * 4 * 4);
constexpr size_t WS_CNT = al(WS_SLOT + (size_t)T * 4 * 4);
constexpr size_t WS_SHW = al(WS_CNT + (size_t)NRT * NE * 4);
constexpr size_t WS_XG = al(WS_SHW + (size_t)DEPTH * NB * NE * 4);
constexpr size_t WS_ACT = al(WS_XG + (size_t)MAXSLOTS * D * 2);
constexpr size_t WS_END = al(WS_ACT + (size_t)MAXSLOTS * D * 2);
constexpr int CW_BAR = 1024;

constexpr int RING_BYTES = 131072;
constexpr int SCR_BYTES = 147456;
constexpr int LDSCTL_OFF = SCR_BYTES;
constexpr int L_MISC = LDSCTL_OFF;
constexpr int L_TILEE = LDSCTL_OFF + 256;
constexpr int L_NM = L_TILEE + MAXTILES * 4;
constexpr int LDS_BYTES = LDSCTL_OFF + 2048;
static_assert(L_NM + 4 <= LDS_BYTES, "LDS map");

#define GAS __attribute__((address_space(1)))
#define LAS __attribute__((address_space(3)))
typedef unsigned short bf16;
typedef unsigned v4u __attribute__((ext_vector_type(4)));
typedef unsigned v2u __attribute__((ext_vector_type(2)));
typedef float f32x4 __attribute__((ext_vector_type(4)));
typedef short bf16x8 __attribute__((ext_vector_type(8)));
#define LDS_WAIT() asm volatile("s_waitcnt lgkmcnt(0)" ::: "memory")
#define FRESH_TID() int tid_ = threadIdx.x; asm volatile("" : "+v"(tid_)); const int tid = tid_, lane = tid & 63, wave = __builtin_amdgcn_readfirstlane(tid >> 6); (void)tid; (void)lane; (void)wave
__device__ __forceinline__ unsigned f2bf(float f) { unsigned u = __builtin_bit_cast(unsigned, f); return (u + 0x7fffu + ((u >> 16) & 1u)) >> 16; }
__device__ __forceinline__ unsigned pk2(float lo, float hi) { return pg8::cvt_pk_bf16(lo, hi); }
__device__ __forceinline__ float bflo(unsigned w) { return __builtin_bit_cast(float, w << 16); }
__device__ __forceinline__ float bfhi(unsigned w) { return __builtin_bit_cast(float, w & 0xffff0000u); }
__device__ __forceinline__ float sigmoidf_(float x) { return __builtin_amdgcn_rcpf(1.0f + __builtin_amdgcn_exp2f(-1.4426950408889634f * x)); }
__device__ __forceinline__ float gelu_tanh(float x) { const float u2 = 1.5957691216057308f * (x + 0.044715f * x * x * x); return x * __builtin_amdgcn_rcpf(1.0f + __builtin_amdgcn_exp2f(-1.4426950408889634f * u2)); }
__device__ __forceinline__ float wave_sum(float v) {
#pragma unroll
    for (int o = 1; o < 64; o <<= 1) v += __shfl_xor(v, o);
    return v;
}
template <int CTRL> __device__ __forceinline__ float dpp_f(float old, float src) { return __builtin_bit_cast(float, __builtin_amdgcn_update_dpp(__builtin_bit_cast(int, old), __builtin_bit_cast(int, src), CTRL, 0xF, 0xF, false)); }
__device__ __forceinline__ float bcast15(float v, int lane) { return __builtin_bit_cast(float, __builtin_amdgcn_ds_bpermute((lane | 15) << 2, __builtin_bit_cast(int, v))); }

#define XB_TMO      128
#define XB_XCNT(j)  (256  + 64 * (j))
#define XB_XSUB(j)  (1280 + 64 * (j))
#define XB_XGEN(j)  (2304 + 64 * (j))
#define XB_TOP      3328
#define XB_TOPGEN   3392
#define XCD_BAR_WORDS 3456
#define XB_SPIN_CAP (1u << 18)
__device__ __forceinline__ unsigned xb_ld(unsigned* p)              { return __hip_atomic_load(p, __ATOMIC_RELAXED, __HIP_MEMORY_SCOPE_AGENT); }
__device__ __forceinline__ unsigned xb_add(unsigned* p, unsigned v) { return __hip_atomic_fetch_add(p, v, __ATOMIC_RELAXED, __HIP_MEMORY_SCOPE_AGENT); }
__device__ __forceinline__ unsigned xb_xcc_id() { return (unsigned)__builtin_amdgcn_s_getreg((3 << 11) | 20) & 0xFu; }
#define XB_SPIN(cond, bar) do { unsigned _sp = 0; while (cond) { __builtin_amdgcn_s_sleep(1); \
    if ((++_sp & 255u) == 0u) { if (xb_ld(&(bar)[XB_TMO])) break; if (_sp > XB_SPIN_CAP) { atomicAdd(&(bar)[XB_TMO], 1u); break; } } } } while (0)
struct XcdBarrier { unsigned* bar; unsigned x; volatile LAS unsigned* st; };
__device__ __forceinline__ XcdBarrier xcd_barrier_post(unsigned* bar, volatile LAS unsigned* st) {
    XcdBarrier b; b.bar = bar; b.x = xb_xcc_id(); b.st = st;
    if (threadIdx.x == 0) (void)xb_add(&bar[XB_XCNT(b.x)], 1u);
    return b;
}
__device__ __forceinline__ void xcd_barrier_complete(unsigned* bar, unsigned x, unsigned& nloc, unsigned& nx) {
    const unsigned G = gridDim.x * gridDim.y * gridDim.z;
    unsigned sum, cnt, mine, sp = 0u;
    for (;;) {
        sum = 0u; cnt = 0u; mine = 0u;
#pragma unroll
        for (unsigned j = 0; j < 16; ++j) { const unsigned c = xb_ld(&bar[XB_XCNT(j)]); sum += c; cnt += (c > 0u) ? 1u : 0u; mine = (j == x) ? c : mine; }
        if (sum == G) break;
        __builtin_amdgcn_s_sleep(1);
        if ((++sp & 255u) == 0u) { if (xb_ld(&bar[XB_TMO])) break; if (sp > XB_SPIN_CAP) { atomicAdd(&bar[XB_TMO], 1u); break; } }
    }
    nloc = mine > 0u ? mine : 1u; nx = cnt > 0u ? cnt : 1u;
}
__device__ __forceinline__ void xcd_barrier(const XcdBarrier& b) {
    asm volatile("s_waitcnt vmcnt(0)" ::: "memory");
    __syncthreads();
    if (threadIdx.x == 0) {
        unsigned* bar = b.bar;
        __builtin_amdgcn_s_waitcnt(0);
        unsigned nloc = b.st[0], nx = b.st[1];
        if (nloc == 0u) { xcd_barrier_complete(bar, b.x, nloc, nx); b.st[0] = nloc; b.st[1] = nx; }
        const unsigned old = xb_add(&bar[XB_XSUB(b.x)], 1u);
        const unsigned gen = old / nloc;
        if (old + 1u == (gen + 1u) * nloc) {
            __builtin_amdgcn_fence(__ATOMIC_RELEASE, "agent");
            asm volatile("s_waitcnt vmcnt(0)" ::: "memory");
            const unsigned og = xb_add(&bar[XB_TOP], 1u);
            const unsigned tg = og / nx;
            if (og + 1u == (tg + 1u) * nx) xb_add(&bar[XB_TOPGEN], 1u);
            else XB_SPIN(xb_ld(&bar[XB_TOPGEN]) == tg, bar);
            __builtin_amdgcn_fence(__ATOMIC_ACQUIRE, "agent");
            xb_add(&bar[XB_XGEN(b.x)], 1u);
            asm volatile("s_waitcnt vmcnt(0)" ::: "memory");
        } else {
            XB_SPIN(xb_ld(&bar[XB_XGEN(b.x)]) == gen, bar);
            __builtin_amdgcn_fence(__ATOMIC_ACQUIRE, "agent");
            asm volatile("s_waitcnt vmcnt(0)" ::: "memory");
        }
    }
    __syncthreads();
}

__device__ __forceinline__ void transpose_item(const float* W, int K, int N, bf16* WT, int k0, int n0, int rowbase, LAS float* scr, int lane) {
    f32x4 v[16];
#pragma unroll
    for (int i = 0; i < 16; ++i) v[i] = *(const f32x4*)(W + (size_t)(k0 + 4 * i + (lane >> 4)) * N + n0 + 4 * (lane & 15));
#pragma unroll
    for (int i = 0; i < 16; ++i) { LAS float* s = scr + (4 * i + (lane >> 4)) * 65 + 4 * (lane & 15); s[0] = v[i][0]; s[1] = v[i][1]; s[2] = v[i][2]; s[3] = v[i][3]; }
    LDS_WAIT(); asm volatile("" ::: "memory");
    const int c = lane & 7;
#pragma unroll
    for (int j = 0; j < 8; ++j) { const int n = (lane >> 3) + 8 * j; const LAS float* s = scr + (8 * c) * 65 + n;
        v4u o; o.x = pk2(s[0 * 65], s[1 * 65]); o.y = pk2(s[2 * 65], s[3 * 65]); o.z = pk2(s[4 * 65], s[5 * 65]); o.w = pk2(s[6 * 65], s[7 * 65]);
        *(v4u*)(WT + (size_t)(rowbase + n) * K + k0 + 8 * c) = o; }
    LDS_WAIT(); asm volatile("" ::: "memory");
}

struct Args { const float* in[26]; float* out; unsigned char* ws; int ph_lo, ph_hi; };

__device__ __forceinline__ void pro_phase(const Args& args, LAS unsigned char* lds, int vcu, int G) {
    FRESH_TID();
    unsigned char* ws = args.ws;
    for (int u = vcu; u < DEPTH * 96; u += G) {
        const int l = u / 96, cbk = u % 96, col = cbk * 64 + lane;
        const float* wa = args.in[4] + (size_t)l * D * 6144; const float* cc = args.in[1];
        float a0 = 0.f, a1 = 0.f, a2 = 0.f, a3 = 0.f;
#pragma unroll 8
        for (int k = wave * 128; k < wave * 128 + 128; ++k) { const float w = wa[(size_t)k * 6144 + col]; a0 += cc[k] * w; a1 += cc[D + k] * w; a2 += cc[2 * D + k] * w; a3 += cc[3 * D + k] * w; }
        LAS float* red = (LAS float*)lds;
        red[(wave * 4 + 0) * 64 + lane] = a0; red[(wave * 4 + 1) * 64 + lane] = a1; red[(wave * 4 + 2) * 64 + lane] = a2; red[(wave * 4 + 3) * 64 + lane] = a3;
        __syncthreads();
        if (tid < 256) { const int b = tid >> 6, cl = tid & 63; float s = args.in[5][(size_t)l * 6144 + cbk * 64 + cl];
#pragma unroll
            for (int w = 0; w < 8; ++w) s += red[(w * 4 + b) * 64 + cl];
            ((float*)(ws + WS_MOD))[(size_t)(l * NB + b) * 6144 + cbk * 64 + cl] = s; }
        __syncthreads();
    }
    const int gt = vcu * NTHR + tid, NGT = G * NTHR;
    for (int i = gt; i < DEPTH * 2 * 8 * 4096; i += NGT) {
        const int ii = i & 63, j = (i >> 6) & 63, lgh = i >> 12;
        ((bf16*)(ws + WS_GWT))[i] = (bf16)f2bf(args.in[14][(size_t)lgh * 4096 + ii * 64 + j]); }
    for (int i = gt; i < DEPTH * 4 * 16384; i += NGT) {
        const int s = i & 127, t = (i >> 7) & 127;
        ((bf16*)(ws + WS_SGW))[i] = (bf16)(s <= t ? f2bf(args.in[8][i]) : 0u); }
    for (int i = gt; i < DEPTH * NE * D; i += NGT) {
        const int k = i & 1023, e = (i >> 10) & 31, l = i >> 15;
        const float w = args.in[19][((size_t)l * D + k) * NE + e]; const unsigned hi = f2bf(w); const float r = w - __builtin_bit_cast(float, hi << 16);
        ((bf16*)(ws + WS_RWH))[i] = (bf16)hi; ((bf16*)(ws + WS_RWL))[i] = (bf16)f2bf(r); }
    LAS float* scr = (LAS float*)(lds + wave * 16640);
    const int gw = vcu * NWAVES + wave, NGW = G * NWAVES;
    constexpr int I_IN = 16 * 36, I_OUT = 16 * 16, I_W1 = NE * 16 * 32, I_W2 = NE * 16 * 16, I_L = I_IN + I_OUT + I_W1 + I_W2;
    for (int it = gw; it < DEPTH * I_L; it += NGW) {
        const int l = it / I_L; int r = it % I_L;
        if (r < I_IN) { const int kb = r / 36, nb = r % 36; transpose_item(args.in[6] + (size_t)l * D * DIN, D, DIN, (bf16*)(ws + WS_WIN) + (size_t)l * DIN * D, kb * 64, nb * 64, nb * 64, scr, lane); continue; } r -= I_IN;
        if (r < I_OUT) { const int kb = r / 16, nb = r % 16; transpose_item(args.in[18] + (size_t)l * D * D, D, D, (bf16*)(ws + WS_WOUT) + (size_t)l * D * D, kb * 64, nb * 64, nb * 64, scr, lane); continue; } r -= I_OUT;
        if (r < I_W1) { const int e = r / 512, q = r % 512, kb = q / 32, nb = q % 32, n0 = nb * 64;
            const int rowbase = (n0 < 1024) ? (n0 >> 7) * 256 + (n0 & 127) : ((n0 - 1024) >> 7) * 256 + 128 + ((n0 - 1024) & 127);
            transpose_item(args.in[21] + ((size_t)l * NE + e) * D * 2048, D, 2048, (bf16*)(ws + WS_W1) + ((size_t)l * NE + e) * 2048 * D, kb * 64, n0, rowbase, scr, lane); continue; } r -= I_W1;
        { const int e = r / 256, q = r % 256, kb = q / 16, nb = q % 16;
            transpose_item(args.in[23] + ((size_t)l * NE + e) * FF * D, FF, D, (bf16*)(ws + WS_W2) + ((size_t)l * NE + e) * D * FF, kb * 64, nb * 64, nb * 64, scr, lane); }
    }
}

__device__ __forceinline__ void adaln_rows(const float* X, bf16* H, const float* g, const float* mod_shift, const float* mod_scale, int vcu, int G) {
    FRESH_TID(); const int gw = vcu * NWAVES + wave, NGW = G * NWAVES;
    for (int row = gw; row < T; row += NGW) {
        const int b = row >> 12; const float* xr = X + (size_t)row * D + 4 * lane;
        f32x4 v[4]; float s = 0.f;
#pragma unroll
        for (int j = 0; j < 4; ++j) { v[j] = *(const f32x4*)(xr + 256 * j); s += (v[j][0] * v[j][0] + v[j][1] * v[j][1]) + (v[j][2] * v[j][2] + v[j][3] * v[j][3]); }
        const float rstd = 1.0f / sqrtf(wave_sum(s) * (1.0f / D) + EPS);
#pragma unroll
        for (int j = 0; j < 4; ++j) { const int c = 4 * lane + 256 * j;
            const f32x4 gv = *(const f32x4*)(g + c), sc = *(const f32x4*)(mod_scale + b * 6144 + c), sh = *(const f32x4*)(mod_shift + b * 6144 + c);
            const f32x4 o = v[j] * rstd * gv * (sc + 1.0f) + sh;
            v2u w; w.x = pk2(o[0], o[1]); w.y = pk2(o[2], o[3]); *(v2u*)(H + (size_t)row * D + c) = w; }
    }
}


__device__ __forceinline__ void shw_phase(const Args& args, LAS unsigned char* lds, int vcu, int G) {
    FRESH_TID();
    unsigned char* ws = args.ws; LAS float* RED = (LAS float*)lds;
    for (int u = vcu; u < DEPTH * NB; u += G) {
        const int l = u >> 2, b = u & 3, e = tid & 31, part = tid >> 5;
        const float* sh = (const float*)(ws + WS_MOD) + (size_t)(l * NB + b) * 6144 + 3 * D; const float* rw = args.in[19] + (size_t)l * D * NE; float s = 0.f;
#pragma unroll 16
        for (int k = part * 64; k < part * 64 + 64; ++k) s = fmaf(sh[k], rw[(size_t)k * NE + e], s);
        RED[part * 32 + e] = s;
        __syncthreads();
        if (tid < 32) { float t = args.in[20][(size_t)l * NE + tid];
#pragma unroll
            for (int p = 0; p < 16; ++p) t += RED[p * 32 + tid];
            ((float*)(ws + WS_SHW))[(l * NB + b) * NE + tid] = t; }
        __syncthreads();
    }
}

constexpr int L3_CARRY = 139264, L3_SS = 141312, L3_SS2 = 143360, L3_SPL = 144384;
template <bool FULL>
__device__ __forceinline__ void mixer_unit(const Args& args, int l, int b, int j, LAS unsigned char* lds) {
    FRESH_TID();
    unsigned char* ws = args.ws;
    const bf16* Z = (const bf16*)(ws + WS_Z); bf16* Y = (bf16*)(ws + WS_Y);
    float* aggA = (float*)(ws + WS_AGA); float* aggH = (float*)(ws + WS_AGH);
    const float* mixg = args.in[17] + (size_t)l * D;
    const int fr = lane & 15, fq = lane >> 4;
    const size_t rowb = (size_t)b * SEQ;
    const int t0 = 64 * j;
    LAS float* CARRY = (LAS float*)(lds + L3_CARRY); LAS float* SS = (LAS float*)(lds + L3_SS); LAS float* SS2 = (LAS float*)(lds + L3_SS2); LAS float* SPL = (LAS float*)(lds + L3_SPL);
    if ((MIX_MASK & 4) || !FULL) {
        {
            const float y = -args.in[16][(size_t)l * 512 + tid];
            SPL[tid] = fmaxf(y, 0.f) + log1pf(expf(-fabsf(y)));
            if (FULL) { float c = 0.f; const float* pa = aggA + (size_t)b * NBLK * 512 + tid; const float* ph = aggH + (size_t)b * NBLK * 512 + tid;
                int jj = 0;
                for (; jj + 16 <= j; jj += 16) { float av[16], hv[16];
#pragma unroll
                    for (int q = 0; q < 16; ++q) { av[q] = pa[(size_t)(jj + q) * 512]; hv[q] = ph[(size_t)(jj + q) * 512]; }
#pragma unroll
                    for (int q = 0; q < 16; ++q) c = fmaf(av[q], c, hv[q]); }
                { float av[16], hv[16];
#pragma unroll
                    for (int q = 0; q < 16; ++q) { const bool ok = jj + q < j; const int jq = ok ? jj + q : 0; av[q] = pa[(size_t)jq * 512]; hv[q] = ph[(size_t)jq * 512]; if (!ok) { av[q] = 1.f; hv[q] = 0.f; } }
#pragma unroll
                    for (int q = 0; q < 16; ++q) c = fmaf(av[q], c, hv[q]); }
                CARRY[tid] = c; }
        }
        __syncthreads();
        const int hd = wave;
        LAS float* XR = (LAS float*)(lds + wave * 17408);
        const float* cw = args.in[12] + (size_t)l * 4 * 512; const float* cbp = args.in[13] + (size_t)l * 512;
        bf16x8 Xa[4][2];
#pragma unroll
        for (int ks = 0; ks < 2; ++ks) {
            const int c8 = 64 * hd + 32 * ks + 8 * fq;
            float wv[4][8], bv[8];
#pragma unroll
            for (int k = 0; k < 4; ++k) { const f32x4 w0 = *(const f32x4*)(cw + k * 512 + c8), w1 = *(const f32x4*)(cw + k * 512 + c8 + 4);
#pragma unroll
                for (int e = 0; e < 4; ++e) { wv[k][e] = w0[e]; wv[k][4 + e] = w1[e]; } }
            { const f32x4 b0 = *(const f32x4*)(cbp + c8), b1 = *(const f32x4*)(cbp + c8 + 4);
#pragma unroll
                for (int e = 0; e < 4; ++e) { bv[e] = b0[e]; bv[4 + e] = b1[e]; } }
#pragma unroll
            for (int m = 0; m < 4; ++m) {
                const int t = t0 + 16 * m + fr;
                float a8[8];
#pragma unroll
                for (int e = 0; e < 8; ++e) a8[e] = bv[e];
#pragma unroll
                for (int k = 0; k < 4; ++k) { const int tt = t - 3 + k; const int tc = tt < 0 ? 0 : tt;
                    const v4u z = *(const v4u*)(Z + (rowb + tc) * DIN + OFF_ZX + c8); const float msk = tt < 0 ? 0.f : 1.f;
                    const unsigned zw[4] = {z.x, z.y, z.z, z.w};
#pragma unroll
                    for (int q = 0; q < 4; ++q) { a8[2 * q] += wv[k][2 * q] * (msk * bflo(zw[q])); a8[2 * q + 1] += wv[k][2 * q + 1] * (msk * bfhi(zw[q])); } }
                v4u pk; pk.x = pk2(a8[0], a8[1]); pk.y = pk2(a8[2], a8[3]); pk.z = pk2(a8[4], a8[5]); pk.w = pk2(a8[6], a8[7]);
                Xa[m][ks] = __builtin_bit_cast(bf16x8, pk);
                LAS float* xp = XR + (16 * m + fr) * 68 + 32 * ks + 8 * fq;
                *(LAS f32x4*)(xp) = (f32x4){a8[0], a8[1], a8[2], a8[3]}; *(LAS f32x4*)(xp + 4) = (f32x4){a8[4], a8[5], a8[6], a8[7]};
            }
        }
        LDS_WAIT(); asm volatile("" ::: "memory");
        const bf16* GwT = (const bf16*)(ws + WS_GWT) + (size_t)l * 2 * 8 * 4096;
        const float* gbp = args.in[15] + (size_t)l * 2 * 512;
        float ss[4] = {0.f, 0.f, 0.f, 0.f};
#pragma unroll 1
        for (int n = 0; n < 4; ++n) {
            const int cc = 16 * n + 4 * fq, c = 64 * hd + cc;
            f32x4 acc[2][4];
#pragma unroll
            for (int g = 0; g < 2; ++g) {
                bf16x8 Wg[2];
#pragma unroll
                for (int ks = 0; ks < 2; ++ks) Wg[ks] = __builtin_bit_cast(bf16x8, *(const v4u*)(GwT + ((size_t)(g * 8 + hd) * 64 + 16 * n + fr) * 64 + 32 * ks + 8 * fq));
#pragma unroll
                for (int m = 0; m < 4; ++m) { acc[g][m] = (f32x4){0.f, 0.f, 0.f, 0.f};
#pragma unroll
                    for (int ks = 0; ks < 2; ++ks) acc[g][m] = __builtin_amdgcn_mfma_f32_16x16x32_bf16(Wg[ks], Xa[m][ks], acc[g][m], 0, 0, 0); }
            }
            const f32x4 gbr = *(const f32x4*)(gbp + hd * 64 + cc), gbi = *(const f32x4*)(gbp + 512 + hd * 64 + cc);
            const f32x4 sp = *(const LAS f32x4*)(SPL + c);
            float A[4][4], Bv[4][4];
#pragma unroll
            for (int m = 0; m < 4; ++m) { const f32x4 xr = *(const LAS f32x4*)(XR + (16 * m + fr) * 68 + cc);
#pragma unroll
                for (int e = 0; e < 4; ++e) { const float r = sigmoidf_(acc[0][m][e] + gbr[e]), ig = sigmoidf_(acc[1][m][e] + gbi[e]);
                    const float la = -8.0f * r * sp[e]; const float a = __builtin_amdgcn_exp2f(la * 1.4426950408889634f);
                    A[m][e] = a; Bv[m][e] = xr[e] * ig * sqrtf(fmaxf(fmaf(-a, a, 1.0f), 0.f)); } }
#pragma unroll
            for (int m = 0; m < 4; ++m)
#pragma unroll
                for (int e = 0; e < 4; ++e) { float a = A[m][e], bb = Bv[m][e];
                    { const float ap = dpp_f<0x111>(1.0f, a), bp = dpp_f<0x111>(0.0f, bb); bb = fmaf(a, bp, bb); a *= ap; }
                    { const float ap = dpp_f<0x112>(1.0f, a), bp = dpp_f<0x112>(0.0f, bb); bb = fmaf(a, bp, bb); a *= ap; }
                    { const float ap = dpp_f<0x114>(1.0f, a), bp = dpp_f<0x114>(0.0f, bb); bb = fmaf(a, bp, bb); a *= ap; }
                    { const float ap = dpp_f<0x118>(1.0f, a), bp = dpp_f<0x118>(0.0f, bb); bb = fmaf(a, bp, bb); a *= ap; }
                    A[m][e] = a; Bv[m][e] = bb; }
            float hc[4], ac[4];
            if (FULL) { const f32x4 cv = *(const LAS f32x4*)(CARRY + c); hc[0] = cv[0]; hc[1] = cv[1]; hc[2] = cv[2]; hc[3] = cv[3]; }
            else { hc[0] = hc[1] = hc[2] = hc[3] = 0.f; }
            ac[0] = ac[1] = ac[2] = ac[3] = 1.f;
#pragma unroll
            for (int m = 0; m < 4; ++m) {
                float hcur[4];
#pragma unroll
                for (int e = 0; e < 4; ++e) { hcur[e] = fmaf(A[m][e], hc[e], Bv[m][e]); hc[e] = bcast15(hcur[e], lane);
                    if (!FULL) ac[e] = bcast15(A[m][e] * ac[e], lane); }
                if (FULL) { const v2u zg = *(const v2u*)(Z + (rowb + t0 + 16 * m + fr) * DIN + OFF_ZG + c);
                    const float g4[4] = {bflo(zg.x), bfhi(zg.x), bflo(zg.y), bfhi(zg.y)};
                    f32x4 yq;
#pragma unroll
                    for (int e = 0; e < 4; ++e) { const float y = gelu_tanh(g4[e]) * hcur[e]; yq[e] = y; ss[m] = fmaf(y, y, ss[m]); }
                    *(LAS f32x4*)(XR + (16 * m + fr) * 68 + cc) = yq; }
            }
            if (!FULL && fr == 0) { const size_t o = ((size_t)b * NBLK + j) * 512 + c; *(f32x4*)(aggA + o) = (f32x4){ac[0], ac[1], ac[2], ac[3]}; *(f32x4*)(aggH + o) = (f32x4){hc[0], hc[1], hc[2], hc[3]}; }
        }
        if (FULL) {
#pragma unroll
            for (int m = 0; m < 4; ++m) { float s = ss[m]; s += __shfl_xor(s, 16); s += __shfl_xor(s, 32); if (fq == 0) SS[wave * 64 + 16 * m + fr] = s; }
            __syncthreads();
#pragma unroll
            for (int m = 0; m < 4; ++m) { float tot = 0.f;
#pragma unroll
                for (int w = 0; w < 8; ++w) tot += SS[w * 64 + 16 * m + fr];
                const float rstd = 1.0f / sqrtf(tot * (1.0f / 512.0f) + EPS);
#pragma unroll
                for (int n = 0; n < 4; ++n) { const int c = 512 + 64 * hd + 16 * n + 4 * fq; const f32x4 mg = *(const f32x4*)(mixg + c);
                    const f32x4 yq = *(const LAS f32x4*)(XR + (16 * m + fr) * 68 + 16 * n + 4 * fq);
                    v2u w; w.x = pk2(yq[0] * rstd * mg[0], yq[1] * rstd * mg[1]); w.y = pk2(yq[2] * rstd * mg[2], yq[3] * rstd * mg[3]);
                    *(v2u*)(Y + (rowb + t0 + 16 * m + fr) * D + c) = w; } }
        }
    } else if (FULL) {
        for (int i = tid; i < 64 * 64; i += NTHR) { const int r = i >> 6, c8 = (i & 63) * 8; *(v4u*)(Y + (rowb + t0 + r) * D + 512 + c8) = (v4u){0u, 0u, 0u, 0u}; }
    }
    if (!FULL) return;
    asm volatile("" ::: "memory");
    if (MIX_MASK & 1) {
        const int tg = tid >> 5, s8 = (tid & 31) * 8; const int tb = t0 + 4 * tg;
        const float* caw = args.in[7] + (size_t)l * 3 * 256;
        float w3[3][8];
#pragma unroll
        for (int k = 0; k < 3; ++k) { const f32x4 w0 = *(const f32x4*)(caw + k * 256 + s8), w1 = *(const f32x4*)(caw + k * 256 + s8 + 4);
#pragma unroll
            for (int e = 0; e < 4; ++e) { w3[k][e] = w0[e]; w3[k][4 + e] = w1[e]; } }
        float cv[6][8];
#pragma unroll
        for (int i = 0; i < 6; ++i) { const int tt = tb - 2 + i; const int tc = tt < 0 ? 0 : tt; const float msk = tt < 0 ? 0.f : 1.f;
            const v4u zc = *(const v4u*)(Z + (rowb + tc) * DIN + OFF_ZC + s8), zv = *(const v4u*)(Z + (rowb + tc) * DIN + OFF_ZV + s8);
            const unsigned a[4] = {zc.x, zc.y, zc.z, zc.w}, bq[4] = {zv.x, zv.y, zv.z, zv.w};
#pragma unroll
            for (int q = 0; q < 4; ++q) { cv[i][2 * q] = msk * bflo(a[q]) * bflo(bq[q]); cv[i][2 * q + 1] = msk * bfhi(a[q]) * bfhi(bq[q]); } }
        const f32x4 mg0 = *(const f32x4*)(mixg + s8), mg1 = *(const f32x4*)(mixg + s8 + 4);
#pragma unroll
        for (int i = 0; i < 4; ++i) {
            const v4u zb = *(const v4u*)(Z + (rowb + tb + i) * DIN + OFF_ZB + s8); const unsigned a[4] = {zb.x, zb.y, zb.z, zb.w};
            float y[8], s = 0.f;
#pragma unroll
            for (int e = 0; e < 8; ++e) { const float zbe = (e & 1) ? bfhi(a[e >> 1]) : bflo(a[e >> 1]);
                y[e] = zbe * (w3[0][e] * cv[i][e] + w3[1][e] * cv[i + 1][e] + w3[2][e] * cv[i + 2][e]); s = fmaf(y[e], y[e], s); }
#pragma unroll
            for (int o = 1; o < 32; o <<= 1) s += __shfl_xor(s, o);
            const float rstd = 1.0f / sqrtf(s * (1.0f / 256.0f) + EPS);
            v4u w; w.x = pk2(y[0] * rstd * mg0[0], y[1] * rstd * mg0[1]); w.y = pk2(y[2] * rstd * mg0[2], y[3] * rstd * mg0[3]);
            w.z = pk2(y[4] * rstd * mg1[0], y[5] * rstd * mg1[1]); w.w = pk2(y[6] * rstd * mg1[2], y[7] * rstd * mg1[3]);
            *(v4u*)(Y + (rowb + tb + i) * D + s8) = w; }
    } else {
        for (int i = tid; i < 64 * 32; i += NTHR) { const int r = i >> 5, c8 = (i & 31) * 8; *(v4u*)(Y + (rowb + t0 + r) * D + c8) = (v4u){0u, 0u, 0u, 0u}; }
    }
    asm volatile("" ::: "memory");
    if (MIX_MASK & 2) {
        __syncthreads();
        const int hf = j & 1, tcs = t0 - 64 * hf, slen = 64 * (hf + 1);
        LAS bf16* Vt = (LAS bf16*)lds;
        const float* lng = args.in[10] + (size_t)l * 256; const float* lnb = args.in[11] + (size_t)l * 256;
        { const f32x4 gq = *(const f32x4*)(lng + 4 * lane), bq = *(const f32x4*)(lnb + 4 * lane);
            for (int s = wave; s < slen; s += NWAVES) {
                const v2u zz = *(const v2u*)(Z + (rowb + tcs + s) * DIN + OFF_ZSV + 4 * lane);
                float v[4] = {gelu_tanh(bflo(zz.x)), gelu_tanh(bfhi(zz.x)), gelu_tanh(bflo(zz.y)), gelu_tanh(bfhi(zz.y))};
                const float mean = wave_sum((v[0] + v[1]) + (v[2] + v[3])) * (1.0f / 256.0f);
#pragma unroll
                for (int e = 0; e < 4; ++e) v[e] -= mean;
                const float var = wave_sum((v[0] * v[0] + v[1] * v[1]) + (v[2] * v[2] + v[3] * v[3])) * (1.0f / 256.0f);
                const float rstd = 1.0f / sqrtf(var + EPS);
#pragma unroll
                for (int e = 0; e < 4; ++e) Vt[(4 * lane + e) * 136 + s] = (bf16)f2bf(v[e] * rstd * gq[e] + bq[e]);
            } }
        __syncthreads();
        const int h = wave >> 1, th = wave & 1;
        const bf16* SGW = (const bf16*)(ws + WS_SGW) + ((size_t)l * 4 + h) * 16384;
        f32x4 acc[2][4];
#pragma unroll
        for (int m = 0; m < 2; ++m)
#pragma unroll
            for (int n = 0; n < 4; ++n) acc[m][n] = (f32x4){0.f, 0.f, 0.f, 0.f};
#pragma unroll
        for (int ks = 0; ks < 4; ++ks) {
            if (ks * 32 < slen) {
                bf16x8 Wq[2];
#pragma unroll
                for (int m = 0; m < 2; ++m) Wq[m] = __builtin_bit_cast(bf16x8, *(const v4u*)(SGW + (size_t)(64 * hf + 32 * th + 16 * m + fr) * 128 + 32 * ks + 8 * fq));
#pragma unroll
                for (int n = 0; n < 4; ++n) { const bf16x8 Vp = *(const LAS bf16x8*)(Vt + (64 * h + 16 * n + fr) * 136 + 32 * ks + 8 * fq);
#pragma unroll
                    for (int m = 0; m < 2; ++m) acc[m][n] = __builtin_amdgcn_mfma_f32_16x16x32_bf16(Vp, Wq[m], acc[m][n], 0, 0, 0); }
            }
        }
        const float* sgb = args.in[9] + ((size_t)l * 4 + h) * 128;
        float ys[2][4][4], s2[2];
#pragma unroll
        for (int m = 0; m < 2; ++m) { const int tl = 32 * th + 16 * m + fr; const float bias = sgb[64 * hf + tl]; float s = 0.f;
#pragma unroll
            for (int n = 0; n < 4; ++n) { const v2u zu = *(const v2u*)(Z + (rowb + t0 + tl) * DIN + OFF_ZU + 64 * h + 16 * n + 4 * fq);
                const float u4[4] = {bflo(zu.x), bfhi(zu.x), bflo(zu.y), bfhi(zu.y)};
#pragma unroll
                for (int e = 0; e < 4; ++e) { const float y = gelu_tanh(u4[e]) * (acc[m][n][e] + bias); ys[m][n][e] = y; s = fmaf(y, y, s); } }
            s += __shfl_xor(s, 16); s += __shfl_xor(s, 32); s2[m] = s; if (fq == 0) SS2[h * 64 + tl] = s; }
        __syncthreads();
#pragma unroll
        for (int m = 0; m < 2; ++m) { const int tl = 32 * th + 16 * m + fr; const float tot = (SS2[tl] + SS2[64 + tl]) + (SS2[128 + tl] + SS2[192 + tl]);
            const float rstd = 1.0f / sqrtf(tot * (1.0f / 256.0f) + EPS);
#pragma unroll
            for (int n = 0; n < 4; ++n) { const int c = 256 + 64 * h + 16 * n + 4 * fq; const f32x4 mg = *(const f32x4*)(mixg + c);
                v2u w; w.x = pk2(ys[m][n][0] * rstd * mg[0], ys[m][n][1] * rstd * mg[1]); w.y = pk2(ys[m][n][2] * rstd * mg[2], ys[m][n][3] * rstd * mg[3]);
                *(v2u*)(Y + (rowb + t0 + tl) * D + c) = w; } }
        (void)s2;
    } else {
        for (int i = tid; i < 64 * 32; i += NTHR) { const int r = i >> 5, c8 = (i & 31) * 8; *(v4u*)(Y + (rowb + t0 + r) * D + 256 + c8) = (v4u){0u, 0u, 0u, 0u}; }
    }
}

__device__ __forceinline__ void route_tile(const Args& args, int l, int tile, const float* X1, LAS unsigned char* lds) {
    FRESH_TID();
    unsigned char* ws = args.ws;
    LAS float* GS = (LAS float*)lds; LAS float* SH = (LAS float*)(lds + 4096); LAS float* SHW = (LAS float*)(lds + 8192); LAS float* RED = (LAS float*)(lds + 8448);
    LAS float* PL = (LAS float*)(lds + 16384); LAS float* PSS = (LAS float*)(lds + 32768); LAS float* RSTD = (LAS float*)(lds + 33280); LAS int* HIST = (LAS int*)(lds + 33792);
    const int row0 = tile * 64, b = row0 >> 12; const int fr = lane & 15, fq = lane >> 4;
    const float* mod = (const float*)(ws + WS_MOD) + (size_t)(l * NB + b) * 6144;
    const float* g2 = args.in[3] + (size_t)l * D;
    for (int k = tid; k < D; k += NTHR) { GS[k] = g2[k] * (1.0f + mod[4 * D + k]); SH[k] = mod[3 * D + k]; }
    if (tid < 32) HIST[tid] = 0;
    __syncthreads();
    if (tid < 32) SHW[tid] = ((const float*)(ws + WS_SHW))[(l * NB + b) * NE + tid];
    const int st = wave >> 1, kh = wave & 1;
    const bf16* RWH = (const bf16*)(ws + WS_RWH) + (size_t)l * NE * D; const bf16* RWL = (const bf16*)(ws + WS_RWL) + (size_t)l * NE * D;
    f32x4 acc[2] = {(f32x4){0.f, 0.f, 0.f, 0.f}, (f32x4){0.f, 0.f, 0.f, 0.f}}; float ssq = 0.f;
    const float* xrow = X1 + (size_t)(row0 + 16 * st + fr) * D;
#pragma unroll 4
    for (int kb = 0; kb < 16; ++kb) {
        const int k = 512 * kh + 32 * kb + 8 * fq;
        const f32x4 x0 = *(const f32x4*)(xrow + k), x1 = *(const f32x4*)(xrow + k + 4);
        const f32x4 g0 = *(const LAS f32x4*)(GS + k), g1 = *(const LAS f32x4*)(GS + k + 4);
        float xs[8], hi[8], lo[8];
#pragma unroll
        for (int e = 0; e < 4; ++e) { xs[e] = x0[e] * g0[e]; xs[4 + e] = x1[e] * g1[e]; ssq = fmaf(x0[e], x0[e], ssq); ssq = fmaf(x1[e], x1[e], ssq); }
        v4u qh, ql; unsigned hh[8], ll[8];
#pragma unroll
        for (int e = 0; e < 8; ++e) { hh[e] = f2bf(xs[e]); hi[e] = __builtin_bit_cast(float, hh[e] << 16); lo[e] = xs[e] - hi[e]; ll[e] = f2bf(lo[e]); }
        qh.x = hh[0] | (hh[1] << 16); qh.y = hh[2] | (hh[3] << 16); qh.z = hh[4] | (hh[5] << 16); qh.w = hh[6] | (hh[7] << 16);
        ql.x = ll[0] | (ll[1] << 16); ql.y = ll[2] | (ll[3] << 16); ql.z = ll[4] | (ll[5] << 16); ql.w = ll[6] | (ll[7] << 16);
        const bf16x8 Qh = __builtin_bit_cast(bf16x8, qh), Ql = __builtin_bit_cast(bf16x8, ql);
#pragma unroll
        for (int n = 0; n < 2; ++n) { const bf16x8 Ph = __builtin_bit_cast(bf16x8, *(const v4u*)(RWH + (size_t)(16 * n + fr) * D + k)), Pl = __builtin_bit_cast(bf16x8, *(const v4u*)(RWL + (size_t)(16 * n + fr) * D + k));
            acc[n] = __builtin_amdgcn_mfma_f32_16x16x32_bf16(Ph, Qh, acc[n], 0, 0, 0);
            acc[n] = __builtin_amdgcn_mfma_f32_16x16x32_bf16(Ph, Ql, acc[n], 0, 0, 0);
            acc[n] = __builtin_amdgcn_mfma_f32_16x16x32_bf16(Pl, Qh, acc[n], 0, 0, 0); }
    }
    ssq += __shfl_xor(ssq, 16); ssq += __shfl_xor(ssq, 32);
#pragma unroll
    for (int n = 0; n < 2; ++n) *(LAS f32x4*)(PL + (wave * 16 + fr) * 32 + 16 * n + 4 * fq) = acc[n];
    if (fq == 0) PSS[wave * 16 + fr] = ssq;
    __syncthreads();
    if (kh == 0) {
        const float tot = PSS[wave * 16 + fr] + PSS[(wave + 1) * 16 + fr]; const float rstd = 1.0f / sqrtf(tot * (1.0f / D) + EPS);
        if (fq == 0) RSTD[16 * st + fr] = rstd;
        float v[8]; int taken = 0;
#pragma unroll
        for (int n = 0; n < 2; ++n) { const f32x4 o = *(const LAS f32x4*)(PL + ((wave + 1) * 16 + fr) * 32 + 16 * n + 4 * fq); const f32x4 sw = *(const LAS f32x4*)(SHW + 16 * n + 4 * fq);
#pragma unroll
            for (int e = 0; e < 4; ++e) v[4 * n + e] = rstd * (acc[n][e] + o[e]) + sw[e]; }
        float selv[4]; int seli[4];
#pragma unroll
        for (int r = 0; r < 4; ++r) {
            float bv = -3.0e38f; int bi = 1 << 20;
#pragma unroll
            for (int q = 0; q < 8; ++q) { const int idx = 16 * (q >> 2) + 4 * fq + (q & 3); const bool ok = !((taken >> q) & 1) && (v[q] > bv); bv = ok ? v[q] : bv; bi = ok ? idx : bi; }
#pragma unroll
            for (int msk = 16; msk <= 32; msk <<= 1) { const float ov = __shfl_xor(bv, msk); const int oi = __shfl_xor(bi, msk); const bool tk = (ov > bv) || (ov == bv && oi < bi); bv = tk ? ov : bv; bi = tk ? oi : bi; }
            selv[r] = bv; seli[r] = bi;
            if (((bi >> 2) & 3) == fq) taken |= 1 << (4 * (bi >> 4) + (bi & 3));
        }
        const float e1 = __expf(selv[1] - selv[0]), e2 = __expf(selv[2] - selv[0]), e3 = __expf(selv[3] - selv[0]); const float inv = 1.0f / (1.0f + e1 + e2 + e3);
        const float wk = (fq == 0 ? 1.0f : fq == 1 ? e1 : fq == 2 ? e2 : e3) * inv; const int ek = fq == 0 ? seli[0] : fq == 1 ? seli[1] : fq == 2 ? seli[2] : seli[3];
        const int rank = __hip_atomic_fetch_add(HIST + ek, 1, __ATOMIC_RELAXED, __HIP_MEMORY_SCOPE_WORKGROUP);
        const size_t ai = (size_t)(row0 + 16 * st + fr) * 4 + fq;
        ((int*)(ws + WS_TOPE))[ai] = ek; ((float*)(ws + WS_TOPW))[ai] = wk; ((int*)(ws + WS_RANK))[ai] = rank;
    }
    __syncthreads();
    bf16* H = (bf16*)(ws + WS_H);
    for (int r = wave * 8; r < wave * 8 + 8; ++r) { const float rstd = RSTD[r]; const float* xr = X1 + (size_t)(row0 + r) * D;
#pragma unroll
        for (int jj = 0; jj < 4; ++jj) { const int c = 4 * lane + 256 * jj; const f32x4 x = *(const f32x4*)(xr + c); const f32x4 gs = *(const LAS f32x4*)(GS + c), sh = *(const LAS f32x4*)(SH + c);
            const f32x4 o = x * rstd * gs + sh; v2u w; w.x = pk2(o[0], o[1]); w.y = pk2(o[2], o[3]); *(v2u*)(H + (size_t)(row0 + r) * D + c) = w; } }
    if (tid < 32) ((int*)(ws + WS_CNT))[tile * 32 + tid] = HIST[tid];
    __syncthreads();
}

__device__ __forceinline__ void gather_phase(const Args& args, LAS unsigned char* lds, int vcu, int G) {
    FRESH_TID();
    unsigned char* ws = args.ws;
    LAS int* PART = (LAS int*)lds; LAS int* SEGS = (LAS int*)(lds + 2048); LAS int* BASE = (LAS int*)(lds + 2304); LAS int* SL = (LAS int*)(lds + 2560);
    LAS int* TILEE = (LAS int*)(lds + L_TILEE); LAS int* NMp = (LAS int*)(lds + L_NM);
    const int* CNT = (const int*)(ws + WS_CNT);
    { const int e = tid & 31, q = tid >> 5; int s = 0;
#pragma unroll
        for (int t = 0; t < 16; ++t) s += CNT[(16 * q + t) * 32 + e];
        PART[q * 32 + e] = s; }
    __syncthreads();
    if (tid < 64) {
        int tot = 0;
        if (tid < 32) {
#pragma unroll
            for (int q = 0; q < 16; ++q) tot += PART[q * 32 + tid]; }
        const int nt = (tot + 255) >> 8; int inc = nt;
#pragma unroll
        for (int o = 1; o < 32; o <<= 1) { const int t = __shfl_up(inc, o); if (lane >= o) inc += t; }
        const int run = inc - nt;
        if (tid < 32) { SEGS[tid] = run * 256; for (int t = 0; t < nt; ++t) TILEE[run + t] = tid; }
        if (tid == 31) NMp[0] = inc;
    }
    __syncthreads();
    const bf16* H = (const bf16*)(ws + WS_H); bf16* XG = (bf16*)(ws + WS_XG);
    for (int tile = vcu; tile < NRT; tile += G) {
        if (tid < 32) { const int qt = tile >> 4; int s = SEGS[tid];
            for (int q = 0; q < qt; ++q) s += PART[q * 32 + tid];
            for (int t = 16 * qt; t < tile; ++t) s += CNT[t * 32 + tid];
            BASE[tid] = s; }
        __syncthreads();
        if (tid < 256) { const size_t ai = (size_t)tile * 256 + tid; const int e = ((const int*)(ws + WS_TOPE))[ai]; const int slot = BASE[e] + ((const int*)(ws + WS_RANK))[ai];
            ((int*)(ws + WS_SLOT))[ai] = slot; SL[tid] = slot; }
        __syncthreads();
        for (int a0 = wave * 32; a0 < wave * 32 + 32; a0 += 4) {
            const int tok = tile * 64 + (a0 >> 2); const v4u* src = (const v4u*)(H + (size_t)tok * D); const v4u x0 = src[lane], x1 = src[64 + lane];
#pragma unroll
            for (int k = 0; k < 4; ++k) { v4u* dst = (v4u*)(XG + (size_t)SL[a0 + k] * D); dst[lane] = x0; dst[64 + lane] = x1; } }
        __syncthreads();
    }
}

template <bool MOE, bool LAST>
__device__ __forceinline__ void combine_rows(const Args& args, int l, const float* X1, float* XN, int vcu, int G) {
    FRESH_TID(); const int gw = vcu * NWAVES + wave, NGW = G * NWAVES;
    unsigned char* ws = args.ws;
    const bf16* YE = (const bf16*)(ws + WS_XG); bf16* H = (bf16*)(ws + WS_H);
    int rpw = 1; while (rpw * NGW < T) rpw <<= 1;
    const int rbeg = gw * rpw, rend = (rbeg + rpw < T) ? rbeg + rpw : T;
    if (rbeg >= T) return;
    const int b = rbeg >> 12;
    const float* modl = (const float*)(ws + WS_MOD) + (size_t)(l * NB + b) * 6144;
    f32x4 gt[4], pa[4], pb[4];
#pragma unroll
    for (int q = 0; q < 4; ++q) { const int c = 8 * lane + 512 * (q >> 1) + 4 * (q & 1);
        gt[q] = MOE ? *(const f32x4*)(modl + 5 * D + c) : (f32x4){0.f, 0.f, 0.f, 0.f};
        if (LAST) { pa[q] = *(const f32x4*)(args.in[25] + c); pb[q] = (f32x4){0.f, 0.f, 0.f, 0.f}; }
        else { const float* modn = (const float*)(ws + WS_MOD) + (size_t)((l + 1) * NB + b) * 6144; const f32x4 g = *(const f32x4*)(args.in[2] + (size_t)(l + 1) * D + c), sc = *(const f32x4*)(modn + D + c);
            pa[q] = g * (sc + 1.0f); pb[q] = *(const f32x4*)(modn + c); } }
    int myslot = 0; float myw = 0.f;
    if (MOE && rpw * 4 <= 64 && lane < (rend - rbeg) * 4) { myslot = ((const int*)(ws + WS_SLOT))[(size_t)rbeg * 4 + lane]; myw = ((const float*)(ws + WS_TOPW))[(size_t)rbeg * 4 + lane]; }
#pragma unroll 2
    for (int row = rbeg; row < rend; ++row) {
        const float* xr = X1 + (size_t)row * D + 8 * lane;
        f32x4 v[4];
#pragma unroll
        for (int q = 0; q < 4; ++q) v[q] = *(const f32x4*)(xr + 512 * (q >> 1) + 4 * (q & 1));
        if (MOE) {
            f32x4 a[4] = {(f32x4){0.f, 0.f, 0.f, 0.f}, (f32x4){0.f, 0.f, 0.f, 0.f}, (f32x4){0.f, 0.f, 0.f, 0.f}, (f32x4){0.f, 0.f, 0.f, 0.f}};
            v4u y[4][2]; float w[4];
#pragma unroll
            for (int k = 0; k < 4; ++k) { int slot;
                if (rpw * 4 <= 64) { slot = __builtin_amdgcn_readlane(myslot, (row - rbeg) * 4 + k); w[k] = __builtin_bit_cast(float, __builtin_amdgcn_readlane(__builtin_bit_cast(int, myw), (row - rbeg) * 4 + k)); }
                else { slot = ((const int*)(ws + WS_SLOT))[(size_t)row * 4 + k]; w[k] = ((const float*)(ws + WS_TOPW))[(size_t)row * 4 + k]; }
                slot = __builtin_amdgcn_readfirstlane(slot);
                const bf16* yr = YE + (size_t)slot * D + 8 * lane; y[k][0] = *(const v4u*)(yr); y[k][1] = *(const v4u*)(yr + 512); }
#pragma unroll
            for (int k = 0; k < 4; ++k)
#pragma unroll
                for (int hh = 0; hh < 2; ++hh) { const v4u t = y[k][hh];
                    a[2 * hh] += w[k] * (f32x4){bflo(t.x), bfhi(t.x), bflo(t.y), bfhi(t.y)}; a[2 * hh + 1] += w[k] * (f32x4){bflo(t.z), bfhi(t.z), bflo(t.w), bfhi(t.w)}; }
#pragma unroll
            for (int q = 0; q < 4; ++q) v[q] += gt[q] * a[q];
        }
        float s = 0.f;
#pragma unroll
        for (int q = 0; q < 4; ++q) s += (v[q][0] * v[q][0] + v[q][1] * v[q][1]) + (v[q][2] * v[q][2] + v[q][3] * v[q][3]);
        const float rstd = 1.0f / sqrtf(wave_sum(s) * (1.0f / D) + EPS);
        if (LAST) {
#pragma unroll
            for (int q = 0; q < 4; ++q) *(f32x4*)(args.out + (size_t)row * D + 8 * lane + 512 * (q >> 1) + 4 * (q & 1)) = v[q] * rstd * pa[q];
        } else {
#pragma unroll
            for (int q = 0; q < 4; ++q) *(f32x4*)(XN + (size_t)row * D + 8 * lane + 512 * (q >> 1) + 4 * (q & 1)) = v[q];
#pragma unroll
            for (int hh = 0; hh < 2; ++hh) { const f32x4 o0 = v[2 * hh] * rstd * pa[2 * hh] + pb[2 * hh], o1 = v[2 * hh + 1] * rstd * pa[2 * hh + 1] + pb[2 * hh + 1];
                v4u wv; wv.x = pk2(o0[0], o0[1]); wv.y = pk2(o0[2], o0[3]); wv.z = pk2(o1[0], o1[1]); wv.w = pk2(o1[2], o1[3]);
                *(v4u*)(H + (size_t)row * D + 8 * lane + 512 * hh) = wv; }
        }
    }
}

template <int L> __device__ __forceinline__ void layer_body(const Args& args, LAS unsigned char* lds, const XcdBarrier& bar, int vcu, int G, const float* xin, float* xnext) {
    unsigned char* ws = args.ws;
    constexpr bool MIX = (RUN_MASK >> (2 * L)) & 1, MOE = (RUN_MASK >> (2 * L + 1)) & 1, LAST = (L == DEPTH - 1);
    const float* modl = (const float*)(ws + WS_MOD) + (size_t)L * NB * 6144;
    float* XA = (float*)(ws + WS_XA);
    const float* x1 = xin;
    if (MIX) {
        if (PH(2)) { asm volatile("; PHASE_MARK P2" ::: "memory");
            _Pragma("unroll 1") for (int rep = 0; rep < NREP(2); ++rep) {
            pg8::Gemm g{(const bf16*)(ws + WS_H), (const bf16*)(ws + WS_WIN) + (size_t)L * DIN * D, D}; pg8::StaticOrder S; S.init(T / 256, DIN / 256, G, (int)blockIdx.x);
            pg8::EpiBf16 E{(bf16*)(ws + WS_Z), DIN, nullptr, 0};
            pg8::gemm_phase<pg8::EpiBf16, pg8::StaticOrder>(lds, g, S, E);
            xcd_barrier(bar); }
        }
        if (PH(3) & ((MIX_MASK >> 2) & 1)) { asm volatile("; PHASE_MARK P3a" ::: "memory");
            _Pragma("unroll 1") for (int rep = 0; rep < NREP(3); ++rep) {
            for (int u = vcu; u < NB * NBLK; u += G) { mixer_unit<false>(args, L, u >> 6, u & 63, lds); __syncthreads(); }
            xcd_barrier(bar); }
        }
        if (PH(4)) { asm volatile("; PHASE_MARK P3b" ::: "memory");
            _Pragma("unroll 1") for (int rep = 0; rep < NREP(4); ++rep) {
            for (int u = vcu; u < NB * NBLK; u += G) { mixer_unit<true>(args, L, u >> 6, u & 63, lds); __syncthreads(); }
            xcd_barrier(bar); }
        }
        if (PH(5)) { asm volatile("; PHASE_MARK P4" ::: "memory");
            _Pragma("unroll 1") for (int rep = 0; rep < NREP(5); ++rep) {
            pg8::Gemm g{(const bf16*)(ws + WS_Y), (const bf16*)(ws + WS_WOUT) + (size_t)L * D * D, D}; pg8::StaticOrder S; S.init(T / 256, D / 256, G, (int)blockIdx.x);
            pg8::EpiResGate E{xin, XA, modl + 2 * D};
            pg8::gemm_phase<pg8::EpiResGate, pg8::StaticOrder>(lds, g, S, E);
            xcd_barrier(bar); }
        }
        x1 = XA;
    }
    if (MOE) {
        if (PH(6)) { asm volatile("; PHASE_MARK P5" ::: "memory");
            _Pragma("unroll 1") for (int rep = 0; rep < NREP(6); ++rep) {
            for (int tile = vcu; tile < NRT; tile += G) route_tile(args, L, tile, x1, lds);
            xcd_barrier(bar); }
        }
        if (PH(7)) { asm volatile("; PHASE_MARK P6" ::: "memory");
            _Pragma("unroll 1") for (int rep = 0; rep < NREP(7); ++rep) {
            gather_phase(args, lds, vcu, G);
            xcd_barrier(bar); }
        }
        const int nM = *(const LAS int*)(lds + L_NM);
        if (PH(8)) { asm volatile("; PHASE_MARK P7" ::: "memory");
            _Pragma("unroll 1") for (int rep = 0; rep < NREP(8); ++rep) {
            pg8::Gemm g{(const bf16*)(ws + WS_XG), (const bf16*)(ws + WS_W1) + (size_t)L * NE * 2048 * D, D}; pg8::MoeOrder S; S.init(nM, 8, G, (int)blockIdx.x); S.tile_e = (const LAS int*)(lds + L_TILEE);
            pg8::EpiSwiglu E{(bf16*)(ws + WS_ACT), args.in[22] + (size_t)L * NE * 2048};
            pg8::gemm_phase<pg8::EpiSwiglu, pg8::MoeOrder>(lds, g, S, E);
            xcd_barrier(bar); }
        }
        if (PH(9)) { asm volatile("; PHASE_MARK P8" ::: "memory");
            _Pragma("unroll 1") for (int rep = 0; rep < NREP(9); ++rep) {
            pg8::Gemm g{(const bf16*)(ws + WS_ACT), (const bf16*)(ws + WS_W2) + (size_t)L * NE * D * FF, FF}; pg8::MoeOrder S; S.init(nM, 4, G, (int)blockIdx.x); S.tile_e = (const LAS int*)(lds + L_TILEE);
            pg8::EpiBf16 E{(bf16*)(ws + WS_XG), D, args.in[24] + (size_t)L * NE * D, D};
            pg8::gemm_phase<pg8::EpiBf16, pg8::MoeOrder>(lds, g, S, E);
            xcd_barrier(bar); }
        }
    }
    asm volatile("; PHASE_MARK P9" ::: "memory");
    if (PH(10)) { _Pragma("unroll 1") for (int rep = 0; rep < NREP(10); ++rep) { combine_rows<MOE, LAST>(args, L, x1, xnext, vcu, G); if (!LAST) xcd_barrier(bar); } }
}

__global__ void __launch_bounds__(NTHR, 2) fwd_kernel(Args args) {
    extern __shared__ __attribute__((aligned(16))) unsigned char lds_raw[];
    LAS unsigned char* lds = (LAS unsigned char*)lds_raw;
    const int tid = threadIdx.x;
    const int G = gridDim.x; const int bx = blockIdx.x; const int vcu = (G % 8 == 0) ? (bx % 8) * (G / 8) + bx / 8 : bx;
    unsigned char* ws = args.ws;
    for (int u = tid; u < (LDS_BYTES - LDSCTL_OFF) / 4; u += NTHR) ((LAS unsigned*)(lds + LDSCTL_OFF))[u] = 0u;
    __syncthreads();
    XcdBarrier bar = xcd_barrier_post((unsigned*)(ws + WS_CTL) + CW_BAR, (volatile LAS unsigned*)(lds + L_MISC) + 8);
    asm volatile("; PHASE_MARK P0" ::: "memory");
    _Pragma("unroll 1") for (int rep = 0; rep < NREP(0); ++rep) { if (PH(0)) pro_phase(args, lds, vcu, G); xcd_barrier(bar); }
    { shw_phase(args, lds, vcu, G); if (PH(1) & (RUN_MASK & 1)) { const float* mod0 = (const float*)(ws + WS_MOD); adaln_rows(args.in[0], (bf16*)(ws + WS_H), args.in[2], mod0, mod0 + D, vcu, G); } xcd_barrier(bar); }
    layer_body<0>(args, lds, bar, vcu, G, args.in[0], (float*)(ws + WS_XB));
    layer_body<1>(args, lds, bar, vcu, G, (const float*)(ws + WS_XB), nullptr);
}

extern "C" void kernel_launch(void* const* d_in, const int* in_sizes, int n_in, void* d_out, int out_size, void* d_ws, size_t ws_size, hipStream_t stream) {
    static int grid = 0;
    if (grid == 0) {
        if (n_in != 26 || in_sizes[0] != T * D || out_size != T * D || ws_size < WS_END) { fprintf(stderr, "kernel_launch: unexpected shapes (n_in %d, in0 %d, out %d, ws %zu < %zu); nothing launched\n", n_in, n_in > 0 ? in_sizes[0] : -1, out_size, ws_size, (size_t)WS_END); grid = -1; return; }
        int dev = 0, cus = 0, per_cu = 0;
        if (hipGetDevice(&dev) != hipSuccess || hipDeviceGetAttribute(&cus, hipDeviceAttributeMultiprocessorCount, dev) != hipSuccess) { grid = -1; return; }
        if (hipFuncSetAttribute((const void*)fwd_kernel, hipFuncAttributeMaxDynamicSharedMemorySize, LDS_BYTES) != hipSuccess) { fprintf(stderr, "kernel_launch: hipFuncSetAttribute failed\n"); grid = -1; return; }
        if (hipOccupancyMaxActiveBlocksPerMultiprocessor(&per_cu, (const void*)fwd_kernel, NTHR, LDS_BYTES) != hipSuccess || per_cu < 1) { fprintf(stderr, "kernel_launch: occupancy query says %d blocks per CU\n", per_cu); }
        (void)hipGetLastError();
        grid = cus;
    }
    if (grid < 0) return;
    if (hipMemsetAsync((char*)d_ws + WS_CTL, 0, CTL_ZERO_BYTES, stream) != hipSuccess) return;
    Args a{};
    for (int i = 0; i < 26; ++i) a.in[i] = (const float*)d_in[i];
    a.out = (float*)d_out; a.ws = (unsigned char*)d_ws; a.ph_lo = 0; a.ph_hi = 0;
    hipLaunchKernelGGL(fwd_kernel, dim3(grid), dim3(NTHR), LDS_BYTES, stream, a);
}
```

```cpp
#include <hip/hip_runtime.h>
#include <cstdio>
#include <cstdint>

#ifndef RUN_MASK
#define RUN_MASK 15
#endif
#ifndef PH_ENABLE
#define PH_ENABLE 0x7ff
#endif
#define PH(k) ((PH_ENABLE >> (k)) & 1)
#ifndef DUP_MASK
#define DUP_MASK 0
#endif
#define NREP(k) (1 + ((DUP_MASK >> (k)) & 1))
#ifndef MIX_MASK
#define MIX_MASK 7
#endif

namespace pg8 {
#define PG8_LAS __attribute__((address_space(3)))
typedef unsigned short bf16_t;
typedef short bf16x8 __attribute__((ext_vector_type(8)));
typedef float f32x4 __attribute__((ext_vector_type(4)));
typedef unsigned u32x4 __attribute__((ext_vector_type(4)));
typedef int i32x4 __attribute__((ext_vector_type(4)));
typedef int i32x8 __attribute__((ext_vector_type(8)));
constexpr int BM = 256, BK = 64, HALF = 128, HTB = HALF * BK * 2, STAGE_BYTES = 8 * HTB, NXCD = 8, WGM = 8;

__host__ __device__ __forceinline__ int lds_byte(int r, int c) { const int st = (r >> 4) * 2 + (c >> 5), rr = r & 15, cc = c & 31, ob = rr * 64 + cc * 2; return st * 1024 + (ob ^ (((ob >> 9) & 1) << 5)); }
__host__ __device__ __forceinline__ void stage_rc(int b, int& R, int& C) { const int st = b / 1024, sb = b % 1024, swz = sb ^ (((sb >> 9) & 1) << 5); R = (st >> 1) * 16 + swz / 64; C = (st & 1) * 32 + (swz % 64) / 2; }
__host__ __device__ __forceinline__ int perm32(int rho) { const int n = rho >> 4, i = rho & 15; return 8 * (i >> 2) + 4 * n + (i & 3); }

struct Unit { int pm, pn, pb, e; };
struct Gemm { const bf16_t* A; const bf16_t* Bt; int K; };

struct StaticOrder {
    int nM, nN, nwg, G, c;
    __device__ void init(int nM_, int nN_, int G_, int c_) { nM = nM_; nN = nN_; nwg = nM * nN; G = G_; c = c_; }
    __device__ __forceinline__ bool map(int i, Unit& u) const {
        const long L = (long)i * G + c; if (L >= nwg) return false;
        int wgid = (int)L; { const int q = nwg / NXCD, r = nwg % NXCD, xcd = wgid % NXCD, off = wgid / NXCD; wgid = (xcd < r ? xcd * (q + 1) : r * (q + 1) + (xcd - r) * q) + off; }
        const int nig = WGM * nN, gid = wgid / nig, fm = gid * WGM, gsz = (nM - fm) < WGM ? (nM - fm) : WGM;
        u.pm = fm + ((wgid % nig) % gsz); u.pn = (wgid % nig) / gsz; return true;
    }
    __device__ __forceinline__ bool next(int i, Unit& u) const { if (!map(i, u)) return false; u.pb = u.pn; u.e = 0; return true; }
};
struct MoeOrder : StaticOrder {
    const PG8_LAS int* tile_e;
    __device__ __forceinline__ bool next(int i, Unit& u) const { if (!map(i, u)) return false; u.e = tile_e[u.pm]; u.pb = u.e * nN + u.pn; return true; }
};

__device__ __forceinline__ unsigned cvt_pk_bf16(float lo, float hi) { unsigned r; asm volatile("v_cvt_pk_bf16_f32 %0, %1, %2" : "=v"(r) : "v"(lo), "v"(hi)); return r; }

__device__ __forceinline__ unsigned q_i8(float x) { return (unsigned)__float2int_rn(fminf(fmaxf(x, -127.0f), 127.0f)) & 0xffu; }
__device__ __forceinline__ unsigned pk4_i8(float a, float b, float c, float d) { return q_i8(a) | (q_i8(b) << 8) | (q_i8(c) << 16) | (q_i8(d) << 24); }
struct EpiBf16 {
    static constexpr bool PERM = true;
    bf16_t* O; int ldc; const float* bias; int bstride; float sc;
    template <class AT> __device__ __forceinline__ void operator()(const AT (&acc)[2][2][4][2], const Unit& u, int wr, int wc, int fr, int fq) const {
        const int row0 = u.pm * BM + wr * 64 + fr; const int col0 = u.pn * BM + wc * 32 + 8 * fq;
        f32x4 bv[2][2];
#pragma unroll
        for (int bj = 0; bj < 2; ++bj)
#pragma unroll
            for (int n = 0; n < 2; ++n) bv[bj][n] = bias ? *(const f32x4*)(bias + (size_t)u.e * bstride + col0 + bj * HALF + 4 * n) : (f32x4){0.f, 0.f, 0.f, 0.f};
#pragma unroll
        for (int ai = 0; ai < 2; ++ai)
#pragma unroll
            for (int m = 0; m < 4; ++m) { bf16_t* rowp = O + (size_t)(row0 + ai * HALF + m * 16) * ldc + col0;
#pragma unroll
                for (int bj = 0; bj < 2; ++bj) { const f32x4 v0 = __builtin_convertvector(acc[ai][bj][m][0], f32x4) * sc + bv[bj][0], v1 = __builtin_convertvector(acc[ai][bj][m][1], f32x4) * sc + bv[bj][1];
                    u32x4 w; w.x = cvt_pk_bf16(v0[0], v0[1]); w.y = cvt_pk_bf16(v0[2], v0[3]); w.z = cvt_pk_bf16(v1[0], v1[1]); w.w = cvt_pk_bf16(v1[2], v1[3]);
                    *(u32x4*)(rowp + bj * HALF) = w; } }
    }
};
struct EpiSwiglu {
    static constexpr bool PERM = true;
    unsigned char* O; const float* b1; float sc, osc;
    template <class AT> __device__ __forceinline__ void operator()(const AT (&acc)[2][2][4][2], const Unit& u, int wr, int wc, int fr, int fq) const {
        const int row0 = u.pm * BM + wr * 64 + fr; const int cg = u.pn * HALF + wc * 32 + 8 * fq;
        const float* bg = b1 + (size_t)u.e * 2048 + cg;
        const f32x4 bg0 = *(const f32x4*)(bg), bg1 = *(const f32x4*)(bg + 4), bu0 = *(const f32x4*)(bg + 1024), bu1 = *(const f32x4*)(bg + 1028);
#pragma unroll
        for (int ai = 0; ai < 2; ++ai)
#pragma unroll
            for (int m = 0; m < 4; ++m) {
                const f32x4 g0 = __builtin_convertvector(acc[ai][0][m][0], f32x4) * sc + bg0, g1 = __builtin_convertvector(acc[ai][0][m][1], f32x4) * sc + bg1, u0 = __builtin_convertvector(acc[ai][1][m][0], f32x4) * sc + bu0, u1 = __builtin_convertvector(acc[ai][1][m][1], f32x4) * sc + bu1;
                float o[8];
#pragma unroll
                for (int j = 0; j < 8; ++j) { float g = j < 4 ? g0[j & 3] : g1[j & 3], uu = j < 4 ? u0[j & 3] : u1[j & 3];
                    g = fminf(g, 7.0f); uu = fminf(fmaxf(uu, -7.0f), 7.0f);
                    const float sg = __builtin_amdgcn_rcpf(1.0f + __builtin_amdgcn_exp2f(g * (-1.702f * 1.4426950408889634f)));
                    o[j] = (uu + 1.0f) * (g * sg) * osc; }
                const int w0 = (int)pk4_i8(o[0], o[1], o[2], o[3]), w1 = (int)pk4_i8(o[4], o[5], o[6], o[7]);
                typedef int i32x2 __attribute__((ext_vector_type(2)));
                *(i32x2*)(O + (size_t)(row0 + ai * HALF + m * 16) * 1024 + cg) = (i32x2){w0, w1}; }
    }
};
struct EpiResGate {
    static constexpr bool PERM = false;
    const float* X; float* O; const float* gate;
    template <class AT> __device__ __forceinline__ void operator()(const AT (&acc)[2][2][4][2], const Unit& u, int wr, int wc, int fr, int fq) const {
        const int row0 = u.pm * BM + wr * 64 + fr, col0 = u.pn * BM + wc * 32 + 4 * fq; const int b = (u.pm * BM) >> 12;
        f32x4 gv[2][2];
#pragma unroll
        for (int bj = 0; bj < 2; ++bj)
#pragma unroll
            for (int n = 0; n < 2; ++n) gv[bj][n] = *(const f32x4*)(gate + b * 6144 + col0 + bj * HALF + n * 16);
#pragma unroll
        for (int ai = 0; ai < 2; ++ai)
#pragma unroll
            for (int m = 0; m < 4; ++m) { const size_t off = (size_t)(row0 + ai * HALF + m * 16) * 1024 + col0;
#pragma unroll
                for (int bj = 0; bj < 2; ++bj)
#pragma unroll
                    for (int n = 0; n < 2; ++n) { const f32x4 xv = *(const f32x4*)(X + off + bj * HALF + n * 16); *(f32x4*)(O + off + bj * HALF + n * 16) = xv + gv[bj][n] * __builtin_convertvector(acc[ai][bj][m][n], f32x4); }
                asm volatile("" ::: "memory"); }
    }
};

template <bool I8> struct AccSel { typedef f32x4 type; };
template <> struct AccSel<true> { typedef i32x4 type; };
__device__ __forceinline__ f32x4 mma16(bf16x8 b, bf16x8 a, f32x4 c) { return __builtin_amdgcn_mfma_f32_16x16x32_bf16(b, a, c, 0, 0, 0); }
__device__ __forceinline__ i32x4 mma16(bf16x8 b, bf16x8 a, i32x4 c) { return __builtin_amdgcn_mfma_i32_16x16x64_i8(__builtin_bit_cast(i32x4, b), __builtin_bit_cast(i32x4, a), c, 0, 0, 0); }
template <class Epi, class Sched, bool I8 = false>
__device__ __forceinline__ void gemm_phase(PG8_LAS unsigned char* lds, const Gemm g, const Sched& S, const Epi& E) {
    int tid_ = threadIdx.x; asm volatile("" : "+v"(tid_));
    const int tid = tid_, wid = __builtin_amdgcn_readfirstlane(tid >> 6), lane = tid & 63, wr = wid >> 2, wc = wid & 3, fr = lane & 15, fq = lane >> 4;
    const int K = I8 ? g.K / 2 : g.K, nt = K / BK;
    unsigned voffA[2], voffB[2];
#pragma unroll
    for (int i = 0; i < 2; ++i) { int R, C; stage_rc(tid * 16 + i * 8192, R, C); const int Rb = Epi::PERM ? ((R & ~31) + perm32(R & 31)) : R;
        voffA[i] = (unsigned)(R * K + C) * 2u; voffB[i] = (unsigned)(Rb * K + C) * 2u; }
    const size_t kstep = (size_t)(BK * 2);
    const size_t hstep = (size_t)HALF * K * 2;
    const size_t tstep = 2 * hstep;
    const unsigned ldsw = (unsigned)wid * 1024u;
    const int aoff = lds_byte(wr * 64 + fr, fq * 8), boff = lds_byte(wc * 32 + fr, fq * 8);
#define PG8_SA(b, h) (((b) * 2 + (h)) * HTB)
#define PG8_SB(b, h) ((4 + (b) * 2 + (h)) * HTB)
#define PG8_STAGE(bufoff, gbase, voff) do { _Pragma("unroll") for (int _i = 0; _i < 2; ++_i) \
        __builtin_amdgcn_global_load_lds((const unsigned*)((const char*)(gbase) + (voff)[_i]), (PG8_LAS unsigned*)(lds + (bufoff) + ldsw + _i * 8192), 16, 0, 0); } while (0)
#define PG8_LDA(dst, b, h) do { _Pragma("unroll") for (int m = 0; m < 4; ++m) _Pragma("unroll") for (int k = 0; k < 2; ++k) dst[m][k] = *(const PG8_LAS bf16x8*)(lds + PG8_SA(b, h) + aoff + m * 2048 + k * 1024); } while (0)
#define PG8_LDB(dst, b, h) do { _Pragma("unroll") for (int n = 0; n < 2; ++n) _Pragma("unroll") for (int k = 0; k < 2; ++k) dst[n][k] = *(const PG8_LAS bf16x8*)(lds + PG8_SB(b, h) + boff + n * 2048 + k * 1024); } while (0)
#define PG8_MMA(ai, bj, At, Bt) do { __builtin_amdgcn_s_setprio(1); _Pragma("unroll") for (int m = 0; m < 4; ++m) _Pragma("unroll") for (int n = 0; n < 2; ++n) _Pragma("unroll") for (int k = 0; k < 2; ++k) \
        acc[ai][bj][m][n] = mma16(Bt[n][k], At[m][k], acc[ai][bj][m][n]); __builtin_amdgcn_s_setprio(0); } while (0)
#define PG8_WAIT_V(n) asm volatile("s_waitcnt vmcnt(" #n ")" ::: "memory")
#define PG8_WAIT_L(n) asm volatile("s_waitcnt lgkmcnt(" #n ")" ::: "memory")
#define PG8_BAR __builtin_amdgcn_s_barrier()
#define PG8_SCHED __builtin_amdgcn_sched_barrier(0)
    Unit cur, nxt; int ui = 0;
    if (!S.next(0, cur)) return;
    typedef typename AccSel<I8>::type AccT;
    AccT acc[2][2][4][2];
#pragma unroll
    for (int a = 0; a < 2; ++a)
#pragma unroll
        for (int b = 0; b < 2; ++b)
#pragma unroll
            for (int m = 0; m < 4; ++m)
#pragma unroll
                for (int n = 0; n < 2; ++n) acc[a][b][m][n] = AccT{};
    bf16x8 At[4][2], B0[2][2], B1[2][2];
    const char* cA = (const char*)g.A + (size_t)cur.pm * tstep; const char* cB = (const char*)g.Bt + (size_t)cur.pb * tstep;
    PG8_STAGE(PG8_SB(0, 0), cB, voffB); PG8_STAGE(PG8_SB(0, 1), cB + hstep, voffB); PG8_STAGE(PG8_SA(0, 0), cA, voffA); PG8_STAGE(PG8_SA(0, 1), cA + hstep, voffA);
    if (wr == 1) PG8_BAR;
    PG8_WAIT_V(2); PG8_BAR;
    PG8_STAGE(PG8_SB(1, 0), cB + kstep, voffB); PG8_STAGE(PG8_SA(1, 0), cA + kstep, voffA); PG8_STAGE(PG8_SB(1, 1), cB + hstep + kstep, voffB);
    PG8_WAIT_V(6); PG8_BAR;
    for (;;) {
        const bool has_next = S.next(ui + 1, nxt);
        const char* nA = has_next ? (const char*)g.A + (size_t)nxt.pm * tstep : cA; const char* nB = has_next ? (const char*)g.Bt + (size_t)nxt.pb * tstep : cB;
#pragma unroll 1
        for (int t = 0; t < nt; t += 2) {
            const bool last = (t == nt - 2);
            const char* a1 = cA + (size_t)(t + 1) * kstep;
            const char* a2 = last ? nA : cA + (size_t)(t + 2) * kstep; const char* b2 = last ? nB : cB + (size_t)(t + 2) * kstep;
            const char* a3 = a2 + kstep; const char* b3 = b2 + kstep;
            PG8_LDB(B0, 0, 0); PG8_LDB(B1, 0, 1); PG8_SCHED; PG8_LDA(At, 0, 0); PG8_STAGE(PG8_SA(1, 1), a1 + hstep, voffA);
            PG8_WAIT_V(8); PG8_WAIT_L(0); PG8_BAR; PG8_MMA(0, 0, At, B0); PG8_MMA(0, 1, At, B1); PG8_BAR; PG8_SCHED;
            PG8_LDA(At, 0, 1); PG8_STAGE(PG8_SB(0, 0), b2, voffB); PG8_STAGE(PG8_SB(0, 1), b2 + hstep, voffB); PG8_STAGE(PG8_SA(0, 0), a2, voffA);
            PG8_WAIT_V(8); PG8_WAIT_L(0); PG8_BAR; PG8_MMA(1, 0, At, B0); PG8_MMA(1, 1, At, B1); PG8_BAR; PG8_SCHED;
            PG8_LDB(B0, 1, 0); PG8_LDB(B1, 1, 1); PG8_SCHED; PG8_LDA(At, 1, 0); PG8_STAGE(PG8_SA(0, 1), a2 + hstep, voffA);
            PG8_WAIT_V(8); PG8_WAIT_L(0); PG8_BAR; PG8_MMA(0, 0, At, B0); PG8_MMA(0, 1, At, B1); PG8_BAR; PG8_SCHED;
            PG8_LDA(At, 1, 1); PG8_STAGE(PG8_SB(1, 0), b3, voffB); PG8_STAGE(PG8_SB(1, 1), b3 + hstep, voffB); PG8_STAGE(PG8_SA(1, 0), a3, voffA);
            PG8_WAIT_V(8); PG8_WAIT_L(0); PG8_BAR; PG8_MMA(1, 0, At, B0); PG8_MMA(1, 1, At, B1); PG8_BAR; PG8_SCHED;
        }
        if (wr == 0) PG8_BAR;
        E(acc, cur, wr, wc, fr, fq);
        if (!has_next) break;
#pragma unroll
        for (int a = 0; a < 2; ++a)
#pragma unroll
            for (int b = 0; b < 2; ++b)
#pragma unroll
                for (int m = 0; m < 4; ++m)
#pragma unroll
                    for (int n = 0; n < 2; ++n) acc[a][b][m][n] = AccT{};
        cur = nxt; cA = nA; cB = nB; ++ui;
        if (wr == 1) PG8_BAR;
    }
    PG8_WAIT_V(0);
    PG8_BAR;
#undef PG8_SA
#undef PG8_SB
#undef PG8_STAGE
#undef PG8_LDA
#undef PG8_LDB
#undef PG8_MMA
#undef PG8_WAIT_V
#undef PG8_WAIT_L
#undef PG8_BAR
#undef PG8_SCHED
}
}

constexpr int NWAVES = 8, NTHR = 512;
constexpr int NB = 4, SEQ = 4096, D = 1024, T = NB * SEQ, DIN = 2304, NE = 32, TOPK = 4, DEPTH = 2, FF = 1024;
constexpr int OFF_ZB = 0, OFF_ZC = 256, OFF_ZV = 512, OFF_ZU = 768, OFF_ZSV = 1024, OFF_ZG = 1280, OFF_ZX = 1792;
constexpr int NBLK = SEQ / 64;
constexpr int NRT = T / 64;
constexpr int MAXTILES = T * TOPK / 256 + NE;
constexpr int MAXSLOTS = MAXTILES * 256;
constexpr float EPS = 1e-6f;
constexpr float W_SCALE = 640.0f, H_SCALE = 16.0f, ACT_SCALE = 8.0f;

constexpr size_t al(size_t x) { return (x + 4095) & ~(size_t)4095; }
constexpr size_t WS_CTL = 0, CTL_ZERO_BYTES = 65536;
constexpr size_t WS_MOD = 65536;
constexpr size_t WS_GWT = al(WS_MOD + (size_t)DEPTH * NB * 6144 * 4);
constexpr size_t WS_SGW = al(WS_GWT + (size_t)DEPTH * 2 * 8 * 4096 * 2);
constexpr size_t WS_RWH = al(WS_SGW + (size_t)DEPTH * 4 * 16384 * 2);
constexpr size_t WS_RWL = al(WS_RWH + (size_t)DEPTH * NE * D * 2);
constexpr size_t WS_WIN = al(WS_RWL + (size_t)DEPTH * NE * D * 2);
constexpr size_t WS_WOUT = al(WS_WIN + (size_t)DEPTH * DIN * D * 2);
constexpr size_t WS_W1 = al(WS_WOUT + (size_t)DEPTH * D * D * 2);
constexpr size_t WS_W2 = al(WS_W1 + (size_t)DEPTH * NE * 2048 * D * 2);
constexpr size_t WS_H = al(WS_W2 + (size_t)DEPTH * NE * D * FF * 2);
constexpr size_t WS_Z = al(WS_H + (size_t)T * D * 2);
constexpr size_t WS_Y = al(WS_Z + (size_t)T * DIN * 2);
constexpr size_t WS_XA = al(WS_Y + (size_t)T * D * 2);
constexpr size_t WS_XB = al(WS_XA + (size_t)T * D * 4);
constexpr size_t WS_AGA = al(WS_XB + (size_t)T * D * 4);
constexpr size_t WS_AGH = al(WS_AGA + (size_t)NB * NBLK * 512 * 4);
constexpr size_t WS_TOPE = al(WS_AGH + (size_t)NB * NBLK * 512 * 4);
constexpr size_t WS_TOPW = al(WS_TOPE + (size_t)T * 4 * 4);
constexpr size_t WS_RANK = al(WS_TOPW + (size_t)T * 4 * 4);
constexpr size_t WS_SLOT = al(WS_RANK + (size_t)T * 4 * 4);
constexpr size_t WS_CNT = al(WS_SLOT + (size_t)T * 4 * 4);
constexpr size_t WS_SHW = al(WS_CNT + (size_t)NRT * NE * 4);
constexpr size_t WS_XG = al(WS_SHW + (size_t)DEPTH * NB * NE * 4);
constexpr size_t WS_ACT = al(WS_XG + (size_t)MAXSLOTS * D * 2);
constexpr size_t WS_END = al(WS_ACT + (size_t)MAXSLOTS * D * 2);
constexpr int CW_BAR = 1024;

constexpr int RING_BYTES = 131072;
constexpr int SCR_BYTES = 147456;
constexpr int LDSCTL_OFF = SCR_BYTES;
constexpr int L_MISC = LDSCTL_OFF;
constexpr int L_TILEE = LDSCTL_OFF + 256;
constexpr int L_NM = L_TILEE + MAXTILES * 4;
constexpr int LDS_BYTES = LDSCTL_OFF + 2048;
static_assert(L_NM + 4 <= LDS_BYTES, "LDS map");

#define GAS __attribute__((address_space(1)))
#define LAS __attribute__((address_space(3)))
typedef unsigned short bf16;
typedef unsigned v4u __attribute__((ext_vector_type(4)));
typedef unsigned v2u __attribute__((ext_vector_type(2)));
typedef float f32x4 __attribute__((ext_vector_type(4)));
typedef short bf16x8 __attribute__((ext_vector_type(8)));
#define LDS_WAIT() asm volatile("s_waitcnt lgkmcnt(0)" ::: "memory")
#define FRESH_TID() int tid_ = threadIdx.x; asm volatile("" : "+v"(tid_)); const int tid = tid_, lane = tid & 63, wave = __builtin_amdgcn_readfirstlane(tid >> 6); (void)tid; (void)lane; (void)wave
__device__ __forceinline__ unsigned f2bf(float f) { unsigned u = __builtin_bit_cast(unsigned, f); return (u + 0x7fffu + ((u >> 16) & 1u)) >> 16; }
__device__ __forceinline__ unsigned pk2(float lo, float hi) { return pg8::cvt_pk_bf16(lo, hi); }
__device__ __forceinline__ float bflo(unsigned w) { return __builtin_bit_cast(float, w << 16); }
__device__ __forceinline__ float bfhi(unsigned w) { return __builtin_bit_cast(float, w & 0xffff0000u); }
__device__ __forceinline__ float sigmoidf_(float x) { return __builtin_amdgcn_rcpf(1.0f + __builtin_amdgcn_exp2f(-1.4426950408889634f * x)); }
__device__ __forceinline__ float gelu_tanh(float x) { const float u2 = 1.5957691216057308f * (x + 0.044715f * x * x * x); return x * __builtin_amdgcn_rcpf(1.0f + __builtin_amdgcn_exp2f(-1.4426950408889634f * u2)); }
__device__ __forceinline__ float wave_sum(float v) {
#pragma unroll
    for (int o = 1; o < 64; o <<= 1) v += __shfl_xor(v, o);
    return v;
}
template <int CTRL> __device__ __forceinline__ float dpp_f(float old, float src) { return __builtin_bit_cast(float, __builtin_amdgcn_update_dpp(__builtin_bit_cast(int, old), __builtin_bit_cast(int, src), CTRL, 0xF, 0xF, false)); }
__device__ __forceinline__ float bcast15(float v, int lane) { return __builtin_bit_cast(float, __builtin_amdgcn_ds_bpermute((lane | 15) << 2, __builtin_bit_cast(int, v))); }

#define XB_TMO      128
#define XB_XCNT(j)  (256  + 64 * (j))
#define XB_XSUB(j)  (1280 + 64 * (j))
#define XB_XGEN(j)  (2304 + 64 * (j))
#define XB_TOP      3328
#define XB_TOPGEN   3392
#define XCD_BAR_WORDS 3456
#define XB_SPIN_CAP (1u << 18)
__device__ __forceinline__ unsigned xb_ld(unsigned* p)              { return __hip_atomic_load(p, __ATOMIC_RELAXED, __HIP_MEMORY_SCOPE_AGENT); }
__device__ __forceinline__ unsigned xb_add(unsigned* p, unsigned v) { return __hip_atomic_fetch_add(p, v, __ATOMIC_RELAXED, __HIP_MEMORY_SCOPE_AGENT); }
__device__ __forceinline__ unsigned xb_xcc_id() { return (unsigned)__builtin_amdgcn_s_getreg((3 << 11) | 20) & 0xFu; }
#define XB_SPIN(cond, bar) do { unsigned _sp = 0; while (cond) { __builtin_amdgcn_s_sleep(1); \
    if ((++_sp & 255u) == 0u) { if (xb_ld(&(bar)[XB_TMO])) break; if (_sp > XB_SPIN_CAP) { atomicAdd(&(bar)[XB_TMO], 1u); break; } } } } while (0)
struct XcdBarrier { unsigned* bar; unsigned x; volatile LAS unsigned* st; };
__device__ __forceinline__ XcdBarrier xcd_barrier_post(unsigned* bar, volatile LAS unsigned* st) {
    XcdBarrier b; b.bar = bar; b.x = xb_xcc_id(); b.st = st;
    if (threadIdx.x == 0) (void)xb_add(&bar[XB_XCNT(b.x)], 1u);
    return b;
}
__device__ __forceinline__ void xcd_barrier_complete(unsigned* bar, unsigned x, unsigned& nloc, unsigned& nx) {
    const unsigned G = gridDim.x * gridDim.y * gridDim.z;
    unsigned sum, cnt, mine, sp = 0u;
    for (;;) {
        sum = 0u; cnt = 0u; mine = 0u;
#pragma unroll
        for (unsigned j = 0; j < 16; ++j) { const unsigned c = xb_ld(&bar[XB_XCNT(j)]); sum += c; cnt += (c > 0u) ? 1u : 0u; mine = (j == x) ? c : mine; }
        if (sum == G) break;
        __builtin_amdgcn_s_sleep(1);
        if ((++sp & 255u) == 0u) { if (xb_ld(&bar[XB_TMO])) break; if (sp > XB_SPIN_CAP) { atomicAdd(&bar[XB_TMO], 1u); break; } }
    }
    nloc = mine > 0u ? mine : 1u; nx = cnt > 0u ? cnt : 1u;
}
__device__ __forceinline__ void xcd_barrier(const XcdBarrier& b) {
    asm volatile("s_waitcnt vmcnt(0)" ::: "memory");
    __syncthreads();
    if (threadIdx.x == 0) {
        unsigned* bar = b.bar;
        __builtin_amdgcn_s_waitcnt(0);
        unsigned nloc = b.st[0], nx = b.st[1];
        if (nloc == 0u) { xcd_barrier_complete(bar, b.x, nloc, nx); b.st[0] = nloc; b.st[1] = nx; }
        const unsigned old = xb_add(&bar[XB_XSUB(b.x)], 1u);
        const unsigned gen = old / nloc;
        if (old + 1u == (gen + 1u) * nloc) {
            __builtin_amdgcn_fence(__ATOMIC_RELEASE, "agent");
            asm volatile("s_waitcnt vmcnt(0)" ::: "memory");
            const unsigned og = xb_add(&bar[XB_TOP], 1u);
            const unsigned tg = og / nx;
            if (og + 1u == (tg + 1u) * nx) xb_add(&bar[XB_TOPGEN], 1u);
            else XB_SPIN(xb_ld(&bar[XB_TOPGEN]) == tg, bar);
            __builtin_amdgcn_fence(__ATOMIC_ACQUIRE, "agent");
            xb_add(&bar[XB_XGEN(b.x)], 1u);
            asm volatile("s_waitcnt vmcnt(0)" ::: "memory");
        } else {
            XB_SPIN(xb_ld(&bar[XB_XGEN(b.x)]) == gen, bar);
            __builtin_amdgcn_fence(__ATOMIC_ACQUIRE, "agent");
            asm volatile("s_waitcnt vmcnt(0)" ::: "memory");
        }
    }
    __syncthreads();
}

struct TItem { const float* W; bf16* WT; int K, N, k0, n0, rowbase, fp8; };
__device__ __forceinline__ void ti_load(const TItem& d, f32x4 (&v)[16], int lane) {
#pragma unroll
    for (int i = 0; i < 16; ++i) v[i] = __builtin_nontemporal_load((const f32x4*)(d.W + (size_t)(d.k0 + 4 * i + (lane >> 4)) * d.N + d.n0 + 4 * (lane & 15)));
}
__device__ __forceinline__ void ti_store(const TItem& d, const f32x4 (&v)[16], LAS float* scr, int lane) {
#pragma unroll
    for (int i = 0; i < 16; ++i) { LAS float* s = scr + (4 * i + (lane >> 4)) * 65 + 4 * (lane & 15); s[0] = v[i][0]; s[1] = v[i][1]; s[2] = v[i][2]; s[3] = v[i][3]; }
    LDS_WAIT(); asm volatile("" ::: "memory");
    const int c = lane & 7;
#pragma unroll
    for (int j = 0; j < 8; ++j) { const int n = (lane >> 3) + 8 * j; const LAS float* s = scr + (8 * c) * 65 + n;
        v4u o; o.x = pk2(s[0 * 65], s[1 * 65]); o.y = pk2(s[2 * 65], s[3 * 65]); o.z = pk2(s[4 * 65], s[5 * 65]); o.w = pk2(s[6 * 65], s[7 * 65]);
        if (d.fp8) { const unsigned w0 = pg8::pk4_i8(s[0 * 65] * W_SCALE, s[1 * 65] * W_SCALE, s[2 * 65] * W_SCALE, s[3 * 65] * W_SCALE), w1 = pg8::pk4_i8(s[4 * 65] * W_SCALE, s[5 * 65] * W_SCALE, s[6 * 65] * W_SCALE, s[7 * 65] * W_SCALE);
            *(v2u*)((unsigned char*)d.WT + (size_t)(d.rowbase + n) * d.K + d.k0 + 8 * c) = (v2u){w0, w1}; }
        else *(v4u*)(d.WT + (size_t)(d.rowbase + n) * d.K + d.k0 + 8 * c) = o; }
    LDS_WAIT(); asm volatile("" ::: "memory");
}

struct Args { const float* in[26]; float* out; unsigned char* ws; int ph_lo, ph_hi; };

__device__ __forceinline__ void pro_phase(const Args& args, LAS unsigned char* lds, int vcu, int G) {
    FRESH_TID();
    unsigned char* ws = args.ws;
    for (int u = vcu; u < DEPTH * 96; u += G) {
        const int l = u / 96, cbk = u % 96, col = cbk * 64 + lane;
        const float* wa = args.in[4] + (size_t)l * D * 6144; const float* cc = args.in[1];
        float a0 = 0.f, a1 = 0.f, a2 = 0.f, a3 = 0.f;
#pragma unroll 8
        for (int k = wave * 128; k < wave * 128 + 128; ++k) { const float w = wa[(size_t)k * 6144 + col]; a0 += cc[k] * w; a1 += cc[D + k] * w; a2 += cc[2 * D + k] * w; a3 += cc[3 * D + k] * w; }
        LAS float* red = (LAS float*)lds;
        red[(wave * 4 + 0) * 64 + lane] = a0; red[(wave * 4 + 1) * 64 + lane] = a1; red[(wave * 4 + 2) * 64 + lane] = a2; red[(wave * 4 + 3) * 64 + lane] = a3;
        __syncthreads();
        if (tid < 256) { const int b = tid >> 6, cl = tid & 63; float s = args.in[5][(size_t)l * 6144 + cbk * 64 + cl];
#pragma unroll
            for (int w = 0; w < 8; ++w) s += red[(w * 4 + b) * 64 + cl];
            ((float*)(ws + WS_MOD))[(size_t)(l * NB + b) * 6144 + cbk * 64 + cl] = s; }
        __syncthreads();
    }
    const int gt = vcu * NTHR + tid, NGT = G * NTHR;
    for (int i = gt; i < DEPTH * 2 * 8 * 4096; i += NGT) {
        const int ii = i & 63, j = (i >> 6) & 63, lgh = i >> 12;
        ((bf16*)(ws + WS_GWT))[i] = (bf16)f2bf(args.in[14][(size_t)lgh * 4096 + ii * 64 + j]); }
    for (int i = gt; i < DEPTH * 4 * 16384; i += NGT) {
        const int s = i & 127, t = (i >> 7) & 127;
        ((bf16*)(ws + WS_SGW))[i] = (bf16)(s <= t ? f2bf(args.in[8][i]) : 0u); }
    for (int i = gt; i < DEPTH * NE * D; i += NGT) {
        const int k = i & 1023, e = (i >> 10) & 31, l = i >> 15;
        const float w = args.in[19][((size_t)l * D + k) * NE + e]; const unsigned hi = f2bf(w); const float r = w - __builtin_bit_cast(float, hi << 16);
        ((bf16*)(ws + WS_RWH))[i] = (bf16)hi; ((bf16*)(ws + WS_RWL))[i] = (bf16)f2bf(r); }
    LAS float* scr = (LAS float*)(lds + wave * 16640);
    const int gw = vcu * NWAVES + wave, NGW = G * NWAVES;
    constexpr int I_IN = 16 * 36, I_OUT = 16 * 16, I_W1 = NE * 16 * 32, I_W2 = NE * 16 * 16, I_L = I_IN + I_OUT + I_W1 + I_W2;
    auto decode = [&](int it, TItem& d) {
        const int l = it / I_L; int r = it % I_L;
        if (r < I_IN) { const int kb = r / 36, nb = r % 36; d = TItem{args.in[6] + (size_t)l * D * DIN, (bf16*)(ws + WS_WIN) + (size_t)l * DIN * D, D, DIN, kb * 64, nb * 64, nb * 64, 0}; return; } r -= I_IN;
        if (r < I_OUT) { const int kb = r / 16, nb = r % 16; d = TItem{args.in[18] + (size_t)l * D * D, (bf16*)(ws + WS_WOUT) + (size_t)l * D * D, D, D, kb * 64, nb * 64, nb * 64, 0}; return; } r -= I_OUT;
        if (r < I_W1) { const int e = r / 512, q = r % 512, kb = q / 32, nb = q % 32, n0 = nb * 64;
            const int rowbase = (n0 < 1024) ? (n0 >> 7) * 256 + (n0 & 127) : ((n0 - 1024) >> 7) * 256 + 128 + ((n0 - 1024) & 127);
            d = TItem{args.in[21] + ((size_t)l * NE + e) * D * 2048, (bf16*)(ws + WS_W1 + ((size_t)l * NE + e) * 2048 * D), D, 2048, kb * 64, n0, rowbase, 1}; return; } r -= I_W1;
        { const int e = r / 256, q = r % 256, kb = q / 16, nb = q % 16;
            d = TItem{args.in[23] + ((size_t)l * NE + e) * FF * D, (bf16*)(ws + WS_W2 + ((size_t)l * NE + e) * D * FF), FF, D, kb * 64, nb * 64, nb * 64, 1}; }
    };
    int it = gw; TItem d, dn; f32x4 v[16], vn[16];
    if (it < DEPTH * I_L) { decode(it, d); ti_load(d, v, lane); }
    while (it < DEPTH * I_L) {
        const int itn = it + NGW; const bool hn = itn < DEPTH * I_L;
        if (hn) { decode(itn, dn); ti_load(dn, vn, lane); }
        ti_store(d, v, scr, lane);
        if (hn) { d = dn;
#pragma unroll
            for (int i = 0; i < 16; ++i) v[i] = vn[i]; }
        it = itn;
    }
}

__device__ __forceinline__ void adaln_rows(const float* X, bf16* H, const float* g, const float* mod_shift, const float* mod_scale, int vcu, int G) {
    FRESH_TID(); const int gw = vcu * NWAVES + wave, NGW = G * NWAVES;
    for (int row = gw; row < T; row += NGW) {
        const int b = row >> 12; const float* xr = X + (size_t)row * D + 4 * lane;
        f32x4 v[4]; float s = 0.f;
#pragma unroll
        for (int j = 0; j < 4; ++j) { v[j] = *(const f32x4*)(xr + 256 * j); s += (v[j][0] * v[j][0] + v[j][1] * v[j][1]) + (v[j][2] * v[j][2] + v[j][3] * v[j][3]); }
        const float rstd = 1.0f / sqrtf(wave_sum(s) * (1.0f / D) + EPS);
#pragma unroll
        for (int j = 0; j < 4; ++j) { const int c = 4 * lane + 256 * j;
            const f32x4 gv = *(const f32x4*)(g + c), sc = *(const f32x4*)(mod_scale + b * 6144 + c), sh = *(const f32x4*)(mod_shift + b * 6144 + c);
            const f32x4 o = v[j] * rstd * gv * (sc + 1.0f) + sh;
            v2u w; w.x = pk2(o[0], o[1]); w.y = pk2(o[2], o[3]); *(v2u*)(H + (size_t)row * D + c) = w; }
    }
}


__device__ __forceinline__ void shw_phase(const Args& args, LAS unsigned char* lds, int vcu, int G) {
    FRESH_TID();
    unsigned char* ws = args.ws; LAS float* RED = (LAS float*)lds;
    for (int u = vcu; u < DEPTH * NB; u += G) {
        const int l = u >> 2, b = u & 3, e = tid & 31, part = tid >> 5;
        const float* sh = (const float*)(ws + WS_MOD) + (size_t)(l * NB + b) * 6144 + 3 * D; const float* rw = args.in[19] + (size_t)l * D * NE; float s = 0.f;
#pragma unroll 16
        for (int k = part * 64; k < part * 64 + 64; ++k) s = fmaf(sh[k], rw[(size_t)k * NE + e], s);
        RED[part * 32 + e] = s;
        __syncthreads();
        if (tid < 32) { float t = args.in[20][(size_t)l * NE + tid];
#pragma unroll
            for (int p = 0; p < 16; ++p) t += RED[p * 32 + tid];
            ((float*)(ws + WS_SHW))[(l * NB + b) * NE + tid] = t; }
        __syncthreads();
    }
}

constexpr int L3_CARRY = 139264, L3_SS = 141312, L3_SS2 = 143360, L3_SPL = 144384;
template <bool FULL>
__device__ __forceinline__ void mixer_unit(const Args& args, int l, int b, int j, LAS unsigned char* lds) {
    FRESH_TID();
    unsigned char* ws = args.ws;
    const bf16* Z = (const bf16*)(ws + WS_Z); bf16* Y = (bf16*)(ws + WS_Y);
    float* aggA = (float*)(ws + WS_AGA); float* aggH = (float*)(ws + WS_AGH);
    const float* mixg = args.in[17] + (size_t)l * D;
    const int fr = lane & 15, fq = lane >> 4;
    const size_t rowb = (size_t)b * SEQ;
    const int t0 = 64 * j;
    LAS float* CARRY = (LAS float*)(lds + L3_CARRY); LAS float* SS = (LAS float*)(lds + L3_SS); LAS float* SS2 = (LAS float*)(lds + L3_SS2); LAS float* SPL = (LAS float*)(lds + L3_SPL);
    if ((MIX_MASK & 4) || !FULL) {
        {
            const float y = -args.in[16][(size_t)l * 512 + tid];
            SPL[tid] = fmaxf(y, 0.f) + log1pf(expf(-fabsf(y)));
            if (FULL) { float c = 0.f; const float* pa = aggA + (size_t)b * NBLK * 512 + tid; const float* ph = aggH + (size_t)b * NBLK * 512 + tid;
                int jj = 0;
                for (; jj + 16 <= j; jj += 16) { float av[16], hv[16];
#pragma unroll
                    for (int q = 0; q < 16; ++q) { av[q] = pa[(size_t)(jj + q) * 512]; hv[q] = ph[(size_t)(jj + q) * 512]; }
#pragma unroll
                    for (int q = 0; q < 16; ++q) c = fmaf(av[q], c, hv[q]); }
                { float av[16], hv[16];
#pragma unroll
                    for (int q = 0; q < 16; ++q) { const bool ok = jj + q < j; const int jq = ok ? jj + q : 0; av[q] = pa[(size_t)jq * 512]; hv[q] = ph[(size_t)jq * 512]; if (!ok) { av[q] = 1.f; hv[q] = 0.f; } }
#pragma unroll
                    for (int q = 0; q < 16; ++q) c = fmaf(av[q], c, hv[q]); }
                CARRY[tid] = c; }
        }
        __syncthreads();
        const int hd = wave;
        LAS float* XR = (LAS float*)(lds + wave * 17408);
        const float* cw = args.in[12] + (size_t)l * 4 * 512; const float* cbp = args.in[13] + (size_t)l * 512;
        bf16x8 Xa[4][2];
#pragma unroll
        for (int ks = 0; ks < 2; ++ks) {
            const int c8 = 64 * hd + 32 * ks + 8 * fq;
            float wv[4][8], bv[8];
#pragma unroll
            for (int k = 0; k < 4; ++k) { const f32x4 w0 = *(const f32x4*)(cw + k * 512 + c8), w1 = *(const f32x4*)(cw + k * 512 + c8 + 4);
#pragma unroll
                for (int e = 0; e < 4; ++e) { wv[k][e] = w0[e]; wv[k][4 + e] = w1[e]; } }
            { const f32x4 b0 = *(const f32x4*)(cbp + c8), b1 = *(const f32x4*)(cbp + c8 + 4);
#pragma unroll
                for (int e = 0; e < 4; ++e) { bv[e] = b0[e]; bv[4 + e] = b1[e]; } }
#pragma unroll
            for (int m = 0; m < 4; ++m) {
                const int t = t0 + 16 * m + fr;
                float a8[8];
#pragma unroll
                for (int e = 0; e < 8; ++e) a8[e] = bv[e];
#pragma unroll
                for (int k = 0; k < 4; ++k) { const int tt = t - 3 + k; const int tc = tt < 0 ? 0 : tt;
                    const v4u z = *(const v4u*)(Z + (rowb + tc) * DIN + OFF_ZX + c8); const float msk = tt < 0 ? 0.f : 1.f;
                    const unsigned zw[4] = {z.x, z.y, z.z, z.w};
#pragma unroll
                    for (int q = 0; q < 4; ++q) { a8[2 * q] += wv[k][2 * q] * (msk * bflo(zw[q])); a8[2 * q + 1] += wv[k][2 * q + 1] * (msk * bfhi(zw[q])); } }
                v4u pk; pk.x = pk2(a8[0], a8[1]); pk.y = pk2(a8[2], a8[3]); pk.z = pk2(a8[4], a8[5]); pk.w = pk2(a8[6], a8[7]);
                Xa[m][ks] = __builtin_bit_cast(bf16x8, pk);
                LAS float* xp = XR + (16 * m + fr) * 68 + 32 * ks + 8 * fq;
                *(LAS f32x4*)(xp) = (f32x4){a8[0], a8[1], a8[2], a8[3]}; *(LAS f32x4*)(xp + 4) = (f32x4){a8[4], a8[5], a8[6], a8[7]};
            }
        }
        LDS_WAIT(); asm volatile("" ::: "memory");
        const bf16* GwT = (const bf16*)(ws + WS_GWT) + (size_t)l * 2 * 8 * 4096;
        const float* gbp = args.in[15] + (size_t)l * 2 * 512;
        float ss[4] = {0.f, 0.f, 0.f, 0.f};
#pragma unroll 1
        for (int n = 0; n < 4; ++n) {
            const int cc = 16 * n + 4 * fq, c = 64 * hd + cc;
            f32x4 acc[2][4];
#pragma unroll
            for (int g = 0; g < 2; ++g) {
                bf16x8 Wg[2];
#pragma unroll
                for (int ks = 0; ks < 2; ++ks) Wg[ks] = __builtin_bit_cast(bf16x8, *(const v4u*)(GwT + ((size_t)(g * 8 + hd) * 64 + 16 * n + fr) * 64 + 32 * ks + 8 * fq));
#pragma unroll
                for (int m = 0; m < 4; ++m) { acc[g][m] = (f32x4){0.f, 0.f, 0.f, 0.f};
#pragma unroll
                    for (int ks = 0; ks < 2; ++ks) acc[g][m] = __builtin_amdgcn_mfma_f32_16x16x32_bf16(Wg[ks], Xa[m][ks], acc[g][m], 0, 0, 0); }
            }
            const f32x4 gbr = *(const f32x4*)(gbp + hd * 64 + cc), gbi = *(const f32x4*)(gbp + 512 + hd * 64 + cc);
            const f32x4 sp = *(const LAS f32x4*)(SPL + c);
            float A[4][4], Bv[4][4];
#pragma unroll
            for (int m = 0; m < 4; ++m) { const f32x4 xr = *(const LAS f32x4*)(XR + (16 * m + fr) * 68 + cc);
#pragma unroll
                for (int e = 0; e < 4; ++e) { const float r = sigmoidf_(acc[0][m][e] + gbr[e]), ig = sigmoidf_(acc[1][m][e] + gbi[e]);
                    const float la = -8.0f * r * sp[e]; const float a = __builtin_amdgcn_exp2f(la * 1.4426950408889634f);
                    A[m][e] = a; Bv[m][e] = xr[e] * ig * sqrtf(fmaxf(fmaf(-a, a, 1.0f), 0.f)); } }
#pragma unroll
            for (int m = 0; m < 4; ++m)
#pragma unroll
                for (int e = 0; e < 4; ++e) { float a = A[m][e], bb = Bv[m][e];
                    { const float ap = dpp_f<0x111>(1.0f, a), bp = dpp_f<0x111>(0.0f, bb); bb = fmaf(a, bp, bb); a *= ap; }
                    { const float ap = dpp_f<0x112>(1.0f, a), bp = dpp_f<0x112>(0.0f, bb); bb = fmaf(a, bp, bb); a *= ap; }
                    { const float ap = dpp_f<0x114>(1.0f, a), bp = dpp_f<0x114>(0.0f, bb); bb = fmaf(a, bp, bb); a *= ap; }
                    { const float ap = dpp_f<0x118>(1.0f, a), bp = dpp_f<0x118>(0.0f, bb); bb = fmaf(a, bp, bb); a *= ap; }
                    A[m][e] = a; Bv[m][e] = bb; }
            float hc[4], ac[4];
            if (FULL) { const f32x4 cv = *(const LAS f32x4*)(CARRY + c); hc[0] = cv[0]; hc[1] = cv[1]; hc[2] = cv[2]; hc[3] = cv[3]; }
            else { hc[0] = hc[1] = hc[2] = hc[3] = 0.f; }
            ac[0] = ac[1] = ac[2] = ac[3] = 1.f;
#pragma unroll
            for (int m = 0; m < 4; ++m) {
                float hcur[4];
#pragma unroll
                for (int e = 0; e < 4; ++e) { hcur[e] = fmaf(A[m][e], hc[e], Bv[m][e]); hc[e] = bcast15(hcur[e], lane);
                    if (!FULL) ac[e] = bcast15(A[m][e] * ac[e], lane); }
                if (FULL) { const v2u zg = *(const v2u*)(Z + (rowb + t0 + 16 * m + fr) * DIN + OFF_ZG + c);
                    const float g4[4] = {bflo(zg.x), bfhi(zg.x), bflo(zg.y), bfhi(zg.y)};
                    f32x4 yq;
#pragma unroll
                    for (int e = 0; e < 4; ++e) { const float y = gelu_tanh(g4[e]) * hcur[e]; yq[e] = y; ss[m] = fmaf(y, y, ss[m]); }
                    *(LAS f32x4*)(XR + (16 * m + fr) * 68 + cc) = yq; }
            }
            if (!FULL && fr == 0) { const size_t o = ((size_t)b * NBLK + j) * 512 + c; *(f32x4*)(aggA + o) = (f32x4){ac[0], ac[1], ac[2], ac[3]}; *(f32x4*)(aggH + o) = (f32x4){hc[0], hc[1], hc[2], hc[3]}; }
        }
        if (FULL) {
#pragma unroll
            for (int m = 0; m < 4; ++m) { float s = ss[m]; s += __shfl_xor(s, 16); s += __shfl_xor(s, 32); if (fq == 0) SS[wave * 64 + 16 * m + fr] = s; }
            __syncthreads();
#pragma unroll
            for (int m = 0; m < 4; ++m) { float tot = 0.f;
#pragma unroll
                for (int w = 0; w < 8; ++w) tot += SS[w * 64 + 16 * m + fr];
                const float rstd = 1.0f / sqrtf(tot * (1.0f / 512.0f) + EPS);
#pragma unroll
                for (int n = 0; n < 4; ++n) { const int c = 512 + 64 * hd + 16 * n + 4 * fq; const f32x4 mg = *(const f32x4*)(mixg + c);
                    const f32x4 yq = *(const LAS f32x4*)(XR + (16 * m + fr) * 68 + 16 * n + 4 * fq);
                    v2u w; w.x = pk2(yq[0] * rstd * mg[0], yq[1] * rstd * mg[1]); w.y = pk2(yq[2] * rstd * mg[2], yq[3] * rstd * mg[3]);
                    *(v2u*)(Y + (rowb + t0 + 16 * m + fr) * D + c) = w; } }
        }
    } else if (FULL) {
        for (int i = tid; i < 64 * 64; i += NTHR) { const int r = i >> 6, c8 = (i & 63) * 8; *(v4u*)(Y + (rowb + t0 + r) * D + 512 + c8) = (v4u){0u, 0u, 0u, 0u}; }
    }
    if (!FULL) return;
    asm volatile("" ::: "memory");
    if (MIX_MASK & 1) {
        const int tg = tid >> 5, s8 = (tid & 31) * 8; const int tb = t0 + 4 * tg;
        const float* caw = args.in[7] + (size_t)l * 3 * 256;
        float w3[3][8];
#pragma unroll
        for (int k = 0; k < 3; ++k) { const f32x4 w0 = *(const f32x4*)(caw + k * 256 + s8), w1 = *(const f32x4*)(caw + k * 256 + s8 + 4);
#pragma unroll
            for (int e = 0; e < 4; ++e) { w3[k][e] = w0[e]; w3[k][4 + e] = w1[e]; } }
        float cv[6][8];
#pragma unroll
        for (int i = 0; i < 6; ++i) { const int tt = tb - 2 + i; const int tc = tt < 0 ? 0 : tt; const float msk = tt < 0 ? 0.f : 1.f;
            const v4u zc = *(const v4u*)(Z + (rowb + tc) * DIN + OFF_ZC + s8), zv = *(const v4u*)(Z + (rowb + tc) * DIN + OFF_ZV + s8);
            const unsigned a[4] = {zc.x, zc.y, zc.z, zc.w}, bq[4] = {zv.x, zv.y, zv.z, zv.w};
#pragma unroll
            for (int q = 0; q < 4; ++q) { cv[i][2 * q] = msk * bflo(a[q]) * bflo(bq[q]); cv[i][2 * q + 1] = msk * bfhi(a[q]) * bfhi(bq[q]); } }
        const f32x4 mg0 = *(const f32x4*)(mixg + s8), mg1 = *(const f32x4*)(mixg + s8 + 4);
#pragma unroll
        for (int i = 0; i < 4; ++i) {
            const v4u zb = *(const v4u*)(Z + (rowb + tb + i) * DIN + OFF_ZB + s8); const unsigned a[4] = {zb.x, zb.y, zb.z, zb.w};
            float y[8], s = 0.f;
#pragma unroll
            for (int e = 0; e < 8; ++e) { const float zbe = (e & 1) ? bfhi(a[e >> 1]) : bflo(a[e >> 1]);
                y[e] = zbe * (w3[0][e] * cv[i][e] + w3[1][e] * cv[i + 1][e] + w3[2][e] * cv[i + 2][e]); s = fmaf(y[e], y[e], s); }
#pragma unroll
            for (int o = 1; o < 32; o <<= 1) s += __shfl_xor(s, o);
            const float rstd = 1.0f / sqrtf(s * (1.0f / 256.0f) + EPS);
            v4u w; w.x = pk2(y[0] * rstd * mg0[0], y[1] * rstd * mg0[1]); w.y = pk2(y[2] * rstd * mg0[2], y[3] * rstd * mg0[3]);
            w.z = pk2(y[4] * rstd * mg1[0], y[5] * rstd * mg1[1]); w.w = pk2(y[6] * rstd * mg1[2], y[7] * rstd * mg1[3]);
            *(v4u*)(Y + (rowb + tb + i) * D + s8) = w; }
    } else {
        for (int i = tid; i < 64 * 32; i += NTHR) { const int r = i >> 5, c8 = (i & 31) * 8; *(v4u*)(Y + (rowb + t0 + r) * D + c8) = (v4u){0u, 0u, 0u, 0u}; }
    }
    asm volatile("" ::: "memory");
    if (MIX_MASK & 2) {
        __syncthreads();
        const int hf = j & 1, tcs = t0 - 64 * hf, slen = 64 * (hf + 1);
        LAS bf16* Vt = (LAS bf16*)lds;
        const float* lng = args.in[10] + (size_t)l * 256; const float* lnb = args.in[11] + (size_t)l * 256;
        { const f32x4 gq = *(const f32x4*)(lng + 4 * lane), bq = *(const f32x4*)(lnb + 4 * lane);
            for (int s = wave; s < slen; s += NWAVES) {
                const v2u zz = *(const v2u*)(Z + (rowb + tcs + s) * DIN + OFF_ZSV + 4 * lane);
                float v[4] = {gelu_tanh(bflo(zz.x)), gelu_tanh(bfhi(zz.x)), gelu_tanh(bflo(zz.y)), gelu_tanh(bfhi(zz.y))};
                const float mean = wave_sum((v[0] + v[1]) + (v[2] + v[3])) * (1.0f / 256.0f);
#pragma unroll
                for (int e = 0; e < 4; ++e) v[e] -= mean;
                const float var = wave_sum((v[0] * v[0] + v[1] * v[1]) + (v[2] * v[2] + v[3] * v[3])) * (1.0f / 256.0f);
                const float rstd = 1.0f / sqrtf(var + EPS);
#pragma unroll
                for (int e = 0; e < 4; ++e) Vt[(4 * lane + e) * 136 + s] = (bf16)f2bf(v[e] * rstd * gq[e] + bq[e]);
            } }
        __syncthreads();
        const int h = wave >> 1, th = wave & 1;
        const bf16* SGW = (const bf16*)(ws + WS_SGW) + ((size_t)l * 4 + h) * 16384;
        f32x4 acc[2][4];
#pragma unroll
        for (int m = 0; m < 2; ++m)
#pragma unroll
            for (int n = 0; n < 4; ++n) acc[m][n] = (f32x4){0.f, 0.f, 0.f, 0.f};
#pragma unroll
        for (int ks = 0; ks < 4; ++ks) {
            if (ks * 32 < slen) {
                bf16x8 Wq[2];
#pragma unroll
                for (int m = 0; m < 2; ++m) Wq[m] = __builtin_bit_cast(bf16x8, *(const v4u*)(SGW + (size_t)(64 * hf + 32 * th + 16 * m + fr) * 128 + 32 * ks + 8 * fq));
#pragma unroll
                for (int n = 0; n < 4; ++n) { const bf16x8 Vp = *(const LAS bf16x8*)(Vt + (64 * h + 16 * n + fr) * 136 + 32 * ks + 8 * fq);
#pragma unroll
                    for (int m = 0; m < 2; ++m) acc[m][n] = __builtin_amdgcn_mfma_f32_16x16x32_bf16(Vp, Wq[m], acc[m][n], 0, 0, 0); }
            }
        }
        const float* sgb = args.in[9] + ((size_t)l * 4 + h) * 128;
        float ys[2][4][4], s2[2];
#pragma unroll
        for (int m = 0; m < 2; ++m) { const int tl = 32 * th + 16 * m + fr; const float bias = sgb[64 * hf + tl]; float s = 0.f;
#pragma unroll
            for (int n = 0; n < 4; ++n) { const v2u zu = *(const v2u*)(Z + (rowb + t0 + tl) * DIN + OFF_ZU + 64 * h + 16 * n + 4 * fq);
                const float u4[4] = {bflo(zu.x), bfhi(zu.x), bflo(zu.y), bfhi(zu.y)};
#pragma unroll
                for (int e = 0; e < 4; ++e) { const float y = gelu_tanh(u4[e]) * (acc[m][n][e] + bias); ys[m][n][e] = y; s = fmaf(y, y, s); } }
            s += __shfl_xor(s, 16); s += __shfl_xor(s, 32); s2[m] = s; if (fq == 0) SS2[h * 64 + tl] = s; }
        __syncthreads();
#pragma unroll
        for (int m = 0; m < 2; ++m) { const int tl = 32 * th + 16 * m + fr; const float tot = (SS2[tl] + SS2[64 + tl]) + (SS2[128 + tl] + SS2[192 + tl]);
            const float rstd = 1.0f / sqrtf(tot * (1.0f / 256.0f) + EPS);
#pragma unroll
            for (int n = 0; n < 4; ++n) { const int c = 256 + 64 * h + 16 * n + 4 * fq; const f32x4 mg = *(const f32x4*)(mixg + c);
                v2u w; w.x = pk2(ys[m][n][0] * rstd * mg[0], ys[m][n][1] * rstd * mg[1]); w.y = pk2(ys[m][n][2] * rstd * mg[2], ys[m][n][3] * rstd * mg[3]);
                *(v2u*)(Y + (rowb + t0 + tl) * D + c) = w; } }
        (void)s2;
    } else {
        for (int i = tid; i < 64 * 32; i += NTHR) { const int r = i >> 5, c8 = (i & 31) * 8; *(v4u*)(Y + (rowb + t0 + r) * D + 256 + c8) = (v4u){0u, 0u, 0u, 0u}; }
    }
}

__device__ __forceinline__ void route_tile(const Args& args, int l, int tile, const float* X1, LAS unsigned char* lds) {
    FRESH_TID();
    unsigned char* ws = args.ws;
    LAS float* GS = (LAS float*)lds; LAS float* SH = (LAS float*)(lds + 4096); LAS float* SHW = (LAS float*)(lds + 8192); LAS float* RED = (LAS float*)(lds + 8448);
    LAS float* PL = (LAS float*)(lds + 16384); LAS float* PSS = (LAS float*)(lds + 32768); LAS float* RSTD = (LAS float*)(lds + 33280); LAS int* HIST = (LAS int*)(lds + 33792);
    const int row0 = tile * 64, b = row0 >> 12; const int fr = lane & 15, fq = lane >> 4;
    const float* mod = (const float*)(ws + WS_MOD) + (size_t)(l * NB + b) * 6144;
    const float* g2 = args.in[3] + (size_t)l * D;
    for (int k = tid; k < D; k += NTHR) { GS[k] = g2[k] * (1.0f + mod[4 * D + k]); SH[k] = mod[3 * D + k]; }
    if (tid < 32) HIST[tid] = 0;
    __syncthreads();
    if (tid < 32) SHW[tid] = ((const float*)(ws + WS_SHW))[(l * NB + b) * NE + tid];
    const int st = wave >> 1, kh = wave & 1;
    const bf16* RWH = (const bf16*)(ws + WS_RWH) + (size_t)l * NE * D; const bf16* RWL = (const bf16*)(ws + WS_RWL) + (size_t)l * NE * D;
    f32x4 acc[2] = {(f32x4){0.f, 0.f, 0.f, 0.f}, (f32x4){0.f, 0.f, 0.f, 0.f}}; float ssq = 0.f;
    const float* xrow = X1 + (size_t)(row0 + 16 * st + fr) * D;
#pragma unroll 4
    for (int kb = 0; kb < 16; ++kb) {
        const int k = 512 * kh + 32 * kb + 8 * fq;
        const f32x4 x0 = *(const f32x4*)(xrow + k), x1 = *(const f32x4*)(xrow + k + 4);
        const f32x4 g0 = *(const LAS f32x4*)(GS + k), g1 = *(const LAS f32x4*)(GS + k + 4);
        float xs[8], hi[8], lo[8];
#pragma unroll
        for (int e = 0; e < 4; ++e) { xs[e] = x0[e] * g0[e]; xs[4 + e] = x1[e] * g1[e]; ssq = fmaf(x0[e], x0[e], ssq); ssq = fmaf(x1[e], x1[e], ssq); }
        v4u qh, ql; unsigned hh[8], ll[8];
#pragma unroll
        for (int e = 0; e < 8; ++e) { hh[e] = f2bf(xs[e]); hi[e] = __builtin_bit_cast(float, hh[e] << 16); lo[e] = xs[e] - hi[e]; ll[e] = f2bf(lo[e]); }
        qh.x = hh[0] | (hh[1] << 16); qh.y = hh[2] | (hh[3] << 16); qh.z = hh[4] | (hh[5] << 16); qh.w = hh[6] | (hh[7] << 16);
        ql.x = ll[0] | (ll[1] << 16); ql.y = ll[2] | (ll[3] << 16); ql.z = ll[4] | (ll[5] << 16); ql.w = ll[6] | (ll[7] << 16);
        const bf16x8 Qh = __builtin_bit_cast(bf16x8, qh), Ql = __builtin_bit_cast(bf16x8, ql);
#pragma unroll
        for (int n = 0; n < 2; ++n) { const bf16x8 Ph = __builtin_bit_cast(bf16x8, *(const v4u*)(RWH + (size_t)(16 * n + fr) * D + k)), Pl = __builtin_bit_cast(bf16x8, *(const v4u*)(RWL + (size_t)(16 * n + fr) * D + k));
            acc[n] = __builtin_amdgcn_mfma_f32_16x16x32_bf16(Ph, Qh, acc[n], 0, 0, 0);
            acc[n] = __builtin_amdgcn_mfma_f32_16x16x32_bf16(Ph, Ql, acc[n], 0, 0, 0);
            acc[n] = __builtin_amdgcn_mfma_f32_16x16x32_bf16(Pl, Qh, acc[n], 0, 0, 0); }
    }
    ssq += __shfl_xor(ssq, 16); ssq += __shfl_xor(ssq, 32);
#pragma unroll
    for (int n = 0; n < 2; ++n) *(LAS f32x4*)(PL + (wave * 16 + fr) * 32 + 16 * n + 4 * fq) = acc[n];
    if (fq == 0) PSS[wave * 16 + fr] = ssq;
    __syncthreads();
    if (kh == 0) {
        const float tot = PSS[wave * 16 + fr] + PSS[(wave + 1) * 16 + fr]; const float rstd = 1.0f / sqrtf(tot * (1.0f / D) + EPS);
        if (fq == 0) RSTD[16 * st + fr] = rstd;
        float v[8]; int taken = 0;
#pragma unroll
        for (int n = 0; n < 2; ++n) { const f32x4 o = *(const LAS f32x4*)(PL + ((wave + 1) * 16 + fr) * 32 + 16 * n + 4 * fq); const f32x4 sw = *(const LAS f32x4*)(SHW + 16 * n + 4 * fq);
#pragma unroll
            for (int e = 0; e < 4; ++e) v[4 * n + e] = rstd * (acc[n][e] + o[e]) + sw[e]; }
        float selv[4]; int seli[4];
#pragma unroll
        for (int r = 0; r < 4; ++r) {
            float bv = -3.0e38f; int bi = 1 << 20;
#pragma unroll
            for (int q = 0; q < 8; ++q) { const int idx = 16 * (q >> 2) + 4 * fq + (q & 3); const bool ok = !((taken >> q) & 1) && (v[q] > bv); bv = ok ? v[q] : bv; bi = ok ? idx : bi; }
#pragma unroll
            for (int msk = 16; msk <= 32; msk <<= 1) { const float ov = __shfl_xor(bv, msk); const int oi = __shfl_xor(bi, msk); const bool tk = (ov > bv) || (ov == bv && oi < bi); bv = tk ? ov : bv; bi = tk ? oi : bi; }
            selv[r] = bv; seli[r] = bi;
            if (((bi >> 2) & 3) == fq) taken |= 1 << (4 * (bi >> 4) + (bi & 3));
        }
        const float e1 = __expf(selv[1] - selv[0]), e2 = __expf(selv[2] - selv[0]), e3 = __expf(selv[3] - selv[0]); const float inv = 1.0f / (1.0f + e1 + e2 + e3);
        const float wk = (fq == 0 ? 1.0f : fq == 1 ? e1 : fq == 2 ? e2 : e3) * inv; const int ek = fq == 0 ? seli[0] : fq == 1 ? seli[1] : fq == 2 ? seli[2] : seli[3];
        const int rank = __hip_atomic_fetch_add(HIST + ek, 1, __ATOMIC_RELAXED, __HIP_MEMORY_SCOPE_WORKGROUP);
        const size_t ai = (size_t)(row0 + 16 * st + fr) * 4 + fq;
        ((int*)(ws + WS_TOPE))[ai] = ek; ((float*)(ws + WS_TOPW))[ai] = wk; ((int*)(ws + WS_RANK))[ai] = rank;
    }
    __syncthreads();
    unsigned char* H8 = (unsigned char*)(ws + WS_H);
    for (int r = wave * 8; r < wave * 8 + 8; ++r) { const float rstd = RSTD[r] * H_SCALE; const float* xr = X1 + (size_t)(row0 + r) * D;
#pragma unroll
        for (int jj = 0; jj < 4; ++jj) { const int c = 4 * lane + 256 * jj; const f32x4 x = *(const f32x4*)(xr + c); const f32x4 gs = *(const LAS f32x4*)(GS + c), sh = *(const LAS f32x4*)(SH + c);
            const f32x4 o = x * rstd * gs + sh * H_SCALE;
            *(unsigned*)(H8 + (size_t)(row0 + r) * D + c) = pg8::pk4_i8(o[0], o[1], o[2], o[3]); } }
    if (tid < 32) ((int*)(ws + WS_CNT))[tile * 32 + tid] = HIST[tid];
    __syncthreads();
}

__device__ __forceinline__ void gather_phase(const Args& args, LAS unsigned char* lds, int vcu, int G) {
    FRESH_TID();
    unsigned char* ws = args.ws;
    LAS int* PART = (LAS int*)lds; LAS int* SEGS = (LAS int*)(lds + 2048); LAS int* BASE = (LAS int*)(lds + 2304); LAS int* SL = (LAS int*)(lds + 2560);
    LAS int* TILEE = (LAS int*)(lds + L_TILEE); LAS int* NMp = (LAS int*)(lds + L_NM);
    const int* CNT = (const int*)(ws + WS_CNT);
    { const int e = tid & 31, q = tid >> 5; int s = 0;
#pragma unroll
        for (int t = 0; t < 16; ++t) s += CNT[(16 * q + t) * 32 + e];
        PART[q * 32 + e] = s; }
    __syncthreads();
    if (tid < 64) {
        int tot = 0;
        if (tid < 32) {
#pragma unroll
            for (int q = 0; q < 16; ++q) tot += PART[q * 32 + tid]; }
        const int nt = (tot + 255) >> 8; int inc = nt;
#pragma unroll
        for (int o = 1; o < 32; o <<= 1) { const int t = __shfl_up(inc, o); if (lane >= o) inc += t; }
        const int run = inc - nt;
        if (tid < 32) { SEGS[tid] = run * 256; for (int t = 0; t < nt; ++t) TILEE[run + t] = tid; }
        if (tid == 31) NMp[0] = inc;
    }
    __syncthreads();
    const unsigned char* H8 = (const unsigned char*)(ws + WS_H); unsigned char* XG = (unsigned char*)(ws + WS_XG);
    for (int tile = vcu; tile < NRT; tile += G) {
        if (tid < 32) { const int qt = tile >> 4; int s = SEGS[tid];
            for (int q = 0; q < qt; ++q) s += PART[q * 32 + tid];
            for (int t = 16 * qt; t < tile; ++t) s += CNT[t * 32 + tid];
            BASE[tid] = s; }
        __syncthreads();
        if (tid < 256) { const size_t ai = (size_t)tile * 256 + tid; const int e = ((const int*)(ws + WS_TOPE))[ai]; const int slot = BASE[e] + ((const int*)(ws + WS_RANK))[ai];
            ((int*)(ws + WS_SLOT))[ai] = slot; SL[tid] = slot; }
        __syncthreads();
        for (int a0 = wave * 32; a0 < wave * 32 + 32; a0 += 4) {
            const int tok = tile * 64 + (a0 >> 2); const v4u x0 = ((const v4u*)(H8 + (size_t)tok * D))[lane];
#pragma unroll
            for (int k = 0; k < 4; ++k) ((v4u*)(XG + (size_t)SL[a0 + k] * D))[lane] = x0; }
        __syncthreads();
    }
}

template <bool MOE, bool LAST>
__device__ __forceinline__ void combine_rows(const Args& args, int l, const float* X1, float* XN, int vcu, int G) {
    FRESH_TID(); const int gw = vcu * NWAVES + wave, NGW = G * NWAVES;
    unsigned char* ws = args.ws;
    const bf16* YE = (const bf16*)(ws + WS_XG); bf16* H = (bf16*)(ws + WS_H);
    int rpw = 1; while (rpw * NGW < T) rpw <<= 1;
    const int rbeg = gw * rpw, rend = (rbeg + rpw < T) ? rbeg + rpw : T;
    if (rbeg >= T) return;
    const int b = rbeg >> 12;
    const float* modl = (const float*)(ws + WS_MOD) + (size_t)(l * NB + b) * 6144;
    f32x4 gt[4], pa[4], pb[4];
#pragma unroll
    for (int q = 0; q < 4; ++q) { const int c = 8 * lane + 512 * (q >> 1) + 4 * (q & 1);
        gt[q] = MOE ? *(const f32x4*)(modl + 5 * D + c) : (f32x4){0.f, 0.f, 0.f, 0.f};
        if (LAST) { pa[q] = *(const f32x4*)(args.in[25] + c); pb[q] = (f32x4){0.f, 0.f, 0.f, 0.f}; }
        else { const float* modn = (const float*)(ws + WS_MOD) + (size_t)((l + 1) * NB + b) * 6144; const f32x4 g = *(const f32x4*)(args.in[2] + (size_t)(l + 1) * D + c), sc = *(const f32x4*)(modn + D + c);
            pa[q] = g * (sc + 1.0f); pb[q] = *(const f32x4*)(modn + c); } }
    int myslot = 0; float myw = 0.f;
    if (MOE && rpw * 4 <= 64 && lane < (rend - rbeg) * 4) { myslot = ((const int*)(ws + WS_SLOT))[(size_t)rbeg * 4 + lane]; myw = ((const float*)(ws + WS_TOPW))[(size_t)rbeg * 4 + lane]; }
#pragma unroll 2
    for (int row = rbeg; row < rend; ++row) {
        const float* xr = X1 + (size_t)row * D + 8 * lane;
        f32x4 v[4];
#pragma unroll
        for (int q = 0; q < 4; ++q) v[q] = *(const f32x4*)(xr + 512 * (q >> 1) + 4 * (q & 1));
        if (MOE) {
            f32x4 a[4] = {(f32x4){0.f, 0.f, 0.f, 0.f}, (f32x4){0.f, 0.f, 0.f, 0.f}, (f32x4){0.f, 0.f, 0.f, 0.f}, (f32x4){0.f, 0.f, 0.f, 0.f}};
            v4u y[4][2]; float w[4];
#pragma unroll
            for (int k = 0; k < 4; ++k) { int slot;
                if (rpw * 4 <= 64) { slot = __builtin_amdgcn_readlane(myslot, (row - rbeg) * 4 + k); w[k] = __builtin_bit_cast(float, __builtin_amdgcn_readlane(__builtin_bit_cast(int, myw), (row - rbeg) * 4 + k)); }
                else { slot = ((const int*)(ws + WS_SLOT))[(size_t)row * 4 + k]; w[k] = ((const float*)(ws + WS_TOPW))[(size_t)row * 4 + k]; }
                slot = __builtin_amdgcn_readfirstlane(slot);
                const bf16* yr = YE + (size_t)slot * D + 8 * lane; y[k][0] = *(const v4u*)(yr); y[k][1] = *(const v4u*)(yr + 512); }
#pragma unroll
            for (int k = 0; k < 4; ++k)
#pragma unroll
                for (int hh = 0; hh < 2; ++hh) { const v4u t = y[k][hh];
                    a[2 * hh] += w[k] * (f32x4){bflo(t.x), bfhi(t.x), bflo(t.y), bfhi(t.y)}; a[2 * hh + 1] += w[k] * (f32x4){bflo(t.z), bfhi(t.z), bflo(t.w), bfhi(t.w)}; }
#pragma unroll
            for (int q = 0; q < 4; ++q) v[q] += gt[q] * a[q];
        }
        float s = 0.f;
#pragma unroll
        for (int q = 0; q < 4; ++q) s += (v[q][0] * v[q][0] + v[q][1] * v[q][1]) + (v[q][2] * v[q][2] + v[q][3] * v[q][3]);
        const float rstd = 1.0f / sqrtf(wave_sum(s) * (1.0f / D) + EPS);
        if (LAST) {
#pragma unroll
            for (int q = 0; q < 4; ++q) *(f32x4*)(args.out + (size_t)row * D + 8 * lane + 512 * (q >> 1) + 4 * (q & 1)) = v[q] * rstd * pa[q];
        } else {
#pragma unroll
            for (int q = 0; q < 4; ++q) *(f32x4*)(XN + (size_t)row * D + 8 * lane + 512 * (q >> 1) + 4 * (q & 1)) = v[q];
#pragma unroll
            for (int hh = 0; hh < 2; ++hh) { const f32x4 o0 = v[2 * hh] * rstd * pa[2 * hh] + pb[2 * hh], o1 = v[2 * hh + 1] * rstd * pa[2 * hh + 1] + pb[2 * hh + 1];
                v4u wv; wv.x = pk2(o0[0], o0[1]); wv.y = pk2(o0[2], o0[3]); wv.z = pk2(o1[0], o1[1]); wv.w = pk2(o1[2], o1[3]);
                *(v4u*)(H + (size_t)row * D + 8 * lane + 512 * hh) = wv; }
        }
    }
}

template <int L> __device__ __forceinline__ void layer_body(const Args& args, LAS unsigned char* lds, const XcdBarrier& bar, int vcu, int G, const float* xin, float* xnext) {
    unsigned char* ws = args.ws;
    constexpr bool MIX = (RUN_MASK >> (2 * L)) & 1, MOE = (RUN_MASK >> (2 * L + 1)) & 1, LAST = (L == DEPTH - 1);
    const float* modl = (const float*)(ws + WS_MOD) + (size_t)L * NB * 6144;
    float* XA = (float*)(ws + WS_XA);
    const float* x1 = xin;
    if (MIX) {
        if (PH(2)) { asm volatile("; PHASE_MARK P2" ::: "memory");
            _Pragma("unroll 1") for (int rep = 0; rep < NREP(2); ++rep) {
            pg8::Gemm g{(const bf16*)(ws + WS_H), (const bf16*)(ws + WS_WIN) + (size_t)L * DIN * D, D}; pg8::StaticOrder S; S.init(T / 256, DIN / 256, G, (int)blockIdx.x);
            pg8::EpiBf16 E{(bf16*)(ws + WS_Z), DIN, nullptr, 0, 1.0f};
            pg8::gemm_phase<pg8::EpiBf16, pg8::StaticOrder>(lds, g, S, E);
            xcd_barrier(bar); }
        }
        if (PH(3) & ((MIX_MASK >> 2) & 1)) { asm volatile("; PHASE_MARK P3a" ::: "memory");
            _Pragma("unroll 1") for (int rep = 0; rep < NREP(3); ++rep) {
            for (int u = vcu; u < NB * NBLK; u += G) { mixer_unit<false>(args, L, u >> 6, u & 63, lds); __syncthreads(); }
            xcd_barrier(bar); }
        }
        if (PH(4)) { asm volatile("; PHASE_MARK P3b" ::: "memory");
            _Pragma("unroll 1") for (int rep = 0; rep < NREP(4); ++rep) {
            for (int u = vcu; u < NB * NBLK; u += G) { mixer_unit<true>(args, L, u >> 6, u & 63, lds); __syncthreads(); }
            xcd_barrier(bar); }
        }
        if (PH(5)) { asm volatile("; PHASE_MARK P4" ::: "memory");
            _Pragma("unroll 1") for (int rep = 0; rep < NREP(5); ++rep) {
            pg8::Gemm g{(const bf16*)(ws + WS_Y), (const bf16*)(ws + WS_WOUT) + (size_t)L * D * D, D}; pg8::StaticOrder S; S.init(T / 256, D / 256, G, (int)blockIdx.x);
            pg8::EpiResGate E{xin, XA, modl + 2 * D};
            pg8::gemm_phase<pg8::EpiResGate, pg8::StaticOrder>(lds, g, S, E);
            xcd_barrier(bar); }
        }
        x1 = XA;
    }
    if (MOE) {
        if (PH(6)) { asm volatile("; PHASE_MARK P5" ::: "memory");
            _Pragma("unroll 1") for (int rep = 0; rep < NREP(6); ++rep) {
            for (int tile = vcu; tile < NRT; tile += G) route_tile(args, L, tile, x1, lds);
            xcd_barrier(bar); }
        }
        if (PH(7)) { asm volatile("; PHASE_MARK P6" ::: "memory");
            _Pragma("unroll 1") for (int rep = 0; rep < NREP(7); ++rep) {
            gather_phase(args, lds, vcu, G);
            xcd_barrier(bar); }
        }
        const int nM = *(const LAS int*)(lds + L_NM);
        if (PH(8)) { asm volatile("; PHASE_MARK P7" ::: "memory");
            _Pragma("unroll 1") for (int rep = 0; rep < NREP(8); ++rep) {
            pg8::Gemm g{(const bf16*)(ws + WS_XG), (const bf16*)(ws + WS_W1 + (size_t)L * NE * 2048 * D), D}; pg8::MoeOrder S; S.init(nM, 8, G, (int)blockIdx.x); S.tile_e = (const LAS int*)(lds + L_TILEE);
            pg8::EpiSwiglu E{(unsigned char*)(ws + WS_ACT), args.in[22] + (size_t)L * NE * 2048, 1.0f / (H_SCALE * W_SCALE), ACT_SCALE};
            pg8::gemm_phase<pg8::EpiSwiglu, pg8::MoeOrder, true>(lds, g, S, E);
            xcd_barrier(bar); }
        }
        if (PH(9)) { asm volatile("; PHASE_MARK P8" ::: "memory");
            _Pragma("unroll 1") for (int rep = 0; rep < NREP(9); ++rep) {
            pg8::Gemm g{(const bf16*)(ws + WS_ACT), (const bf16*)(ws + WS_W2 + (size_t)L * NE * D * FF), FF}; pg8::MoeOrder S; S.init(nM, 4, G, (int)blockIdx.x); S.tile_e = (const LAS int*)(lds + L_TILEE);
            pg8::EpiBf16 E{(bf16*)(ws + WS_XG), D, args.in[24] + (size_t)L * NE * D, D, 1.0f / (ACT_SCALE * W_SCALE)};
            pg8::gemm_phase<pg8::EpiBf16, pg8::MoeOrder, true>(lds, g, S, E);
            xcd_barrier(bar); }
        }
    }
    asm volatile("; PHASE_MARK P9" ::: "memory");
    if (PH(10)) { _Pragma("unroll 1") for (int rep = 0; rep < NREP(10); ++rep) { combine_rows<MOE, LAST>(args, L, x1, xnext, vcu, G); if (!LAST) xcd_barrier(bar); } }
}

__global__ void __launch_bounds__(NTHR, 2) fwd_kernel(Args args) {
    extern __shared__ __attribute__((aligned(16))) unsigned char lds_raw[];
    LAS unsigned char* lds = (LAS unsigned char*)lds_raw;
    const int tid = threadIdx.x;
    const int G = gridDim.x; const int bx = blockIdx.x; const int vcu = (G % 8 == 0) ? (bx % 8) * (G / 8) + bx / 8 : bx;
    unsigned char* ws = args.ws;
    for (int u = tid; u < (LDS_BYTES - LDSCTL_OFF) / 4; u += NTHR) ((LAS unsigned*)(lds + LDSCTL_OFF))[u] = 0u;
    __syncthreads();
    XcdBarrier bar = xcd_barrier_post((unsigned*)(ws + WS_CTL) + CW_BAR, (volatile LAS unsigned*)(lds + L_MISC) + 8);
    asm volatile("; PHASE_MARK P0" ::: "memory");
    _Pragma("unroll 1") for (int rep = 0; rep < NREP(0); ++rep) { if (PH(0)) pro_phase(args, lds, vcu, G); xcd_barrier(bar); }
    { shw_phase(args, lds, vcu, G); if (PH(1) & (RUN_MASK & 1)) { const float* mod0 = (const float*)(ws + WS_MOD); adaln_rows(args.in[0], (bf16*)(ws + WS_H), args.in[2], mod0, mod0 + D, vcu, G); } xcd_barrier(bar); }
    layer_body<0>(args, lds, bar, vcu, G, args.in[0], (float*)(ws + WS_XB));
    layer_body<1>(args, lds, bar, vcu, G, (const float*)(ws + WS_XB), nullptr);
}

extern "C" void kernel_launch(void* const* d_in, const int* in_sizes, int n_in, void* d_out, int out_size, void* d_ws, size_t ws_size, hipStream_t stream) {
    static int grid = 0;
    if (grid == 0) {
        if (n_in != 26 || in_sizes[0] != T * D || out_size != T * D || ws_size < WS_END) { fprintf(stderr, "kernel_launch: unexpected shapes (n_in %d, in0 %d, out %d, ws %zu < %zu); nothing launched\n", n_in, n_in > 0 ? in_sizes[0] : -1, out_size, ws_size, (size_t)WS_END); grid = -1; return; }
        int dev = 0, cus = 0, per_cu = 0;
        if (hipGetDevice(&dev) != hipSuccess || hipDeviceGetAttribute(&cus, hipDeviceAttributeMultiprocessorCount, dev) != hipSuccess) { grid = -1; return; }
        if (hipFuncSetAttribute((const void*)fwd_kernel, hipFuncAttributeMaxDynamicSharedMemorySize, LDS_BYTES) != hipSuccess) { fprintf(stderr, "kernel_launch: hipFuncSetAttribute failed\n"); grid = -1; return; }
        if (hipOccupancyMaxActiveBlocksPerMultiprocessor(&per_cu, (const void*)fwd_kernel, NTHR, LDS_BYTES) != hipSuccess || per_cu < 1) { fprintf(stderr, "kernel_launch: occupancy query says %d blocks per CU\n", per_cu); }
        (void)hipGetLastError();
        grid = cus;
    }
    if (grid < 0) return;
    if (hipMemsetAsync((char*)d_ws + WS_CTL, 0, CTL_ZERO_BYTES, stream) != hipSuccess) return;
    Args a{};
    for (int i = 0; i < 26; ++i) a.in[i] = (const float*)d_in[i];
    a.out = (float*)d_out; a.ws = (unsigned char*)d_ws; a.ph_lo = 0; a.ph_hi = 0;
    hipLaunchKernelGGL(fwd_kernel, dim3(grid), dim3(NTHR), LDS_BYTES, stream, a);
}
```

```cpp
#include <hip/hip_runtime.h>
#include <cstdio>
#include <cstdint>

#ifndef RUN_MASK
#define RUN_MASK 15
#endif
#ifndef PH_ENABLE
#define PH_ENABLE 0x7ff
#endif
#define PH(k) ((PH_ENABLE >> (k)) & 1)
#ifndef DUP_MASK
#define DUP_MASK 0
#endif
#define NREP(k) (1 + ((DUP_MASK >> (k)) & 1))
#ifndef MIX_MASK
#define MIX_MASK 7
#endif

namespace pg8 {
#define PG8_LAS __attribute__((address_space(3)))
typedef unsigned short bf16_t;
typedef short bf16x8 __attribute__((ext_vector_type(8)));
typedef float f32x4 __attribute__((ext_vector_type(4)));
typedef unsigned u32x4 __attribute__((ext_vector_type(4)));
typedef int i32x4 __attribute__((ext_vector_type(4)));
typedef int i32x8 __attribute__((ext_vector_type(8)));
constexpr int BM = 256, BK = 64, HALF = 128, HTB = HALF * BK * 2, STAGE_BYTES = 8 * HTB, NXCD = 8, WGM = 8;

__host__ __device__ __forceinline__ int lds_byte(int r, int c) { const int st = (r >> 4) * 2 + (c >> 5), rr = r & 15, cc = c & 31, ob = rr * 64 + cc * 2; return st * 1024 + (ob ^ (((ob >> 9) & 1) << 5)); }
__host__ __device__ __forceinline__ void stage_rc(int b, int& R, int& C) { const int st = b / 1024, sb = b % 1024, swz = sb ^ (((sb >> 9) & 1) << 5); R = (st >> 1) * 16 + swz / 64; C = (st & 1) * 32 + (swz % 64) / 2; }
__host__ __device__ __forceinline__ int perm32(int rho) { const int n = rho >> 4, i = rho & 15; return 8 * (i >> 2) + 4 * n + (i & 3); }

struct Unit { int pm, pn, pb, e; };
struct Gemm { const bf16_t* A; const bf16_t* Bt; int K; };

struct StaticOrder {
    int nM, nN, nwg, G, c;
    __device__ void init(int nM_, int nN_, int G_, int c_) { nM = nM_; nN = nN_; nwg = nM * nN; G = G_; c = c_; }
    __device__ __forceinline__ bool map(int i, Unit& u) const {
        const long L = (long)i * G + c; if (L >= nwg) return false;
        int wgid = (int)L; { const int q = nwg / NXCD, r = nwg % NXCD, xcd = wgid % NXCD, off = wgid / NXCD; wgid = (xcd < r ? xcd * (q + 1) : r * (q + 1) + (xcd - r) * q) + off; }
        const int nig = WGM * nN, gid = wgid / nig, fm = gid * WGM, gsz = (nM - fm) < WGM ? (nM - fm) : WGM;
        u.pm = fm + ((wgid % nig) % gsz); u.pn = (wgid % nig) / gsz; return true;
    }
    __device__ __forceinline__ bool next(int i, Unit& u) const { if (!map(i, u)) return false; u.pb = u.pn; u.e = 0; return true; }
};
struct MoeOrder : StaticOrder {
    const PG8_LAS int* tile_e;
    __device__ __forceinline__ bool next(int i, Unit& u) const { if (!map(i, u)) return false; u.e = tile_e[u.pm]; u.pb = u.e * nN + u.pn; return true; }
};

__device__ __forceinline__ unsigned cvt_pk_bf16(float lo, float hi) { unsigned r; asm volatile("v_cvt_pk_bf16_f32 %0, %1, %2" : "=v"(r) : "v"(lo), "v"(hi)); return r; }

__device__ __forceinline__ unsigned q_i8(float x) { return (unsigned)__float2int_rn(fminf(fmaxf(x, -127.0f), 127.0f)) & 0xffu; }
__device__ __forceinline__ unsigned pk4_i8(float a, float b, float c, float d) { return q_i8(a) | (q_i8(b) << 8) | (q_i8(c) << 16) | (q_i8(d) << 24); }
struct EpiBf16 {
    static constexpr bool PERM = true;
    bf16_t* O; int ldc; const float* bias; int bstride; float sc;
    template <class AT> __device__ __forceinline__ void operator()(const AT (&acc)[2][2][4][2], const Unit& u, int wr, int wc, int fr, int fq) const {
        const int row0 = u.pm * BM + wr * 64 + fr; const int col0 = u.pn * BM + wc * 32 + 8 * fq;
        f32x4 bv[2][2];
#pragma unroll
        for (int bj = 0; bj < 2; ++bj)
#pragma unroll
            for (int n = 0; n < 2; ++n) bv[bj][n] = bias ? *(const f32x4*)(bias + (size_t)u.e * bstride + col0 + bj * HALF + 4 * n) : (f32x4){0.f, 0.f, 0.f, 0.f};
#pragma unroll
        for (int ai = 0; ai < 2; ++ai)
#pragma unroll
            for (int m = 0; m < 4; ++m) { bf16_t* rowp = O + (size_t)(row0 + ai * HALF + m * 16) * ldc + col0;
#pragma unroll
                for (int bj = 0; bj < 2; ++bj) { const f32x4 v0 = __builtin_convertvector(acc[ai][bj][m][0], f32x4) * sc + bv[bj][0], v1 = __builtin_convertvector(acc[ai][bj][m][1], f32x4) * sc + bv[bj][1];
                    u32x4 w; w.x = cvt_pk_bf16(v0[0], v0[1]); w.y = cvt_pk_bf16(v0[2], v0[3]); w.z = cvt_pk_bf16(v1[0], v1[1]); w.w = cvt_pk_bf16(v1[2], v1[3]);
                    *(u32x4*)(rowp + bj * HALF) = w; } }
    }
};
struct EpiSwiglu {
    static constexpr bool PERM = true;
    unsigned char* O; const float* b1; float sc, osc;
    template <class AT> __device__ __forceinline__ void operator()(const AT (&acc)[2][2][4][2], const Unit& u, int wr, int wc, int fr, int fq) const {
        const int row0 = u.pm * BM + wr * 64 + fr; const int cg = u.pn * HALF + wc * 32 + 8 * fq;
        const float* bg = b1 + (size_t)u.e * 2048 + cg;
        const f32x4 bg0 = *(const f32x4*)(bg), bg1 = *(const f32x4*)(bg + 4), bu0 = *(const f32x4*)(bg + 1024), bu1 = *(const f32x4*)(bg + 1028);
#pragma unroll
        for (int ai = 0; ai < 2; ++ai)
#pragma unroll
            for (int m = 0; m < 4; ++m) {
                const f32x4 g0 = __builtin_convertvector(acc[ai][0][m][0], f32x4) * sc + bg0, g1 = __builtin_convertvector(acc[ai][0][m][1], f32x4) * sc + bg1, u0 = __builtin_convertvector(acc[ai][1][m][0], f32x4) * sc + bu0, u1 = __builtin_convertvector(acc[ai][1][m][1], f32x4) * sc + bu1;
                float o[8];
#pragma unroll
                for (int j = 0; j < 8; ++j) { float g = j < 4 ? g0[j & 3] : g1[j & 3], uu = j < 4 ? u0[j & 3] : u1[j & 3];
                    g = fminf(g, 7.0f); uu = fminf(fmaxf(uu, -7.0f), 7.0f);
                    const float sg = __builtin_amdgcn_rcpf(1.0f + __builtin_amdgcn_exp2f(g * (-1.702f * 1.4426950408889634f)));
                    o[j] = (uu + 1.0f) * (g * sg) * osc; }
                const int w0 = (int)pk4_i8(o[0], o[1], o[2], o[3]), w1 = (int)pk4_i8(o[4], o[5], o[6], o[7]);
                typedef int i32x2 __attribute__((ext_vector_type(2)));
                *(i32x2*)(O + (size_t)(row0 + ai * HALF + m * 16) * 1024 + cg) = (i32x2){w0, w1}; }
    }
};
template <bool XBF> struct EpiResGate {
    static constexpr bool PERM = true;
    const void* X; bf16_t* O; const float* gate;
    template <class AT> __device__ __forceinline__ void operator()(const AT (&acc)[2][2][4][2], const Unit& u, int wr, int wc, int fr, int fq) const {
        const int row0 = u.pm * BM + wr * 64 + fr, col0 = u.pn * BM + wc * 32 + 8 * fq; const int b = (u.pm * BM) >> 12;
        f32x4 gv[2][2];
#pragma unroll
        for (int bj = 0; bj < 2; ++bj)
#pragma unroll
            for (int n = 0; n < 2; ++n) gv[bj][n] = *(const f32x4*)(gate + b * 6144 + col0 + bj * HALF + 4 * n);
#pragma unroll
        for (int ai = 0; ai < 2; ++ai)
#pragma unroll
            for (int m = 0; m < 4; ++m) { const size_t off = (size_t)(row0 + ai * HALF + m * 16) * 1024 + col0;
#pragma unroll
                for (int bj = 0; bj < 2; ++bj) { f32x4 x0, x1;
                    if (XBF) { const u32x4 w = *(const u32x4*)((const bf16_t*)X + off + bj * HALF);
                        x0 = (f32x4){__builtin_bit_cast(float, w.x << 16), __builtin_bit_cast(float, w.x & 0xffff0000u), __builtin_bit_cast(float, w.y << 16), __builtin_bit_cast(float, w.y & 0xffff0000u)};
                        x1 = (f32x4){__builtin_bit_cast(float, w.z << 16), __builtin_bit_cast(float, w.z & 0xffff0000u), __builtin_bit_cast(float, w.w << 16), __builtin_bit_cast(float, w.w & 0xffff0000u)}; }
                    else { x0 = *(const f32x4*)((const float*)X + off + bj * HALF); x1 = *(const f32x4*)((const float*)X + off + bj * HALF + 4); }
                    const f32x4 v0 = x0 + gv[bj][0] * __builtin_convertvector(acc[ai][bj][m][0], f32x4), v1 = x1 + gv[bj][1] * __builtin_convertvector(acc[ai][bj][m][1], f32x4);
                    u32x4 w; w.x = cvt_pk_bf16(v0[0], v0[1]); w.y = cvt_pk_bf16(v0[2], v0[3]); w.z = cvt_pk_bf16(v1[0], v1[1]); w.w = cvt_pk_bf16(v1[2], v1[3]);
                    *(u32x4*)(O + off + bj * HALF) = w; }
                asm volatile("" ::: "memory"); }
    }
};
template <bool I8> struct AccSel { typedef f32x4 type; };
template <> struct AccSel<true> { typedef i32x4 type; };
__device__ __forceinline__ f32x4 mma16(bf16x8 b, bf16x8 a, f32x4 c) { return __builtin_amdgcn_mfma_f32_16x16x32_bf16(b, a, c, 0, 0, 0); }
__device__ __forceinline__ i32x4 mma16(bf16x8 b, bf16x8 a, i32x4 c) { return __builtin_amdgcn_mfma_i32_16x16x64_i8(__builtin_bit_cast(i32x4, b), __builtin_bit_cast(i32x4, a), c, 0, 0, 0); }
template <class Epi, class Sched, bool I8 = false>
__device__ __forceinline__ void gemm_phase(PG8_LAS unsigned char* lds, const Gemm g, const Sched& S, const Epi& E) {
    int tid_ = threadIdx.x; asm volatile("" : "+v"(tid_));
    const int tid = tid_, wid = __builtin_amdgcn_readfirstlane(tid >> 6), lane = tid & 63, wr = wid >> 2, wc = wid & 3, fr = lane & 15, fq = lane >> 4;
    const int K = I8 ? g.K / 2 : g.K, nt = K / BK;
    unsigned voffA[2], voffB[2];
#pragma unroll
    for (int i = 0; i < 2; ++i) { int R, C; stage_rc(tid * 16 + i * 8192, R, C); const int Rb = Epi::PERM ? ((R & ~31) + perm32(R & 31)) : R;
        voffA[i] = (unsigned)(R * K + C) * 2u; voffB[i] = (unsigned)(Rb * K + C) * 2u; }
    const size_t kstep = (size_t)(BK * 2);
    const size_t hstep = (size_t)HALF * K * 2;
    const size_t tstep = 2 * hstep;
    const unsigned ldsw = (unsigned)wid * 1024u;
    const int aoff = lds_byte(wr * 64 + fr, fq * 8), boff = lds_byte(wc * 32 + fr, fq * 8);
#define PG8_SA(b, h) (((b) * 2 + (h)) * HTB)
#define PG8_SB(b, h) ((4 + (b) * 2 + (h)) * HTB)
#define PG8_STAGE(bufoff, gbase, voff) do { _Pragma("unroll") for (int _i = 0; _i < 2; ++_i) \
        __builtin_amdgcn_global_load_lds((const unsigned*)((const char*)(gbase) + (voff)[_i]), (PG8_LAS unsigned*)(lds + (bufoff) + ldsw + _i * 8192), 16, 0, 0); } while (0)
#define PG8_LDA(dst, b, h) do { _Pragma("unroll") for (int m = 0; m < 4; ++m) _Pragma("unroll") for (int k = 0; k < 2; ++k) dst[m][k] = *(const PG8_LAS bf16x8*)(lds + PG8_SA(b, h) + aoff + m * 2048 + k * 1024); } while (0)
#define PG8_LDB(dst, b, h) do { _Pragma("unroll") for (int n = 0; n < 2; ++n) _Pragma("unroll") for (int k = 0; k < 2; ++k) dst[n][k] = *(const PG8_LAS bf16x8*)(lds + PG8_SB(b, h) + boff + n * 2048 + k * 1024); } while (0)
#define PG8_MMA(ai, bj, At, Bt) do { __builtin_amdgcn_s_setprio(1); _Pragma("unroll") for (int m = 0; m < 4; ++m) _Pragma("unroll") for (int n = 0; n < 2; ++n) _Pragma("unroll") for (int k = 0; k < 2; ++k) \
        acc[ai][bj][m][n] = mma16(Bt[n][k], At[m][k], acc[ai][bj][m][n]); __builtin_amdgcn_s_setprio(0); } while (0)
#define PG8_WAIT_V(n) asm volatile("s_waitcnt vmcnt(" #n ")" ::: "memory")
#define PG8_WAIT_L(n) asm volatile("s_waitcnt lgkmcnt(" #n ")" ::: "memory")
#define PG8_BAR __builtin_amdgcn_s_barrier()
#define PG8_SCHED __builtin_amdgcn_sched_barrier(0)
    Unit cur, nxt; int ui = 0;
    if (!S.next(0, cur)) return;
    typedef typename AccSel<I8>::type AccT;
    AccT acc[2][2][4][2];
#pragma unroll
    for (int a = 0; a < 2; ++a)
#pragma unroll
        for (int b = 0; b < 2; ++b)
#pragma unroll
            for (int m = 0; m < 4; ++m)
#pragma unroll
                for (int n = 0; n < 2; ++n) acc[a][b][m][n] = AccT{};
    bf16x8 At[4][2], B0[2][2], B1[2][2];
    const char* cA = (const char*)g.A + (size_t)cur.pm * tstep; const char* cB = (const char*)g.Bt + (size_t)cur.pb * tstep;
    PG8_STAGE(PG8_SB(0, 0), cB, voffB); PG8_STAGE(PG8_SB(0, 1), cB + hstep, voffB); PG8_STAGE(PG8_SA(0, 0), cA, voffA); PG8_STAGE(PG8_SA(0, 1), cA + hstep, voffA);
    if (wr == 1) PG8_BAR;
    PG8_WAIT_V(2); PG8_BAR;
    PG8_STAGE(PG8_SB(1, 0), cB + kstep, voffB); PG8_STAGE(PG8_SA(1, 0), cA + kstep, voffA); PG8_STAGE(PG8_SB(1, 1), cB + hstep + kstep, voffB);
    PG8_WAIT_V(6); PG8_BAR;
    for (;;) {
        const bool has_next = S.next(ui + 1, nxt);
        const char* nA = has_next ? (const char*)g.A + (size_t)nxt.pm * tstep : cA; const char* nB = has_next ? (const char*)g.Bt + (size_t)nxt.pb * tstep : cB;
#pragma unroll 1
        for (int t = 0; t < nt; t += 2) {
            const bool last = (t == nt - 2);
            const char* a1 = cA + (size_t)(t + 1) * kstep;
            const char* a2 = last ? nA : cA + (size_t)(t + 2) * kstep; const char* b2 = last ? nB : cB + (size_t)(t + 2) * kstep;
            const char* a3 = a2 + kstep; const char* b3 = b2 + kstep;
            PG8_LDB(B0, 0, 0); PG8_LDB(B1, 0, 1); PG8_SCHED; PG8_LDA(At, 0, 0); PG8_STAGE(PG8_SA(1, 1), a1 + hstep, voffA);
            PG8_WAIT_V(8); PG8_WAIT_L(0); PG8_BAR; PG8_MMA(0, 0, At, B0); PG8_MMA(0, 1, At, B1); PG8_BAR; PG8_SCHED;
            PG8_LDA(At, 0, 1); PG8_STAGE(PG8_SB(0, 0), b2, voffB); PG8_STAGE(PG8_SB(0, 1), b2 + hstep, voffB); PG8_STAGE(PG8_SA(0, 0), a2, voffA);
            PG8_WAIT_V(8); PG8_WAIT_L(0); PG8_BAR; PG8_MMA(1, 0, At, B0); PG8_MMA(1, 1, At, B1); PG8_BAR; PG8_SCHED;
            PG8_LDB(B0, 1, 0); PG8_LDB(B1, 1, 1); PG8_SCHED; PG8_LDA(At, 1, 0); PG8_STAGE(PG8_SA(0, 1), a2 + hstep, voffA);
            PG8_WAIT_V(8); PG8_WAIT_L(0); PG8_BAR; PG8_MMA(0, 0, At, B0); PG8_MMA(0, 1, At, B1); PG8_BAR; PG8_SCHED;
            PG8_LDA(At, 1, 1); PG8_STAGE(PG8_SB(1, 0), b3, voffB); PG8_STAGE(PG8_SB(1, 1), b3 + hstep, voffB); PG8_STAGE(PG8_SA(1, 0), a3, voffA);
            PG8_WAIT_V(8); PG8_WAIT_L(0); PG8_BAR; PG8_MMA(1, 0, At, B0); PG8_MMA(1, 1, At, B1); PG8_BAR; PG8_SCHED;
        }
        if (wr == 0) PG8_BAR;
        E(acc, cur, wr, wc, fr, fq);
        if (!has_next) break;
#pragma unroll
        for (int a = 0; a < 2; ++a)
#pragma unroll
            for (int b = 0; b < 2; ++b)
#pragma unroll
                for (int m = 0; m < 4; ++m)
#pragma unroll
                    for (int n = 0; n < 2; ++n) acc[a][b][m][n] = AccT{};
        cur = nxt; cA = nA; cB = nB; ++ui;
        if (wr == 1) PG8_BAR;
    }
    PG8_WAIT_V(0);
    PG8_BAR;
#undef PG8_SA
#undef PG8_SB
#undef PG8_STAGE
#undef PG8_LDA
#undef PG8_LDB
#undef PG8_MMA
#undef PG8_WAIT_V
#undef PG8_WAIT_L
#undef PG8_BAR
#undef PG8_SCHED
}
}

constexpr int NWAVES = 8, NTHR = 512;
constexpr int NB = 4, SEQ = 4096, D = 1024, T = NB * SEQ, DIN = 2304, NE = 32, TOPK = 4, DEPTH = 2, FF = 1024;
constexpr int OFF_ZB = 0, OFF_ZC = 256, OFF_ZV = 512, OFF_ZU = 768, OFF_ZSV = 1024, OFF_ZG = 1280, OFF_ZX = 1792;
constexpr int NBLK = SEQ / 64;
constexpr int NRT = T / 64;
constexpr int MAXTILES = T * TOPK / 256 + NE;
constexpr int MAXSLOTS = MAXTILES * 256;
constexpr float EPS = 1e-6f;
constexpr float W_SCALE = 960.0f, H_SCALE = 28.0f, ACT_SCALE = 12.0f;

constexpr size_t al(size_t x) { return (x + 4095) & ~(size_t)4095; }
constexpr size_t WS_CTL = 0, CTL_ZERO_BYTES = 65536;
constexpr size_t WS_MOD = 65536;
constexpr size_t WS_GWT = al(WS_MOD + (size_t)DEPTH * NB * 6144 * 4);
constexpr size_t WS_SGW = al(WS_GWT + (size_t)DEPTH * 2 * 8 * 4096 * 2);
constexpr size_t WS_RWH = al(WS_SGW + (size_t)DEPTH * 4 * 16384 * 2);
constexpr size_t WS_RWL = al(WS_RWH + (size_t)DEPTH * NE * D * 2);
constexpr size_t WS_WIN = al(WS_RWL + (size_t)DEPTH * NE * D * 2);
constexpr size_t WS_WOUT = al(WS_WIN + (size_t)DEPTH * DIN * D * 2);
constexpr size_t WS_W1 = al(WS_WOUT + (size_t)DEPTH * D * D * 2);
constexpr size_t WS_W2 = al(WS_W1 + (size_t)DEPTH * NE * 2048 * D * 2);
constexpr size_t WS_H = al(WS_W2 + (size_t)DEPTH * NE * D * FF * 2);
constexpr size_t WS_Z = al(WS_H + (size_t)T * D * 2);
constexpr size_t WS_Y = al(WS_Z + (size_t)T * DIN * 2);
constexpr size_t WS_XA = al(WS_Y + (size_t)T * D * 2);
constexpr size_t WS_XB = al(WS_XA + (size_t)T * D * 4);
constexpr size_t WS_AGA = al(WS_XB + (size_t)T * D * 4);
constexpr size_t WS_AGH = al(WS_AGA + (size_t)NB * NBLK * 512 * 4);
constexpr size_t WS_TOPE = al(WS_AGH + (size_t)NB * NBLK * 512 * 4);
constexpr size_t WS_TOPW = al(WS_TOPE + (size_t)T * 4 * 4);
constexpr size_t WS_RANK = al(WS_TOPW + (size_t)T * 4 * 4);
constexpr size_t WS_SLOT = al(WS_RANK + (size_t)T * 4 * 4);
constexpr size_t WS_CNT = al(WS_SLOT + (size_t)T * 4 * 4);
constexpr size_t WS_SHW = al(WS_CNT + (size_t)NRT * NE * 4);
constexpr size_t WS_XG = al(WS_SHW + (size_t)DEPTH * NB * NE * 4);
constexpr size_t WS_ACT = al(WS_XG + (size_t)MAXSLOTS * D * 2);
constexpr size_t WS_END = al(WS_ACT + (size_t)MAXSLOTS * D * 2);
constexpr int CW_BAR = 1024;

constexpr int RING_BYTES = 131072;
constexpr int SCR_BYTES = 147456;
constexpr int LDSCTL_OFF = SCR_BYTES;
constexpr int L_MISC = LDSCTL_OFF;
constexpr int L_TILEE = LDSCTL_OFF + 256;
constexpr int L_NM = L_TILEE + MAXTILES * 4;
constexpr int LDS_BYTES = LDSCTL_OFF + 2048;
static_assert(L_NM + 4 <= LDS_BYTES, "LDS map");

#define GAS __attribute__((address_space(1)))
#define LAS __attribute__((address_space(3)))
typedef unsigned short bf16;
typedef unsigned v4u __attribute__((ext_vector_type(4)));
typedef unsigned v2u __attribute__((ext_vector_type(2)));
typedef float f32x4 __attribute__((ext_vector_type(4)));
typedef short bf16x8 __attribute__((ext_vector_type(8)));
#define LDS_WAIT() asm volatile("s_waitcnt lgkmcnt(0)" ::: "memory")
#define FRESH_TID() int tid_ = threadIdx.x; asm volatile("" : "+v"(tid_)); const int tid = tid_, lane = tid & 63, wave = __builtin_amdgcn_readfirstlane(tid >> 6); (void)tid; (void)lane; (void)wave
__device__ __forceinline__ unsigned f2bf(float f) { unsigned u = __builtin_bit_cast(unsigned, f); return (u + 0x7fffu + ((u >> 16) & 1u)) >> 16; }
__device__ __forceinline__ unsigned pk2(float lo, float hi) { return pg8::cvt_pk_bf16(lo, hi); }
__device__ __forceinline__ float bflo(unsigned w) { return __builtin_bit_cast(float, w << 16); }
__device__ __forceinline__ float bfhi(unsigned w) { return __builtin_bit_cast(float, w & 0xffff0000u); }
template <bool BF> __device__ __forceinline__ void ld8(const void* p, size_t idx, float (&o)[8]) {
    if (BF) { const v4u w = *(const v4u*)((const bf16*)p + idx); o[0] = bflo(w.x); o[1] = bfhi(w.x); o[2] = bflo(w.y); o[3] = bfhi(w.y); o[4] = bflo(w.z); o[5] = bfhi(w.z); o[6] = bflo(w.w); o[7] = bfhi(w.w); }
    else { const f32x4 a = *(const f32x4*)((const float*)p + idx), b = *(const f32x4*)((const float*)p + idx + 4); o[0] = a[0]; o[1] = a[1]; o[2] = a[2]; o[3] = a[3]; o[4] = b[0]; o[5] = b[1]; o[6] = b[2]; o[7] = b[3]; } }
template <bool BF> __device__ __forceinline__ f32x4 ld4(const void* p, size_t idx) {
    if (BF) { const v2u w = *(const v2u*)((const bf16*)p + idx); return (f32x4){bflo(w.x), bfhi(w.x), bflo(w.y), bfhi(w.y)}; }
    else return *(const f32x4*)((const float*)p + idx); }
__device__ __forceinline__ float sigmoidf_(float x) { return __builtin_amdgcn_rcpf(1.0f + __builtin_amdgcn_exp2f(-1.4426950408889634f * x)); }
__device__ __forceinline__ float gelu_tanh(float x) { const float u2 = 1.5957691216057308f * (x + 0.044715f * x * x * x); return x * __builtin_amdgcn_rcpf(1.0f + __builtin_amdgcn_exp2f(-1.4426950408889634f * u2)); }
__device__ __forceinline__ float wave_sum(float v) {
#pragma unroll
    for (int o = 1; o < 64; o <<= 1) v += __shfl_xor(v, o);
    return v;
}
template <int CTRL> __device__ __forceinline__ float dpp_f(float old, float src) { return __builtin_bit_cast(float, __builtin_amdgcn_update_dpp(__builtin_bit_cast(int, old), __builtin_bit_cast(int, src), CTRL, 0xF, 0xF, false)); }
__device__ __forceinline__ float sum16(float v) {
    v += dpp_f<0xB1>(v, v); v += dpp_f<0x4E>(v, v); v += dpp_f<0x141>(v, v); v += dpp_f<0x140>(v, v); return v; }
__device__ __forceinline__ float bcast15(float v, int lane) { return __builtin_bit_cast(float, __builtin_amdgcn_ds_bpermute((lane | 15) << 2, __builtin_bit_cast(int, v))); }

#define XB_TMO      128
#define XB_XCNT(j)  (256  + 64 * (j))
#define XB_XSUB(j)  (1280 + 64 * (j))
#define XB_XGEN(j)  (2304 + 64 * (j))
#define XB_TOP      3328
#define XB_TOPGEN   3392
#define XCD_BAR_WORDS 3456
#define XB_SPIN_CAP (1u << 18)
__device__ __forceinline__ unsigned xb_ld(unsigned* p)              { return __hip_atomic_load(p, __ATOMIC_RELAXED, __HIP_MEMORY_SCOPE_AGENT); }
__device__ __forceinline__ unsigned xb_add(unsigned* p, unsigned v) { return __hip_atomic_fetch_add(p, v, __ATOMIC_RELAXED, __HIP_MEMORY_SCOPE_AGENT); }
__device__ __forceinline__ unsigned xb_xcc_id() { return (unsigned)__builtin_amdgcn_s_getreg((3 << 11) | 20) & 0xFu; }
#define XB_SPIN(cond, bar) do { unsigned _sp = 0; while (cond) { __builtin_amdgcn_s_sleep(1); \
    if ((++_sp & 255u) == 0u) { if (xb_ld(&(bar)[XB_TMO])) break; if (_sp > XB_SPIN_CAP) { atomicAdd(&(bar)[XB_TMO], 1u); break; } } } } while (0)
struct XcdBarrier { unsigned* bar; unsigned x; volatile LAS unsigned* st; };
__device__ __forceinline__ XcdBarrier xcd_barrier_post(unsigned* bar, volatile LAS unsigned* st) {
    XcdBarrier b; b.bar = bar; b.x = xb_xcc_id(); b.st = st;
    if (threadIdx.x == 0) (void)xb_add(&bar[XB_XCNT(b.x)], 1u);
    return b;
}
__device__ __forceinline__ void xcd_barrier_complete(unsigned* bar, unsigned x, unsigned& nloc, unsigned& nx) {
    const unsigned G = gridDim.x * gridDim.y * gridDim.z;
    unsigned sum, cnt, mine, sp = 0u;
    for (;;) {
        sum = 0u; cnt = 0u; mine = 0u;
#pragma unroll
        for (unsigned j = 0; j < 16; ++j) { const unsigned c = xb_ld(&bar[XB_XCNT(j)]); sum += c; cnt += (c > 0u) ? 1u : 0u; mine = (j == x) ? c : mine; }
        if (sum == G) break;
        __builtin_amdgcn_s_sleep(1);
        if ((++sp & 255u) == 0u) { if (xb_ld(&bar[XB_TMO])) break; if (sp > XB_SPIN_CAP) { atomicAdd(&bar[XB_TMO], 1u); break; } }
    }
    nloc = mine > 0u ? mine : 1u; nx = cnt > 0u ? cnt : 1u;
}
__device__ __forceinline__ void xcd_barrier(const XcdBarrier& b) {
    asm volatile("s_waitcnt vmcnt(0)" ::: "memory");
    __syncthreads();
    if (threadIdx.x == 0) {
        unsigned* bar = b.bar;
        __builtin_amdgcn_s_waitcnt(0);
        unsigned nloc = b.st[0], nx = b.st[1];
        if (nloc == 0u) { xcd_barrier_complete(bar, b.x, nloc, nx); b.st[0] = nloc; b.st[1] = nx; }
        const unsigned old = xb_add(&bar[XB_XSUB(b.x)], 1u);
        const unsigned gen = old / nloc;
        if (old + 1u == (gen + 1u) * nloc) {
            __builtin_amdgcn_fence(__ATOMIC_RELEASE, "agent");
            asm volatile("s_waitcnt vmcnt(0)" ::: "memory");
            const unsigned og = xb_add(&bar[XB_TOP], 1u);
            const unsigned tg = og / nx;
            if (og + 1u == (tg + 1u) * nx) xb_add(&bar[XB_TOPGEN], 1u);
            else XB_SPIN(xb_ld(&bar[XB_TOPGEN]) == tg, bar);
            __builtin_amdgcn_fence(__ATOMIC_ACQUIRE, "agent");
            xb_add(&bar[XB_XGEN(b.x)], 1u);
            asm volatile("s_waitcnt vmcnt(0)" ::: "memory");
        } else {
            XB_SPIN(xb_ld(&bar[XB_XGEN(b.x)]) == gen, bar);
            __builtin_amdgcn_fence(__ATOMIC_ACQUIRE, "agent");
            asm volatile("s_waitcnt vmcnt(0)" ::: "memory");
        }
    }
    __syncthreads();
}

struct TItem { const float* W; bf16* WT; int K, N, k0, n0, rowbase, fp8; };
__device__ __forceinline__ void ti_load(const TItem& d, f32x4 (&v)[16], int lane) {
#pragma unroll
    for (int i = 0; i < 16; ++i) v[i] = __builtin_nontemporal_load((const f32x4*)(d.W + (size_t)(d.k0 + 4 * i + (lane >> 4)) * d.N + d.n0 + 4 * (lane & 15)));
}
__device__ __forceinline__ void ti_store(const TItem& d, const f32x4 (&v)[16], LAS float* scr, int lane) {
#pragma unroll
    for (int i = 0; i < 16; ++i) { LAS float* s = scr + (4 * i + (lane >> 4)) * 65 + 4 * (lane & 15); s[0] = v[i][0]; s[1] = v[i][1]; s[2] = v[i][2]; s[3] = v[i][3]; }
    LDS_WAIT(); asm volatile("" ::: "memory");
    const int c = lane & 7;
#pragma unroll
    for (int j = 0; j < 8; ++j) { const int n = (lane >> 3) + 8 * j; const LAS float* s = scr + (8 * c) * 65 + n;
        v4u o; o.x = pk2(s[0 * 65], s[1 * 65]); o.y = pk2(s[2 * 65], s[3 * 65]); o.z = pk2(s[4 * 65], s[5 * 65]); o.w = pk2(s[6 * 65], s[7 * 65]);
        if (d.fp8) { const unsigned w0 = pg8::pk4_i8(s[0 * 65] * W_SCALE, s[1 * 65] * W_SCALE, s[2 * 65] * W_SCALE, s[3 * 65] * W_SCALE), w1 = pg8::pk4_i8(s[4 * 65] * W_SCALE, s[5 * 65] * W_SCALE, s[6 * 65] * W_SCALE, s[7 * 65] * W_SCALE);
            *(v2u*)((unsigned char*)d.WT + (size_t)(d.rowbase + n) * d.K + d.k0 + 8 * c) = (v2u){w0, w1}; }
        else *(v4u*)(d.WT + (size_t)(d.rowbase + n) * d.K + d.k0 + 8 * c) = o; }
    LDS_WAIT(); asm volatile("" ::: "memory");
}

struct Args { const float* in[26]; float* out; unsigned char* ws; int ph_lo, ph_hi; };

__device__ __forceinline__ void pro_phase(const Args& args, LAS unsigned char* lds, int vcu, int G) {
    FRESH_TID();
    unsigned char* ws = args.ws;
    for (int u = vcu; u < DEPTH * 96; u += G) {
        const int l = u / 96, cbk = u % 96, col = cbk * 64 + lane;
        const float* wa = args.in[4] + (size_t)l * D * 6144; const float* cc = args.in[1];
        float a0 = 0.f, a1 = 0.f, a2 = 0.f, a3 = 0.f;
#pragma unroll 8
        for (int k = wave * 128; k < wave * 128 + 128; ++k) { const float w = wa[(size_t)k * 6144 + col]; a0 += cc[k] * w; a1 += cc[D + k] * w; a2 += cc[2 * D + k] * w; a3 += cc[3 * D + k] * w; }
        LAS float* red = (LAS float*)lds;
        red[(wave * 4 + 0) * 64 + lane] = a0; red[(wave * 4 + 1) * 64 + lane] = a1; red[(wave * 4 + 2) * 64 + lane] = a2; red[(wave * 4 + 3) * 64 + lane] = a3;
        __syncthreads();
        if (tid < 256) { const int b = tid >> 6, cl = tid & 63; float s = args.in[5][(size_t)l * 6144 + cbk * 64 + cl];
#pragma unroll
            for (int w = 0; w < 8; ++w) s += red[(w * 4 + b) * 64 + cl];
            ((float*)(ws + WS_MOD))[(size_t)(l * NB + b) * 6144 + cbk * 64 + cl] = s; }
        __syncthreads();
    }
    const int gt = vcu * NTHR + tid, NGT = G * NTHR;
    for (int i = gt; i < DEPTH * 2 * 8 * 4096; i += NGT) {
        const int ii = i & 63, j = (i >> 6) & 63, lgh = i >> 12;
        ((bf16*)(ws + WS_GWT))[i] = (bf16)f2bf(args.in[14][(size_t)lgh * 4096 + ii * 64 + j]); }
    for (int i = gt; i < DEPTH * 4 * 16384; i += NGT) {
        const int s = i & 127, t = (i >> 7) & 127;
        ((bf16*)(ws + WS_SGW))[i] = (bf16)(s <= t ? f2bf(args.in[8][i]) : 0u); }
    for (int i = gt; i < DEPTH * NE * D; i += NGT) {
        const int k = i & 1023, e = (i >> 10) & 31, l = i >> 15;
        const float w = args.in[19][((size_t)l * D + k) * NE + e]; const unsigned hi = f2bf(w); const float r = w - __builtin_bit_cast(float, hi << 16);
        ((bf16*)(ws + WS_RWH))[i] = (bf16)hi; ((bf16*)(ws + WS_RWL))[i] = (bf16)f2bf(r); }
    LAS float* scr = (LAS float*)(lds + wave * 16640);
    const int gw = vcu * NWAVES + wave, NGW = G * NWAVES;
    constexpr int I_IN = 16 * 36, I_OUT = 16 * 16, I_W1 = NE * 16 * 32, I_W2 = NE * 16 * 16, I_L = I_IN + I_OUT + I_W1 + I_W2;
    auto decode = [&](int it, TItem& d) {
        const int l = it / I_L; int r = it % I_L;
        if (r < I_IN) { const int kb = r / 36, nb = r % 36; d = TItem{args.in[6] + (size_t)l * D * DIN, (bf16*)(ws + WS_WIN) + (size_t)l * DIN * D, D, DIN, kb * 64, nb * 64, nb * 64, 0}; return; } r -= I_IN;
        if (r < I_OUT) { const int kb = r / 16, nb = r % 16; d = TItem{args.in[18] + (size_t)l * D * D, (bf16*)(ws + WS_WOUT) + (size_t)l * D * D, D, D, kb * 64, nb * 64, nb * 64, 0}; return; } r -= I_OUT;
        if (r < I_W1) { const int e = r / 512, q = r % 512, kb = q / 32, nb = q % 32, n0 = nb * 64;
            const int rowbase = (n0 < 1024) ? (n0 >> 7) * 256 + (n0 & 127) : ((n0 - 1024) >> 7) * 256 + 128 + ((n0 - 1024) & 127);
            d = TItem{args.in[21] + ((size_t)l * NE + e) * D * 2048, (bf16*)(ws + WS_W1 + ((size_t)l * NE + e) * 2048 * D), D, 2048, kb * 64, n0, rowbase, 1}; return; } r -= I_W1;
        { const int e = r / 256, q = r % 256, kb = q / 16, nb = q % 16;
            d = TItem{args.in[23] + ((size_t)l * NE + e) * FF * D, (bf16*)(ws + WS_W2 + ((size_t)l * NE + e) * D * FF), FF, D, kb * 64, nb * 64, nb * 64, 1}; }
    };
    int it = gw; TItem d, dn; f32x4 v[16], vn[16];
    if (it < DEPTH * I_L) { decode(it, d); ti_load(d, v, lane); }
    while (it < DEPTH * I_L) {
        const int itn = it + NGW; const bool hn = itn < DEPTH * I_L;
        if (hn) { decode(itn, dn); ti_load(dn, vn, lane); }
        ti_store(d, v, scr, lane);
        if (hn) { d = dn;
#pragma unroll
            for (int i = 0; i < 16; ++i) v[i] = vn[i]; }
        it = itn;
    }
}

__device__ __forceinline__ void adaln_rows(const float* X, bf16* H, const float* g, const float* mod_shift, const float* mod_scale, int vcu, int G) {
    FRESH_TID(); const int gw = vcu * NWAVES + wave, NGW = G * NWAVES;
    for (int row = gw; row < T; row += NGW) {
        const int b = row >> 12; const float* xr = X + (size_t)row * D + 4 * lane;
        f32x4 v[4]; float s = 0.f;
#pragma unroll
        for (int j = 0; j < 4; ++j) { v[j] = *(const f32x4*)(xr + 256 * j); s += (v[j][0] * v[j][0] + v[j][1] * v[j][1]) + (v[j][2] * v[j][2] + v[j][3] * v[j][3]); }
        const float rstd = __builtin_amdgcn_rsqf(wave_sum(s) * (1.0f / D) + EPS);
#pragma unroll
        for (int j = 0; j < 4; ++j) { const int c = 4 * lane + 256 * j;
            const f32x4 gv = *(const f32x4*)(g + c), sc = *(const f32x4*)(mod_scale + b * 6144 + c), sh = *(const f32x4*)(mod_shift + b * 6144 + c);
            const f32x4 o = v[j] * rstd * gv * (sc + 1.0f) + sh;
            v2u w; w.x = pk2(o[0], o[1]); w.y = pk2(o[2], o[3]); *(v2u*)(H + (size_t)row * D + c) = w; }
    }
}


__device__ __forceinline__ void shw_phase(const Args& args, LAS unsigned char* lds, int vcu, int G) {
    FRESH_TID();
    unsigned char* ws = args.ws; LAS float* RED = (LAS float*)lds;
    for (int u = vcu; u < DEPTH * NB; u += G) {
        const int l = u >> 2, b = u & 3, e = tid & 31, part = tid >> 5;
        const float* sh = (const float*)(ws + WS_MOD) + (size_t)(l * NB + b) * 6144 + 3 * D; const float* rw = args.in[19] + (size_t)l * D * NE; float s = 0.f;
#pragma unroll 16
        for (int k = part * 64; k < part * 64 + 64; ++k) s = fmaf(sh[k], rw[(size_t)k * NE + e], s);
        RED[part * 32 + e] = s;
        __syncthreads();
        if (tid < 32) { float t = args.in[20][(size_t)l * NE + tid];
#pragma unroll
            for (int p = 0; p < 16; ++p) t += RED[p * 32 + tid];
            ((float*)(ws + WS_SHW))[(l * NB + b) * NE + tid] = t; }
        __syncthreads();
    }
}

constexpr int L3_CARRY = 139264, L3_SS = 141312, L3_SS2 = 143360, L3_SPL = 144384;
template <bool FULL>
__device__ __forceinline__ void mixer_unit(const Args& args, int l, int b, int j, LAS unsigned char* lds) {
    FRESH_TID();
    unsigned char* ws = args.ws;
    const bf16* Z = (const bf16*)(ws + WS_Z); bf16* Y = (bf16*)(ws + WS_Y);
    float* aggA = (float*)(ws + WS_AGA); float* aggH = (float*)(ws + WS_AGH);
    const float* mixg = args.in[17] + (size_t)l * D;
    const int fr = lane & 15, fq = lane >> 4;
    const size_t rowb = (size_t)b * SEQ;
    const int t0 = 64 * j;
    LAS float* CARRY = (LAS float*)(lds + L3_CARRY); LAS float* SS = (LAS float*)(lds + L3_SS); LAS float* SS2 = (LAS float*)(lds + L3_SS2); LAS float* SPL = (LAS float*)(lds + L3_SPL);
    if ((MIX_MASK & 4) || !FULL) {
        {
            const float y = -args.in[16][(size_t)l * 512 + tid];
            SPL[tid] = fmaxf(y, 0.f) + log1pf(expf(-fabsf(y)));
            if (FULL) { float c = 0.f; const float* pa = aggA + (size_t)b * NBLK * 512 + tid; const float* ph = aggH + (size_t)b * NBLK * 512 + tid;
                int jj = 0;
                for (; jj + 16 <= j; jj += 16) { float av[16], hv[16];
#pragma unroll
                    for (int q = 0; q < 16; ++q) { av[q] = pa[(size_t)(jj + q) * 512]; hv[q] = ph[(size_t)(jj + q) * 512]; }
#pragma unroll
                    for (int q = 0; q < 16; ++q) c = fmaf(av[q], c, hv[q]); }
                { float av[16], hv[16];
#pragma unroll
                    for (int q = 0; q < 16; ++q) { const bool ok = jj + q < j; const int jq = ok ? jj + q : 0; av[q] = pa[(size_t)jq * 512]; hv[q] = ph[(size_t)jq * 512]; if (!ok) { av[q] = 1.f; hv[q] = 0.f; } }
#pragma unroll
                    for (int q = 0; q < 16; ++q) c = fmaf(av[q], c, hv[q]); }
                CARRY[tid] = c; }
        }
        __syncthreads();
        const int hd = wave;
        LAS float* XR = (LAS float*)(lds + wave * 17408);
        const float* cw = args.in[12] + (size_t)l * 4 * 512; const float* cbp = args.in[13] + (size_t)l * 512;
        bf16x8 Xa[4][2];
#pragma unroll
        for (int ks = 0; ks < 2; ++ks) {
            const int c8 = 64 * hd + 32 * ks + 8 * fq;
            float wv[4][8], bv[8];
#pragma unroll
            for (int k = 0; k < 4; ++k) { const f32x4 w0 = *(const f32x4*)(cw + k * 512 + c8), w1 = *(const f32x4*)(cw + k * 512 + c8 + 4);
#pragma unroll
                for (int e = 0; e < 4; ++e) { wv[k][e] = w0[e]; wv[k][4 + e] = w1[e]; } }
            { const f32x4 b0 = *(const f32x4*)(cbp + c8), b1 = *(const f32x4*)(cbp + c8 + 4);
#pragma unroll
                for (int e = 0; e < 4; ++e) { bv[e] = b0[e]; bv[4 + e] = b1[e]; } }
#pragma unroll
            for (int m = 0; m < 4; ++m) {
                const int t = t0 + 16 * m + fr;
                float a8[8];
#pragma unroll
                for (int e = 0; e < 8; ++e) a8[e] = bv[e];
#pragma unroll
                for (int k = 0; k < 4; ++k) { const int tt = t - 3 + k; const int tc = tt < 0 ? 0 : tt;
                    const v4u z = *(const v4u*)(Z + (rowb + tc) * DIN + OFF_ZX + c8); const float msk = tt < 0 ? 0.f : 1.f;
                    const unsigned zw[4] = {z.x, z.y, z.z, z.w};
#pragma unroll
                    for (int q = 0; q < 4; ++q) { a8[2 * q] += wv[k][2 * q] * (msk * bflo(zw[q])); a8[2 * q + 1] += wv[k][2 * q + 1] * (msk * bfhi(zw[q])); } }
                v4u pk; pk.x = pk2(a8[0], a8[1]); pk.y = pk2(a8[2], a8[3]); pk.z = pk2(a8[4], a8[5]); pk.w = pk2(a8[6], a8[7]);
                Xa[m][ks] = __builtin_bit_cast(bf16x8, pk);
                LAS float* xp = XR + (16 * m + fr) * 68 + 32 * ks + 8 * fq;
                *(LAS f32x4*)(xp) = (f32x4){a8[0], a8[1], a8[2], a8[3]}; *(LAS f32x4*)(xp + 4) = (f32x4){a8[4], a8[5], a8[6], a8[7]};
            }
        }
        LDS_WAIT(); asm volatile("" ::: "memory");
        const bf16* GwT = (const bf16*)(ws + WS_GWT) + (size_t)l * 2 * 8 * 4096;
        const float* gbp = args.in[15] + (size_t)l * 2 * 512;
        float ss[4] = {0.f, 0.f, 0.f, 0.f};
        bf16x8 Wn[2][2]; f32x4 gbr_n, gbi_n; v2u zg_n[4];
#define LRU_PREFETCH(nn) do { \
            _Pragma("unroll") for (int g_ = 0; g_ < 2; ++g_) _Pragma("unroll") for (int ks_ = 0; ks_ < 2; ++ks_) \
                Wn[g_][ks_] = __builtin_bit_cast(bf16x8, *(const v4u*)(GwT + ((size_t)(g_ * 8 + hd) * 64 + 16 * (nn) + fr) * 64 + 32 * ks_ + 8 * fq)); \
            gbr_n = *(const f32x4*)(gbp + hd * 64 + 16 * (nn) + 4 * fq); gbi_n = *(const f32x4*)(gbp + 512 + hd * 64 + 16 * (nn) + 4 * fq); \
            if (FULL) { _Pragma("unroll") for (int m_ = 0; m_ < 4; ++m_) zg_n[m_] = *(const v2u*)(Z + (rowb + t0 + 16 * m_ + fr) * DIN + OFF_ZG + 64 * hd + 16 * (nn) + 4 * fq); } } while (0)
        LRU_PREFETCH(0);
#pragma unroll 1
        for (int n = 0; n < 4; ++n) {
            const int cc = 16 * n + 4 * fq, c = 64 * hd + cc;
            bf16x8 Wc[2][2]; v2u zgc[4];
#pragma unroll
            for (int g = 0; g < 2; ++g)
#pragma unroll
                for (int ks = 0; ks < 2; ++ks) Wc[g][ks] = Wn[g][ks];
            const f32x4 gbr = gbr_n, gbi = gbi_n;
#pragma unroll
            for (int m = 0; m < 4; ++m) zgc[m] = zg_n[m];
            { const int nn = n < 3 ? n + 1 : 3; LRU_PREFETCH(nn); }
            f32x4 acc[2][4];
#pragma unroll
            for (int g = 0; g < 2; ++g)
#pragma unroll
                for (int m = 0; m < 4; ++m) { acc[g][m] = (f32x4){0.f, 0.f, 0.f, 0.f};
#pragma unroll
                    for (int ks = 0; ks < 2; ++ks) acc[g][m] = __builtin_amdgcn_mfma_f32_16x16x32_bf16(Wc[g][ks], Xa[m][ks], acc[g][m], 0, 0, 0); }
            const f32x4 sp = *(const LAS f32x4*)(SPL + c);
            float A[4][4], Bv[4][4];
#pragma unroll
            for (int m = 0; m < 4; ++m) { const f32x4 xr = *(const LAS f32x4*)(XR + (16 * m + fr) * 68 + cc);
#pragma unroll
                for (int e = 0; e < 4; ++e) { const float r = sigmoidf_(acc[0][m][e] + gbr[e]), ig = sigmoidf_(acc[1][m][e] + gbi[e]);
                    const float la = -8.0f * r * sp[e]; const float a = __builtin_amdgcn_exp2f(la * 1.4426950408889634f);
                    A[m][e] = a; Bv[m][e] = xr[e] * ig * __builtin_amdgcn_sqrtf(fmaxf(fmaf(-a, a, 1.0f), 0.f)); } }
#pragma unroll
            for (int m = 0; m < 4; ++m)
#pragma unroll
                for (int e = 0; e < 4; ++e) { float a = A[m][e], bb = Bv[m][e];
                    { const float ap = dpp_f<0x111>(1.0f, a), bp = dpp_f<0x111>(0.0f, bb); bb = fmaf(a, bp, bb); a *= ap; }
                    { const float ap = dpp_f<0x112>(1.0f, a), bp = dpp_f<0x112>(0.0f, bb); bb = fmaf(a, bp, bb); a *= ap; }
                    { const float ap = dpp_f<0x114>(1.0f, a), bp = dpp_f<0x114>(0.0f, bb); bb = fmaf(a, bp, bb); a *= ap; }
                    { const float ap = dpp_f<0x118>(1.0f, a), bp = dpp_f<0x118>(0.0f, bb); bb = fmaf(a, bp, bb); a *= ap; }
                    A[m][e] = a; Bv[m][e] = bb; }
            float hc[4], ac[4];
            if (FULL) { const f32x4 cv = *(const LAS f32x4*)(CARRY + c); hc[0] = cv[0]; hc[1] = cv[1]; hc[2] = cv[2]; hc[3] = cv[3]; }
            else { hc[0] = hc[1] = hc[2] = hc[3] = 0.f; }
            ac[0] = ac[1] = ac[2] = ac[3] = 1.f;
#pragma unroll
            for (int m = 0; m < 4; ++m) {
                float hcur[4];
#pragma unroll
                for (int e = 0; e < 4; ++e) { hcur[e] = fmaf(A[m][e], hc[e], Bv[m][e]); hc[e] = bcast15(hcur[e], lane);
                    if (!FULL) ac[e] = bcast15(A[m][e] * ac[e], lane); }
                if (FULL) { const v2u zg = zgc[m];
                    const float g4[4] = {bflo(zg.x), bfhi(zg.x), bflo(zg.y), bfhi(zg.y)};
                    f32x4 yq;
#pragma unroll
                    for (int e = 0; e < 4; ++e) { const float y = gelu_tanh(g4[e]) * hcur[e]; yq[e] = y; ss[m] = fmaf(y, y, ss[m]); }
                    *(LAS f32x4*)(XR + (16 * m + fr) * 68 + cc) = yq; }
            }
            if (!FULL && fr == 0) { const size_t o = ((size_t)b * NBLK + j) * 512 + c; *(f32x4*)(aggA + o) = (f32x4){ac[0], ac[1], ac[2], ac[3]}; *(f32x4*)(aggH + o) = (f32x4){hc[0], hc[1], hc[2], hc[3]}; }
        }
#undef LRU_PREFETCH
        if (FULL) {
#pragma unroll
            for (int m = 0; m < 4; ++m) { float s = ss[m]; s += __shfl_xor(s, 16); s += __shfl_xor(s, 32); if (fq == 0) SS[wave * 64 + 16 * m + fr] = s; }
            __syncthreads();
#pragma unroll
            for (int m = 0; m < 4; ++m) { float tot = 0.f;
#pragma unroll
                for (int w = 0; w < 8; ++w) tot += SS[w * 64 + 16 * m + fr];
                const float rstd = __builtin_amdgcn_rsqf(tot * (1.0f / 512.0f) + EPS);
#pragma unroll
                for (int n = 0; n < 4; ++n) { const int c = 512 + 64 * hd + 16 * n + 4 * fq; const f32x4 mg = *(const f32x4*)(mixg + c);
                    const f32x4 yq = *(const LAS f32x4*)(XR + (16 * m + fr) * 68 + 16 * n + 4 * fq);
                    v2u w; w.x = pk2(yq[0] * rstd * mg[0], yq[1] * rstd * mg[1]); w.y = pk2(yq[2] * rstd * mg[2], yq[3] * rstd * mg[3]);
                    *(v2u*)(Y + (rowb + t0 + 16 * m + fr) * D + c) = w; } }
        }
    } else if (FULL) {
        for (int i = tid; i < 64 * 64; i += NTHR) { const int r = i >> 6, c8 = (i & 63) * 8; *(v4u*)(Y + (rowb + t0 + r) * D + 512 + c8) = (v4u){0u, 0u, 0u, 0u}; }
    }
    if (!FULL) return;
    asm volatile("" ::: "memory");
    if (MIX_MASK & 1) {
        const int tg = tid >> 5, s8 = (tid & 31) * 8; const int tb = t0 + 4 * tg;
        const float* caw = args.in[7] + (size_t)l * 3 * 256;
        float w3[3][8];
#pragma unroll
        for (int k = 0; k < 3; ++k) { const f32x4 w0 = *(const f32x4*)(caw + k * 256 + s8), w1 = *(const f32x4*)(caw + k * 256 + s8 + 4);
#pragma unroll
            for (int e = 0; e < 4; ++e) { w3[k][e] = w0[e]; w3[k][4 + e] = w1[e]; } }
        float cv[6][8];
#pragma unroll
        for (int i = 0; i < 6; ++i) { const int tt = tb - 2 + i; const int tc = tt < 0 ? 0 : tt; const float msk = tt < 0 ? 0.f : 1.f;
            const v4u zc = *(const v4u*)(Z + (rowb + tc) * DIN + OFF_ZC + s8), zv = *(const v4u*)(Z + (rowb + tc) * DIN + OFF_ZV + s8);
            const unsigned a[4] = {zc.x, zc.y, zc.z, zc.w}, bq[4] = {zv.x, zv.y, zv.z, zv.w};
#pragma unroll
            for (int q = 0; q < 4; ++q) { cv[i][2 * q] = msk * bflo(a[q]) * bflo(bq[q]); cv[i][2 * q + 1] = msk * bfhi(a[q]) * bfhi(bq[q]); } }
        const f32x4 mg0 = *(const f32x4*)(mixg + s8), mg1 = *(const f32x4*)(mixg + s8 + 4);
#pragma unroll
        for (int i = 0; i < 4; ++i) {
            const v4u zb = *(const v4u*)(Z + (rowb + tb + i) * DIN + OFF_ZB + s8); const unsigned a[4] = {zb.x, zb.y, zb.z, zb.w};
            float y[8], s = 0.f;
#pragma unroll
            for (int e = 0; e < 8; ++e) { const float zbe = (e & 1) ? bfhi(a[e >> 1]) : bflo(a[e >> 1]);
                y[e] = zbe * (w3[0][e] * cv[i][e] + w3[1][e] * cv[i + 1][e] + w3[2][e] * cv[i + 2][e]); s = fmaf(y[e], y[e], s); }
#pragma unroll
            for (int o = 1; o < 32; o <<= 1) s += __shfl_xor(s, o);
            const float rstd = __builtin_amdgcn_rsqf(s * (1.0f / 256.0f) + EPS);
            v4u w; w.x = pk2(y[0] * rstd * mg0[0], y[1] * rstd * mg0[1]); w.y = pk2(y[2] * rstd * mg0[2], y[3] * rstd * mg0[3]);
            w.z = pk2(y[4] * rstd * mg1[0], y[5] * rstd * mg1[1]); w.w = pk2(y[6] * rstd * mg1[2], y[7] * rstd * mg1[3]);
            *(v4u*)(Y + (rowb + tb + i) * D + s8) = w; }
    } else {
        for (int i = tid; i < 64 * 32; i += NTHR) { const int r = i >> 5, c8 = (i & 31) * 8; *(v4u*)(Y + (rowb + t0 + r) * D + c8) = (v4u){0u, 0u, 0u, 0u}; }
    }
    asm volatile("" ::: "memory");
    if (MIX_MASK & 2) {
        __syncthreads();
        const int hf = j & 1, tcs = t0 - 64 * hf, slen = 64 * (hf + 1);
        LAS bf16* Vt = (LAS bf16*)lds;
        const float* lng = args.in[10] + (size_t)l * 256; const float* lnb = args.in[11] + (size_t)l * 256;
        {
            const int rr = lane >> 4, ci = lane & 15;
            float gq[16], bq[16];
#pragma unroll
            for (int q = 0; q < 4; ++q) { const f32x4 a = *(const f32x4*)(lng + 16 * ci + 4 * q), bb = *(const f32x4*)(lnb + 16 * ci + 4 * q);
#pragma unroll
                for (int e = 0; e < 4; ++e) { gq[4 * q + e] = a[e]; bq[4 * q + e] = bb[e]; } }
            v4u zz[4][2];
#pragma unroll
            for (int it = 0; it < 4; ++it) if (it * 32 < slen) { const int sr = 32 * it + 4 * wave + rr; const bf16* zp = Z + (rowb + tcs + sr) * DIN + OFF_ZSV + 16 * ci;
                zz[it][0] = *(const v4u*)(zp); zz[it][1] = *(const v4u*)(zp + 8); }
#pragma unroll
            for (int it = 0; it < 4; ++it) if (it * 32 < slen) { const int sr = 32 * it + 4 * wave + rr;
                float v[16]; float sm = 0.f;
#pragma unroll
                for (int hh = 0; hh < 2; ++hh) { const unsigned w4[4] = {zz[it][hh].x, zz[it][hh].y, zz[it][hh].z, zz[it][hh].w};
#pragma unroll
                    for (int q = 0; q < 4; ++q) { v[8 * hh + 2 * q] = gelu_tanh(bflo(w4[q])); v[8 * hh + 2 * q + 1] = gelu_tanh(bfhi(w4[q])); } }
#pragma unroll
                for (int e = 0; e < 16; ++e) sm += v[e];
                const float mean = sum16(sm) * (1.0f / 256.0f); float sq = 0.f;
#pragma unroll
                for (int e = 0; e < 16; ++e) { v[e] -= mean; sq = fmaf(v[e], v[e], sq); }
                const float rstd = __builtin_amdgcn_rsqf(sum16(sq) * (1.0f / 256.0f) + EPS);
#pragma unroll
                for (int e = 0; e < 16; ++e) Vt[(16 * ci + e) * 136 + sr] = (bf16)f2bf(v[e] * rstd * gq[e] + bq[e]);
            } }
        __syncthreads();
        const int h = wave >> 1, th = wave & 1;
        const bf16* SGW = (const bf16*)(ws + WS_SGW) + ((size_t)l * 4 + h) * 16384;
        f32x4 acc[2][4];
#pragma unroll
        for (int m = 0; m < 2; ++m)
#pragma unroll
            for (int n = 0; n < 4; ++n) acc[m][n] = (f32x4){0.f, 0.f, 0.f, 0.f};
#pragma unroll
        for (int ks = 0; ks < 4; ++ks) {
            if (ks * 32 < slen) {
                bf16x8 Wq[2];
#pragma unroll
                for (int m = 0; m < 2; ++m) Wq[m] = __builtin_bit_cast(bf16x8, *(const v4u*)(SGW + (size_t)(64 * hf + 32 * th + 16 * m + fr) * 128 + 32 * ks + 8 * fq));
#pragma unroll
                for (int n = 0; n < 4; ++n) { const bf16x8 Vp = *(const LAS bf16x8*)(Vt + (64 * h + 16 * n + fr) * 136 + 32 * ks + 8 * fq);
#pragma unroll
                    for (int m = 0; m < 2; ++m) acc[m][n] = __builtin_amdgcn_mfma_f32_16x16x32_bf16(Vp, Wq[m], acc[m][n], 0, 0, 0); }
            }
        }
        const float* sgb = args.in[9] + ((size_t)l * 4 + h) * 128;
        float ys[2][4][4], s2[2];
#pragma unroll
        for (int m = 0; m < 2; ++m) { const int tl = 32 * th + 16 * m + fr; const float bias = sgb[64 * hf + tl]; float s = 0.f;
#pragma unroll
            for (int n = 0; n < 4; ++n) { const v2u zu = *(const v2u*)(Z + (rowb + t0 + tl) * DIN + OFF_ZU + 64 * h + 16 * n + 4 * fq);
                const float u4[4] = {bflo(zu.x), bfhi(zu.x), bflo(zu.y), bfhi(zu.y)};
#pragma unroll
                for (int e = 0; e < 4; ++e) { const float y = gelu_tanh(u4[e]) * (acc[m][n][e] + bias); ys[m][n][e] = y; s = fmaf(y, y, s); } }
            s += __shfl_xor(s, 16); s += __shfl_xor(s, 32); s2[m] = s; if (fq == 0) SS2[h * 64 + tl] = s; }
        __syncthreads();
#pragma unroll
        for (int m = 0; m < 2; ++m) { const int tl = 32 * th + 16 * m + fr; const float tot = (SS2[tl] + SS2[64 + tl]) + (SS2[128 + tl] + SS2[192 + tl]);
            const float rstd = __builtin_amdgcn_rsqf(tot * (1.0f / 256.0f) + EPS);
#pragma unroll
            for (int n = 0; n < 4; ++n) { const int c = 256 + 64 * h + 16 * n + 4 * fq; const f32x4 mg = *(const f32x4*)(mixg + c);
                v2u w; w.x = pk2(ys[m][n][0] * rstd * mg[0], ys[m][n][1] * rstd * mg[1]); w.y = pk2(ys[m][n][2] * rstd * mg[2], ys[m][n][3] * rstd * mg[3]);
                *(v2u*)(Y + (rowb + t0 + tl) * D + c) = w; } }
        (void)s2;
    } else {
        for (int i = tid; i < 64 * 32; i += NTHR) { const int r = i >> 5, c8 = (i & 31) * 8; *(v4u*)(Y + (rowb + t0 + r) * D + 256 + c8) = (v4u){0u, 0u, 0u, 0u}; }
    }
}

template <bool XBF> __device__ __forceinline__ void route_tile(const Args& args, int l, int tile, const void* X1, LAS unsigned char* lds) {
    FRESH_TID();
    unsigned char* ws = args.ws;
    LAS float* GS = (LAS float*)lds; LAS float* SH = (LAS float*)(lds + 4096); LAS float* SHW = (LAS float*)(lds + 8192); LAS float* RED = (LAS float*)(lds + 8448);
    LAS float* PL = (LAS float*)(lds + 16384); LAS float* PSS = (LAS float*)(lds + 32768); LAS float* RSTD = (LAS float*)(lds + 33280); LAS int* HIST = (LAS int*)(lds + 33792);
    const int row0 = tile * 64, b = row0 >> 12; const int fr = lane & 15, fq = lane >> 4;
    const float* mod = (const float*)(ws + WS_MOD) + (size_t)(l * NB + b) * 6144;
    const float* g2 = args.in[3] + (size_t)l * D;
    for (int k = tid; k < D; k += NTHR) { GS[k] = g2[k] * (1.0f + mod[4 * D + k]); SH[k] = mod[3 * D + k]; }
    if (tid < 32) HIST[tid] = 0;
    __syncthreads();
    if (tid < 32) SHW[tid] = ((const float*)(ws + WS_SHW))[(l * NB + b) * NE + tid];
    const int st = wave >> 1, kh = wave & 1;
    const bf16* RWH = (const bf16*)(ws + WS_RWH) + (size_t)l * NE * D; const bf16* RWL = (const bf16*)(ws + WS_RWL) + (size_t)l * NE * D;
    f32x4 acc[2] = {(f32x4){0.f, 0.f, 0.f, 0.f}, (f32x4){0.f, 0.f, 0.f, 0.f}}; float ssq = 0.f;
    const size_t xrow = (size_t)(row0 + 16 * st + fr) * D;
#pragma unroll 8
    for (int kb = 0; kb < 16; ++kb) {
        const int k = 512 * kh + 32 * kb + 8 * fq;
        float xv[8]; ld8<XBF>(X1, xrow + k, xv);
        const f32x4 g0 = *(const LAS f32x4*)(GS + k), g1 = *(const LAS f32x4*)(GS + k + 4);
        float xs[8], hi[8], lo[8];
#pragma unroll
        for (int e = 0; e < 4; ++e) { xs[e] = xv[e] * g0[e]; xs[4 + e] = xv[4 + e] * g1[e]; ssq = fmaf(xv[e], xv[e], ssq); ssq = fmaf(xv[4 + e], xv[4 + e], ssq); }
        v4u qh, ql; unsigned hh[8], ll[8];
#pragma unroll
        for (int e = 0; e < 8; ++e) { hh[e] = f2bf(xs[e]); hi[e] = __builtin_bit_cast(float, hh[e] << 16); lo[e] = xs[e] - hi[e]; ll[e] = f2bf(lo[e]); }
        qh.x = hh[0] | (hh[1] << 16); qh.y = hh[2] | (hh[3] << 16); qh.z = hh[4] | (hh[5] << 16); qh.w = hh[6] | (hh[7] << 16);
        ql.x = ll[0] | (ll[1] << 16); ql.y = ll[2] | (ll[3] << 16); ql.z = ll[4] | (ll[5] << 16); ql.w = ll[6] | (ll[7] << 16);
        const bf16x8 Qh = __builtin_bit_cast(bf16x8, qh), Ql = __builtin_bit_cast(bf16x8, ql);
#pragma unroll
        for (int n = 0; n < 2; ++n) { const bf16x8 Ph = __builtin_bit_cast(bf16x8, *(const v4u*)(RWH + (size_t)(16 * n + fr) * D + k)), Pl = __builtin_bit_cast(bf16x8, *(const v4u*)(RWL + (size_t)(16 * n + fr) * D + k));
            acc[n] = __builtin_amdgcn_mfma_f32_16x16x32_bf16(Ph, Qh, acc[n], 0, 0, 0);
            acc[n] = __builtin_amdgcn_mfma_f32_16x16x32_bf16(Ph, Ql, acc[n], 0, 0, 0);
            acc[n] = __builtin_amdgcn_mfma_f32_16x16x32_bf16(Pl, Qh, acc[n], 0, 0, 0); }
    }
    ssq += __shfl_xor(ssq, 16); ssq += __shfl_xor(ssq, 32);
#pragma unroll
    for (int n = 0; n < 2; ++n) *(LAS f32x4*)(PL + (wave * 16 + fr) * 32 + 16 * n + 4 * fq) = acc[n];
    if (fq == 0) PSS[wave * 16 + fr] = ssq;
    __syncthreads();
    if (kh == 0) {
        const float tot = PSS[wave * 16 + fr] + PSS[(wave + 1) * 16 + fr]; const float rstd = __builtin_amdgcn_rsqf(tot * (1.0f / D) + EPS);
        if (fq == 0) RSTD[16 * st + fr] = rstd;
        float v[8]; int taken = 0;
#pragma unroll
        for (int n = 0; n < 2; ++n) { const f32x4 o = *(const LAS f32x4*)(PL + ((wave + 1) * 16 + fr) * 32 + 16 * n + 4 * fq); const f32x4 sw = *(const LAS f32x4*)(SHW + 16 * n + 4 * fq);
#pragma unroll
            for (int e = 0; e < 4; ++e) v[4 * n + e] = rstd * (acc[n][e] + o[e]) + sw[e]; }
        float selv[4]; int seli[4];
#pragma unroll
        for (int r = 0; r < 4; ++r) {
            float bv = -3.0e38f; int bi = 1 << 20;
#pragma unroll
            for (int q = 0; q < 8; ++q) { const int idx = 16 * (q >> 2) + 4 * fq + (q & 3); const bool ok = !((taken >> q) & 1) && (v[q] > bv); bv = ok ? v[q] : bv; bi = ok ? idx : bi; }
#pragma unroll
            for (int msk = 16; msk <= 32; msk <<= 1) { const float ov = __shfl_xor(bv, msk); const int oi = __shfl_xor(bi, msk); const bool tk = (ov > bv) || (ov == bv && oi < bi); bv = tk ? ov : bv; bi = tk ? oi : bi; }
            selv[r] = bv; seli[r] = bi;
            if (((bi >> 2) & 3) == fq) taken |= 1 << (4 * (bi >> 4) + (bi & 3));
        }
        const float e1 = __expf(selv[1] - selv[0]), e2 = __expf(selv[2] - selv[0]), e3 = __expf(selv[3] - selv[0]); const float inv = 1.0f / (1.0f + e1 + e2 + e3);
        const float wk = (fq == 0 ? 1.0f : fq == 1 ? e1 : fq == 2 ? e2 : e3) * inv; const int ek = fq == 0 ? seli[0] : fq == 1 ? seli[1] : fq == 2 ? seli[2] : seli[3];
        const int rank = __hip_atomic_fetch_add(HIST + ek, 1, __ATOMIC_RELAXED, __HIP_MEMORY_SCOPE_WORKGROUP);
        const size_t ai = (size_t)(row0 + 16 * st + fr) * 4 + fq;
        ((int*)(ws + WS_TOPE))[ai] = ek; ((float*)(ws + WS_TOPW))[ai] = wk; ((int*)(ws + WS_RANK))[ai] = rank;
    }
    __syncthreads();
    unsigned char* H8 = (unsigned char*)(ws + WS_H);
#pragma unroll
    for (int r0 = wave * 8; r0 < wave * 8 + 8; r0 += 4) {
        f32x4 xq[4][4];
#pragma unroll
        for (int i = 0; i < 4; ++i)
#pragma unroll
            for (int jj = 0; jj < 4; ++jj) xq[i][jj] = ld4<XBF>(X1, (size_t)(row0 + r0 + i) * D + 4 * lane + 256 * jj);
#pragma unroll
        for (int i = 0; i < 4; ++i) { const float rstd = RSTD[r0 + i] * H_SCALE;
#pragma unroll
            for (int jj = 0; jj < 4; ++jj) { const int c = 4 * lane + 256 * jj; const f32x4 gs = *(const LAS f32x4*)(GS + c), sh = *(const LAS f32x4*)(SH + c);
                const f32x4 o = xq[i][jj] * rstd * gs + sh * H_SCALE;
                *(unsigned*)(H8 + (size_t)(row0 + r0 + i) * D + c) = pg8::pk4_i8(o[0], o[1], o[2], o[3]); } } }
    if (tid < 32) ((int*)(ws + WS_CNT))[tile * 32 + tid] = HIST[tid];
    __syncthreads();
}

__device__ __forceinline__ void gather_phase(const Args& args, LAS unsigned char* lds, int vcu, int G) {
    FRESH_TID();
    unsigned char* ws = args.ws;
    LAS int* PART = (LAS int*)lds; LAS int* SEGS = (LAS int*)(lds + 2048); LAS int* BASE = (LAS int*)(lds + 2304); LAS int* SL = (LAS int*)(lds + 2560); LAS int* WK = (LAS int*)(lds + 4096);
    LAS int* TILEE = (LAS int*)(lds + L_TILEE); LAS int* NMp = (LAS int*)(lds + L_NM);
    const int* CNT = (const int*)(ws + WS_CNT);
    { const int e = tid & 31, q = tid >> 5; int s = 0;
#pragma unroll
        for (int t = 0; t < 16; ++t) s += CNT[(16 * q + t) * 32 + e];
        PART[q * 32 + e] = s; }
    __syncthreads();
    if (tid < 64) {
        int tot = 0;
        if (tid < 32) {
#pragma unroll
            for (int q = 0; q < 16; ++q) tot += PART[q * 32 + tid]; }
        const int nt = (tot + 255) >> 8; int inc = nt;
#pragma unroll
        for (int o = 1; o < 32; o <<= 1) { const int t = __shfl_up(inc, o); if (lane >= o) inc += t; }
        const int run = inc - nt;
        if (tid < 32) { SEGS[tid] = run * 256; for (int t = 0; t < nt; ++t) TILEE[run + t] = tid; }
        if (tid == 31) NMp[0] = inc;
    }
    __syncthreads();
    const unsigned char* H8 = (const unsigned char*)(ws + WS_H); unsigned char* XG = (unsigned char*)(ws + WS_XG);
    for (int tile = vcu; tile < NRT; tile += G) {
        { const int qt = tile >> 4, e = tid & 31, tq = tid >> 5, tt = 16 * qt + tq;
            WK[tq * 32 + e] = tt < tile ? CNT[tt * 32 + e] : 0; }
        __syncthreads();
        if (tid < 32) { const int qt = tile >> 4; int s = SEGS[tid];
            for (int q = 0; q < qt; ++q) s += PART[q * 32 + tid];
#pragma unroll
            for (int t = 0; t < 16; ++t) s += WK[t * 32 + tid];
            BASE[tid] = s; }
        __syncthreads();
        if (tid < 256) { const size_t ai = (size_t)tile * 256 + tid; const int e = ((const int*)(ws + WS_TOPE))[ai]; const int slot = BASE[e] + ((const int*)(ws + WS_RANK))[ai];
            ((int*)(ws + WS_SLOT))[ai] = slot; SL[tid] = slot; }
        __syncthreads();
        { v4u xr[8];
#pragma unroll
            for (int i = 0; i < 8; ++i) xr[i] = ((const v4u*)(H8 + (size_t)(tile * 64 + wave * 8 + i) * D))[lane];
#pragma unroll
            for (int i = 0; i < 8; ++i)
#pragma unroll
                for (int k = 0; k < 4; ++k) ((v4u*)(XG + (size_t)SL[wave * 32 + 4 * i + k] * D))[lane] = xr[i]; }
        __syncthreads();
    }
}

template <bool MOE, bool LAST, bool XBF>
__device__ __forceinline__ void combine_rows(const Args& args, int l, const void* X1, bf16* XN, int vcu, int G) {
    FRESH_TID(); const int gw = vcu * NWAVES + wave, NGW = G * NWAVES;
    unsigned char* ws = args.ws;
    const bf16* YE = (const bf16*)(ws + WS_XG); bf16* H = (bf16*)(ws + WS_H);
    int rpw = 1; while (rpw * NGW < T) rpw <<= 1;
    const int rbeg = gw * rpw, rend = (rbeg + rpw < T) ? rbeg + rpw : T;
    if (rbeg >= T) return;
    const int b = rbeg >> 12;
    const float* modl = (const float*)(ws + WS_MOD) + (size_t)(l * NB + b) * 6144;
    f32x4 gt[4], pa[4], pb[4];
#pragma unroll
    for (int q = 0; q < 4; ++q) { const int c = 8 * lane + 512 * (q >> 1) + 4 * (q & 1);
        gt[q] = MOE ? *(const f32x4*)(modl + 5 * D + c) : (f32x4){0.f, 0.f, 0.f, 0.f};
        if (LAST) { pa[q] = *(const f32x4*)(args.in[25] + c); pb[q] = (f32x4){0.f, 0.f, 0.f, 0.f}; }
        else { const float* modn = (const float*)(ws + WS_MOD) + (size_t)((l + 1) * NB + b) * 6144; const f32x4 g = *(const f32x4*)(args.in[2] + (size_t)(l + 1) * D + c), sc = *(const f32x4*)(modn + D + c);
            pa[q] = g * (sc + 1.0f); pb[q] = *(const f32x4*)(modn + c); } }
    int myslot = 0; float myw = 0.f;
    if (MOE && rpw * 4 <= 64 && lane < (rend - rbeg) * 4) { myslot = ((const int*)(ws + WS_SLOT))[(size_t)rbeg * 4 + lane]; myw = ((const float*)(ws + WS_TOPW))[(size_t)rbeg * 4 + lane]; }
#pragma unroll 2
    for (int row = rbeg; row < rend; ++row) {
        f32x4 v[4];
        { float t0[8], t1[8]; ld8<XBF>(X1, (size_t)row * D + 8 * lane, t0); ld8<XBF>(X1, (size_t)row * D + 512 + 8 * lane, t1);
            v[0] = (f32x4){t0[0], t0[1], t0[2], t0[3]}; v[1] = (f32x4){t0[4], t0[5], t0[6], t0[7]}; v[2] = (f32x4){t1[0], t1[1], t1[2], t1[3]}; v[3] = (f32x4){t1[4], t1[5], t1[6], t1[7]}; }
        if (MOE) {
            f32x4 a[4] = {(f32x4){0.f, 0.f, 0.f, 0.f}, (f32x4){0.f, 0.f, 0.f, 0.f}, (f32x4){0.f, 0.f, 0.f, 0.f}, (f32x4){0.f, 0.f, 0.f, 0.f}};
            v4u y[4][2]; float w[4];
#pragma unroll
            for (int k = 0; k < 4; ++k) { int slot;
                if (rpw * 4 <= 64) { slot = __builtin_amdgcn_readlane(myslot, (row - rbeg) * 4 + k); w[k] = __builtin_bit_cast(float, __builtin_amdgcn_readlane(__builtin_bit_cast(int, myw), (row - rbeg) * 4 + k)); }
                else { slot = ((const int*)(ws + WS_SLOT))[(size_t)row * 4 + k]; w[k] = ((const float*)(ws + WS_TOPW))[(size_t)row * 4 + k]; }
                slot = __builtin_amdgcn_readfirstlane(slot);
                const bf16* yr = YE + (size_t)slot * D + 8 * lane; y[k][0] = *(const v4u*)(yr); y[k][1] = *(const v4u*)(yr + 512); }
#pragma unroll
            for (int k = 0; k < 4; ++k)
#pragma unroll
                for (int hh = 0; hh < 2; ++hh) { const v4u t = y[k][hh];
                    a[2 * hh] += w[k] * (f32x4){bflo(t.x), bfhi(t.x), bflo(t.y), bfhi(t.y)}; a[2 * hh + 1] += w[k] * (f32x4){bflo(t.z), bfhi(t.z), bflo(t.w), bfhi(t.w)}; }
#pragma unroll
            for (int q = 0; q < 4; ++q) v[q] += gt[q] * a[q];
        }
        float s = 0.f;
#pragma unroll
        for (int q = 0; q < 4; ++q) s += (v[q][0] * v[q][0] + v[q][1] * v[q][1]) + (v[q][2] * v[q][2] + v[q][3] * v[q][3]);
        const float rstd = __builtin_amdgcn_rsqf(wave_sum(s) * (1.0f / D) + EPS);
        if (LAST) {
#pragma unroll
            for (int q = 0; q < 4; ++q) *(f32x4*)(args.out + (size_t)row * D + 8 * lane + 512 * (q >> 1) + 4 * (q & 1)) = v[q] * rstd * pa[q];
        } else {
#pragma unroll
            for (int hh = 0; hh < 2; ++hh) { v4u wv; wv.x = pk2(v[2 * hh][0], v[2 * hh][1]); wv.y = pk2(v[2 * hh][2], v[2 * hh][3]); wv.z = pk2(v[2 * hh + 1][0], v[2 * hh + 1][1]); wv.w = pk2(v[2 * hh + 1][2], v[2 * hh + 1][3]);
                *(v4u*)(XN + (size_t)row * D + 8 * lane + 512 * hh) = wv; }
#pragma unroll
            for (int hh = 0; hh < 2; ++hh) { const f32x4 o0 = v[2 * hh] * rstd * pa[2 * hh] + pb[2 * hh], o1 = v[2 * hh + 1] * rstd * pa[2 * hh + 1] + pb[2 * hh + 1];
                v4u wv; wv.x = pk2(o0[0], o0[1]); wv.y = pk2(o0[2], o0[3]); wv.z = pk2(o1[0], o1[1]); wv.w = pk2(o1[2], o1[3]);
                *(v4u*)(H + (size_t)row * D + 8 * lane + 512 * hh) = wv; }
        }
    }
}

template <int L> __device__ __forceinline__ void layer_body(const Args& args, LAS unsigned char* lds, const XcdBarrier& bar, int vcu, int G, const void* xin, bf16* xnext) {
    unsigned char* ws = args.ws;
    constexpr bool MIX = (RUN_MASK >> (2 * L)) & 1, MOE = (RUN_MASK >> (2 * L + 1)) & 1, LAST = (L == DEPTH - 1);
    const float* modl = (const float*)(ws + WS_MOD) + (size_t)L * NB * 6144;
    constexpr bool XIN_BF = (L > 0), X1_BF = MIX ? true : XIN_BF;
    bf16* XA = (bf16*)(ws + WS_XA);
    const void* x1 = xin;
    if (MIX) {
        if (PH(2)) { asm volatile("; PHASE_MARK P2" ::: "memory");
            _Pragma("unroll 1") for (int rep = 0; rep < NREP(2); ++rep) {
            pg8::Gemm g{(const bf16*)(ws + WS_H), (const bf16*)(ws + WS_WIN) + (size_t)L * DIN * D, D}; pg8::StaticOrder S; S.init(T / 256, DIN / 256, G, (int)blockIdx.x);
            pg8::EpiBf16 E{(bf16*)(ws + WS_Z), DIN, nullptr, 0, 1.0f};
            pg8::gemm_phase<pg8::EpiBf16, pg8::StaticOrder>(lds, g, S, E);
            xcd_barrier(bar); }
        }
        if (PH(3) & ((MIX_MASK >> 2) & 1)) { asm volatile("; PHASE_MARK P3a" ::: "memory");
            _Pragma("unroll 1") for (int rep = 0; rep < NREP(3); ++rep) {
            for (int u = vcu; u < NB * NBLK; u += G) { mixer_unit<false>(args, L, u >> 6, u & 63, lds); __syncthreads(); }
            xcd_barrier(bar); }
        }
        if (PH(4)) { asm volatile("; PHASE_MARK P3b" ::: "memory");
            _Pragma("unroll 1") for (int rep = 0; rep < NREP(4); ++rep) {
            for (int u = vcu; u < NB * NBLK; u += G) { mixer_unit<true>(args, L, u >> 6, u & 63, lds); __syncthreads(); }
            xcd_barrier(bar); }
        }
        if (PH(5)) { asm volatile("; PHASE_MARK P4" ::: "memory");
            _Pragma("unroll 1") for (int rep = 0; rep < NREP(5); ++rep) {
            pg8::Gemm g{(const bf16*)(ws + WS_Y), (const bf16*)(ws + WS_WOUT) + (size_t)L * D * D, D}; pg8::StaticOrder S; S.init(T / 256, D / 256, G, (int)blockIdx.x);
            pg8::EpiResGate<XIN_BF> E{xin, XA, modl + 2 * D};
            pg8::gemm_phase<pg8::EpiResGate<XIN_BF>, pg8::StaticOrder>(lds, g, S, E);
            xcd_barrier(bar); }
        }
        x1 = XA;
    }
    if (MOE) {
        if (PH(6)) { asm volatile("; PHASE_MARK P5" ::: "memory");
            _Pragma("unroll 1") for (int rep = 0; rep < NREP(6); ++rep) {
            for (int tile = vcu; tile < NRT; tile += G) route_tile<X1_BF>(args, L, tile, x1, lds);
            xcd_barrier(bar); }
        }
        if (PH(7)) { asm volatile("; PHASE_MARK P6" ::: "memory");
            _Pragma("unroll 1") for (int rep = 0; rep < NREP(7); ++rep) {
            gather_phase(args, lds, vcu, G);
            xcd_barrier(bar); }
        }
        const int nM = *(const LAS int*)(lds + L_NM);
        if (PH(8)) { asm volatile("; PHASE_MARK P7" ::: "memory");
            _Pragma("unroll 1") for (int rep = 0; rep < NREP(8); ++rep) {
            pg8::Gemm g{(const bf16*)(ws + WS_XG), (const bf16*)(ws + WS_W1 + (size_t)L * NE * 2048 * D), D}; pg8::MoeOrder S; S.init(nM, 8, G, (int)blockIdx.x); S.tile_e = (const LAS int*)(lds + L_TILEE);
            pg8::EpiSwiglu E{(unsigned char*)(ws + WS_ACT), args.in[22] + (size_t)L * NE * 2048, 1.0f / (H_SCALE * W_SCALE), ACT_SCALE};
            pg8::gemm_phase<pg8::EpiSwiglu, pg8::MoeOrder, true>(lds, g, S, E);
            xcd_barrier(bar); }
        }
        if (PH(9)) { asm volatile("; PHASE_MARK P8" ::: "memory");
            _Pragma("unroll 1") for (int rep = 0; rep < NREP(9); ++rep) {
            pg8::Gemm g{(const bf16*)(ws + WS_ACT), (const bf16*)(ws + WS_W2 + (size_t)L * NE * D * FF), FF}; pg8::MoeOrder S; S.init(nM, 4, G, (int)blockIdx.x); S.tile_e = (const LAS int*)(lds + L_TILEE);
            pg8::EpiBf16 E{(bf16*)(ws + WS_XG), D, args.in[24] + (size_t)L * NE * D, D, 1.0f / (ACT_SCALE * W_SCALE)};
            pg8::gemm_phase<pg8::EpiBf16, pg8::MoeOrder, true>(lds, g, S, E);
            xcd_barrier(bar); }
        }
    }
    asm volatile("; PHASE_MARK P9" ::: "memory");
    if (PH(10)) { _Pragma("unroll 1") for (int rep = 0; rep < NREP(10); ++rep) { combine_rows<MOE, LAST, X1_BF>(args, L, x1, xnext, vcu, G); if (!LAST) xcd_barrier(bar); } }
}

__global__ void __launch_bounds__(NTHR, 2) fwd_kernel(Args args) {
    extern __shared__ __attribute__((aligned(16))) unsigned char lds_raw[];
    LAS unsigned char* lds = (LAS unsigned char*)lds_raw;
    const int tid = threadIdx.x;
    const int G = gridDim.x; const int bx = blockIdx.x; const int vcu = (G % 8 == 0) ? (bx % 8) * (G / 8) + bx / 8 : bx;
    unsigned char* ws = args.ws;
    for (int u = tid; u < (LDS_BYTES - LDSCTL_OFF) / 4; u += NTHR) ((LAS unsigned*)(lds + LDSCTL_OFF))[u] = 0u;
    __syncthreads();
    XcdBarrier bar = xcd_barrier_post((unsigned*)(ws + WS_CTL) + CW_BAR, (volatile LAS unsigned*)(lds + L_MISC) + 8);
    asm volatile("; PHASE_MARK P0" ::: "memory");
    _Pragma("unroll 1") for (int rep = 0; rep < NREP(0); ++rep) { if (PH(0)) pro_phase(args, lds, vcu, G); xcd_barrier(bar); }
    { shw_phase(args, lds, vcu, G); if (PH(1) & (RUN_MASK & 1)) { const float* mod0 = (const float*)(ws + WS_MOD); adaln_rows(args.in[0], (bf16*)(ws + WS_H), args.in[2], mod0, mod0 + D, vcu, G); } xcd_barrier(bar); }
    layer_body<0>(args, lds, bar, vcu, G, args.in[0], (bf16*)(ws + WS_XB));
    layer_body<1>(args, lds, bar, vcu, G, (const void*)(ws + WS_XB), nullptr);
}

extern "C" void kernel_launch(void* const* d_in, const int* in_sizes, int n_in, void* d_out, int out_size, void* d_ws, size_t ws_size, hipStream_t stream) {
    static int grid = 0;
    if (grid == 0) {
        if (n_in != 26 || in_sizes[0] != T * D || out_size != T * D || ws_size < WS_END) { fprintf(stderr, "kernel_launch: unexpected shapes (n_in %d, in0 %d, out %d, ws %zu < %zu); nothing launched\n", n_in, n_in > 0 ? in_sizes[0] : -1, out_size, ws_size, (size_t)WS_END); grid = -1; return; }
        int dev = 0, cus = 0, per_cu = 0;
        if (hipGetDevice(&dev) != hipSuccess || hipDeviceGetAttribute(&cus, hipDeviceAttributeMultiprocessorCount, dev) != hipSuccess) { grid = -1; return; }
        if (hipFuncSetAttribute((const void*)fwd_kernel, hipFuncAttributeMaxDynamicSharedMemorySize, LDS_BYTES) != hipSuccess) { fprintf(stderr, "kernel_launch: hipFuncSetAttribute failed\n"); grid = -1; return; }
        if (hipOccupancyMaxActiveBlocksPerMultiprocessor(&per_cu, (const void*)fwd_kernel, NTHR, LDS_BYTES) != hipSuccess || per_cu < 1) { fprintf(stderr, "kernel_launch: occupancy query says %d blocks per CU\n", per_cu); }
        (void)hipGetLastError();
        grid = cus;
    }
    if (grid < 0) return;
    if (hipMemsetAsync((char*)d_ws + WS_CTL, 0, CTL_ZERO_BYTES, stream) != hipSuccess) return;
    Args a{};
    for (int i = 0; i < 26; ++i) a.in[i] = (const float*)d_in[i];
    a.out = (float*)d_out; a.ws = (unsigned char*)d_ws; a.ph_lo = 0; a.ph_hi = 0;
    hipLaunchKernelGGL(fwd_kernel, dim3(grid), dim3(NTHR), LDS_BYTES, stream, a);
}
```

```cpp
#include <hip/hip_runtime.h>
#include <cstdio>
#include <cstdint>

#ifndef RUN_MASK
#define RUN_MASK 15
#endif
#ifndef PH_ENABLE
#define PH_ENABLE 0x7ff
#endif
#define PH(k) ((PH_ENABLE >> (k)) & 1)
#ifndef DUP_MASK
#define DUP_MASK 0
#endif
#define NREP(k) (1 + ((DUP_MASK >> (k)) & 1))
#ifndef MIX_MASK
#define MIX_MASK 7
#endif

namespace pg8 {
#define PG8_LAS __attribute__((address_space(3)))
typedef unsigned short bf16_t;
typedef short bf16x8 __attribute__((ext_vector_type(8)));
typedef float f32x4 __attribute__((ext_vector_type(4)));
typedef unsigned u32x4 __attribute__((ext_vector_type(4)));
typedef int i32x4 __attribute__((ext_vector_type(4)));
typedef int i32x8 __attribute__((ext_vector_type(8)));
constexpr int BM = 256, BK = 64, HALF = 128, HTB = HALF * BK * 2, STAGE_BYTES = 8 * HTB, NXCD = 8, WGM = 8;

__host__ __device__ __forceinline__ int lds_byte(int r, int c) { const int st = (r >> 4) * 2 + (c >> 5), rr = r & 15, cc = c & 31, ob = rr * 64 + cc * 2; return st * 1024 + (ob ^ (((ob >> 9) & 1) << 5)); }
__host__ __device__ __forceinline__ void stage_rc(int b, int& R, int& C) { const int st = b / 1024, sb = b % 1024, swz = sb ^ (((sb >> 9) & 1) << 5); R = (st >> 1) * 16 + swz / 64; C = (st & 1) * 32 + (swz % 64) / 2; }
__host__ __device__ __forceinline__ int perm32(int rho) { const int n = rho >> 4, i = rho & 15; return 8 * (i >> 2) + 4 * n + (i & 3); }

struct Unit { int pm, pn, pb, e; };
struct Gemm { const bf16_t* A; const bf16_t* Bt; int K; };

struct StaticOrder {
    int nM, nN, nwg, G, c;
    __device__ void init(int nM_, int nN_, int G_, int c_) { nM = nM_; nN = nN_; nwg = nM * nN; G = G_; c = c_; }
    __device__ __forceinline__ bool map(int i, Unit& u) const {
        const long L = (long)i * G + c; if (L >= nwg) return false;
        int wgid = (int)L; { const int q = nwg / NXCD, r = nwg % NXCD, xcd = wgid % NXCD, off = wgid / NXCD; wgid = (xcd < r ? xcd * (q + 1) : r * (q + 1) + (xcd - r) * q) + off; }
        const int nig = WGM * nN, gid = wgid / nig, fm = gid * WGM, gsz = (nM - fm) < WGM ? (nM - fm) : WGM;
        u.pm = fm + ((wgid % nig) % gsz); u.pn = (wgid % nig) / gsz; return true;
    }
    __device__ __forceinline__ bool next(int i, Unit& u) const { if (!map(i, u)) return false; u.pb = u.pn; u.e = 0; return true; }
};
struct MoeOrder : StaticOrder {
    const PG8_LAS int* tile_e;
    __device__ __forceinline__ bool next(int i, Unit& u) const { if (!map(i, u)) return false; u.e = tile_e[u.pm]; u.pb = u.e * nN + u.pn; return true; }
};

__device__ __forceinline__ unsigned cvt_pk_bf16(float lo, float hi) { unsigned r; asm volatile("v_cvt_pk_bf16_f32 %0, %1, %2" : "=v"(r) : "v"(lo), "v"(hi)); return r; }

__device__ __forceinline__ unsigned q_i8(float x) { return (unsigned)__float2int_rn(fminf(fmaxf(x, -127.0f), 127.0f)) & 0xffu; }
__device__ __forceinline__ unsigned pk4_i8(float a, float b, float c, float d) { return q_i8(a) | (q_i8(b) << 8) | (q_i8(c) << 16) | (q_i8(d) << 24); }
struct EpiBf16 {
    static constexpr bool PERM = true;
    bf16_t* O; int ldc; const float* bias; int bstride; float sc;
    template <class AT> __device__ __forceinline__ void operator()(const AT (&acc)[2][2][4][2], const Unit& u, int wr, int wc, int fr, int fq) const {
        const int row0 = u.pm * BM + wr * 64 + fr; const int col0 = u.pn * BM + wc * 32 + 8 * fq;
        f32x4 bv[2][2];
#pragma unroll
        for (int bj = 0; bj < 2; ++bj)
#pragma unroll
            for (int n = 0; n < 2; ++n) bv[bj][n] = bias ? *(const f32x4*)(bias + (size_t)u.e * bstride + col0 + bj * HALF + 4 * n) : (f32x4){0.f, 0.f, 0.f, 0.f};
#pragma unroll
        for (int ai = 0; ai < 2; ++ai)
#pragma unroll
            for (int m = 0; m < 4; ++m) { bf16_t* rowp = O + (size_t)(row0 + ai * HALF + m * 16) * ldc + col0;
#pragma unroll
                for (int bj = 0; bj < 2; ++bj) { const f32x4 v0 = __builtin_convertvector(acc[ai][bj][m][0], f32x4) * sc + bv[bj][0], v1 = __builtin_convertvector(acc[ai][bj][m][1], f32x4) * sc + bv[bj][1];
                    u32x4 w; w.x = cvt_pk_bf16(v0[0], v0[1]); w.y = cvt_pk_bf16(v0[2], v0[3]); w.z = cvt_pk_bf16(v1[0], v1[1]); w.w = cvt_pk_bf16(v1[2], v1[3]);
                    *(u32x4*)(rowp + bj * HALF) = w; } }
    }
};
struct EpiSwiglu {
    static constexpr bool PERM = true;
    unsigned char* O; const float* b1; float sc, osc;
    template <class AT> __device__ __forceinline__ void operator()(const AT (&acc)[2][2][4][2], const Unit& u, int wr, int wc, int fr, int fq) const {
        const int row0 = u.pm * BM + wr * 64 + fr; const int cg = u.pn * HALF + wc * 32 + 8 * fq;
        const float* bg = b1 + (size_t)u.e * 2048 + cg;
        const f32x4 bg0 = *(const f32x4*)(bg), bg1 = *(const f32x4*)(bg + 4), bu0 = *(const f32x4*)(bg + 1024), bu1 = *(const f32x4*)(bg + 1028);
#pragma unroll
        for (int ai = 0; ai < 2; ++ai)
#pragma unroll
            for (int m = 0; m < 4; ++m) {
                const f32x4 g0 = __builtin_convertvector(acc[ai][0][m][0], f32x4) * sc + bg0, g1 = __builtin_convertvector(acc[ai][0][m][1], f32x4) * sc + bg1, u0 = __builtin_convertvector(acc[ai][1][m][0], f32x4) * sc + bu0, u1 = __builtin_convertvector(acc[ai][1][m][1], f32x4) * sc + bu1;
                float o[8];
#pragma unroll
                for (int j = 0; j < 8; ++j) { float g = j < 4 ? g0[j & 3] : g1[j & 3], uu = j < 4 ? u0[j & 3] : u1[j & 3];
                    g = fminf(g, 7.0f); uu = fminf(fmaxf(uu, -7.0f), 7.0f);
                    const float sg = __builtin_amdgcn_rcpf(1.0f + __builtin_amdgcn_exp2f(g * (-1.702f * 1.4426950408889634f)));
                    o[j] = (uu + 1.0f) * (g * sg) * osc; }
                const int w0 = (int)pk4_i8(o[0], o[1], o[2], o[3]), w1 = (int)pk4_i8(o[4], o[5], o[6], o[7]);
                typedef int i32x2 __attribute__((ext_vector_type(2)));
                *(i32x2*)(O + (size_t)(row0 + ai * HALF + m * 16) * 1024 + cg) = (i32x2){w0, w1}; }
    }
};
template <bool XBF> struct EpiResGate {
    static constexpr bool PERM = true;
    const void* X; bf16_t* O; const float* gate;
    template <class AT> __device__ __forceinline__ void operator()(const AT (&acc)[2][2][4][2], const Unit& u, int wr, int wc, int fr, int fq) const {
        const int row0 = u.pm * BM + wr * 64 + fr, col0 = u.pn * BM + wc * 32 + 8 * fq; const int b = (u.pm * BM) >> 12;
        f32x4 gv[2][2];
#pragma unroll
        for (int bj = 0; bj < 2; ++bj)
#pragma unroll
            for (int n = 0; n < 2; ++n) gv[bj][n] = *(const f32x4*)(gate + b * 6144 + col0 + bj * HALF + 4 * n);
#pragma unroll
        for (int ai = 0; ai < 2; ++ai)
#pragma unroll
            for (int m = 0; m < 4; ++m) { const size_t off = (size_t)(row0 + ai * HALF + m * 16) * 1024 + col0;
#pragma unroll
                for (int bj = 0; bj < 2; ++bj) { f32x4 x0, x1;
                    if (XBF) { const u32x4 w = *(const u32x4*)((const bf16_t*)X + off + bj * HALF);
                        x0 = (f32x4){__builtin_bit_cast(float, w.x << 16), __builtin_bit_cast(float, w.x & 0xffff0000u), __builtin_bit_cast(float, w.y << 16), __builtin_bit_cast(float, w.y & 0xffff0000u)};
                        x1 = (f32x4){__builtin_bit_cast(float, w.z << 16), __builtin_bit_cast(float, w.z & 0xffff0000u), __builtin_bit_cast(float, w.w << 16), __builtin_bit_cast(float, w.w & 0xffff0000u)}; }
                    else { x0 = *(const f32x4*)((const float*)X + off + bj * HALF); x1 = *(const f32x4*)((const float*)X + off + bj * HALF + 4); }
                    const f32x4 v0 = x0 + gv[bj][0] * __builtin_convertvector(acc[ai][bj][m][0], f32x4), v1 = x1 + gv[bj][1] * __builtin_convertvector(acc[ai][bj][m][1], f32x4);
                    u32x4 w; w.x = cvt_pk_bf16(v0[0], v0[1]); w.y = cvt_pk_bf16(v0[2], v0[3]); w.z = cvt_pk_bf16(v1[0], v1[1]); w.w = cvt_pk_bf16(v1[2], v1[3]);
                    *(u32x4*)(O + off + bj * HALF) = w; }
                asm volatile("" ::: "memory"); }
    }
};
template <bool I8> struct AccSel { typedef f32x4 type; };
template <> struct AccSel<true> { typedef i32x4 type; };
__device__ __forceinline__ f32x4 mma16(bf16x8 b, bf16x8 a, f32x4 c) { return __builtin_amdgcn_mfma_f32_16x16x32_bf16(b, a, c, 0, 0, 0); }
__device__ __forceinline__ i32x4 mma16(bf16x8 b, bf16x8 a, i32x4 c) { return __builtin_amdgcn_mfma_i32_16x16x64_i8(__builtin_bit_cast(i32x4, b), __builtin_bit_cast(i32x4, a), c, 0, 0, 0); }
template <class Epi, class Sched, bool I8 = false>
__device__ __forceinline__ void gemm_phase(PG8_LAS unsigned char* lds, const Gemm g, const Sched& S, const Epi& E) {
    int tid_ = threadIdx.x; asm volatile("" : "+v"(tid_));
    const int tid = tid_, wid = __builtin_amdgcn_readfirstlane(tid >> 6), lane = tid & 63, wr = wid >> 2, wc = wid & 3, fr = lane & 15, fq = lane >> 4;
    const int K = I8 ? g.K / 2 : g.K, nt = K / BK;
    unsigned voffA[2], voffB[2];
#pragma unroll
    for (int i = 0; i < 2; ++i) { int R, C; stage_rc(tid * 16 + i * 8192, R, C); const int Rb = Epi::PERM ? ((R & ~31) + perm32(R & 31)) : R;
        voffA[i] = (unsigned)(R * K + C) * 2u; voffB[i] = (unsigned)(Rb * K + C) * 2u; }
    const size_t kstep = (size_t)(BK * 2);
    const size_t hstep = (size_t)HALF * K * 2;
    const size_t tstep = 2 * hstep;
    const unsigned ldsw = (unsigned)wid * 1024u;
    const int aoff = lds_byte(wr * 64 + fr, fq * 8), boff = lds_byte(wc * 32 + fr, fq * 8);
#define PG8_SA(b, h) (((b) * 2 + (h)) * HTB)
#define PG8_SB(b, h) ((4 + (b) * 2 + (h)) * HTB)
#define PG8_STAGE(bufoff, gbase, voff) do { _Pragma("unroll") for (int _i = 0; _i < 2; ++_i) \
        __builtin_amdgcn_global_load_lds((const unsigned*)((const char*)(gbase) + (voff)[_i]), (PG8_LAS unsigned*)(lds + (bufoff) + ldsw + _i * 8192), 16, 0, 0); } while (0)
#define PG8_LDA(dst, b, h) do { _Pragma("unroll") for (int m = 0; m < 4; ++m) _Pragma("unroll") for (int k = 0; k < 2; ++k) dst[m][k] = *(const PG8_LAS bf16x8*)(lds + PG8_SA(b, h) + aoff + m * 2048 + k * 1024); } while (0)
#define PG8_LDB(dst, b, h) do { _Pragma("unroll") for (int n = 0; n < 2; ++n) _Pragma("unroll") for (int k = 0; k < 2; ++k) dst[n][k] = *(const PG8_LAS bf16x8*)(lds + PG8_SB(b, h) + boff + n * 2048 + k * 1024); } while (0)
#define PG8_MMA(ai, bj, At, Bt) do { __builtin_amdgcn_s_setprio(1); _Pragma("unroll") for (int m = 0; m < 4; ++m) _Pragma("unroll") for (int n = 0; n < 2; ++n) _Pragma("unroll") for (int k = 0; k < 2; ++k) \
        acc[ai][bj][m][n] = mma16(Bt[n][k], At[m][k], acc[ai][bj][m][n]); __builtin_amdgcn_s_setprio(0); } while (0)
#define PG8_WAIT_V(n) asm volatile("s_waitcnt vmcnt(" #n ")" ::: "memory")
#define PG8_WAIT_L(n) asm volatile("s_waitcnt lgkmcnt(" #n ")" ::: "memory")
#define PG8_BAR __builtin_amdgcn_s_barrier()
#define PG8_SCHED __builtin_amdgcn_sched_barrier(0)
    Unit cur, nxt; int ui = 0;
    if (!S.next(0, cur)) return;
    typedef typename AccSel<I8>::type AccT;
    AccT acc[2][2][4][2];
#pragma unroll
    for (int a = 0; a < 2; ++a)
#pragma unroll
        for (int b = 0; b < 2; ++b)
#pragma unroll
            for (int m = 0; m < 4; ++m)
#pragma unroll
                for (int n = 0; n < 2; ++n) acc[a][b][m][n] = AccT{};
    bf16x8 At[4][2], B0[2][2], B1[2][2];
    const char* cA = (const char*)g.A + (size_t)cur.pm * tstep; const char* cB = (const char*)g.Bt + (size_t)cur.pb * tstep;
    PG8_STAGE(PG8_SB(0, 0), cB, voffB); PG8_STAGE(PG8_SB(0, 1), cB + hstep, voffB); PG8_STAGE(PG8_SA(0, 0), cA, voffA); PG8_STAGE(PG8_SA(0, 1), cA + hstep, voffA);
    if (wr == 1) PG8_BAR;
    PG8_WAIT_V(2); PG8_BAR;
    PG8_STAGE(PG8_SB(1, 0), cB + kstep, voffB); PG8_STAGE(PG8_SA(1, 0), cA + kstep, voffA); PG8_STAGE(PG8_SB(1, 1), cB + hstep + kstep, voffB);
    PG8_WAIT_V(6); PG8_BAR;
    for (;;) {
        const bool has_next = S.next(ui + 1, nxt);
        const char* nA = has_next ? (const char*)g.A + (size_t)nxt.pm * tstep : cA; const char* nB = has_next ? (const char*)g.Bt + (size_t)nxt.pb * tstep : cB;
#pragma unroll 1
        for (int t = 0; t < nt; t += 2) {
            const bool last = (t == nt - 2);
            const char* a1 = cA + (size_t)(t + 1) * kstep;
            const char* a2 = last ? nA : cA + (size_t)(t + 2) * kstep; const char* b2 = last ? nB : cB + (size_t)(t + 2) * kstep;
            const char* a3 = a2 + kstep; const char* b3 = b2 + kstep;
            PG8_LDB(B0, 0, 0); PG8_LDB(B1, 0, 1); PG8_SCHED; PG8_LDA(At, 0, 0); PG8_STAGE(PG8_SA(1, 1), a1 + hstep, voffA);
            PG8_WAIT_V(8); PG8_WAIT_L(0); PG8_BAR; PG8_MMA(0, 0, At, B0); PG8_MMA(0, 1, At, B1); PG8_BAR; PG8_SCHED;
            PG8_LDA(At, 0, 1); PG8_STAGE(PG8_SB(0, 0), b2, voffB); PG8_STAGE(PG8_SB(0, 1), b2 + hstep, voffB); PG8_STAGE(PG8_SA(0, 0), a2, voffA);
            PG8_WAIT_V(8); PG8_WAIT_L(0); PG8_BAR; PG8_MMA(1, 0, At, B0); PG8_MMA(1, 1, At, B1); PG8_BAR; PG8_SCHED;
            PG8_LDB(B0, 1, 0); PG8_LDB(B1, 1, 1); PG8_SCHED; PG8_LDA(At, 1, 0); PG8_STAGE(PG8_SA(0, 1), a2 + hstep, voffA);
            PG8_WAIT_V(8); PG8_WAIT_L(0); PG8_BAR; PG8_MMA(0, 0, At, B0); PG8_MMA(0, 1, At, B1); PG8_BAR; PG8_SCHED;
            PG8_LDA(At, 1, 1); PG8_STAGE(PG8_SB(1, 0), b3, voffB); PG8_STAGE(PG8_SB(1, 1), b3 + hstep, voffB); PG8_STAGE(PG8_SA(1, 0), a3, voffA);
            PG8_WAIT_V(8); PG8_WAIT_L(0); PG8_BAR; PG8_MMA(1, 0, At, B0); PG8_MMA(1, 1, At, B1); PG8_BAR; PG8_SCHED;
        }
        if (wr == 0) PG8_BAR;
        E(acc, cur, wr, wc, fr, fq);
        if (!has_next) break;
#pragma unroll
        for (int a = 0; a < 2; ++a)
#pragma unroll
            for (int b = 0; b < 2; ++b)
#pragma unroll
                for (int m = 0; m < 4; ++m)
#pragma unroll
                    for (int n = 0; n < 2; ++n) acc[a][b][m][n] = AccT{};
        cur = nxt; cA = nA; cB = nB; ++ui;
        if (wr == 1) PG8_BAR;
    }
    PG8_WAIT_V(0);
    PG8_BAR;
#undef PG8_SA
#undef PG8_SB
#undef PG8_STAGE
#undef PG8_LDA
#undef PG8_LDB
#undef PG8_MMA
#undef PG8_WAIT_V
#undef PG8_WAIT_L
#undef PG8_BAR
#undef PG8_SCHED
}
}

constexpr int NWAVES = 8, NTHR = 512;
constexpr int NB = 4, SEQ = 4096, D = 1024, T = NB * SEQ, DIN = 2304, NE = 32, TOPK = 4, DEPTH = 2, FF = 1024;
constexpr int OFF_ZB = 0, OFF_ZC = 256, OFF_ZV = 512, OFF_ZU = 768, OFF_ZSV = 1024, OFF_ZG = 1280, OFF_ZX = 1792;
constexpr int NBLK = SEQ / 64;
constexpr int NRT = T / 64;
constexpr int MAXTILES = T * TOPK / 256 + NE;
constexpr int MAXSLOTS = MAXTILES * 256;
constexpr float EPS = 1e-6f;
constexpr float W_SCALE = 960.0f, H_SCALE = 28.0f, ACT_SCALE = 12.0f, HIN_SCALE = 28.0f;

constexpr size_t al(size_t x) { return (x + 4095) & ~(size_t)4095; }
constexpr size_t WS_CTL = 0, CTL_ZERO_BYTES = 65536;
constexpr size_t WS_MOD = 65536;
constexpr size_t WS_GWT = al(WS_MOD + (size_t)DEPTH * NB * 6144 * 4);
constexpr size_t WS_SGW = al(WS_GWT + (size_t)DEPTH * 2 * 8 * 4096 * 2);
constexpr size_t WS_RWH = al(WS_SGW + (size_t)DEPTH * 4 * 16384 * 2);
constexpr size_t WS_RWL = al(WS_RWH + (size_t)DEPTH * NE * D * 2);
constexpr size_t WS_WIN = al(WS_RWL + (size_t)DEPTH * NE * D * 2);
constexpr size_t WS_WOUT = al(WS_WIN + (size_t)DEPTH * DIN * D * 2);
constexpr size_t WS_W1 = al(WS_WOUT + (size_t)DEPTH * D * D * 2);
constexpr size_t WS_W2 = al(WS_W1 + (size_t)DEPTH * NE * 2048 * D * 2);
constexpr size_t WS_H = al(WS_W2 + (size_t)DEPTH * NE * D * FF * 2);
constexpr size_t WS_Z = al(WS_H + (size_t)T * D * 2);
constexpr size_t WS_Y = al(WS_Z + (size_t)T * DIN * 2);
constexpr size_t WS_XA = al(WS_Y + (size_t)T * D * 2);
constexpr size_t WS_XB = al(WS_XA + (size_t)T * D * 4);
constexpr size_t WS_AGA = al(WS_XB + (size_t)T * D * 4);
constexpr size_t WS_AGH = al(WS_AGA + (size_t)NB * NBLK * 512 * 4);
constexpr size_t WS_TOPE = al(WS_AGH + (size_t)NB * NBLK * 512 * 4);
constexpr size_t WS_TOPW = al(WS_TOPE + (size_t)T * 4 * 4);
constexpr size_t WS_RANK = al(WS_TOPW + (size_t)T * 4 * 4);
constexpr size_t WS_SLOT = al(WS_RANK + (size_t)T * 4 * 4);
constexpr size_t WS_CNT = al(WS_SLOT + (size_t)T * 4 * 4);
constexpr size_t WS_SHW = al(WS_CNT + (size_t)NRT * NE * 4);
constexpr size_t WS_XG = al(WS_SHW + (size_t)DEPTH * NB * NE * 4);
constexpr size_t WS_ACT = al(WS_XG + (size_t)MAXSLOTS * D * 2);
constexpr size_t WS_END = al(WS_ACT + (size_t)MAXSLOTS * D * 2);
constexpr int CW_BAR = 1024;

constexpr int RING_BYTES = 131072;
constexpr int SCR_BYTES = 147456;
constexpr int LDSCTL_OFF = SCR_BYTES;
constexpr int L_MISC = LDSCTL_OFF;
constexpr int L_TILEE = LDSCTL_OFF + 256;
constexpr int L_NM = L_TILEE + MAXTILES * 4;
constexpr int LDS_BYTES = LDSCTL_OFF + 2048;
static_assert(L_NM + 4 <= LDS_BYTES, "LDS map");

#define GAS __attribute__((address_space(1)))
#define LAS __attribute__((address_space(3)))
typedef unsigned short bf16;
typedef unsigned v4u __attribute__((ext_vector_type(4)));
typedef unsigned v2u __attribute__((ext_vector_type(2)));
typedef float f32x4 __attribute__((ext_vector_type(4)));
typedef short bf16x8 __attribute__((ext_vector_type(8)));
#define LDS_WAIT() asm volatile("s_waitcnt lgkmcnt(0)" ::: "memory")
#define FRESH_TID() int tid_ = threadIdx.x; asm volatile("" : "+v"(tid_)); const int tid = tid_, lane = tid & 63, wave = __builtin_amdgcn_readfirstlane(tid >> 6); (void)tid; (void)lane; (void)wave
__device__ __forceinline__ unsigned f2bf(float f) { unsigned u = __builtin_bit_cast(unsigned, f); return (u + 0x7fffu + ((u >> 16) & 1u)) >> 16; }
__device__ __forceinline__ unsigned pk2(float lo, float hi) { return pg8::cvt_pk_bf16(lo, hi); }
__device__ __forceinline__ float bflo(unsigned w) { return __builtin_bit_cast(float, w << 16); }
__device__ __forceinline__ float bfhi(unsigned w) { return __builtin_bit_cast(float, w & 0xffff0000u); }
template <bool BF> __device__ __forceinline__ void ld8(const void* p, size_t idx, float (&o)[8]) {
    if (BF) { const v4u w = *(const v4u*)((const bf16*)p + idx); o[0] = bflo(w.x); o[1] = bfhi(w.x); o[2] = bflo(w.y); o[3] = bfhi(w.y); o[4] = bflo(w.z); o[5] = bfhi(w.z); o[6] = bflo(w.w); o[7] = bfhi(w.w); }
    else { const f32x4 a = *(const f32x4*)((const float*)p + idx), b = *(const f32x4*)((const float*)p + idx + 4); o[0] = a[0]; o[1] = a[1]; o[2] = a[2]; o[3] = a[3]; o[4] = b[0]; o[5] = b[1]; o[6] = b[2]; o[7] = b[3]; } }
template <bool BF> __device__ __forceinline__ f32x4 ld4(const void* p, size_t idx) {
    if (BF) { const v2u w = *(const v2u*)((const bf16*)p + idx); return (f32x4){bflo(w.x), bfhi(w.x), bflo(w.y), bfhi(w.y)}; }
    else return *(const f32x4*)((const float*)p + idx); }
__device__ __forceinline__ float sigmoidf_(float x) { return __builtin_amdgcn_rcpf(1.0f + __builtin_amdgcn_exp2f(-1.4426950408889634f * x)); }
__device__ __forceinline__ float gelu_tanh(float x) { const float u2 = 1.5957691216057308f * (x + 0.044715f * x * x * x); return x * __builtin_amdgcn_rcpf(1.0f + __builtin_amdgcn_exp2f(-1.4426950408889634f * u2)); }
__device__ __forceinline__ float wave_sum(float v) {
#pragma unroll
    for (int o = 1; o < 64; o <<= 1) v += __shfl_xor(v, o);
    return v;
}
template <int CTRL> __device__ __forceinline__ float dpp_f(float old, float src) { return __builtin_bit_cast(float, __builtin_amdgcn_update_dpp(__builtin_bit_cast(int, old), __builtin_bit_cast(int, src), CTRL, 0xF, 0xF, false)); }
__device__ __forceinline__ float sum16(float v) {
    v += dpp_f<0xB1>(v, v); v += dpp_f<0x4E>(v, v); v += dpp_f<0x141>(v, v); v += dpp_f<0x140>(v, v); return v; }
__device__ __forceinline__ float bcast15(float v, int lane) { return __builtin_bit_cast(float, __builtin_amdgcn_ds_bpermute((lane | 15) << 2, __builtin_bit_cast(int, v))); }

#define XB_TMO      128
#define XB_XCNT(j)  (256  + 64 * (j))
#define XB_XSUB(j)  (1280 + 64 * (j))
#define XB_XGEN(j)  (2304 + 64 * (j))
#define XB_TOP      3328
#define XB_TOPGEN   3392
#define XCD_BAR_WORDS 3456
#define XB_SPIN_CAP (1u << 18)
__device__ __forceinline__ unsigned xb_ld(unsigned* p)              { return __hip_atomic_load(p, __ATOMIC_RELAXED, __HIP_MEMORY_SCOPE_AGENT); }
__device__ __forceinline__ unsigned xb_add(unsigned* p, unsigned v) { return __hip_atomic_fetch_add(p, v, __ATOMIC_RELAXED, __HIP_MEMORY_SCOPE_AGENT); }
__device__ __forceinline__ unsigned xb_xcc_id() { return (unsigned)__builtin_amdgcn_s_getreg((3 << 11) | 20) & 0xFu; }
#define XB_SPIN(cond, bar) do { unsigned _sp = 0; while (cond) { __builtin_amdgcn_s_sleep(1); \
    if ((++_sp & 255u) == 0u) { if (xb_ld(&(bar)[XB_TMO])) break; if (_sp > XB_SPIN_CAP) { atomicAdd(&(bar)[XB_TMO], 1u); break; } } } } while (0)
struct XcdBarrier { unsigned* bar; unsigned x; volatile LAS unsigned* st; };
__device__ __forceinline__ XcdBarrier xcd_barrier_post(unsigned* bar, volatile LAS unsigned* st) {
    XcdBarrier b; b.bar = bar; b.x = xb_xcc_id(); b.st = st;
    if (threadIdx.x == 0) (void)xb_add(&bar[XB_XCNT(b.x)], 1u);
    return b;
}
__device__ __forceinline__ void xcd_barrier_complete(unsigned* bar, unsigned x, unsigned& nloc, unsigned& nx) {
    const unsigned G = gridDim.x * gridDim.y * gridDim.z;
    unsigned sum, cnt, mine, sp = 0u;
    for (;;) {
        sum = 0u; cnt = 0u; mine = 0u;
#pragma unroll
        for (unsigned j = 0; j < 16; ++j) { const unsigned c = xb_ld(&bar[XB_XCNT(j)]); sum += c; cnt += (c > 0u) ? 1u : 0u; mine = (j == x) ? c : mine; }
        if (sum == G) break;
        __builtin_amdgcn_s_sleep(1);
        if ((++sp & 255u) == 0u) { if (xb_ld(&bar[XB_TMO])) break; if (sp > XB_SPIN_CAP) { atomicAdd(&bar[XB_TMO], 1u); break; } }
    }
    nloc = mine > 0u ? mine : 1u; nx = cnt > 0u ? cnt : 1u;
}
__device__ __forceinline__ void xcd_barrier(const XcdBarrier& b) {
    asm volatile("s_waitcnt vmcnt(0)" ::: "memory");
    __syncthreads();
    if (threadIdx.x == 0) {
        unsigned* bar = b.bar;
        __builtin_amdgcn_s_waitcnt(0);
        unsigned nloc = b.st[0], nx = b.st[1];
        if (nloc == 0u) { xcd_barrier_complete(bar, b.x, nloc, nx); b.st[0] = nloc; b.st[1] = nx; }
        const unsigned old = xb_add(&bar[XB_XSUB(b.x)], 1u);
        const unsigned gen = old / nloc;
        if (old + 1u == (gen + 1u) * nloc) {
            __builtin_amdgcn_fence(__ATOMIC_RELEASE, "agent");
            asm volatile("s_waitcnt vmcnt(0)" ::: "memory");
            const unsigned og = xb_add(&bar[XB_TOP], 1u);
            const unsigned tg = og / nx;
            if (og + 1u == (tg + 1u) * nx) xb_add(&bar[XB_TOPGEN], 1u);
            else XB_SPIN(xb_ld(&bar[XB_TOPGEN]) == tg, bar);
            __builtin_amdgcn_fence(__ATOMIC_ACQUIRE, "agent");
            xb_add(&bar[XB_XGEN(b.x)], 1u);
            asm volatile("s_waitcnt vmcnt(0)" ::: "memory");
        } else {
            XB_SPIN(xb_ld(&bar[XB_XGEN(b.x)]) == gen, bar);
            __builtin_amdgcn_fence(__ATOMIC_ACQUIRE, "agent");
            asm volatile("s_waitcnt vmcnt(0)" ::: "memory");
        }
    }
    __syncthreads();
}

struct TItem { const float* W; bf16* WT; int K, N, k0, n0, rowbase, fp8; };
__device__ __forceinline__ void ti_load(const TItem& d, f32x4 (&v)[16], int lane) {
#pragma unroll
    for (int i = 0; i < 16; ++i) v[i] = __builtin_nontemporal_load((const f32x4*)(d.W + (size_t)(d.k0 + 4 * i + (lane >> 4)) * d.N + d.n0 + 4 * (lane & 15)));
}
__device__ __forceinline__ void ti_store(const TItem& d, const f32x4 (&v)[16], LAS float* scr, int lane) {
#pragma unroll
    for (int i = 0; i < 16; ++i) { LAS float* s = scr + (4 * i + (lane >> 4)) * 65 + 4 * (lane & 15); s[0] = v[i][0]; s[1] = v[i][1]; s[2] = v[i][2]; s[3] = v[i][3]; }
    LDS_WAIT(); asm volatile("" ::: "memory");
    const int c = lane & 7;
#pragma unroll
    for (int j = 0; j < 8; ++j) { const int n = (lane >> 3) + 8 * j; const LAS float* s = scr + (8 * c) * 65 + n;
        v4u o; o.x = pk2(s[0 * 65], s[1 * 65]); o.y = pk2(s[2 * 65], s[3 * 65]); o.z = pk2(s[4 * 65], s[5 * 65]); o.w = pk2(s[6 * 65], s[7 * 65]);
        if (d.fp8) { const unsigned w0 = pg8::pk4_i8(s[0 * 65] * W_SCALE, s[1 * 65] * W_SCALE, s[2 * 65] * W_SCALE, s[3 * 65] * W_SCALE), w1 = pg8::pk4_i8(s[4 * 65] * W_SCALE, s[5 * 65] * W_SCALE, s[6 * 65] * W_SCALE, s[7 * 65] * W_SCALE);
            *(v2u*)((unsigned char*)d.WT + (size_t)(d.rowbase + n) * d.K + d.k0 + 8 * c) = (v2u){w0, w1}; }
        else *(v4u*)(d.WT + (size_t)(d.rowbase + n) * d.K + d.k0 + 8 * c) = o; }
    LDS_WAIT(); asm volatile("" ::: "memory");
}

struct Args { const float* in[26]; float* out; unsigned char* ws; int ph_lo, ph_hi; };

__device__ __forceinline__ void pro_phase(const Args& args, LAS unsigned char* lds, int vcu, int G) {
    FRESH_TID();
    unsigned char* ws = args.ws;
    for (int u = vcu; u < DEPTH * 96; u += G) {
        const int l = u / 96, cbk = u % 96, col = cbk * 64 + lane;
        const float* wa = args.in[4] + (size_t)l * D * 6144; const float* cc = args.in[1];
        float a0 = 0.f, a1 = 0.f, a2 = 0.f, a3 = 0.f;
#pragma unroll 8
        for (int k = wave * 128; k < wave * 128 + 128; ++k) { const float w = wa[(size_t)k * 6144 + col]; a0 += cc[k] * w; a1 += cc[D + k] * w; a2 += cc[2 * D + k] * w; a3 += cc[3 * D + k] * w; }
        LAS float* red = (LAS float*)lds;
        red[(wave * 4 + 0) * 64 + lane] = a0; red[(wave * 4 + 1) * 64 + lane] = a1; red[(wave * 4 + 2) * 64 + lane] = a2; red[(wave * 4 + 3) * 64 + lane] = a3;
        __syncthreads();
        if (tid < 256) { const int b = tid >> 6, cl = tid & 63; float s = args.in[5][(size_t)l * 6144 + cbk * 64 + cl];
#pragma unroll
            for (int w = 0; w < 8; ++w) s += red[(w * 4 + b) * 64 + cl];
            ((float*)(ws + WS_MOD))[(size_t)(l * NB + b) * 6144 + cbk * 64 + cl] = s; }
        __syncthreads();
    }
    const int gt = vcu * NTHR + tid, NGT = G * NTHR;
    for (int i = gt; i < DEPTH * 2 * 8 * 4096; i += NGT) {
        const int ii = i & 63, j = (i >> 6) & 63, lgh = i >> 12;
        ((bf16*)(ws + WS_GWT))[i] = (bf16)f2bf(args.in[14][(size_t)lgh * 4096 + ii * 64 + j]); }
    for (int i = gt; i < DEPTH * 4 * 16384; i += NGT) {
        const int s = i & 127, t = (i >> 7) & 127;
        ((bf16*)(ws + WS_SGW))[i] = (bf16)(s <= t ? f2bf(args.in[8][i]) : 0u); }
    for (int i = gt; i < DEPTH * NE * D; i += NGT) {
        const int k = i & 1023, e = (i >> 10) & 31, l = i >> 15;
        const float w = args.in[19][((size_t)l * D + k) * NE + e]; const unsigned hi = f2bf(w); const float r = w - __builtin_bit_cast(float, hi << 16);
        ((bf16*)(ws + WS_RWH))[i] = (bf16)hi; ((bf16*)(ws + WS_RWL))[i] = (bf16)f2bf(r); }
    LAS float* scr = (LAS float*)(lds + wave * 16640);
    const int gw = vcu * NWAVES + wave, NGW = G * NWAVES;
    constexpr int I_IN = 16 * 36, I_OUT = 16 * 16, I_W1 = NE * 16 * 32, I_W2 = NE * 16 * 16, I_L = I_IN + I_OUT + I_W1 + I_W2;
    auto decode = [&](int it, TItem& d) {
        const int l = it / I_L; int r = it % I_L;
        if (r < I_IN) { const int kb = r / 36, nb = r % 36; d = TItem{args.in[6] + (size_t)l * D * DIN, (bf16*)(ws + WS_WIN + (size_t)l * DIN * D), D, DIN, kb * 64, nb * 64, nb * 64, 1}; return; } r -= I_IN;
        if (r < I_OUT) { const int kb = r / 16, nb = r % 16; d = TItem{args.in[18] + (size_t)l * D * D, (bf16*)(ws + WS_WOUT) + (size_t)l * D * D, D, D, kb * 64, nb * 64, nb * 64, 0}; return; } r -= I_OUT;
        if (r < I_W1) { const int e = r / 512, q = r % 512, kb = q / 32, nb = q % 32, n0 = nb * 64;
            const int rowbase = (n0 < 1024) ? (n0 >> 7) * 256 + (n0 & 127) : ((n0 - 1024) >> 7) * 256 + 128 + ((n0 - 1024) & 127);
            d = TItem{args.in[21] + ((size_t)l * NE + e) * D * 2048, (bf16*)(ws + WS_W1 + ((size_t)l * NE + e) * 2048 * D), D, 2048, kb * 64, n0, rowbase, 1}; return; } r -= I_W1;
        { const int e = r / 256, q = r % 256, kb = q / 16, nb = q % 16;
            d = TItem{args.in[23] + ((size_t)l * NE + e) * FF * D, (bf16*)(ws + WS_W2 + ((size_t)l * NE + e) * D * FF), FF, D, kb * 64, nb * 64, nb * 64, 1}; }
    };
    int it = gw; TItem d, dn; f32x4 v[16], vn[16];
    if (it < DEPTH * I_L) { decode(it, d); ti_load(d, v, lane); }
    while (it < DEPTH * I_L) {
        const int itn = it + NGW; const bool hn = itn < DEPTH * I_L;
        if (hn) { decode(itn, dn); ti_load(dn, vn, lane); }
        ti_store(d, v, scr, lane);
        if (hn) { d = dn;
#pragma unroll
            for (int i = 0; i < 16; ++i) v[i] = vn[i]; }
        it = itn;
    }
}

__device__ __forceinline__ void adaln_rows(const float* X, unsigned char* H, const float* g, const float* mod_shift, const float* mod_scale, int vcu, int G) {
    FRESH_TID(); const int gw = vcu * NWAVES + wave, NGW = G * NWAVES;
    for (int row = gw; row < T; row += NGW) {
        const int b = row >> 12; const float* xr = X + (size_t)row * D + 4 * lane;
        f32x4 v[4]; float s = 0.f;
#pragma unroll
        for (int j = 0; j < 4; ++j) { v[j] = *(const f32x4*)(xr + 256 * j); s += (v[j][0] * v[j][0] + v[j][1] * v[j][1]) + (v[j][2] * v[j][2] + v[j][3] * v[j][3]); }
        const float rstd = __builtin_amdgcn_rsqf(wave_sum(s) * (1.0f / D) + EPS);
#pragma unroll
        for (int j = 0; j < 4; ++j) { const int c = 4 * lane + 256 * j;
            const f32x4 gv = *(const f32x4*)(g + c), sc = *(const f32x4*)(mod_scale + b * 6144 + c), sh = *(const f32x4*)(mod_shift + b * 6144 + c);
            const f32x4 o = (v[j] * rstd * gv * (sc + 1.0f) + sh) * HIN_SCALE;
            *(unsigned*)(H + (size_t)row * D + c) = pg8::pk4_i8(o[0], o[1], o[2], o[3]); }
    }
}


__device__ __forceinline__ void shw_phase(const Args& args, LAS unsigned char* lds, int vcu, int G) {
    FRESH_TID();
    unsigned char* ws = args.ws; LAS float* RED = (LAS float*)lds;
    for (int u = vcu; u < DEPTH * NB; u += G) {
        const int l = u >> 2, b = u & 3, e = tid & 31, part = tid >> 5;
        const float* sh = (const float*)(ws + WS_MOD) + (size_t)(l * NB + b) * 6144 + 3 * D; const float* rw = args.in[19] + (size_t)l * D * NE; float s = 0.f;
#pragma unroll 16
        for (int k = part * 64; k < part * 64 + 64; ++k) s = fmaf(sh[k], rw[(size_t)k * NE + e], s);
        RED[part * 32 + e] = s;
        __syncthreads();
        if (tid < 32) { float t = args.in[20][(size_t)l * NE + tid];
#pragma unroll
            for (int p = 0; p < 16; ++p) t += RED[p * 32 + tid];
            ((float*)(ws + WS_SHW))[(l * NB + b) * NE + tid] = t; }
        __syncthreads();
    }
}

constexpr int L3_CARRY = 139264, L3_SS = 141312, L3_SS2 = 143360, L3_SPL = 144384;
template <bool FULL>
__device__ __forceinline__ void mixer_unit(const Args& args, int l, int b, int j, LAS unsigned char* lds) {
    FRESH_TID();
    unsigned char* ws = args.ws;
    const bf16* Z = (const bf16*)(ws + WS_Z); bf16* Y = (bf16*)(ws + WS_Y);
    float* aggA = (float*)(ws + WS_AGA); float* aggH = (float*)(ws + WS_AGH);
    const float* mixg = args.in[17] + (size_t)l * D;
    const int fr = lane & 15, fq = lane >> 4;
    const size_t rowb = (size_t)b * SEQ;
    const int t0 = 64 * j;
    LAS float* CARRY = (LAS float*)(lds + L3_CARRY); LAS float* SS = (LAS float*)(lds + L3_SS); LAS float* SS2 = (LAS float*)(lds + L3_SS2); LAS float* SPL = (LAS float*)(lds + L3_SPL);
    if ((MIX_MASK & 4) || !FULL) {
        {
            const float y = -args.in[16][(size_t)l * 512 + tid];
            SPL[tid] = fmaxf(y, 0.f) + log1pf(expf(-fabsf(y)));
            if (FULL) { float c = 0.f; const float* pa = aggA + (size_t)b * NBLK * 512 + tid; const float* ph = aggH + (size_t)b * NBLK * 512 + tid;
                int jj = 0;
                for (; jj + 16 <= j; jj += 16) { float av[16], hv[16];
#pragma unroll
                    for (int q = 0; q < 16; ++q) { av[q] = pa[(size_t)(jj + q) * 512]; hv[q] = ph[(size_t)(jj + q) * 512]; }
#pragma unroll
                    for (int q = 0; q < 16; ++q) c = fmaf(av[q], c, hv[q]); }
                { float av[16], hv[16];
#pragma unroll
                    for (int q = 0; q < 16; ++q) { const bool ok = jj + q < j; const int jq = ok ? jj + q : 0; av[q] = pa[(size_t)jq * 512]; hv[q] = ph[(size_t)jq * 512]; if (!ok) { av[q] = 1.f; hv[q] = 0.f; } }
#pragma unroll
                    for (int q = 0; q < 16; ++q) c = fmaf(av[q], c, hv[q]); }
                CARRY[tid] = c; }
        }
        __syncthreads();
        const int hd = wave;
        LAS float* XR = (LAS float*)(lds + wave * 17408);
        const float* cw = args.in[12] + (size_t)l * 4 * 512; const float* cbp = args.in[13] + (size_t)l * 512;
        bf16x8 Xa[4][2];
#pragma unroll
        for (int ks = 0; ks < 2; ++ks) {
            const int c8 = 64 * hd + 32 * ks + 8 * fq;
            float wv[4][8], bv[8];
#pragma unroll
            for (int k = 0; k < 4; ++k) { const f32x4 w0 = *(const f32x4*)(cw + k * 512 + c8), w1 = *(const f32x4*)(cw + k * 512 + c8 + 4);
#pragma unroll
                for (int e = 0; e < 4; ++e) { wv[k][e] = w0[e]; wv[k][4 + e] = w1[e]; } }
            { const f32x4 b0 = *(const f32x4*)(cbp + c8), b1 = *(const f32x4*)(cbp + c8 + 4);
#pragma unroll
                for (int e = 0; e < 4; ++e) { bv[e] = b0[e]; bv[4 + e] = b1[e]; } }
#pragma unroll
            for (int m = 0; m < 4; ++m) {
                const int t = t0 + 16 * m + fr;
                float a8[8];
#pragma unroll
                for (int e = 0; e < 8; ++e) a8[e] = bv[e];
#pragma unroll
                for (int k = 0; k < 4; ++k) { const int tt = t - 3 + k; const int tc = tt < 0 ? 0 : tt;
                    const v4u z = *(const v4u*)(Z + (rowb + tc) * DIN + OFF_ZX + c8); const float msk = tt < 0 ? 0.f : 1.f;
                    const unsigned zw[4] = {z.x, z.y, z.z, z.w};
#pragma unroll
                    for (int q = 0; q < 4; ++q) { a8[2 * q] += wv[k][2 * q] * (msk * bflo(zw[q])); a8[2 * q + 1] += wv[k][2 * q + 1] * (msk * bfhi(zw[q])); } }
                v4u pk; pk.x = pk2(a8[0], a8[1]); pk.y = pk2(a8[2], a8[3]); pk.z = pk2(a8[4], a8[5]); pk.w = pk2(a8[6], a8[7]);
                Xa[m][ks] = __builtin_bit_cast(bf16x8, pk);
                LAS float* xp = XR + (16 * m + fr) * 68 + 32 * ks + 8 * fq;
                *(LAS f32x4*)(xp) = (f32x4){a8[0], a8[1], a8[2], a8[3]}; *(LAS f32x4*)(xp + 4) = (f32x4){a8[4], a8[5], a8[6], a8[7]};
            }
        }
        LDS_WAIT(); asm volatile("" ::: "memory");
        const bf16* GwT = (const bf16*)(ws + WS_GWT) + (size_t)l * 2 * 8 * 4096;
        const float* gbp = args.in[15] + (size_t)l * 2 * 512;
        float ss[4] = {0.f, 0.f, 0.f, 0.f};
        bf16x8 Wn[2][2]; f32x4 gbr_n, gbi_n; v2u zg_n[4];
#define LRU_PREFETCH(nn) do { \
            _Pragma("unroll") for (int g_ = 0; g_ < 2; ++g_) _Pragma("unroll") for (int ks_ = 0; ks_ < 2; ++ks_) \
                Wn[g_][ks_] = __builtin_bit_cast(bf16x8, *(const v4u*)(GwT + ((size_t)(g_ * 8 + hd) * 64 + 16 * (nn) + fr) * 64 + 32 * ks_ + 8 * fq)); \
            gbr_n = *(const f32x4*)(gbp + hd * 64 + 16 * (nn) + 4 * fq); gbi_n = *(const f32x4*)(gbp + 512 + hd * 64 + 16 * (nn) + 4 * fq); \
            if (FULL) { _Pragma("unroll") for (int m_ = 0; m_ < 4; ++m_) zg_n[m_] = *(const v2u*)(Z + (rowb + t0 + 16 * m_ + fr) * DIN + OFF_ZG + 64 * hd + 16 * (nn) + 4 * fq); } } while (0)
        LRU_PREFETCH(0);
#pragma unroll 1
        for (int n = 0; n < 4; ++n) {
            const int cc = 16 * n + 4 * fq, c = 64 * hd + cc;
            bf16x8 Wc[2][2]; v2u zgc[4];
#pragma unroll
            for (int g = 0; g < 2; ++g)
#pragma unroll
                for (int ks = 0; ks < 2; ++ks) Wc[g][ks] = Wn[g][ks];
            const f32x4 gbr = gbr_n, gbi = gbi_n;
#pragma unroll
            for (int m = 0; m < 4; ++m) zgc[m] = zg_n[m];
            { const int nn = n < 3 ? n + 1 : 3; LRU_PREFETCH(nn); }
            f32x4 acc[2][4];
#pragma unroll
            for (int g = 0; g < 2; ++g)
#pragma unroll
                for (int m = 0; m < 4; ++m) { acc[g][m] = (f32x4){0.f, 0.f, 0.f, 0.f};
#pragma unroll
                    for (int ks = 0; ks < 2; ++ks) acc[g][m] = __builtin_amdgcn_mfma_f32_16x16x32_bf16(Wc[g][ks], Xa[m][ks], acc[g][m], 0, 0, 0); }
            const f32x4 sp = *(const LAS f32x4*)(SPL + c);
            float A[4][4], Bv[4][4];
#pragma unroll
            for (int m = 0; m < 4; ++m) { const f32x4 xr = *(const LAS f32x4*)(XR + (16 * m + fr) * 68 + cc);
#pragma unroll
                for (int e = 0; e < 4; ++e) { const float r = sigmoidf_(acc[0][m][e] + gbr[e]), ig = sigmoidf_(acc[1][m][e] + gbi[e]);
                    const float la = -8.0f * r * sp[e]; const float a = __builtin_amdgcn_exp2f(la * 1.4426950408889634f);
                    A[m][e] = a; Bv[m][e] = xr[e] * ig * __builtin_amdgcn_sqrtf(fmaxf(fmaf(-a, a, 1.0f), 0.f)); } }
#pragma unroll
            for (int m = 0; m < 4; ++m)
#pragma unroll
                for (int e = 0; e < 4; ++e) { float a = A[m][e], bb = Bv[m][e];
                    { const float ap = dpp_f<0x111>(1.0f, a), bp = dpp_f<0x111>(0.0f, bb); bb = fmaf(a, bp, bb); a *= ap; }
                    { const float ap = dpp_f<0x112>(1.0f, a), bp = dpp_f<0x112>(0.0f, bb); bb = fmaf(a, bp, bb); a *= ap; }
                    { const float ap = dpp_f<0x114>(1.0f, a), bp = dpp_f<0x114>(0.0f, bb); bb = fmaf(a, bp, bb); a *= ap; }
                    { const float ap = dpp_f<0x118>(1.0f, a), bp = dpp_f<0x118>(0.0f, bb); bb = fmaf(a, bp, bb); a *= ap; }
                    A[m][e] = a; Bv[m][e] = bb; }
            float hc[4], ac[4];
            if (FULL) { const f32x4 cv = *(const LAS f32x4*)(CARRY + c); hc[0] = cv[0]; hc[1] = cv[1]; hc[2] = cv[2]; hc[3] = cv[3]; }
            else { hc[0] = hc[1] = hc[2] = hc[3] = 0.f; }
            ac[0] = ac[1] = ac[2] = ac[3] = 1.f;
#pragma unroll
            for (int m = 0; m < 4; ++m) {
                float hcur[4];
#pragma unroll
                for (int e = 0; e < 4; ++e) { hcur[e] = fmaf(A[m][e], hc[e], Bv[m][e]); hc[e] = bcast15(hcur[e], lane);
                    if (!FULL) ac[e] = bcast15(A[m][e] * ac[e], lane); }
                if (FULL) { const v2u zg = zgc[m];
                    const float g4[4] = {bflo(zg.x), bfhi(zg.x), bflo(zg.y), bfhi(zg.y)};
                    f32x4 yq;
#pragma unroll
                    for (int e = 0; e < 4; ++e) { const float y = gelu_tanh(g4[e]) * hcur[e]; yq[e] = y; ss[m] = fmaf(y, y, ss[m]); }
                    *(LAS f32x4*)(XR + (16 * m + fr) * 68 + cc) = yq; }
            }
            if (!FULL && fr == 0) { const size_t o = ((size_t)b * NBLK + j) * 512 + c; *(f32x4*)(aggA + o) = (f32x4){ac[0], ac[1], ac[2], ac[3]}; *(f32x4*)(aggH + o) = (f32x4){hc[0], hc[1], hc[2], hc[3]}; }
        }
#undef LRU_PREFETCH
        if (FULL) {
#pragma unroll
            for (int m = 0; m < 4; ++m) { float s = ss[m]; s += __shfl_xor(s, 16); s += __shfl_xor(s, 32); if (fq == 0) SS[wave * 64 + 16 * m + fr] = s; }
            __syncthreads();
#pragma unroll
            for (int m = 0; m < 4; ++m) { float tot = 0.f;
#pragma unroll
                for (int w = 0; w < 8; ++w) tot += SS[w * 64 + 16 * m + fr];
                const float rstd = __builtin_amdgcn_rsqf(tot * (1.0f / 512.0f) + EPS);
#pragma unroll
                for (int n = 0; n < 4; ++n) { const int c = 512 + 64 * hd + 16 * n + 4 * fq; const f32x4 mg = *(const f32x4*)(mixg + c);
                    const f32x4 yq = *(const LAS f32x4*)(XR + (16 * m + fr) * 68 + 16 * n + 4 * fq);
                    v2u w; w.x = pk2(yq[0] * rstd * mg[0], yq[1] * rstd * mg[1]); w.y = pk2(yq[2] * rstd * mg[2], yq[3] * rstd * mg[3]);
                    *(v2u*)(Y + (rowb + t0 + 16 * m + fr) * D + c) = w; } }
        }
    } else if (FULL) {
        for (int i = tid; i < 64 * 64; i += NTHR) { const int r = i >> 6, c8 = (i & 63) * 8; *(v4u*)(Y + (rowb + t0 + r) * D + 512 + c8) = (v4u){0u, 0u, 0u, 0u}; }
    }
    if (!FULL) return;
    asm volatile("" ::: "memory");
    if (MIX_MASK & 1) {
        const int tg = tid >> 5, s8 = (tid & 31) * 8; const int tb = t0 + 4 * tg;
        const float* caw = args.in[7] + (size_t)l * 3 * 256;
        float w3[3][8];
#pragma unroll
        for (int k = 0; k < 3; ++k) { const f32x4 w0 = *(const f32x4*)(caw + k * 256 + s8), w1 = *(const f32x4*)(caw + k * 256 + s8 + 4);
#pragma unroll
            for (int e = 0; e < 4; ++e) { w3[k][e] = w0[e]; w3[k][4 + e] = w1[e]; } }
        float cv[6][8];
#pragma unroll
        for (int i = 0; i < 6; ++i) { const int tt = tb - 2 + i; const int tc = tt < 0 ? 0 : tt; const float msk = tt < 0 ? 0.f : 1.f;
            const v4u zc = *(const v4u*)(Z + (rowb + tc) * DIN + OFF_ZC + s8), zv = *(const v4u*)(Z + (rowb + tc) * DIN + OFF_ZV + s8);
            const unsigned a[4] = {zc.x, zc.y, zc.z, zc.w}, bq[4] = {zv.x, zv.y, zv.z, zv.w};
#pragma unroll
            for (int q = 0; q < 4; ++q) { cv[i][2 * q] = msk * bflo(a[q]) * bflo(bq[q]); cv[i][2 * q + 1] = msk * bfhi(a[q]) * bfhi(bq[q]); } }
        const f32x4 mg0 = *(const f32x4*)(mixg + s8), mg1 = *(const f32x4*)(mixg + s8 + 4);
#pragma unroll
        for (int i = 0; i < 4; ++i) {
            const v4u zb = *(const v4u*)(Z + (rowb + tb + i) * DIN + OFF_ZB + s8); const unsigned a[4] = {zb.x, zb.y, zb.z, zb.w};
            float y[8], s = 0.f;
#pragma unroll
            for (int e = 0; e < 8; ++e) { const float zbe = (e & 1) ? bfhi(a[e >> 1]) : bflo(a[e >> 1]);
                y[e] = zbe * (w3[0][e] * cv[i][e] + w3[1][e] * cv[i + 1][e] + w3[2][e] * cv[i + 2][e]); s = fmaf(y[e], y[e], s); }
#pragma unroll
            for (int o = 1; o < 32; o <<= 1) s += __shfl_xor(s, o);
            const float rstd = __builtin_amdgcn_rsqf(s * (1.0f / 256.0f) + EPS);
            v4u w; w.x = pk2(y[0] * rstd * mg0[0], y[1] * rstd * mg0[1]); w.y = pk2(y[2] * rstd * mg0[2], y[3] * rstd * mg0[3]);
            w.z = pk2(y[4] * rstd * mg1[0], y[5] * rstd * mg1[1]); w.w = pk2(y[6] * rstd * mg1[2], y[7] * rstd * mg1[3]);
            *(v4u*)(Y + (rowb + tb + i) * D + s8) = w; }
    } else {
        for (int i = tid; i < 64 * 32; i += NTHR) { const int r = i >> 5, c8 = (i & 31) * 8; *(v4u*)(Y + (rowb + t0 + r) * D + c8) = (v4u){0u, 0u, 0u, 0u}; }
    }
    asm volatile("" ::: "memory");
    if (MIX_MASK & 2) {
        __syncthreads();
        const int hf = j & 1, tcs = t0 - 64 * hf, slen = 64 * (hf + 1);
        LAS bf16* Vt = (LAS bf16*)lds;
        const float* lng = args.in[10] + (size_t)l * 256; const float* lnb = args.in[11] + (size_t)l * 256;
        {
            const int rr = lane >> 4, ci = lane & 15;
            float gq[16], bq[16];
#pragma unroll
            for (int q = 0; q < 4; ++q) { const f32x4 a = *(const f32x4*)(lng + 16 * ci + 4 * q), bb = *(const f32x4*)(lnb + 16 * ci + 4 * q);
#pragma unroll
                for (int e = 0; e < 4; ++e) { gq[4 * q + e] = a[e]; bq[4 * q + e] = bb[e]; } }
            v4u zz[4][2];
#pragma unroll
            for (int it = 0; it < 4; ++it) if (it * 32 < slen) { const int sr = 32 * it + 4 * wave + rr; const bf16* zp = Z + (rowb + tcs + sr) * DIN + OFF_ZSV + 16 * ci;
                zz[it][0] = *(const v4u*)(zp); zz[it][1] = *(const v4u*)(zp + 8); }
#pragma unroll
            for (int it = 0; it < 4; ++it) if (it * 32 < slen) { const int sr = 32 * it + 4 * wave + rr;
                float v[16]; float sm = 0.f;
#pragma unroll
                for (int hh = 0; hh < 2; ++hh) { const unsigned w4[4] = {zz[it][hh].x, zz[it][hh].y, zz[it][hh].z, zz[it][hh].w};
#pragma unroll
                    for (int q = 0; q < 4; ++q) { v[8 * hh + 2 * q] = gelu_tanh(bflo(w4[q])); v[8 * hh + 2 * q + 1] = gelu_tanh(bfhi(w4[q])); } }
#pragma unroll
                for (int e = 0; e < 16; ++e) sm += v[e];
                const float mean = sum16(sm) * (1.0f / 256.0f); float sq = 0.f;
#pragma unroll
                for (int e = 0; e < 16; ++e) { v[e] -= mean; sq = fmaf(v[e], v[e], sq); }
                const float rstd = __builtin_amdgcn_rsqf(sum16(sq) * (1.0f / 256.0f) + EPS);
#pragma unroll
                for (int e = 0; e < 16; ++e) Vt[(16 * ci + e) * 136 + sr] = (bf16)f2bf(v[e] * rstd * gq[e] + bq[e]);
            } }
        __syncthreads();
        const int h = wave >> 1, th = wave & 1;
        const bf16* SGW = (const bf16*)(ws + WS_SGW) + ((size_t)l * 4 + h) * 16384;
        f32x4 acc[2][4];
#pragma unroll
        for (int m = 0; m < 2; ++m)
#pragma unroll
            for (int n = 0; n < 4; ++n) acc[m][n] = (f32x4){0.f, 0.f, 0.f, 0.f};
#pragma unroll
        for (int ks = 0; ks < 4; ++ks) {
            if (ks * 32 < slen) {
                bf16x8 Wq[2];
#pragma unroll
                for (int m = 0; m < 2; ++m) Wq[m] = __builtin_bit_cast(bf16x8, *(const v4u*)(SGW + (size_t)(64 * hf + 32 * th + 16 * m + fr) * 128 + 32 * ks + 8 * fq));
#pragma unroll
                for (int n = 0; n < 4; ++n) { const bf16x8 Vp = *(const LAS bf16x8*)(Vt + (64 * h + 16 * n + fr) * 136 + 32 * ks + 8 * fq);
#pragma unroll
                    for (int m = 0; m < 2; ++m) acc[m][n] = __builtin_amdgcn_mfma_f32_16x16x32_bf16(Vp, Wq[m], acc[m][n], 0, 0, 0); }
            }
        }
        const float* sgb = args.in[9] + ((size_t)l * 4 + h) * 128;
        float ys[2][4][4], s2[2];
#pragma unroll
        for (int m = 0; m < 2; ++m) { const int tl = 32 * th + 16 * m + fr; const float bias = sgb[64 * hf + tl]; float s = 0.f;
#pragma unroll
            for (int n = 0; n < 4; ++n) { const v2u zu = *(const v2u*)(Z + (rowb + t0 + tl) * DIN + OFF_ZU + 64 * h + 16 * n + 4 * fq);
                const float u4[4] = {bflo(zu.x), bfhi(zu.x), bflo(zu.y), bfhi(zu.y)};
#pragma unroll
                for (int e = 0; e < 4; ++e) { const float y = gelu_tanh(u4[e]) * (acc[m][n][e] + bias); ys[m][n][e] = y; s = fmaf(y, y, s); } }
            s += __shfl_xor(s, 16); s += __shfl_xor(s, 32); s2[m] = s; if (fq == 0) SS2[h * 64 + tl] = s; }
        __syncthreads();
#pragma unroll
        for (int m = 0; m < 2; ++m) { const int tl = 32 * th + 16 * m + fr; const float tot = (SS2[tl] + SS2[64 + tl]) + (SS2[128 + tl] + SS2[192 + tl]);
            const float rstd = __builtin_amdgcn_rsqf(tot * (1.0f / 256.0f) + EPS);
#pragma unroll
            for (int n = 0; n < 4; ++n) { const int c = 256 + 64 * h + 16 * n + 4 * fq; const f32x4 mg = *(const f32x4*)(mixg + c);
                v2u w; w.x = pk2(ys[m][n][0] * rstd * mg[0], ys[m][n][1] * rstd * mg[1]); w.y = pk2(ys[m][n][2] * rstd * mg[2], ys[m][n][3] * rstd * mg[3]);
                *(v2u*)(Y + (rowb + t0 + tl) * D + c) = w; } }
        (void)s2;
    } else {
        for (int i = tid; i < 64 * 32; i += NTHR) { const int r = i >> 5, c8 = (i & 31) * 8; *(v4u*)(Y + (rowb + t0 + r) * D + 256 + c8) = (v4u){0u, 0u, 0u, 0u}; }
    }
}

template <bool XBF> __device__ __forceinline__ void route_tile(const Args& args, int l, int tile, const void* X1, LAS unsigned char* lds) {
    FRESH_TID();
    unsigned char* ws = args.ws;
    LAS float* GS = (LAS float*)lds; LAS float* SH = (LAS float*)(lds + 4096); LAS float* SHW = (LAS float*)(lds + 8192); LAS float* RED = (LAS float*)(lds + 8448);
    LAS float* PL = (LAS float*)(lds + 16384); LAS float* PSS = (LAS float*)(lds + 32768); LAS float* RSTD = (LAS float*)(lds + 33280); LAS int* HIST = (LAS int*)(lds + 33792);
    const int row0 = tile * 64, b = row0 >> 12; const int fr = lane & 15, fq = lane >> 4;
    const float* mod = (const float*)(ws + WS_MOD) + (size_t)(l * NB + b) * 6144;
    const float* g2 = args.in[3] + (size_t)l * D;
    for (int k = tid; k < D; k += NTHR) { GS[k] = g2[k] * (1.0f + mod[4 * D + k]); SH[k] = mod[3 * D + k]; }
    if (tid < 32) HIST[tid] = 0;
    __syncthreads();
    if (tid < 32) SHW[tid] = ((const float*)(ws + WS_SHW))[(l * NB + b) * NE + tid];
    const int st = wave >> 1, kh = wave & 1;
    const bf16* RWH = (const bf16*)(ws + WS_RWH) + (size_t)l * NE * D; const bf16* RWL = (const bf16*)(ws + WS_RWL) + (size_t)l * NE * D;
    f32x4 acc[2] = {(f32x4){0.f, 0.f, 0.f, 0.f}, (f32x4){0.f, 0.f, 0.f, 0.f}}; float ssq = 0.f;
    const size_t xrow = (size_t)(row0 + 16 * st + fr) * D;
#pragma unroll 8
    for (int kb = 0; kb < 16; ++kb) {
        const int k = 512 * kh + 32 * kb + 8 * fq;
        float xv[8]; ld8<XBF>(X1, xrow + k, xv);
        const f32x4 g0 = *(const LAS f32x4*)(GS + k), g1 = *(const LAS f32x4*)(GS + k + 4);
        float xs[8], hi[8], lo[8];
#pragma unroll
        for (int e = 0; e < 4; ++e) { xs[e] = xv[e] * g0[e]; xs[4 + e] = xv[4 + e] * g1[e]; ssq = fmaf(xv[e], xv[e], ssq); ssq = fmaf(xv[4 + e], xv[4 + e], ssq); }
        v4u qh, ql; unsigned hh[8], ll[8];
#pragma unroll
        for (int e = 0; e < 8; ++e) { hh[e] = f2bf(xs[e]); hi[e] = __builtin_bit_cast(float, hh[e] << 16); lo[e] = xs[e] - hi[e]; ll[e] = f2bf(lo[e]); }
        qh.x = hh[0] | (hh[1] << 16); qh.y = hh[2] | (hh[3] << 16); qh.z = hh[4] | (hh[5] << 16); qh.w = hh[6] | (hh[7] << 16);
        ql.x = ll[0] | (ll[1] << 16); ql.y = ll[2] | (ll[3] << 16); ql.z = ll[4] | (ll[5] << 16); ql.w = ll[6] | (ll[7] << 16);
        const bf16x8 Qh = __builtin_bit_cast(bf16x8, qh), Ql = __builtin_bit_cast(bf16x8, ql);
#pragma unroll
        for (int n = 0; n < 2; ++n) { const bf16x8 Ph = __builtin_bit_cast(bf16x8, *(const v4u*)(RWH + (size_t)(16 * n + fr) * D + k)), Pl = __builtin_bit_cast(bf16x8, *(const v4u*)(RWL + (size_t)(16 * n + fr) * D + k));
            acc[n] = __builtin_amdgcn_mfma_f32_16x16x32_bf16(Ph, Qh, acc[n], 0, 0, 0);
            acc[n] = __builtin_amdgcn_mfma_f32_16x16x32_bf16(Ph, Ql, acc[n], 0, 0, 0);
            acc[n] = __builtin_amdgcn_mfma_f32_16x16x32_bf16(Pl, Qh, acc[n], 0, 0, 0); }
    }
    ssq += __shfl_xor(ssq, 16); ssq += __shfl_xor(ssq, 32);
#pragma unroll
    for (int n = 0; n < 2; ++n) *(LAS f32x4*)(PL + (wave * 16 + fr) * 32 + 16 * n + 4 * fq) = acc[n];
    if (fq == 0) PSS[wave * 16 + fr] = ssq;
    __syncthreads();
    if (kh == 0) {
        const float tot = PSS[wave * 16 + fr] + PSS[(wave + 1) * 16 + fr]; const float rstd = __builtin_amdgcn_rsqf(tot * (1.0f / D) + EPS);
        if (fq == 0) RSTD[16 * st + fr] = rstd;
        float v[8]; int taken = 0;
#pragma unroll
        for (int n = 0; n < 2; ++n) { const f32x4 o = *(const LAS f32x4*)(PL + ((wave + 1) * 16 + fr) * 32 + 16 * n + 4 * fq); const f32x4 sw = *(const LAS f32x4*)(SHW + 16 * n + 4 * fq);
#pragma unroll
            for (int e = 0; e < 4; ++e) v[4 * n + e] = rstd * (acc[n][e] + o[e]) + sw[e]; }
        float selv[4]; int seli[4];
#pragma unroll
        for (int r = 0; r < 4; ++r) {
            float bv = -3.0e38f; int bi = 1 << 20;
#pragma unroll
            for (int q = 0; q < 8; ++q) { const int idx = 16 * (q >> 2) + 4 * fq + (q & 3); const bool ok = !((taken >> q) & 1) && (v[q] > bv); bv = ok ? v[q] : bv; bi = ok ? idx : bi; }
#pragma unroll
            for (int msk = 16; msk <= 32; msk <<= 1) { const float ov = __shfl_xor(bv, msk); const int oi = __shfl_xor(bi, msk); const bool tk = (ov > bv) || (ov == bv && oi < bi); bv = tk ? ov : bv; bi = tk ? oi : bi; }
            selv[r] = bv; seli[r] = bi;
            if (((bi >> 2) & 3) == fq) taken |= 1 << (4 * (bi >> 4) + (bi & 3));
        }
        const float e1 = __expf(selv[1] - selv[0]), e2 = __expf(selv[2] - selv[0]), e3 = __expf(selv[3] - selv[0]); const float inv = 1.0f / (1.0f + e1 + e2 + e3);
        const float wk = (fq == 0 ? 1.0f : fq == 1 ? e1 : fq == 2 ? e2 : e3) * inv; const int ek = fq == 0 ? seli[0] : fq == 1 ? seli[1] : fq == 2 ? seli[2] : seli[3];
        const int rank = __hip_atomic_fetch_add(HIST + ek, 1, __ATOMIC_RELAXED, __HIP_MEMORY_SCOPE_WORKGROUP);
        const size_t ai = (size_t)(row0 + 16 * st + fr) * 4 + fq;
        ((int*)(ws + WS_TOPE))[ai] = ek; ((float*)(ws + WS_TOPW))[ai] = wk; ((int*)(ws + WS_RANK))[ai] = rank;
    }
    __syncthreads();
    unsigned char* H8 = (unsigned char*)(ws + WS_H);
#pragma unroll
    for (int r0 = wave * 8; r0 < wave * 8 + 8; r0 += 4) {
        f32x4 xq[4][4];
#pragma unroll
        for (int i = 0; i < 4; ++i)
#pragma unroll
            for (int jj = 0; jj < 4; ++jj) xq[i][jj] = ld4<XBF>(X1, (size_t)(row0 + r0 + i) * D + 4 * lane + 256 * jj);
#pragma unroll
        for (int i = 0; i < 4; ++i) { const float rstd = RSTD[r0 + i] * H_SCALE;
#pragma unroll
            for (int jj = 0; jj < 4; ++jj) { const int c = 4 * lane + 256 * jj; const f32x4 gs = *(const LAS f32x4*)(GS + c), sh = *(const LAS f32x4*)(SH + c);
                const f32x4 o = xq[i][jj] * rstd * gs + sh * H_SCALE;
                *(unsigned*)(H8 + (size_t)(row0 + r0 + i) * D + c) = pg8::pk4_i8(o[0], o[1], o[2], o[3]); } } }
    if (tid < 32) ((int*)(ws + WS_CNT))[tile * 32 + tid] = HIST[tid];
    __syncthreads();
}

__device__ __forceinline__ void gather_phase(const Args& args, LAS unsigned char* lds, int vcu, int G) {
    FRESH_TID();
    unsigned char* ws = args.ws;
    LAS int* PART = (LAS int*)lds; LAS int* SEGS = (LAS int*)(lds + 2048); LAS int* BASE = (LAS int*)(lds + 2304); LAS int* SL = (LAS int*)(lds + 2560); LAS int* WK = (LAS int*)(lds + 4096);
    LAS int* TILEE = (LAS int*)(lds + L_TILEE); LAS int* NMp = (LAS int*)(lds + L_NM);
    const int* CNT = (const int*)(ws + WS_CNT);
    { const int e = tid & 31, q = tid >> 5; int s = 0;
#pragma unroll
        for (int t = 0; t < 16; ++t) s += CNT[(16 * q + t) * 32 + e];
        PART[q * 32 + e] = s; }
    __syncthreads();
    if (tid < 64) {
        int tot = 0;
        if (tid < 32) {
#pragma unroll
            for (int q = 0; q < 16; ++q) tot += PART[q * 32 + tid]; }
        const int nt = (tot + 255) >> 8; int inc = nt;
#pragma unroll
        for (int o = 1; o < 32; o <<= 1) { const int t = __shfl_up(inc, o); if (lane >= o) inc += t; }
        const int run = inc - nt;
        if (tid < 32) { SEGS[tid] = run * 256; for (int t = 0; t < nt; ++t) TILEE[run + t] = tid; }
        if (tid == 31) NMp[0] = inc;
    }
    __syncthreads();
    const unsigned char* H8 = (const unsigned char*)(ws + WS_H); unsigned char* XG = (unsigned char*)(ws + WS_XG);
    for (int tile = vcu; tile < NRT; tile += G) {
        { const int qt = tile >> 4, e = tid & 31, tq = tid >> 5, tt = 16 * qt + tq;
            WK[tq * 32 + e] = tt < tile ? CNT[tt * 32 + e] : 0; }
        __syncthreads();
        if (tid < 32) { const int qt = tile >> 4; int s = SEGS[tid];
            for (int q = 0; q < qt; ++q) s += PART[q * 32 + tid];
#pragma unroll
            for (int t = 0; t < 16; ++t) s += WK[t * 32 + tid];
            BASE[tid] = s; }
        __syncthreads();
        if (tid < 256) { const size_t ai = (size_t)tile * 256 + tid; const int e = ((const int*)(ws + WS_TOPE))[ai]; const int slot = BASE[e] + ((const int*)(ws + WS_RANK))[ai];
            ((int*)(ws + WS_SLOT))[ai] = slot; SL[tid] = slot; }
        __syncthreads();
        { v4u xr[8];
#pragma unroll
            for (int i = 0; i < 8; ++i) xr[i] = ((const v4u*)(H8 + (size_t)(tile * 64 + wave * 8 + i) * D))[lane];
#pragma unroll
            for (int i = 0; i < 8; ++i)
#pragma unroll
                for (int k = 0; k < 4; ++k) ((v4u*)(XG + (size_t)SL[wave * 32 + 4 * i + k] * D))[lane] = xr[i]; }
        __syncthreads();
    }
}

template <bool MOE, bool LAST, bool XBF>
__device__ __forceinline__ void combine_rows(const Args& args, int l, const void* X1, bf16* XN, int vcu, int G) {
    FRESH_TID(); const int gw = vcu * NWAVES + wave, NGW = G * NWAVES;
    unsigned char* ws = args.ws;
    const bf16* YE = (const bf16*)(ws + WS_XG); unsigned char* H = (unsigned char*)(ws + WS_H);
    int rpw = 1; while (rpw * NGW < T) rpw <<= 1;
    const int rbeg = gw * rpw, rend = (rbeg + rpw < T) ? rbeg + rpw : T;
    if (rbeg >= T) return;
    const int b = rbeg >> 12;
    const float* modl = (const float*)(ws + WS_MOD) + (size_t)(l * NB + b) * 6144;
    f32x4 gt[4], pa[4], pb[4];
#pragma unroll
    for (int q = 0; q < 4; ++q) { const int c = 8 * lane + 512 * (q >> 1) + 4 * (q & 1);
        gt[q] = MOE ? *(const f32x4*)(modl + 5 * D + c) : (f32x4){0.f, 0.f, 0.f, 0.f};
        if (LAST) { pa[q] = *(const f32x4*)(args.in[25] + c); pb[q] = (f32x4){0.f, 0.f, 0.f, 0.f}; }
        else { const float* modn = (const float*)(ws + WS_MOD) + (size_t)((l + 1) * NB + b) * 6144; const f32x4 g = *(const f32x4*)(args.in[2] + (size_t)(l + 1) * D + c), sc = *(const f32x4*)(modn + D + c);
            pa[q] = g * (sc + 1.0f); pb[q] = *(const f32x4*)(modn + c); } }
    int myslot = 0; float myw = 0.f;
    if (MOE && rpw * 4 <= 64 && lane < (rend - rbeg) * 4) { myslot = ((const int*)(ws + WS_SLOT))[(size_t)rbeg * 4 + lane]; myw = ((const float*)(ws + WS_TOPW))[(size_t)rbeg * 4 + lane]; }
#pragma unroll 2
    for (int row = rbeg; row < rend; ++row) {
        f32x4 v[4];
        { float t0[8], t1[8]; ld8<XBF>(X1, (size_t)row * D + 8 * lane, t0); ld8<XBF>(X1, (size_t)row * D + 512 + 8 * lane, t1);
            v[0] = (f32x4){t0[0], t0[1], t0[2], t0[3]}; v[1] = (f32x4){t0[4], t0[5], t0[6], t0[7]}; v[2] = (f32x4){t1[0], t1[1], t1[2], t1[3]}; v[3] = (f32x4){t1[4], t1[5], t1[6], t1[7]}; }
        if (MOE) {
            f32x4 a[4] = {(f32x4){0.f, 0.f, 0.f, 0.f}, (f32x4){0.f, 0.f, 0.f, 0.f}, (f32x4){0.f, 0.f, 0.f, 0.f}, (f32x4){0.f, 0.f, 0.f, 0.f}};
            v4u y[4][2]; float w[4];
#pragma unroll
            for (int k = 0; k < 4; ++k) { int slot;
                if (rpw * 4 <= 64) { slot = __builtin_amdgcn_readlane(myslot, (row - rbeg) * 4 + k); w[k] = __builtin_bit_cast(float, __builtin_amdgcn_readlane(__builtin_bit_cast(int, myw), (row - rbeg) * 4 + k)); }
                else { slot = ((const int*)(ws + WS_SLOT))[(size_t)row * 4 + k]; w[k] = ((const float*)(ws + WS_TOPW))[(size_t)row * 4 + k]; }
                slot = __builtin_amdgcn_readfirstlane(slot);
                const bf16* yr = YE + (size_t)slot * D + 8 * lane; y[k][0] = *(const v4u*)(yr); y[k][1] = *(const v4u*)(yr + 512); }
#pragma unroll
            for (int k = 0; k < 4; ++k)
#pragma unroll
                for (int hh = 0; hh < 2; ++hh) { const v4u t = y[k][hh];
                    a[2 * hh] += w[k] * (f32x4){bflo(t.x), bfhi(t.x), bflo(t.y), bfhi(t.y)}; a[2 * hh + 1] += w[k] * (f32x4){bflo(t.z), bfhi(t.z), bflo(t.w), bfhi(t.w)}; }
#pragma unroll
            for (int q = 0; q < 4; ++q) v[q] += gt[q] * a[q];
        }
        float s = 0.f;
#pragma unroll
        for (int q = 0; q < 4; ++q) s += (v[q][0] * v[q][0] + v[q][1] * v[q][1]) + (v[q][2] * v[q][2] + v[q][3] * v[q][3]);
        const float rstd = __builtin_amdgcn_rsqf(wave_sum(s) * (1.0f / D) + EPS);
        if (LAST) {
#pragma unroll
            for (int q = 0; q < 4; ++q) *(f32x4*)(args.out + (size_t)row * D + 8 * lane + 512 * (q >> 1) + 4 * (q & 1)) = v[q] * rstd * pa[q];
        } else {
#pragma unroll
            for (int hh = 0; hh < 2; ++hh) { v4u wv; wv.x = pk2(v[2 * hh][0], v[2 * hh][1]); wv.y = pk2(v[2 * hh][2], v[2 * hh][3]); wv.z = pk2(v[2 * hh + 1][0], v[2 * hh + 1][1]); wv.w = pk2(v[2 * hh + 1][2], v[2 * hh + 1][3]);
                *(v4u*)(XN + (size_t)row * D + 8 * lane + 512 * hh) = wv; }
#pragma unroll
            for (int hh = 0; hh < 2; ++hh) { const f32x4 o0 = (v[2 * hh] * rstd * pa[2 * hh] + pb[2 * hh]) * HIN_SCALE, o1 = (v[2 * hh + 1] * rstd * pa[2 * hh + 1] + pb[2 * hh + 1]) * HIN_SCALE;
                *(v2u*)(H + (size_t)row * D + 8 * lane + 512 * hh) = (v2u){pg8::pk4_i8(o0[0], o0[1], o0[2], o0[3]), pg8::pk4_i8(o1[0], o1[1], o1[2], o1[3])}; }
        }
    }
}

template <int L> __device__ __forceinline__ void layer_body(const Args& args, LAS unsigned char* lds, const XcdBarrier& bar, int vcu, int G, const void* xin, bf16* xnext) {
    unsigned char* ws = args.ws;
    constexpr bool MIX = (RUN_MASK >> (2 * L)) & 1, MOE = (RUN_MASK >> (2 * L + 1)) & 1, LAST = (L == DEPTH - 1);
    const float* modl = (const float*)(ws + WS_MOD) + (size_t)L * NB * 6144;
    constexpr bool XIN_BF = (L > 0), X1_BF = MIX ? true : XIN_BF;
    bf16* XA = (bf16*)(ws + WS_XA);
    const void* x1 = xin;
    if (MIX) {
        if (PH(2)) { asm volatile("; PHASE_MARK P2" ::: "memory");
            _Pragma("unroll 1") for (int rep = 0; rep < NREP(2); ++rep) {
            pg8::Gemm g{(const bf16*)(ws + WS_H), (const bf16*)(ws + WS_WIN + (size_t)L * DIN * D), D}; pg8::StaticOrder S; S.init(T / 256, DIN / 256, G, (int)blockIdx.x);
            pg8::EpiBf16 E{(bf16*)(ws + WS_Z), DIN, nullptr, 0, 1.0f / (HIN_SCALE * W_SCALE)};
            pg8::gemm_phase<pg8::EpiBf16, pg8::StaticOrder, true>(lds, g, S, E);
            xcd_barrier(bar); }
        }
        if (PH(3) & ((MIX_MASK >> 2) & 1)) { asm volatile("; PHASE_MARK P3a" ::: "memory");
            _Pragma("unroll 1") for (int rep = 0; rep < NREP(3); ++rep) {
            for (int u = vcu; u < NB * NBLK; u += G) { mixer_unit<false>(args, L, u >> 6, u & 63, lds); __syncthreads(); }
            xcd_barrier(bar); }
        }
        if (PH(4)) { asm volatile("; PHASE_MARK P3b" ::: "memory");
            _Pragma("unroll 1") for (int rep = 0; rep < NREP(4); ++rep) {
            for (int u = vcu; u < NB * NBLK; u += G) { mixer_unit<true>(args, L, u >> 6, u & 63, lds); __syncthreads(); }
            xcd_barrier(bar); }
        }
        if (PH(5)) { asm volatile("; PHASE_MARK P4" ::: "memory");
            _Pragma("unroll 1") for (int rep = 0; rep < NREP(5); ++rep) {
            pg8::Gemm g{(const bf16*)(ws + WS_Y), (const bf16*)(ws + WS_WOUT) + (size_t)L * D * D, D}; pg8::StaticOrder S; S.init(T / 256, D / 256, G, (int)blockIdx.x);
            pg8::EpiResGate<XIN_BF> E{xin, XA, modl + 2 * D};
            pg8::gemm_phase<pg8::EpiResGate<XIN_BF>, pg8::StaticOrder>(lds, g, S, E);
            xcd_barrier(bar); }
        }
        x1 = XA;
    }
    if (MOE) {
        if (PH(6)) { asm volatile("; PHASE_MARK P5" ::: "memory");
            _Pragma("unroll 1") for (int rep = 0; rep < NREP(6); ++rep) {
            for (int tile = vcu; tile < NRT; tile += G) route_tile<X1_BF>(args, L, tile, x1, lds);
            xcd_barrier(bar); }
        }
        if (PH(7)) { asm volatile("; PHASE_MARK P6" ::: "memory");
            _Pragma("unroll 1") for (int rep = 0; rep < NREP(7); ++rep) {
            gather_phase(args, lds, vcu, G);
            xcd_barrier(bar); }
        }
        const int nM = *(const LAS int*)(lds + L_NM);
        if (PH(8)) { asm volatile("; PHASE_MARK P7" ::: "memory");
            _Pragma("unroll 1") for (int rep = 0; rep < NREP(8); ++rep) {
            pg8::Gemm g{(const bf16*)(ws + WS_XG), (const bf16*)(ws + WS_W1 + (size_t)L * NE * 2048 * D), D}; pg8::MoeOrder S; S.init(nM, 8, G, (int)blockIdx.x); S.tile_e = (const LAS int*)(lds + L_TILEE);
            pg8::EpiSwiglu E{(unsigned char*)(ws + WS_ACT), args.in[22] + (size_t)L * NE * 2048, 1.0f / (H_SCALE * W_SCALE), ACT_SCALE};
            pg8::gemm_phase<pg8::EpiSwiglu, pg8::MoeOrder, true>(lds, g, S, E);
            xcd_barrier(bar); }
        }
        if (PH(9)) { asm volatile("; PHASE_MARK P8" ::: "memory");
            _Pragma("unroll 1") for (int rep = 0; rep < NREP(9); ++rep) {
            pg8::Gemm g{(const bf16*)(ws + WS_ACT), (const bf16*)(ws + WS_W2 + (size_t)L * NE * D * FF), FF}; pg8::MoeOrder S; S.init(nM, 4, G, (int)blockIdx.x); S.tile_e = (const LAS int*)(lds + L_TILEE);
            pg8::EpiBf16 E{(bf16*)(ws + WS_XG), D, args.in[24] + (size_t)L * NE * D, D, 1.0f / (ACT_SCALE * W_SCALE)};
            pg8::gemm_phase<pg8::EpiBf16, pg8::MoeOrder, true>(lds, g, S, E);
            xcd_barrier(bar); }
        }
    }
    asm volatile("; PHASE_MARK P9" ::: "memory");
    if (PH(10)) { _Pragma("unroll 1") for (int rep = 0; rep < NREP(10); ++rep) { combine_rows<MOE, LAST, X1_BF>(args, L, x1, xnext, vcu, G); if (!LAST) xcd_barrier(bar); } }
}

__global__ void __launch_bounds__(NTHR, 2) fwd_kernel(Args args) {
    extern __shared__ __attribute__((aligned(16))) unsigned char lds_raw[];
    LAS unsigned char* lds = (LAS unsigned char*)lds_raw;
    const int tid = threadIdx.x;
    const int G = gridDim.x; const int bx = blockIdx.x; const int vcu = (G % 8 == 0) ? (bx % 8) * (G / 8) + bx / 8 : bx;
    unsigned char* ws = args.ws;
    for (int u = tid; u < (LDS_BYTES - LDSCTL_OFF) / 4; u += NTHR) ((LAS unsigned*)(lds + LDSCTL_OFF))[u] = 0u;
    __syncthreads();
    XcdBarrier bar = xcd_barrier_post((unsigned*)(ws + WS_CTL) + CW_BAR, (volatile LAS unsigned*)(lds + L_MISC) + 8);
    asm volatile("; PHASE_MARK P0" ::: "memory");
    _Pragma("unroll 1") for (int rep = 0; rep < NREP(0); ++rep) { if (PH(0)) pro_phase(args, lds, vcu, G); xcd_barrier(bar); }
    { shw_phase(args, lds, vcu, G); if (PH(1) & (RUN_MASK & 1)) { const float* mod0 = (const float*)(ws + WS_MOD); adaln_rows(args.in[0], (unsigned char*)(ws + WS_H), args.in[2], mod0, mod0 + D, vcu, G); } xcd_barrier(bar); }
    layer_body<0>(args, lds, bar, vcu, G, args.in[0], (bf16*)(ws + WS_XB));
    layer_body<1>(args, lds, bar, vcu, G, (const void*)(ws + WS_XB), nullptr);
}

extern "C" void kernel_launch(void* const* d_in, const int* in_sizes, int n_in, void* d_out, int out_size, void* d_ws, size_t ws_size, hipStream_t stream) {
    static int grid = 0;
    if (grid == 0) {
        if (n_in != 26 || in_sizes[0] != T * D || out_size != T * D || ws_size < WS_END) { fprintf(stderr, "kernel_launch: unexpected shapes (n_in %d, in0 %d, out %d, ws %zu < %zu); nothing launched\n", n_in, n_in > 0 ? in_sizes[0] : -1, out_size, ws_size, (size_t)WS_END); grid = -1; return; }
        int dev = 0, cus = 0, per_cu = 0;
        if (hipGetDevice(&dev) != hipSuccess || hipDeviceGetAttribute(&cus, hipDeviceAttributeMultiprocessorCount, dev) != hipSuccess) { grid = -1; return; }
        if (hipFuncSetAttribute((const void*)fwd_kernel, hipFuncAttributeMaxDynamicSharedMemorySize, LDS_BYTES) != hipSuccess) { fprintf(stderr, "kernel_launch: hipFuncSetAttribute failed\n"); grid = -1; return; }
        if (hipOccupancyMaxActiveBlocksPerMultiprocessor(&per_cu, (const void*)fwd_kernel, NTHR, LDS_BYTES) != hipSuccess || per_cu < 1) { fprintf(stderr, "kernel_launch: occupancy query says %d blocks per CU\n", per_cu); }
        (void)hipGetLastError();
        grid = cus;
    }
    if (grid < 0) return;
    if (hipMemsetAsync((char*)d_ws + WS_CTL, 0, CTL_ZERO_BYTES, stream) != hipSuccess) return;
    Args a{};
    for (int i = 0; i < 26; ++i) a.in[i] = (const float*)d_in[i];
    a.out = (float*)d_out; a.ws = (unsigned char*)d_ws; a.ph_lo = 0; a.ph_hi = 0;
    hipLaunchKernelGGL(fwd_kernel, dim3(grid), dim3(NTHR), LDS_BYTES, stream, a);
}
```

```cpp
#include <hip/hip_runtime.h>
#include <cstdio>
#include <cstdint>

#ifndef RUN_MASK
#define RUN_MASK 15
#endif
#ifndef PH_ENABLE
#define PH_ENABLE 0x7ff
#endif
#define PH(k) ((PH_ENABLE >> (k)) & 1)
#ifndef DUP_MASK
#define DUP_MASK 0
#endif
#define NREP(k) (1 + ((DUP_MASK >> (k)) & 1))
#ifndef MIX_MASK
#define MIX_MASK 7
#endif

namespace pg8 {
#define PG8_LAS __attribute__((address_space(3)))
typedef unsigned short bf16_t;
typedef short bf16x8 __attribute__((ext_vector_type(8)));
typedef float f32x4 __attribute__((ext_vector_type(4)));
typedef unsigned u32x4 __attribute__((ext_vector_type(4)));
typedef int i32x4 __attribute__((ext_vector_type(4)));
typedef int i32x8 __attribute__((ext_vector_type(8)));
constexpr int BM = 256, BK = 64, HALF = 128, HTB = HALF * BK * 2, STAGE_BYTES = 8 * HTB, NXCD = 8, WGM = 8;

__host__ __device__ __forceinline__ int lds_byte(int r, int c) { const int st = (r >> 4) * 2 + (c >> 5), rr = r & 15, cc = c & 31, ob = rr * 64 + cc * 2; return st * 1024 + (ob ^ (((ob >> 9) & 1) << 5)); }
__host__ __device__ __forceinline__ void stage_rc(int b, int& R, int& C) { const int st = b / 1024, sb = b % 1024, swz = sb ^ (((sb >> 9) & 1) << 5); R = (st >> 1) * 16 + swz / 64; C = (st & 1) * 32 + (swz % 64) / 2; }
__host__ __device__ __forceinline__ int perm32(int rho) { const int n = rho >> 4, i = rho & 15; return 8 * (i >> 2) + 4 * n + (i & 3); }

struct Unit { int pm, pn, pb, e; };
struct Gemm { const bf16_t* A; const bf16_t* Bt; int K; };

struct StaticOrder {
    int nM, nN, nwg, G, c;
    __device__ void init(int nM_, int nN_, int G_, int c_) { nM = nM_; nN = nN_; nwg = nM * nN; G = G_; c = c_; }
    __device__ __forceinline__ bool map(int i, Unit& u) const {
        const long L = (long)i * G + c; if (L >= nwg) return false;
        int wgid = (int)L; { const int q = nwg / NXCD, r = nwg % NXCD, xcd = wgid % NXCD, off = wgid / NXCD; wgid = (xcd < r ? xcd * (q + 1) : r * (q + 1) + (xcd - r) * q) + off; }
        const int nig = WGM * nN, gid = wgid / nig, fm = gid * WGM, gsz = (nM - fm) < WGM ? (nM - fm) : WGM;
        u.pm = fm + ((wgid % nig) % gsz); u.pn = (wgid % nig) / gsz; return true;
    }
    __device__ __forceinline__ bool next(int i, Unit& u) const { if (!map(i, u)) return false; u.pb = u.pn; u.e = 0; return true; }
};
struct MoeOrder : StaticOrder {
    const PG8_LAS int* tile_e;
    __device__ __forceinline__ bool next(int i, Unit& u) const { if (!map(i, u)) return false; u.e = tile_e[u.pm]; u.pb = u.e * nN + u.pn; return true; }
};

__device__ __forceinline__ unsigned cvt_pk_bf16(float lo, float hi) { unsigned r; asm volatile("v_cvt_pk_bf16_f32 %0, %1, %2" : "=v"(r) : "v"(lo), "v"(hi)); return r; }

__device__ __forceinline__ unsigned q_i8(float x) { const float y = __builtin_amdgcn_fmed3f(x, -127.0f, 127.0f) + 12582912.0f; return __builtin_bit_cast(unsigned, y); }
__device__ __forceinline__ unsigned pk4_i8(float a, float b, float c, float d) { return __builtin_amdgcn_perm(q_i8(b), q_i8(a), 0x0c0c0400u) | __builtin_amdgcn_perm(q_i8(d), q_i8(c), 0x04000c0cu); }
struct EpiBf16 {
    static constexpr bool PERM = true;
    bf16_t* O; int ldc; const float* bias; int bstride; float sc;
    template <class AT> __device__ __forceinline__ void operator()(const AT (&acc)[2][2][4][2], const Unit& u, int wr, int wc, int fr, int fq) const {
        const int row0 = u.pm * BM + wr * 64 + fr; const int col0 = u.pn * BM + wc * 32 + 8 * fq;
        f32x4 bv[2][2];
#pragma unroll
        for (int bj = 0; bj < 2; ++bj)
#pragma unroll
            for (int n = 0; n < 2; ++n) bv[bj][n] = bias ? *(const f32x4*)(bias + (size_t)u.e * bstride + col0 + bj * HALF + 4 * n) : (f32x4){0.f, 0.f, 0.f, 0.f};
#pragma unroll
        for (int ai = 0; ai < 2; ++ai)
#pragma unroll
            for (int m = 0; m < 4; ++m) { bf16_t* rowp = O + (size_t)(row0 + ai * HALF + m * 16) * ldc + col0;
#pragma unroll
                for (int bj = 0; bj < 2; ++bj) { const f32x4 v0 = __builtin_convertvector(acc[ai][bj][m][0], f32x4) * sc + bv[bj][0], v1 = __builtin_convertvector(acc[ai][bj][m][1], f32x4) * sc + bv[bj][1];
                    u32x4 w; w.x = cvt_pk_bf16(v0[0], v0[1]); w.y = cvt_pk_bf16(v0[2], v0[3]); w.z = cvt_pk_bf16(v1[0], v1[1]); w.w = cvt_pk_bf16(v1[2], v1[3]);
                    *(u32x4*)(rowp + bj * HALF) = w; } }
    }
};
typedef float f32x2 __attribute__((ext_vector_type(2)));
__device__ __forceinline__ unsigned pack4_lowbytes(unsigned w0, unsigned w1, unsigned w2, unsigned w3) {
    return __builtin_amdgcn_perm(w1, w0, 0x0c0c0400u) | __builtin_amdgcn_perm(w3, w2, 0x04000c0cu); }
struct EpiSwiglu {
    static constexpr bool PERM = true;
    unsigned char* O; const float* b1; float sc, osc;
    template <class AT> __device__ __forceinline__ void operator()(const AT (&acc)[2][2][4][2], const Unit& u, int wr, int wc, int fr, int fq) const {
        const int row0 = u.pm * BM + wr * 64 + fr; const int cg = u.pn * HALF + wc * 32 + 8 * fq;
        const float* bg = b1 + (size_t)u.e * 2048 + cg;
        f32x4 bgv[2], buv[2]; bgv[0] = *(const f32x4*)(bg); bgv[1] = *(const f32x4*)(bg + 4); buv[0] = *(const f32x4*)(bg + 1024); buv[1] = *(const f32x4*)(bg + 1028);
        const f32x2 sc2 = {sc, sc}, osc2 = {osc, osc}, k1 = {-1.702f * 1.4426950408889634f, -1.702f * 1.4426950408889634f}, one2 = {1.0f, 1.0f}, magic = {12582912.0f, 12582912.0f};
#pragma unroll
        for (int ai = 0; ai < 2; ++ai)
#pragma unroll
            for (int m = 0; m < 4; ++m) {
                unsigned wq[2];
#pragma unroll
                for (int hh = 0; hh < 2; ++hh) {
                    const f32x4 gf = __builtin_convertvector(acc[ai][0][m][hh], f32x4), uf = __builtin_convertvector(acc[ai][1][m][hh], f32x4);
                    unsigned bits[4];
#pragma unroll
                    for (int p = 0; p < 2; ++p) {
                        f32x2 g2 = __builtin_elementwise_fma((f32x2){gf[2 * p], gf[2 * p + 1]}, sc2, (f32x2){bgv[hh][2 * p], bgv[hh][2 * p + 1]});
                        f32x2 u2 = __builtin_elementwise_fma((f32x2){uf[2 * p], uf[2 * p + 1]}, sc2, (f32x2){buv[hh][2 * p], buv[hh][2 * p + 1]});
                        g2.x = fminf(g2.x, 7.0f); g2.y = fminf(g2.y, 7.0f);
                        u2.x = __builtin_amdgcn_fmed3f(u2.x, -7.0f, 7.0f); u2.y = __builtin_amdgcn_fmed3f(u2.y, -7.0f, 7.0f);
                        const f32x2 t = g2 * k1; f32x2 e; e.x = __builtin_amdgcn_exp2f(t.x); e.y = __builtin_amdgcn_exp2f(t.y);
                        const f32x2 d = e + one2; f32x2 r; r.x = __builtin_amdgcn_rcpf(d.x); r.y = __builtin_amdgcn_rcpf(d.y);
                        f32x2 o = __builtin_elementwise_fma(u2, osc2, osc2) * (g2 * r);
                        o.x = __builtin_amdgcn_fmed3f(o.x, -127.0f, 127.0f); o.y = __builtin_amdgcn_fmed3f(o.y, -127.0f, 127.0f);
                        o = o + magic;
                        const float ox = o.x, oy = o.y;
                        bits[2 * p] = __builtin_bit_cast(unsigned, ox); bits[2 * p + 1] = __builtin_bit_cast(unsigned, oy); }
                    wq[hh] = pack4_lowbytes(bits[0], bits[1], bits[2], bits[3]); }
                typedef unsigned u32x2 __attribute__((ext_vector_type(2)));
                *(u32x2*)(O + (size_t)(row0 + ai * HALF + m * 16) * 1024 + cg) = (u32x2){wq[0], wq[1]}; }
    }
};
template <bool XBF> struct EpiResGate {
    static constexpr bool PERM = true;
    const void* X; bf16_t* O; const float* gate;
    template <class AT> __device__ __forceinline__ void operator()(const AT (&acc)[2][2][4][2], const Unit& u, int wr, int wc, int fr, int fq) const {
        const int row0 = u.pm * BM + wr * 64 + fr, col0 = u.pn * BM + wc * 32 + 8 * fq; const int b = (u.pm * BM) >> 12;
        f32x4 gv[2][2];
#pragma unroll
        for (int bj = 0; bj < 2; ++bj)
#pragma unroll
            for (int n = 0; n < 2; ++n) gv[bj][n] = *(const f32x4*)(gate + b * 6144 + col0 + bj * HALF + 4 * n);
#pragma unroll
        for (int ai = 0; ai < 2; ++ai)
#pragma unroll
            for (int m = 0; m < 4; ++m) { const size_t off = (size_t)(row0 + ai * HALF + m * 16) * 1024 + col0;
#pragma unroll
                for (int bj = 0; bj < 2; ++bj) { f32x4 x0, x1;
                    if (XBF) { const u32x4 w = *(const u32x4*)((const bf16_t*)X + off + bj * HALF);
                        x0 = (f32x4){__builtin_bit_cast(float, w.x << 16), __builtin_bit_cast(float, w.x & 0xffff0000u), __builtin_bit_cast(float, w.y << 16), __builtin_bit_cast(float, w.y & 0xffff0000u)};
                        x1 = (f32x4){__builtin_bit_cast(float, w.z << 16), __builtin_bit_cast(float, w.z & 0xffff0000u), __builtin_bit_cast(float, w.w << 16), __builtin_bit_cast(float, w.w & 0xffff0000u)}; }
                    else { x0 = *(const f32x4*)((const float*)X + off + bj * HALF); x1 = *(const f32x4*)((const float*)X + off + bj * HALF + 4); }
                    const f32x4 v0 = x0 + gv[bj][0] * __builtin_convertvector(acc[ai][bj][m][0], f32x4), v1 = x1 + gv[bj][1] * __builtin_convertvector(acc[ai][bj][m][1], f32x4);
                    u32x4 w; w.x = cvt_pk_bf16(v0[0], v0[1]); w.y = cvt_pk_bf16(v0[2], v0[3]); w.z = cvt_pk_bf16(v1[0], v1[1]); w.w = cvt_pk_bf16(v1[2], v1[3]);
                    *(u32x4*)(O + off + bj * HALF) = w; }
                asm volatile("" ::: "memory"); }
    }
};
template <bool I8> struct AccSel { typedef f32x4 type; };
template <> struct AccSel<true> { typedef i32x4 type; };
__device__ __forceinline__ f32x4 mma16(bf16x8 b, bf16x8 a, f32x4 c) { return __builtin_amdgcn_mfma_f32_16x16x32_bf16(b, a, c, 0, 0, 0); }
__device__ __forceinline__ i32x4 mma16(bf16x8 b, bf16x8 a, i32x4 c) { return __builtin_amdgcn_mfma_i32_16x16x64_i8(__builtin_bit_cast(i32x4, b), __builtin_bit_cast(i32x4, a), c, 0, 0, 0); }
template <class Epi, class Sched, bool I8 = false>
__device__ __forceinline__ void gemm_phase(PG8_LAS unsigned char* lds, const Gemm g, const Sched& S, const Epi& E) {
    int tid_ = threadIdx.x; asm volatile("" : "+v"(tid_));
    const int tid = tid_, wid = __builtin_amdgcn_readfirstlane(tid >> 6), lane = tid & 63, wr = wid >> 2, wc = wid & 3, fr = lane & 15, fq = lane >> 4;
    const int K = I8 ? g.K / 2 : g.K, nt = K / BK;
    unsigned voffA[2], voffB[2];
#pragma unroll
    for (int i = 0; i < 2; ++i) { int R, C; stage_rc(tid * 16 + i * 8192, R, C); const int Rb = Epi::PERM ? ((R & ~31) + perm32(R & 31)) : R;
        voffA[i] = (unsigned)(R * K + C) * 2u; voffB[i] = (unsigned)(Rb * K + C) * 2u; }
    const size_t kstep = (size_t)(BK * 2);
    const size_t hstep = (size_t)HALF * K * 2;
    const size_t tstep = 2 * hstep;
    const unsigned ldsw = (unsigned)wid * 1024u;
    const int aoff = lds_byte(wr * 64 + fr, fq * 8), boff = lds_byte(wc * 32 + fr, fq * 8);
#define PG8_SA(b, h) (((b) * 2 + (h)) * HTB)
#define PG8_SB(b, h) ((4 + (b) * 2 + (h)) * HTB)
#define PG8_STAGE(bufoff, gbase, voff) do { _Pragma("unroll") for (int _i = 0; _i < 2; ++_i) \
        __builtin_amdgcn_global_load_lds((const unsigned*)((const char*)(gbase) + (voff)[_i]), (PG8_LAS unsigned*)(lds + (bufoff) + ldsw + _i * 8192), 16, 0, 0); } while (0)
#define PG8_LDA(dst, b, h) do { _Pragma("unroll") for (int m = 0; m < 4; ++m) _Pragma("unroll") for (int k = 0; k < 2; ++k) dst[m][k] = *(const PG8_LAS bf16x8*)(lds + PG8_SA(b, h) + aoff + m * 2048 + k * 1024); } while (0)
#define PG8_LDB(dst, b, h) do { _Pragma("unroll") for (int n = 0; n < 2; ++n) _Pragma("unroll") for (int k = 0; k < 2; ++k) dst[n][k] = *(const PG8_LAS bf16x8*)(lds + PG8_SB(b, h) + boff + n * 2048 + k * 1024); } while (0)
#define PG8_MMA(ai, bj, At, Bt) do { __builtin_amdgcn_s_setprio(1); _Pragma("unroll") for (int m = 0; m < 4; ++m) _Pragma("unroll") for (int n = 0; n < 2; ++n) _Pragma("unroll") for (int k = 0; k < 2; ++k) \
        acc[ai][bj][m][n] = mma16(Bt[n][k], At[m][k], acc[ai][bj][m][n]); __builtin_amdgcn_s_setprio(0); } while (0)
#define PG8_WAIT_V(n) asm volatile("s_waitcnt vmcnt(" #n ")" ::: "memory")
#define PG8_WAIT_L(n) asm volatile("s_waitcnt lgkmcnt(" #n ")" ::: "memory")
#define PG8_BAR __builtin_amdgcn_s_barrier()
#define PG8_SCHED __builtin_amdgcn_sched_barrier(0)
    Unit cur, nxt; int ui = 0;
    if (!S.next(0, cur)) return;
    typedef typename AccSel<I8>::type AccT;
    AccT acc[2][2][4][2];
#pragma unroll
    for (int a = 0; a < 2; ++a)
#pragma unroll
        for (int b = 0; b < 2; ++b)
#pragma unroll
            for (int m = 0; m < 4; ++m)
#pragma unroll
                for (int n = 0; n < 2; ++n) acc[a][b][m][n] = AccT{};
    bf16x8 At[4][2], B0[2][2], B1[2][2];
    const char* cA = (const char*)g.A + (size_t)cur.pm * tstep; const char* cB = (const char*)g.Bt + (size_t)cur.pb * tstep;
    PG8_STAGE(PG8_SB(0, 0), cB, voffB); PG8_STAGE(PG8_SB(0, 1), cB + hstep, voffB); PG8_STAGE(PG8_SA(0, 0), cA, voffA); PG8_STAGE(PG8_SA(0, 1), cA + hstep, voffA);
    if (wr == 1) PG8_BAR;
    PG8_WAIT_V(2); PG8_BAR;
    PG8_STAGE(PG8_SB(1, 0), cB + kstep, voffB); PG8_STAGE(PG8_SA(1, 0), cA + kstep, voffA); PG8_STAGE(PG8_SB(1, 1), cB + hstep + kstep, voffB);
    PG8_WAIT_V(6); PG8_BAR;
    for (;;) {
        const bool has_next = S.next(ui + 1, nxt);
        const char* nA = has_next ? (const char*)g.A + (size_t)nxt.pm * tstep : cA; const char* nB = has_next ? (const char*)g.Bt + (size_t)nxt.pb * tstep : cB;
#pragma unroll 1
        for (int t = 0; t < nt; t += 2) {
            const bool last = (t == nt - 2);
            const char* a1 = cA + (size_t)(t + 1) * kstep;
            const char* a2 = last ? nA : cA + (size_t)(t + 2) * kstep; const char* b2 = last ? nB : cB + (size_t)(t + 2) * kstep;
            const char* a3 = a2 + kstep; const char* b3 = b2 + kstep;
            PG8_LDB(B0, 0, 0); PG8_LDB(B1, 0, 1); PG8_SCHED; PG8_LDA(At, 0, 0); PG8_STAGE(PG8_SA(1, 1), a1 + hstep, voffA);
            PG8_WAIT_V(8); PG8_WAIT_L(0); PG8_BAR; PG8_MMA(0, 0, At, B0); PG8_MMA(0, 1, At, B1); PG8_BAR; PG8_SCHED;
            PG8_LDA(At, 0, 1); PG8_STAGE(PG8_SB(0, 0), b2, voffB); PG8_STAGE(PG8_SB(0, 1), b2 + hstep, voffB); PG8_STAGE(PG8_SA(0, 0), a2, voffA);
            PG8_WAIT_V(8); PG8_WAIT_L(0); PG8_BAR; PG8_MMA(1, 0, At, B0); PG8_MMA(1, 1, At, B1); PG8_BAR; PG8_SCHED;
            PG8_LDB(B0, 1, 0); PG8_LDB(B1, 1, 1); PG8_SCHED; PG8_LDA(At, 1, 0); PG8_STAGE(PG8_SA(0, 1), a2 + hstep, voffA);
            PG8_WAIT_V(8); PG8_WAIT_L(0); PG8_BAR; PG8_MMA(0, 0, At, B0); PG8_MMA(0, 1, At, B1); PG8_BAR; PG8_SCHED;
            PG8_LDA(At, 1, 1); PG8_STAGE(PG8_SB(1, 0), b3, voffB); PG8_STAGE(PG8_SB(1, 1), b3 + hstep, voffB); PG8_STAGE(PG8_SA(1, 0), a3, voffA);
            PG8_WAIT_V(8); PG8_WAIT_L(0); PG8_BAR; PG8_MMA(1, 0, At, B0); PG8_MMA(1, 1, At, B1); PG8_BAR; PG8_SCHED;
        }
        if (wr == 0) PG8_BAR;
        E(acc, cur, wr, wc, fr, fq);
        if (!has_next) break;
#pragma unroll
        for (int a = 0; a < 2; ++a)
#pragma unroll
            for (int b = 0; b < 2; ++b)
#pragma unroll
                for (int m = 0; m < 4; ++m)
#pragma unroll
                    for (int n = 0; n < 2; ++n) acc[a][b][m][n] = AccT{};
        cur = nxt; cA = nA; cB = nB; ++ui;
        if (wr == 1) PG8_BAR;
    }
    PG8_WAIT_V(0);
    PG8_BAR;
#undef PG8_SA
#undef PG8_SB
#undef PG8_STAGE
#undef PG8_LDA
#undef PG8_LDB
#undef PG8_MMA
#undef PG8_WAIT_V
#undef PG8_WAIT_L
#undef PG8_BAR
#undef PG8_SCHED
}
}

constexpr int NWAVES = 8, NTHR = 512;
constexpr int NB = 4, SEQ = 4096, D = 1024, T = NB * SEQ, DIN = 2304, NE = 32, TOPK = 4, DEPTH = 2, FF = 1024;
constexpr int OFF_ZB = 0, OFF_ZC = 256, OFF_ZV = 512, OFF_ZU = 768, OFF_ZSV = 1024, OFF_ZG = 1280, OFF_ZX = 1792;
constexpr int NBLK = SEQ / 64;
constexpr int NRT = T / 64;
constexpr int MAXTILES = T * TOPK / 256 + NE;
constexpr int MAXSLOTS = MAXTILES * 256;
constexpr float EPS = 1e-6f;
constexpr float W_SCALE = 960.0f, H_SCALE = 28.0f, ACT_SCALE = 12.0f, HIN_SCALE = 28.0f;

constexpr size_t al(size_t x) { return (x + 4095) & ~(size_t)4095; }
constexpr size_t WS_CTL = 0, CTL_ZERO_BYTES = 65536;
constexpr size_t WS_MOD = 65536;
constexpr size_t WS_GWT = al(WS_MOD + (size_t)DEPTH * NB * 6144 * 4);
constexpr size_t WS_SGW = al(WS_GWT + (size_t)DEPTH * 2 * 8 * 4096 * 2);
constexpr size_t WS_RWH = al(WS_SGW + (size_t)DEPTH * 4 * 16384 * 2);
constexpr size_t WS_RWL = al(WS_RWH + (size_t)DEPTH * NE * D * 2);
constexpr size_t WS_WIN = al(WS_RWL + (size_t)DEPTH * NE * D * 2);
constexpr size_t WS_WOUT = al(WS_WIN + (size_t)DEPTH * DIN * D * 2);
constexpr size_t WS_W1 = al(WS_WOUT + (size_t)DEPTH * D * D * 2);
constexpr size_t WS_W2 = al(WS_W1 + (size_t)DEPTH * NE * 2048 * D * 2);
constexpr size_t WS_H = al(WS_W2 + (size_t)DEPTH * NE * D * FF * 2);
constexpr size_t WS_Z = al(WS_H + (size_t)T * D * 2);
constexpr size_t WS_Y = al(WS_Z + (size_t)T * DIN * 2);
constexpr size_t WS_XA = al(WS_Y + (size_t)T * D * 2);
constexpr size_t WS_XB = al(WS_XA + (size_t)T * D * 4);
constexpr size_t WS_AGA = al(WS_XB + (size_t)T * D * 4);
constexpr size_t WS_AGH = al(WS_AGA + (size_t)NB * NBLK * 512 * 4);
constexpr size_t WS_TOPE = al(WS_AGH + (size_t)NB * NBLK * 512 * 4);
constexpr size_t WS_TOPW = al(WS_TOPE + (size_t)T * 4 * 4);
constexpr size_t WS_RANK = al(WS_TOPW + (size_t)T * 4 * 4);
constexpr size_t WS_SLOT = al(WS_RANK + (size_t)T * 4 * 4);
constexpr size_t WS_CNT = al(WS_SLOT + (size_t)T * 4 * 4);
constexpr size_t WS_SHW = al(WS_CNT + (size_t)NRT * NE * 4);
constexpr size_t WS_XG = al(WS_SHW + (size_t)DEPTH * NB * NE * 4);
constexpr size_t WS_ACT = al(WS_XG + (size_t)MAXSLOTS * D * 2);
constexpr size_t WS_END = al(WS_ACT + (size_t)MAXSLOTS * D * 2);
constexpr int CW_BAR = 1024;

constexpr int RING_BYTES = 131072;
constexpr int SCR_BYTES = 147456;
constexpr int LDSCTL_OFF = SCR_BYTES;
constexpr int L_MISC = LDSCTL_OFF;
constexpr int L_TILEE = LDSCTL_OFF + 256;
constexpr int L_NM = L_TILEE + MAXTILES * 4;
constexpr int LDS_BYTES = LDSCTL_OFF + 2048;
static_assert(L_NM + 4 <= LDS_BYTES, "LDS map");

#define GAS __attribute__((address_space(1)))
#define LAS __attribute__((address_space(3)))
typedef unsigned short bf16;
typedef unsigned v4u __attribute__((ext_vector_type(4)));
typedef unsigned v2u __attribute__((ext_vector_type(2)));
typedef float f32x4 __attribute__((ext_vector_type(4)));
typedef short bf16x8 __attribute__((ext_vector_type(8)));
#define LDS_WAIT() asm volatile("s_waitcnt lgkmcnt(0)" ::: "memory")
#define FRESH_TID() int tid_ = threadIdx.x; asm volatile("" : "+v"(tid_)); const int tid = tid_, lane = tid & 63, wave = __builtin_amdgcn_readfirstlane(tid >> 6); (void)tid; (void)lane; (void)wave
__device__ __forceinline__ unsigned f2bf(float f) { unsigned u = __builtin_bit_cast(unsigned, f); return (u + 0x7fffu + ((u >> 16) & 1u)) >> 16; }
__device__ __forceinline__ unsigned pk2(float lo, float hi) { return pg8::cvt_pk_bf16(lo, hi); }
__device__ __forceinline__ float bflo(unsigned w) { return __builtin_bit_cast(float, w << 16); }
__device__ __forceinline__ float bfhi(unsigned w) { return __builtin_bit_cast(float, w & 0xffff0000u); }
template <bool BF> __device__ __forceinline__ void ld8(const void* p, size_t idx, float (&o)[8]) {
    if (BF) { const v4u w = *(const v4u*)((const bf16*)p + idx); o[0] = bflo(w.x); o[1] = bfhi(w.x); o[2] = bflo(w.y); o[3] = bfhi(w.y); o[4] = bflo(w.z); o[5] = bfhi(w.z); o[6] = bflo(w.w); o[7] = bfhi(w.w); }
    else { const f32x4 a = *(const f32x4*)((const float*)p + idx), b = *(const f32x4*)((const float*)p + idx + 4); o[0] = a[0]; o[1] = a[1]; o[2] = a[2]; o[3] = a[3]; o[4] = b[0]; o[5] = b[1]; o[6] = b[2]; o[7] = b[3]; } }
template <bool BF> __device__ __forceinline__ f32x4 ld4(const void* p, size_t idx) {
    if (BF) { const v2u w = *(const v2u*)((const bf16*)p + idx); return (f32x4){bflo(w.x), bfhi(w.x), bflo(w.y), bfhi(w.y)}; }
    else return *(const f32x4*)((const float*)p + idx); }
__device__ __forceinline__ float sigmoidf_(float x) { return __builtin_amdgcn_rcpf(1.0f + __builtin_amdgcn_exp2f(-1.4426950408889634f * x)); }
__device__ __forceinline__ float gelu_tanh(float x) { const float u2 = 1.5957691216057308f * (x + 0.044715f * x * x * x); return x * __builtin_amdgcn_rcpf(1.0f + __builtin_amdgcn_exp2f(-1.4426950408889634f * u2)); }
__device__ __forceinline__ float wave_sum(float v) {
#pragma unroll
    for (int o = 1; o < 64; o <<= 1) v += __shfl_xor(v, o);
    return v;
}
template <int CTRL> __device__ __forceinline__ float dpp_f(float old, float src) { return __builtin_bit_cast(float, __builtin_amdgcn_update_dpp(__builtin_bit_cast(int, old), __builtin_bit_cast(int, src), CTRL, 0xF, 0xF, false)); }
__device__ __forceinline__ float sum16(float v) {
    v += dpp_f<0xB1>(v, v); v += dpp_f<0x4E>(v, v); v += dpp_f<0x141>(v, v); v += dpp_f<0x140>(v, v); return v; }
__device__ __forceinline__ float bcast15(float v, int lane) { return __builtin_bit_cast(float, __builtin_amdgcn_ds_bpermute((lane | 15) << 2, __builtin_bit_cast(int, v))); }

#define XB_TMO      128
#define XB_XCNT(j)  (256  + 64 * (j))
#define XB_XSUB(j)  (1280 + 64 * (j))
#define XB_XGEN(j)  (2304 + 64 * (j))
#define XB_TOP      3328
#define XB_TOPGEN   3392
#define XCD_BAR_WORDS 3456
#define XB_SPIN_CAP (1u << 18)
__device__ __forceinline__ unsigned xb_ld(unsigned* p)              { return __hip_atomic_load(p, __ATOMIC_RELAXED, __HIP_MEMORY_SCOPE_AGENT); }
__device__ __forceinline__ unsigned xb_add(unsigned* p, unsigned v) { return __hip_atomic_fetch_add(p, v, __ATOMIC_RELAXED, __HIP_MEMORY_SCOPE_AGENT); }
__device__ __forceinline__ unsigned xb_xcc_id() { return (unsigned)__builtin_amdgcn_s_getreg((3 << 11) | 20) & 0xFu; }
#define XB_SPIN(cond, bar) do { unsigned _sp = 0; while (cond) { __builtin_amdgcn_s_sleep(1); \
    if ((++_sp & 255u) == 0u) { if (xb_ld(&(bar)[XB_TMO])) break; if (_sp > XB_SPIN_CAP) { atomicAdd(&(bar)[XB_TMO], 1u); break; } } } } while (0)
struct XcdBarrier { unsigned* bar; unsigned x; volatile LAS unsigned* st; };
__device__ __forceinline__ XcdBarrier xcd_barrier_post(unsigned* bar, volatile LAS unsigned* st) {
    XcdBarrier b; b.bar = bar; b.x = xb_xcc_id(); b.st = st;
    if (threadIdx.x == 0) (void)xb_add(&bar[XB_XCNT(b.x)], 1u);
    return b;
}
__device__ __forceinline__ void xcd_barrier_complete(unsigned* bar, unsigned x, unsigned& nloc, unsigned& nx) {
    const unsigned G = gridDim.x * gridDim.y * gridDim.z;
    unsigned sum, cnt, mine, sp = 0u;
    for (;;) {
        sum = 0u; cnt = 0u; mine = 0u;
#pragma unroll
        for (unsigned j = 0; j < 16; ++j) { const unsigned c = xb_ld(&bar[XB_XCNT(j)]); sum += c; cnt += (c > 0u) ? 1u : 0u; mine = (j == x) ? c : mine; }
        if (sum == G) break;
        __builtin_amdgcn_s_sleep(1);
        if ((++sp & 255u) == 0u) { if (xb_ld(&bar[XB_TMO])) break; if (sp > XB_SPIN_CAP) { atomicAdd(&bar[XB_TMO], 1u); break; } }
    }
    nloc = mine > 0u ? mine : 1u; nx = cnt > 0u ? cnt : 1u;
}
__device__ __forceinline__ void xcd_barrier(const XcdBarrier& b) {
    asm volatile("s_waitcnt vmcnt(0)" ::: "memory");
    __syncthreads();
    if (threadIdx.x == 0) {
        unsigned* bar = b.bar;
        __builtin_amdgcn_s_waitcnt(0);
        unsigned nloc = b.st[0], nx = b.st[1];
        if (nloc == 0u) { xcd_barrier_complete(bar, b.x, nloc, nx); b.st[0] = nloc; b.st[1] = nx; }
        const unsigned old = xb_add(&bar[XB_XSUB(b.x)], 1u);
        const unsigned gen = old / nloc;
        if (old + 1u == (gen + 1u) * nloc) {
            __builtin_amdgcn_fence(__ATOMIC_RELEASE, "agent");
            asm volatile("s_waitcnt vmcnt(0)" ::: "memory");
            const unsigned og = xb_add(&bar[XB_TOP], 1u);
            const unsigned tg = og / nx;
            if (og + 1u == (tg + 1u) * nx) xb_add(&bar[XB_TOPGEN], 1u);
            else XB_SPIN(xb_ld(&bar[XB_TOPGEN]) == tg, bar);
            __builtin_amdgcn_fence(__ATOMIC_ACQUIRE, "agent");
            xb_add(&bar[XB_XGEN(b.x)], 1u);
            asm volatile("s_waitcnt vmcnt(0)" ::: "memory");
        } else {
            XB_SPIN(xb_ld(&bar[XB_XGEN(b.x)]) == gen, bar);
            __builtin_amdgcn_fence(__ATOMIC_ACQUIRE, "agent");
            asm volatile("s_waitcnt vmcnt(0)" ::: "memory");
        }
    }
    __syncthreads();
}

struct TItem { const float* W; bf16* WT; int K, N, k0, n0, rowbase, fp8; };
__device__ __forceinline__ void ti_load(const TItem& d, f32x4 (&v)[16], int lane) {
    if (d.fp8) {
#pragma unroll
        for (int i = 0; i < 16; ++i) v[i] = __builtin_nontemporal_load((const f32x4*)(d.W + (size_t)(d.k0 + 8 * i + (lane >> 3)) * d.N + d.n0 + 4 * (lane & 7)));
    } else {
#pragma unroll
        for (int i = 0; i < 16; ++i) v[i] = __builtin_nontemporal_load((const f32x4*)(d.W + (size_t)(d.k0 + 4 * i + (lane >> 4)) * d.N + d.n0 + 4 * (lane & 15)));
    }
}
__device__ __forceinline__ void ti_store(const TItem& d, const f32x4 (&v)[16], LAS float* scr, int lane) {
    if (d.fp8) {
#pragma unroll
        for (int i = 0; i < 16; ++i) *(LAS f32x4*)(scr + (8 * (i & 1) + (lane >> 3)) * 288 + (i >> 1) * 36 + 4 * (lane & 7)) = v[i];
        LDS_WAIT(); asm volatile("" ::: "memory");
        const int c = lane & 7, nl = lane >> 3;
#pragma unroll
        for (int jj = 0; jj < 4; ++jj) { const int n = nl + 8 * jj; const LAS float* sp = scr + c * 36 + n; v4u o;
            o.x = pg8::pk4_i8(sp[0 * 288] * W_SCALE, sp[1 * 288] * W_SCALE, sp[2 * 288] * W_SCALE, sp[3 * 288] * W_SCALE);
            o.y = pg8::pk4_i8(sp[4 * 288] * W_SCALE, sp[5 * 288] * W_SCALE, sp[6 * 288] * W_SCALE, sp[7 * 288] * W_SCALE);
            o.z = pg8::pk4_i8(sp[8 * 288] * W_SCALE, sp[9 * 288] * W_SCALE, sp[10 * 288] * W_SCALE, sp[11 * 288] * W_SCALE);
            o.w = pg8::pk4_i8(sp[12 * 288] * W_SCALE, sp[13 * 288] * W_SCALE, sp[14 * 288] * W_SCALE, sp[15 * 288] * W_SCALE);
            *(v4u*)((unsigned char*)d.WT + (size_t)(d.rowbase + n) * d.K + d.k0 + 16 * c) = o; }
        LDS_WAIT(); asm volatile("" ::: "memory");
        return;
    }
#pragma unroll
    for (int i = 0; i < 16; ++i) { LAS float* s = scr + (4 * i + (lane >> 4)) * 65 + 4 * (lane & 15); s[0] = v[i][0]; s[1] = v[i][1]; s[2] = v[i][2]; s[3] = v[i][3]; }
    LDS_WAIT(); asm volatile("" ::: "memory");
    const int c = lane & 7;
#pragma unroll
    for (int j = 0; j < 8; ++j) { const int n = (lane >> 3) + 8 * j; const LAS float* s = scr + (8 * c) * 65 + n;
        v4u o; o.x = pk2(s[0 * 65], s[1 * 65]); o.y = pk2(s[2 * 65], s[3 * 65]); o.z = pk2(s[4 * 65], s[5 * 65]); o.w = pk2(s[6 * 65], s[7 * 65]);
        *(v4u*)(d.WT + (size_t)(d.rowbase + n) * d.K + d.k0 + 8 * c) = o; }
    LDS_WAIT(); asm volatile("" ::: "memory");
}

struct Args { const float* in[26]; float* out; unsigned char* ws; int ph_lo, ph_hi; };

__device__ __forceinline__ void pro_phase(const Args& args, LAS unsigned char* lds, int vcu, int G) {
    FRESH_TID();
    unsigned char* ws = args.ws;
    for (int u = vcu; u < DEPTH * 96; u += G) {
        const int l = u / 96, cbk = u % 96, col = cbk * 64 + lane;
        const float* wa = args.in[4] + (size_t)l * D * 6144; const float* cc = args.in[1];
        float a0 = 0.f, a1 = 0.f, a2 = 0.f, a3 = 0.f;
#pragma unroll 8
        for (int k = wave * 128; k < wave * 128 + 128; ++k) { const float w = wa[(size_t)k * 6144 + col]; a0 += cc[k] * w; a1 += cc[D + k] * w; a2 += cc[2 * D + k] * w; a3 += cc[3 * D + k] * w; }
        LAS float* red = (LAS float*)lds;
        red[(wave * 4 + 0) * 64 + lane] = a0; red[(wave * 4 + 1) * 64 + lane] = a1; red[(wave * 4 + 2) * 64 + lane] = a2; red[(wave * 4 + 3) * 64 + lane] = a3;
        __syncthreads();
        if (tid < 256) { const int b = tid >> 6, cl = tid & 63; float s = args.in[5][(size_t)l * 6144 + cbk * 64 + cl];
#pragma unroll
            for (int w = 0; w < 8; ++w) s += red[(w * 4 + b) * 64 + cl];
            ((float*)(ws + WS_MOD))[(size_t)(l * NB + b) * 6144 + cbk * 64 + cl] = s; }
        __syncthreads();
    }
    const int gt = vcu * NTHR + tid, NGT = G * NTHR;
    for (int i = gt; i < DEPTH * 2 * 8 * 4096; i += NGT) {
        const int ii = i & 63, j = (i >> 6) & 63, lgh = i >> 12;
        ((bf16*)(ws + WS_GWT))[i] = (bf16)f2bf(args.in[14][(size_t)lgh * 4096 + ii * 64 + j]); }
    for (int i = gt; i < DEPTH * 4 * 16384; i += NGT) {
        const int s = i & 127, t = (i >> 7) & 127;
        ((bf16*)(ws + WS_SGW))[i] = (bf16)(s <= t ? f2bf(args.in[8][i]) : 0u); }
    for (int i = gt; i < DEPTH * NE * D; i += NGT) {
        const int k = i & 1023, e = (i >> 10) & 31, l = i >> 15;
        const float w = args.in[19][((size_t)l * D + k) * NE + e]; const unsigned hi = f2bf(w); const float r = w - __builtin_bit_cast(float, hi << 16);
        ((bf16*)(ws + WS_RWH))[i] = (bf16)hi; ((bf16*)(ws + WS_RWL))[i] = (bf16)f2bf(r); }
    LAS float* scr = (LAS float*)(lds + wave * 18432);
    const int gw = vcu * NWAVES + wave, NGW = G * NWAVES;
    constexpr int I_IN = 16 * 36, I_OUT = 16 * 16, I_W1 = NE * 16 * 32, I_W2 = NE * 16 * 16, I_L = I_IN + I_OUT + I_W1 + I_W2;
    auto decode = [&](int it, TItem& d) {
        const int l = it / I_L; int r = it % I_L;
        if (r < I_IN) { const int kb = r / 72, nb = r % 72; d = TItem{args.in[6] + (size_t)l * D * DIN, (bf16*)(ws + WS_WIN + (size_t)l * DIN * D), D, DIN, kb * 128, nb * 32, nb * 32, 1}; return; } r -= I_IN;
        if (r < I_OUT) { const int kb = r / 16, nb = r % 16; d = TItem{args.in[18] + (size_t)l * D * D, (bf16*)(ws + WS_WOUT) + (size_t)l * D * D, D, D, kb * 64, nb * 64, nb * 64, 0}; return; } r -= I_OUT;
        if (r < I_W1) { const int e = r / 512, q = r % 512, kb = q / 64, nb = q % 64, n0 = nb * 32;
            const int rowbase = (n0 < 1024) ? (n0 >> 7) * 256 + (n0 & 127) : ((n0 - 1024) >> 7) * 256 + 128 + ((n0 - 1024) & 127);
            d = TItem{args.in[21] + ((size_t)l * NE + e) * D * 2048, (bf16*)(ws + WS_W1 + ((size_t)l * NE + e) * 2048 * D), D, 2048, kb * 128, n0, rowbase, 1}; return; } r -= I_W1;
        { const int e = r / 256, q = r % 256, kb = q / 32, nb = q % 32;
            d = TItem{args.in[23] + ((size_t)l * NE + e) * FF * D, (bf16*)(ws + WS_W2 + ((size_t)l * NE + e) * D * FF), FF, D, kb * 128, nb * 32, nb * 32, 1}; }
    };
    int it = gw; TItem d, dn; f32x4 v[16], vn[16];
    if (it < DEPTH * I_L) { decode(it, d); ti_load(d, v, lane); }
    while (it < DEPTH * I_L) {
        const int itn = it + NGW; const bool hn = itn < DEPTH * I_L;
        if (hn) { decode(itn, dn); ti_load(dn, vn, lane); }
        ti_store(d, v, scr, lane);
        if (hn) { d = dn;
#pragma unroll
            for (int i = 0; i < 16; ++i) v[i] = vn[i]; }
        it = itn;
    }
}

__device__ __forceinline__ void adaln_rows(const float* X, unsigned char* H, const float* g, const float* mod_shift, const float* mod_scale, int vcu, int G) {
    FRESH_TID(); const int gw = vcu * NWAVES + wave, NGW = G * NWAVES;
    for (int row = gw; row < T; row += NGW) {
        const int b = row >> 12; const float* xr = X + (size_t)row * D + 4 * lane;
        f32x4 v[4]; float s = 0.f;
#pragma unroll
        for (int j = 0; j < 4; ++j) { v[j] = *(const f32x4*)(xr + 256 * j); s += (v[j][0] * v[j][0] + v[j][1] * v[j][1]) + (v[j][2] * v[j][2] + v[j][3] * v[j][3]); }
        const float rstd = __builtin_amdgcn_rsqf(wave_sum(s) * (1.0f / D) + EPS);
#pragma unroll
        for (int j = 0; j < 4; ++j) { const int c = 4 * lane + 256 * j;
            const f32x4 gv = *(const f32x4*)(g + c), sc = *(const f32x4*)(mod_scale + b * 6144 + c), sh = *(const f32x4*)(mod_shift + b * 6144 + c);
            const f32x4 o = (v[j] * rstd * gv * (sc + 1.0f) + sh) * HIN_SCALE;
            *(unsigned*)(H + (size_t)row * D + c) = pg8::pk4_i8(o[0], o[1], o[2], o[3]); }
    }
}


__device__ __forceinline__ void shw_phase(const Args& args, LAS unsigned char* lds, int vcu, int G) {
    FRESH_TID();
    unsigned char* ws = args.ws; LAS float* RED = (LAS float*)lds;
    for (int u = vcu; u < DEPTH * NB; u += G) {
        const int l = u >> 2, b = u & 3, e = tid & 31, part = tid >> 5;
        const float* sh = (const float*)(ws + WS_MOD) + (size_t)(l * NB + b) * 6144 + 3 * D; const float* rw = args.in[19] + (size_t)l * D * NE; float s = 0.f;
#pragma unroll 16
        for (int k = part * 64; k < part * 64 + 64; ++k) s = fmaf(sh[k], rw[(size_t)k * NE + e], s);
        RED[part * 32 + e] = s;
        __syncthreads();
        if (tid < 32) { float t = args.in[20][(size_t)l * NE + tid];
#pragma unroll
            for (int p = 0; p < 16; ++p) t += RED[p * 32 + tid];
            ((float*)(ws + WS_SHW))[(l * NB + b) * NE + tid] = t; }
        __syncthreads();
    }
}

constexpr int L3_CARRY = 139264, L3_SS = 141312, L3_SS2 = 143360, L3_SPL = 144384;
template <bool FULL>
__device__ __forceinline__ void mixer_unit(const Args& args, int l, int b, int j, LAS unsigned char* lds) {
    FRESH_TID();
    unsigned char* ws = args.ws;
    const bf16* Z = (const bf16*)(ws + WS_Z); bf16* Y = (bf16*)(ws + WS_Y);
    float* aggA = (float*)(ws + WS_AGA); float* aggH = (float*)(ws + WS_AGH);
    const float* mixg = args.in[17] + (size_t)l * D;
    const int fr = lane & 15, fq = lane >> 4;
    const size_t rowb = (size_t)b * SEQ;
    const int t0 = 64 * j;
    LAS float* CARRY = (LAS float*)(lds + L3_CARRY); LAS float* SS = (LAS float*)(lds + L3_SS); LAS float* SS2 = (LAS float*)(lds + L3_SS2); LAS float* SPL = (LAS float*)(lds + L3_SPL);
    if ((MIX_MASK & 4) || !FULL) {
        {
            const float y = -args.in[16][(size_t)l * 512 + tid];
            SPL[tid] = fmaxf(y, 0.f) + log1pf(expf(-fabsf(y)));
            if (FULL) { float c = 0.f; const float* pa = aggA + (size_t)b * NBLK * 512 + tid; const float* ph = aggH + (size_t)b * NBLK * 512 + tid;
                int jj = 0;
                for (; jj + 16 <= j; jj += 16) { float av[16], hv[16];
#pragma unroll
                    for (int q = 0; q < 16; ++q) { av[q] = pa[(size_t)(jj + q) * 512]; hv[q] = ph[(size_t)(jj + q) * 512]; }
#pragma unroll
                    for (int q = 0; q < 16; ++q) c = fmaf(av[q], c, hv[q]); }
                { float av[16], hv[16];
#pragma unroll
                    for (int q = 0; q < 16; ++q) { const bool ok = jj + q < j; const int jq = ok ? jj + q : 0; av[q] = pa[(size_t)jq * 512]; hv[q] = ph[(size_t)jq * 512]; if (!ok) { av[q] = 1.f; hv[q] = 0.f; } }
#pragma unroll
                    for (int q = 0; q < 16; ++q) c = fmaf(av[q], c, hv[q]); }
                CARRY[tid] = c; }
        }
        __syncthreads();
        const int hd = wave;
        LAS float* XR = (LAS float*)(lds + wave * 17408);
        const float* cw = args.in[12] + (size_t)l * 4 * 512; const float* cbp = args.in[13] + (size_t)l * 512;
        bf16x8 Xa[4][2];
#pragma unroll
        for (int ks = 0; ks < 2; ++ks) {
            const int c8 = 64 * hd + 32 * ks + 8 * fq;
            float wv[4][8], bv[8];
#pragma unroll
            for (int k = 0; k < 4; ++k) { const f32x4 w0 = *(const f32x4*)(cw + k * 512 + c8), w1 = *(const f32x4*)(cw + k * 512 + c8 + 4);
#pragma unroll
                for (int e = 0; e < 4; ++e) { wv[k][e] = w0[e]; wv[k][4 + e] = w1[e]; } }
            { const f32x4 b0 = *(const f32x4*)(cbp + c8), b1 = *(const f32x4*)(cbp + c8 + 4);
#pragma unroll
                for (int e = 0; e < 4; ++e) { bv[e] = b0[e]; bv[4 + e] = b1[e]; } }
#pragma unroll
            for (int m = 0; m < 4; ++m) {
                const int t = t0 + 16 * m + fr;
                float a8[8];
#pragma unroll
                for (int e = 0; e < 8; ++e) a8[e] = bv[e];
#pragma unroll
                for (int k = 0; k < 4; ++k) { const int tt = t - 3 + k; const int tc = tt < 0 ? 0 : tt;
                    const v4u z = *(const v4u*)(Z + (rowb + tc) * DIN + OFF_ZX + c8); const float msk = tt < 0 ? 0.f : 1.f;
                    const unsigned zw[4] = {z.x, z.y, z.z, z.w};
#pragma unroll
                    for (int q = 0; q < 4; ++q) { a8[2 * q] += wv[k][2 * q] * (msk * bflo(zw[q])); a8[2 * q + 1] += wv[k][2 * q + 1] * (msk * bfhi(zw[q])); } }
                v4u pk; pk.x = pk2(a8[0], a8[1]); pk.y = pk2(a8[2], a8[3]); pk.z = pk2(a8[4], a8[5]); pk.w = pk2(a8[6], a8[7]);
                Xa[m][ks] = __builtin_bit_cast(bf16x8, pk);
                LAS float* xp = XR + (16 * m + fr) * 68 + 32 * ks + 8 * fq;
                *(LAS f32x4*)(xp) = (f32x4){a8[0], a8[1], a8[2], a8[3]}; *(LAS f32x4*)(xp + 4) = (f32x4){a8[4], a8[5], a8[6], a8[7]};
            }
        }
        LDS_WAIT(); asm volatile("" ::: "memory");
        const bf16* GwT = (const bf16*)(ws + WS_GWT) + (size_t)l * 2 * 8 * 4096;
        const float* gbp = args.in[15] + (size_t)l * 2 * 512;
        float ss[4] = {0.f, 0.f, 0.f, 0.f};
        bf16x8 Wn[2][2]; f32x4 gbr_n, gbi_n; v2u zg_n[4];
#define LRU_PREFETCH(nn) do { \
            _Pragma("unroll") for (int g_ = 0; g_ < 2; ++g_) _Pragma("unroll") for (int ks_ = 0; ks_ < 2; ++ks_) \
                Wn[g_][ks_] = __builtin_bit_cast(bf16x8, *(const v4u*)(GwT + ((size_t)(g_ * 8 + hd) * 64 + 16 * (nn) + fr) * 64 + 32 * ks_ + 8 * fq)); \
            gbr_n = *(const f32x4*)(gbp + hd * 64 + 16 * (nn) + 4 * fq); gbi_n = *(const f32x4*)(gbp + 512 + hd * 64 + 16 * (nn) + 4 * fq); \
            if (FULL) { _Pragma("unroll") for (int m_ = 0; m_ < 4; ++m_) zg_n[m_] = *(const v2u*)(Z + (rowb + t0 + 16 * m_ + fr) * DIN + OFF_ZG + 64 * hd + 16 * (nn) + 4 * fq); } } while (0)
        LRU_PREFETCH(0);
#pragma unroll 1
        for (int n = 0; n < 4; ++n) {
            const int cc = 16 * n + 4 * fq, c = 64 * hd + cc;
            bf16x8 Wc[2][2]; v2u zgc[4];
#pragma unroll
            for (int g = 0; g < 2; ++g)
#pragma unroll
                for (int ks = 0; ks < 2; ++ks) Wc[g][ks] = Wn[g][ks];
            const f32x4 gbr = gbr_n, gbi = gbi_n;
#pragma unroll
            for (int m = 0; m < 4; ++m) zgc[m] = zg_n[m];
            { const int nn = n < 3 ? n + 1 : 3; LRU_PREFETCH(nn); }
            f32x4 acc[2][4];
#pragma unroll
            for (int g = 0; g < 2; ++g)
#pragma unroll
                for (int m = 0; m < 4; ++m) { acc[g][m] = (f32x4){0.f, 0.f, 0.f, 0.f};
#pragma unroll
                    for (int ks = 0; ks < 2; ++ks) acc[g][m] = __builtin_amdgcn_mfma_f32_16x16x32_bf16(Wc[g][ks], Xa[m][ks], acc[g][m], 0, 0, 0); }
            const f32x4 sp = *(const LAS f32x4*)(SPL + c);
            float A[4][4], Bv[4][4];
#pragma unroll
            for (int m = 0; m < 4; ++m) { const f32x4 xr = *(const LAS f32x4*)(XR + (16 * m + fr) * 68 + cc);
#pragma unroll
                for (int e = 0; e < 4; ++e) { const float r = sigmoidf_(acc[0][m][e] + gbr[e]), ig = sigmoidf_(acc[1][m][e] + gbi[e]);
                    const float la = -8.0f * r * sp[e]; const float a = __builtin_amdgcn_exp2f(la * 1.4426950408889634f);
                    A[m][e] = a; Bv[m][e] = xr[e] * ig * __builtin_amdgcn_sqrtf(fmaxf(fmaf(-a, a, 1.0f), 0.f)); } }
#pragma unroll
            for (int m = 0; m < 4; ++m)
#pragma unroll
                for (int e = 0; e < 4; ++e) { float a = A[m][e], bb = Bv[m][e];
                    { const float ap = dpp_f<0x111>(1.0f, a), bp = dpp_f<0x111>(0.0f, bb); bb = fmaf(a, bp, bb); a *= ap; }
                    { const float ap = dpp_f<0x112>(1.0f, a), bp = dpp_f<0x112>(0.0f, bb); bb = fmaf(a, bp, bb); a *= ap; }
                    { const float ap = dpp_f<0x114>(1.0f, a), bp = dpp_f<0x114>(0.0f, bb); bb = fmaf(a, bp, bb); a *= ap; }
                    { const float ap = dpp_f<0x118>(1.0f, a), bp = dpp_f<0x118>(0.0f, bb); bb = fmaf(a, bp, bb); a *= ap; }
                    A[m][e] = a; Bv[m][e] = bb; }
            float hc[4], ac[4];
            if (FULL) { const f32x4 cv = *(const LAS f32x4*)(CARRY + c); hc[0] = cv[0]; hc[1] = cv[1]; hc[2] = cv[2]; hc[3] = cv[3]; }
            else { hc[0] = hc[1] = hc[2] = hc[3] = 0.f; }
            ac[0] = ac[1] = ac[2] = ac[3] = 1.f;
#pragma unroll
            for (int m = 0; m < 4; ++m) {
                float hcur[4];
#pragma unroll
                for (int e = 0; e < 4; ++e) { hcur[e] = fmaf(A[m][e], hc[e], Bv[m][e]); hc[e] = bcast15(hcur[e], lane);
                    if (!FULL) ac[e] = bcast15(A[m][e] * ac[e], lane); }
                if (FULL) { const v2u zg = zgc[m];
                    const float g4[4] = {bflo(zg.x), bfhi(zg.x), bflo(zg.y), bfhi(zg.y)};
                    f32x4 yq;
#pragma unroll
                    for (int e = 0; e < 4; ++e) { const float y = gelu_tanh(g4[e]) * hcur[e]; yq[e] = y; ss[m] = fmaf(y, y, ss[m]); }
                    *(LAS f32x4*)(XR + (16 * m + fr) * 68 + cc) = yq; }
            }
            if (!FULL && fr == 0) { const size_t o = ((size_t)b * NBLK + j) * 512 + c; *(f32x4*)(aggA + o) = (f32x4){ac[0], ac[1], ac[2], ac[3]}; *(f32x4*)(aggH + o) = (f32x4){hc[0], hc[1], hc[2], hc[3]}; }
        }
#undef LRU_PREFETCH
        if (FULL) {
#pragma unroll
            for (int m = 0; m < 4; ++m) { float s = ss[m]; s += __shfl_xor(s, 16); s += __shfl_xor(s, 32); if (fq == 0) SS[wave * 64 + 16 * m + fr] = s; }
            __syncthreads();
#pragma unroll
            for (int m = 0; m < 4; ++m) { float tot = 0.f;
#pragma unroll
                for (int w = 0; w < 8; ++w) tot += SS[w * 64 + 16 * m + fr];
                const float rstd = __builtin_amdgcn_rsqf(tot * (1.0f / 512.0f) + EPS);
#pragma unroll
                for (int n = 0; n < 4; ++n) { const int c = 512 + 64 * hd + 16 * n + 4 * fq; const f32x4 mg = *(const f32x4*)(mixg + c);
                    const f32x4 yq = *(const LAS f32x4*)(XR + (16 * m + fr) * 68 + 16 * n + 4 * fq);
                    v2u w; w.x = pk2(yq[0] * rstd * mg[0], yq[1] * rstd * mg[1]); w.y = pk2(yq[2] * rstd * mg[2], yq[3] * rstd * mg[3]);
                    *(v2u*)(Y + (rowb + t0 + 16 * m + fr) * D + c) = w; } }
        }
    } else if (FULL) {
        for (int i = tid; i < 64 * 64; i += NTHR) { const int r = i >> 6, c8 = (i & 63) * 8; *(v4u*)(Y + (rowb + t0 + r) * D + 512 + c8) = (v4u){0u, 0u, 0u, 0u}; }
    }
    if (!FULL) return;
    asm volatile("" ::: "memory");
    if (MIX_MASK & 1) {
        const int tg = tid >> 5, s8 = (tid & 31) * 8; const int tb = t0 + 4 * tg;
        const float* caw = args.in[7] + (size_t)l * 3 * 256;
        float w3[3][8];
#pragma unroll
        for (int k = 0; k < 3; ++k) { const f32x4 w0 = *(const f32x4*)(caw + k * 256 + s8), w1 = *(const f32x4*)(caw + k * 256 + s8 + 4);
#pragma unroll
            for (int e = 0; e < 4; ++e) { w3[k][e] = w0[e]; w3[k][4 + e] = w1[e]; } }
        float cv[6][8];
#pragma unroll
        for (int i = 0; i < 6; ++i) { const int tt = tb - 2 + i; const int tc = tt < 0 ? 0 : tt; const float msk = tt < 0 ? 0.f : 1.f;
            const v4u zc = *(const v4u*)(Z + (rowb + tc) * DIN + OFF_ZC + s8), zv = *(const v4u*)(Z + (rowb + tc) * DIN + OFF_ZV + s8);
            const unsigned a[4] = {zc.x, zc.y, zc.z, zc.w}, bq[4] = {zv.x, zv.y, zv.z, zv.w};
#pragma unroll
            for (int q = 0; q < 4; ++q) { cv[i][2 * q] = msk * bflo(a[q]) * bflo(bq[q]); cv[i][2 * q + 1] = msk * bfhi(a[q]) * bfhi(bq[q]); } }
        const f32x4 mg0 = *(const f32x4*)(mixg + s8), mg1 = *(const f32x4*)(mixg + s8 + 4);
#pragma unroll
        for (int i = 0; i < 4; ++i) {
            const v4u zb = *(const v4u*)(Z + (rowb + tb + i) * DIN + OFF_ZB + s8); const unsigned a[4] = {zb.x, zb.y, zb.z, zb.w};
            float y[8], s = 0.f;
#pragma unroll
            for (int e = 0; e < 8; ++e) { const float zbe = (e & 1) ? bfhi(a[e >> 1]) : bflo(a[e >> 1]);
                y[e] = zbe * (w3[0][e] * cv[i][e] + w3[1][e] * cv[i + 1][e] + w3[2][e] * cv[i + 2][e]); s = fmaf(y[e], y[e], s); }
#pragma unroll
            for (int o = 1; o < 32; o <<= 1) s += __shfl_xor(s, o);
            const float rstd = __builtin_amdgcn_rsqf(s * (1.0f / 256.0f) + EPS);
            v4u w; w.x = pk2(y[0] * rstd * mg0[0], y[1] * rstd * mg0[1]); w.y = pk2(y[2] * rstd * mg0[2], y[3] * rstd * mg0[3]);
            w.z = pk2(y[4] * rstd * mg1[0], y[5] * rstd * mg1[1]); w.w = pk2(y[6] * rstd * mg1[2], y[7] * rstd * mg1[3]);
            *(v4u*)(Y + (rowb + tb + i) * D + s8) = w; }
    } else {
        for (int i = tid; i < 64 * 32; i += NTHR) { const int r = i >> 5, c8 = (i & 31) * 8; *(v4u*)(Y + (rowb + t0 + r) * D + c8) = (v4u){0u, 0u, 0u, 0u}; }
    }
    asm volatile("" ::: "memory");
    if (MIX_MASK & 2) {
        __syncthreads();
        const int hf = j & 1, tcs = t0 - 64 * hf, slen = 64 * (hf + 1);
        LAS bf16* Vt = (LAS bf16*)lds;
        const float* lng = args.in[10] + (size_t)l * 256; const float* lnb = args.in[11] + (size_t)l * 256;
        {
            const int rr = lane >> 4, ci = lane & 15;
            float gq[16], bq[16];
#pragma unroll
            for (int q = 0; q < 4; ++q) { const f32x4 a = *(const f32x4*)(lng + 16 * ci + 4 * q), bb = *(const f32x4*)(lnb + 16 * ci + 4 * q);
#pragma unroll
                for (int e = 0; e < 4; ++e) { gq[4 * q + e] = a[e]; bq[4 * q + e] = bb[e]; } }
            v4u zz[4][2];
#pragma unroll
            for (int it = 0; it < 4; ++it) if (it * 32 < slen) { const int sr = 32 * it + 4 * wave + rr; const bf16* zp = Z + (rowb + tcs + sr) * DIN + OFF_ZSV + 16 * ci;
                zz[it][0] = *(const v4u*)(zp); zz[it][1] = *(const v4u*)(zp + 8); }
#pragma unroll
            for (int it = 0; it < 4; ++it) if (it * 32 < slen) { const int sr = 32 * it + 4 * wave + rr;
                float v[16]; float sm = 0.f;
#pragma unroll
                for (int hh = 0; hh < 2; ++hh) { const unsigned w4[4] = {zz[it][hh].x, zz[it][hh].y, zz[it][hh].z, zz[it][hh].w};
#pragma unroll
                    for (int q = 0; q < 4; ++q) { v[8 * hh + 2 * q] = gelu_tanh(bflo(w4[q])); v[8 * hh + 2 * q + 1] = gelu_tanh(bfhi(w4[q])); } }
#pragma unroll
                for (int e = 0; e < 16; ++e) sm += v[e];
                const float mean = sum16(sm) * (1.0f / 256.0f); float sq = 0.f;
#pragma unroll
                for (int e = 0; e < 16; ++e) { v[e] -= mean; sq = fmaf(v[e], v[e], sq); }
                const float rstd = __builtin_amdgcn_rsqf(sum16(sq) * (1.0f / 256.0f) + EPS);
#pragma unroll
                for (int e = 0; e < 16; ++e) Vt[(16 * ci + e) * 136 + sr] = (bf16)f2bf(v[e] * rstd * gq[e] + bq[e]);
            } }
        __syncthreads();
        const int h = wave >> 1, th = wave & 1;
        const bf16* SGW = (const bf16*)(ws + WS_SGW) + ((size_t)l * 4 + h) * 16384;
        f32x4 acc[2][4];
#pragma unroll
        for (int m = 0; m < 2; ++m)
#pragma unroll
            for (int n = 0; n < 4; ++n) acc[m][n] = (f32x4){0.f, 0.f, 0.f, 0.f};
#pragma unroll
        for (int ks = 0; ks < 4; ++ks) {
            if (ks * 32 < slen) {
                bf16x8 Wq[2];
#pragma unroll
                for (int m = 0; m < 2; ++m) Wq[m] = __builtin_bit_cast(bf16x8, *(const v4u*)(SGW + (size_t)(64 * hf + 32 * th + 16 * m + fr) * 128 + 32 * ks + 8 * fq));
#pragma unroll
                for (int n = 0; n < 4; ++n) { const bf16x8 Vp = *(const LAS bf16x8*)(Vt + (64 * h + 16 * n + fr) * 136 + 32 * ks + 8 * fq);
#pragma unroll
                    for (int m = 0; m < 2; ++m) acc[m][n] = __builtin_amdgcn_mfma_f32_16x16x32_bf16(Vp, Wq[m], acc[m][n], 0, 0, 0); }
            }
        }
        const float* sgb = args.in[9] + ((size_t)l * 4 + h) * 128;
        float ys[2][4][4], s2[2];
#pragma unroll
        for (int m = 0; m < 2; ++m) { const int tl = 32 * th + 16 * m + fr; const float bias = sgb[64 * hf + tl]; float s = 0.f;
#pragma unroll
            for (int n = 0; n < 4; ++n) { const v2u zu = *(const v2u*)(Z + (rowb + t0 + tl) * DIN + OFF_ZU + 64 * h + 16 * n + 4 * fq);
                const float u4[4] = {bflo(zu.x), bfhi(zu.x), bflo(zu.y), bfhi(zu.y)};
#pragma unroll
                for (int e = 0; e < 4; ++e) { const float y = gelu_tanh(u4[e]) * (acc[m][n][e] + bias); ys[m][n][e] = y; s = fmaf(y, y, s); } }
            s += __shfl_xor(s, 16); s += __shfl_xor(s, 32); s2[m] = s; if (fq == 0) SS2[h * 64 + tl] = s; }
        __syncthreads();
#pragma unroll
        for (int m = 0; m < 2; ++m) { const int tl = 32 * th + 16 * m + fr; const float tot = (SS2[tl] + SS2[64 + tl]) + (SS2[128 + tl] + SS2[192 + tl]);
            const float rstd = __builtin_amdgcn_rsqf(tot * (1.0f / 256.0f) + EPS);
#pragma unroll
            for (int n = 0; n < 4; ++n) { const int c = 256 + 64 * h + 16 * n + 4 * fq; const f32x4 mg = *(const f32x4*)(mixg + c);
                v2u w; w.x = pk2(ys[m][n][0] * rstd * mg[0], ys[m][n][1] * rstd * mg[1]); w.y = pk2(ys[m][n][2] * rstd * mg[2], ys[m][n][3] * rstd * mg[3]);
                *(v2u*)(Y + (rowb + t0 + tl) * D + c) = w; } }
        (void)s2;
    } else {
        for (int i = tid; i < 64 * 32; i += NTHR) { const int r = i >> 5, c8 = (i & 31) * 8; *(v4u*)(Y + (rowb + t0 + r) * D + 256 + c8) = (v4u){0u, 0u, 0u, 0u}; }
    }
}

template <bool XBF> __device__ __forceinline__ void route_tile(const Args& args, int l, int tile, const void* X1, LAS unsigned char* lds) {
    FRESH_TID();
    unsigned char* ws = args.ws;
    LAS float* GS = (LAS float*)lds; LAS float* SH = (LAS float*)(lds + 4096); LAS float* SHW = (LAS float*)(lds + 8192); LAS float* RED = (LAS float*)(lds + 8448);
    LAS float* PL = (LAS float*)(lds + 16384); LAS float* PSS = (LAS float*)(lds + 32768); LAS float* RSTD = (LAS float*)(lds + 33280); LAS int* HIST = (LAS int*)(lds + 33792);
    const int row0 = tile * 64, b = row0 >> 12; const int fr = lane & 15, fq = lane >> 4;
    const float* mod = (const float*)(ws + WS_MOD) + (size_t)(l * NB + b) * 6144;
    const float* g2 = args.in[3] + (size_t)l * D;
    for (int k = tid; k < D; k += NTHR) { GS[k] = g2[k] * (1.0f + mod[4 * D + k]); SH[k] = mod[3 * D + k]; }
    if (tid < 32) HIST[tid] = 0;
    __syncthreads();
    if (tid < 32) SHW[tid] = ((const float*)(ws + WS_SHW))[(l * NB + b) * NE + tid];
    const int st = wave >> 1, kh = wave & 1;
    const bf16* RWH = (const bf16*)(ws + WS_RWH) + (size_t)l * NE * D; const bf16* RWL = (const bf16*)(ws + WS_RWL) + (size_t)l * NE * D;
    f32x4 acc[2] = {(f32x4){0.f, 0.f, 0.f, 0.f}, (f32x4){0.f, 0.f, 0.f, 0.f}}; float ssq = 0.f;
    const size_t xrow = (size_t)(row0 + 16 * st + fr) * D;
#pragma unroll 8
    for (int kb = 0; kb < 16; ++kb) {
        const int k = 512 * kh + 32 * kb + 8 * fq;
        float xv[8]; ld8<XBF>(X1, xrow + k, xv);
        const f32x4 g0 = *(const LAS f32x4*)(GS + k), g1 = *(const LAS f32x4*)(GS + k + 4);
        float xs[8], hi[8], lo[8];
#pragma unroll
        for (int e = 0; e < 4; ++e) { xs[e] = xv[e] * g0[e]; xs[4 + e] = xv[4 + e] * g1[e]; ssq = fmaf(xv[e], xv[e], ssq); ssq = fmaf(xv[4 + e], xv[4 + e], ssq); }
        v4u qh, ql; unsigned hh[8], ll[8];
#pragma unroll
        for (int e = 0; e < 8; ++e) { hh[e] = f2bf(xs[e]); hi[e] = __builtin_bit_cast(float, hh[e] << 16); lo[e] = xs[e] - hi[e]; ll[e] = f2bf(lo[e]); }
        qh.x = hh[0] | (hh[1] << 16); qh.y = hh[2] | (hh[3] << 16); qh.z = hh[4] | (hh[5] << 16); qh.w = hh[6] | (hh[7] << 16);
        ql.x = ll[0] | (ll[1] << 16); ql.y = ll[2] | (ll[3] << 16); ql.z = ll[4] | (ll[5] << 16); ql.w = ll[6] | (ll[7] << 16);
        const bf16x8 Qh = __builtin_bit_cast(bf16x8, qh), Ql = __builtin_bit_cast(bf16x8, ql);
#pragma unroll
        for (int n = 0; n < 2; ++n) { const bf16x8 Ph = __builtin_bit_cast(bf16x8, *(const v4u*)(RWH + (size_t)(16 * n + fr) * D + k)), Pl = __builtin_bit_cast(bf16x8, *(const v4u*)(RWL + (size_t)(16 * n + fr) * D + k));
            acc[n] = __builtin_amdgcn_mfma_f32_16x16x32_bf16(Ph, Qh, acc[n], 0, 0, 0);
            acc[n] = __builtin_amdgcn_mfma_f32_16x16x32_bf16(Ph, Ql, acc[n], 0, 0, 0);
            acc[n] = __builtin_amdgcn_mfma_f32_16x16x32_bf16(Pl, Qh, acc[n], 0, 0, 0); }
    }
    ssq += __shfl_xor(ssq, 16); ssq += __shfl_xor(ssq, 32);
#pragma unroll
    for (int n = 0; n < 2; ++n) *(LAS f32x4*)(PL + (wave * 16 + fr) * 32 + 16 * n + 4 * fq) = acc[n];
    if (fq == 0) PSS[wave * 16 + fr] = ssq;
    __syncthreads();
    if (kh == 0) {
        const float tot = PSS[wave * 16 + fr] + PSS[(wave + 1) * 16 + fr]; const float rstd = __builtin_amdgcn_rsqf(tot * (1.0f / D) + EPS);
        if (fq == 0) RSTD[16 * st + fr] = rstd;
        float v[8]; int taken = 0;
#pragma unroll
        for (int n = 0; n < 2; ++n) { const f32x4 o = *(const LAS f32x4*)(PL + ((wave + 1) * 16 + fr) * 32 + 16 * n + 4 * fq); const f32x4 sw = *(const LAS f32x4*)(SHW + 16 * n + 4 * fq);
#pragma unroll
            for (int e = 0; e < 4; ++e) v[4 * n + e] = rstd * (acc[n][e] + o[e]) + sw[e]; }
        float selv[4]; int seli[4];
#pragma unroll
        for (int r = 0; r < 4; ++r) {
            float bv = -3.0e38f; int bi = 1 << 20;
#pragma unroll
            for (int q = 0; q < 8; ++q) { const int idx = 16 * (q >> 2) + 4 * fq + (q & 3); const bool ok = !((taken >> q) & 1) && (v[q] > bv); bv = ok ? v[q] : bv; bi = ok ? idx : bi; }
#pragma unroll
            for (int msk = 16; msk <= 32; msk <<= 1) { const float ov = __shfl_xor(bv, msk); const int oi = __shfl_xor(bi, msk); const bool tk = (ov > bv) || (ov == bv && oi < bi); bv = tk ? ov : bv; bi = tk ? oi : bi; }
            selv[r] = bv; seli[r] = bi;
            if (((bi >> 2) & 3) == fq) taken |= 1 << (4 * (bi >> 4) + (bi & 3));
        }
        const float e1 = __expf(selv[1] - selv[0]), e2 = __expf(selv[2] - selv[0]), e3 = __expf(selv[3] - selv[0]); const float inv = 1.0f / (1.0f + e1 + e2 + e3);
        const float wk = (fq == 0 ? 1.0f : fq == 1 ? e1 : fq == 2 ? e2 : e3) * inv; const int ek = fq == 0 ? seli[0] : fq == 1 ? seli[1] : fq == 2 ? seli[2] : seli[3];
        const int rank = __hip_atomic_fetch_add(HIST + ek, 1, __ATOMIC_RELAXED, __HIP_MEMORY_SCOPE_WORKGROUP);
        const size_t ai = (size_t)(row0 + 16 * st + fr) * 4 + fq;
        ((int*)(ws + WS_TOPE))[ai] = ek; ((float*)(ws + WS_TOPW))[ai] = wk; ((int*)(ws + WS_RANK))[ai] = rank;
    }
    __syncthreads();
    unsigned char* H8 = (unsigned char*)(ws + WS_H);
#pragma unroll
    for (int r0 = wave * 8; r0 < wave * 8 + 8; r0 += 4) {
        f32x4 xq[4][4];
#pragma unroll
        for (int i = 0; i < 4; ++i)
#pragma unroll
            for (int jj = 0; jj < 4; ++jj) xq[i][jj] = ld4<XBF>(X1, (size_t)(row0 + r0 + i) * D + 4 * lane + 256 * jj);
#pragma unroll
        for (int i = 0; i < 4; ++i) { const float rstd = RSTD[r0 + i] * H_SCALE;
#pragma unroll
            for (int jj = 0; jj < 4; ++jj) { const int c = 4 * lane + 256 * jj; const f32x4 gs = *(const LAS f32x4*)(GS + c), sh = *(const LAS f32x4*)(SH + c);
                const f32x4 o = xq[i][jj] * rstd * gs + sh * H_SCALE;
                *(unsigned*)(H8 + (size_t)(row0 + r0 + i) * D + c) = pg8::pk4_i8(o[0], o[1], o[2], o[3]); } } }
    if (tid < 32) ((int*)(ws + WS_CNT))[tile * 32 + tid] = HIST[tid];
    __syncthreads();
}

__device__ __forceinline__ void gather_phase(const Args& args, LAS unsigned char* lds, int vcu, int G) {
    FRESH_TID();
    unsigned char* ws = args.ws;
    LAS int* PART = (LAS int*)lds; LAS int* SEGS = (LAS int*)(lds + 2048); LAS int* BASE = (LAS int*)(lds + 2304); LAS int* SL = (LAS int*)(lds + 2560); LAS int* WK = (LAS int*)(lds + 4096);
    LAS int* TILEE = (LAS int*)(lds + L_TILEE); LAS int* NMp = (LAS int*)(lds + L_NM);
    const int* CNT = (const int*)(ws + WS_CNT);
    { const int e = tid & 31, q = tid >> 5; int s = 0;
#pragma unroll
        for (int t = 0; t < 16; ++t) s += CNT[(16 * q + t) * 32 + e];
        PART[q * 32 + e] = s; }
    __syncthreads();
    if (tid < 64) {
        int tot = 0;
        if (tid < 32) {
#pragma unroll
            for (int q = 0; q < 16; ++q) tot += PART[q * 32 + tid]; }
        const int nt = (tot + 255) >> 8; int inc = nt;
#pragma unroll
        for (int o = 1; o < 32; o <<= 1) { const int t = __shfl_up(inc, o); if (lane >= o) inc += t; }
        const int run = inc - nt;
        if (tid < 32) { SEGS[tid] = run * 256; for (int t = 0; t < nt; ++t) TILEE[run + t] = tid; }
        if (tid == 31) NMp[0] = inc;
    }
    __syncthreads();
    const unsigned char* H8 = (const unsigned char*)(ws + WS_H); unsigned char* XG = (unsigned char*)(ws + WS_XG);
    for (int tile = vcu; tile < NRT; tile += G) {
        { const int qt = tile >> 4, e = tid & 31, tq = tid >> 5, tt = 16 * qt + tq;
            WK[tq * 32 + e] = tt < tile ? CNT[tt * 32 + e] : 0; }
        __syncthreads();
        if (tid < 32) { const int qt = tile >> 4; int s = SEGS[tid];
            for (int q = 0; q < qt; ++q) s += PART[q * 32 + tid];
#pragma unroll
            for (int t = 0; t < 16; ++t) s += WK[t * 32 + tid];
            BASE[tid] = s; }
        __syncthreads();
        if (tid < 256) { const size_t ai = (size_t)tile * 256 + tid; const int e = ((const int*)(ws + WS_TOPE))[ai]; const int slot = BASE[e] + ((const int*)(ws + WS_RANK))[ai];
            ((int*)(ws + WS_SLOT))[ai] = slot; SL[tid] = slot; }
        __syncthreads();
        { v4u xr[8];
#pragma unroll
            for (int i = 0; i < 8; ++i) xr[i] = ((const v4u*)(H8 + (size_t)(tile * 64 + wave * 8 + i) * D))[lane];
#pragma unroll
            for (int i = 0; i < 8; ++i)
#pragma unroll
                for (int k = 0; k < 4; ++k) ((v4u*)(XG + (size_t)SL[wave * 32 + 4 * i + k] * D))[lane] = xr[i]; }
        __syncthreads();
    }
}

template <bool MOE, bool LAST, bool XBF>
__device__ __forceinline__ void combine_rows(const Args& args, int l, const void* X1, bf16* XN, int vcu, int G) {
    FRESH_TID(); const int gw = vcu * NWAVES + wave, NGW = G * NWAVES;
    unsigned char* ws = args.ws;
    const bf16* YE = (const bf16*)(ws + WS_XG); unsigned char* H = (unsigned char*)(ws + WS_H);
    int rpw = 1; while (rpw * NGW < T) rpw <<= 1;
    const int rbeg = gw * rpw, rend = (rbeg + rpw < T) ? rbeg + rpw : T;
    if (rbeg >= T) return;
    const int b = rbeg >> 12;
    const float* modl = (const float*)(ws + WS_MOD) + (size_t)(l * NB + b) * 6144;
    f32x4 gt[4], pa[4], pb[4];
#pragma unroll
    for (int q = 0; q < 4; ++q) { const int c = 8 * lane + 512 * (q >> 1) + 4 * (q & 1);
        gt[q] = MOE ? *(const f32x4*)(modl + 5 * D + c) : (f32x4){0.f, 0.f, 0.f, 0.f};
        if (LAST) { pa[q] = *(const f32x4*)(args.in[25] + c); pb[q] = (f32x4){0.f, 0.f, 0.f, 0.f}; }
        else { const float* modn = (const float*)(ws + WS_MOD) + (size_t)((l + 1) * NB + b) * 6144; const f32x4 g = *(const f32x4*)(args.in[2] + (size_t)(l + 1) * D + c), sc = *(const f32x4*)(modn + D + c);
            pa[q] = g * (sc + 1.0f); pb[q] = *(const f32x4*)(modn + c); } }
    int myslot = 0; float myw = 0.f;
    if (MOE && rpw * 4 <= 64 && lane < (rend - rbeg) * 4) { myslot = ((const int*)(ws + WS_SLOT))[(size_t)rbeg * 4 + lane]; myw = ((const float*)(ws + WS_TOPW))[(size_t)rbeg * 4 + lane]; }
#pragma unroll 2
    for (int row = rbeg; row < rend; ++row) {
        f32x4 v[4];
        { float t0[8], t1[8]; ld8<XBF>(X1, (size_t)row * D + 8 * lane, t0); ld8<XBF>(X1, (size_t)row * D + 512 + 8 * lane, t1);
            v[0] = (f32x4){t0[0], t0[1], t0[2], t0[3]}; v[1] = (f32x4){t0[4], t0[5], t0[6], t0[7]}; v[2] = (f32x4){t1[0], t1[1], t1[2], t1[3]}; v[3] = (f32x4){t1[4], t1[5], t1[6], t1[7]}; }
        if (MOE) {
            f32x4 a[4] = {(f32x4){0.f, 0.f, 0.f, 0.f}, (f32x4){0.f, 0.f, 0.f, 0.f}, (f32x4){0.f, 0.f, 0.f, 0.f}, (f32x4){0.f, 0.f, 0.f, 0.f}};
            v4u y[4][2]; float w[4];
#pragma unroll
            for (int k = 0; k < 4; ++k) { int slot;
                if (rpw * 4 <= 64) { slot = __builtin_amdgcn_readlane(myslot, (row - rbeg) * 4 + k); w[k] = __builtin_bit_cast(float, __builtin_amdgcn_readlane(__builtin_bit_cast(int, myw), (row - rbeg) * 4 + k)); }
                else { slot = ((const int*)(ws + WS_SLOT))[(size_t)row * 4 + k]; w[k] = ((const float*)(ws + WS_TOPW))[(size_t)row * 4 + k]; }
                slot = __builtin_amdgcn_readfirstlane(slot);
                const bf16* yr = YE + (size_t)slot * D + 8 * lane; y[k][0] = *(const v4u*)(yr); y[k][1] = *(const v4u*)(yr + 512); }
#pragma unroll
            for (int k = 0; k < 4; ++k)
#pragma unroll
                for (int hh = 0; hh < 2; ++hh) { const v4u t = y[k][hh];
                    a[2 * hh] += w[k] * (f32x4){bflo(t.x), bfhi(t.x), bflo(t.y), bfhi(t.y)}; a[2 * hh + 1] += w[k] * (f32x4){bflo(t.z), bfhi(t.z), bflo(t.w), bfhi(t.w)}; }
#pragma unroll
            for (int q = 0; q < 4; ++q) v[q] += gt[q] * a[q];
        }
        float s = 0.f;
#pragma unroll
        for (int q = 0; q < 4; ++q) s += (v[q][0] * v[q][0] + v[q][1] * v[q][1]) + (v[q][2] * v[q][2] + v[q][3] * v[q][3]);
        const float rstd = __builtin_amdgcn_rsqf(wave_sum(s) * (1.0f / D) + EPS);
        if (LAST) {
#pragma unroll
            for (int q = 0; q < 4; ++q) *(f32x4*)(args.out + (size_t)row * D + 8 * lane + 512 * (q >> 1) + 4 * (q & 1)) = v[q] * rstd * pa[q];
        } else {
#pragma unroll
            for (int hh = 0; hh < 2; ++hh) { v4u wv; wv.x = pk2(v[2 * hh][0], v[2 * hh][1]); wv.y = pk2(v[2 * hh][2], v[2 * hh][3]); wv.z = pk2(v[2 * hh + 1][0], v[2 * hh + 1][1]); wv.w = pk2(v[2 * hh + 1][2], v[2 * hh + 1][3]);
                *(v4u*)(XN + (size_t)row * D + 8 * lane + 512 * hh) = wv; }
#pragma unroll
            for (int hh = 0; hh < 2; ++hh) { const f32x4 o0 = (v[2 * hh] * rstd * pa[2 * hh] + pb[2 * hh]) * HIN_SCALE, o1 = (v[2 * hh + 1] * rstd * pa[2 * hh + 1] + pb[2 * hh + 1]) * HIN_SCALE;
                *(v2u*)(H + (size_t)row * D + 8 * lane + 512 * hh) = (v2u){pg8::pk4_i8(o0[0], o0[1], o0[2], o0[3]), pg8::pk4_i8(o1[0], o1[1], o1[2], o1[3])}; }
        }
    }
}

template <int L> __device__ __forceinline__ void layer_body(const Args& args, LAS unsigned char* lds, const XcdBarrier& bar, int vcu, int G, const void* xin, bf16* xnext) {
    unsigned char* ws = args.ws;
    constexpr bool MIX = (RUN_MASK >> (2 * L)) & 1, MOE = (RUN_MASK >> (2 * L + 1)) & 1, LAST = (L == DEPTH - 1);
    const float* modl = (const float*)(ws + WS_MOD) + (size_t)L * NB * 6144;
    constexpr bool XIN_BF = (L > 0), X1_BF = MIX ? true : XIN_BF;
    bf16* XA = (bf16*)(ws + WS_XA);
    const void* x1 = xin;
    if (MIX) {
        if (PH(2)) { asm volatile("; PHASE_MARK P2" ::: "memory");
            _Pragma("unroll 1") for (int rep = 0; rep < NREP(2); ++rep) {
            pg8::Gemm g{(const bf16*)(ws + WS_H), (const bf16*)(ws + WS_WIN + (size_t)L * DIN * D), D}; pg8::StaticOrder S; S.init(T / 256, DIN / 256, G, (int)blockIdx.x);
            pg8::EpiBf16 E{(bf16*)(ws + WS_Z), DIN, nullptr, 0, 1.0f / (HIN_SCALE * W_SCALE)};
            pg8::gemm_phase<pg8::EpiBf16, pg8::StaticOrder, true>(lds, g, S, E);
            xcd_barrier(bar); }
        }
        if (PH(3) & ((MIX_MASK >> 2) & 1)) { asm volatile("; PHASE_MARK P3a" ::: "memory");
            _Pragma("unroll 1") for (int rep = 0; rep < NREP(3); ++rep) {
            for (int u = vcu; u < NB * NBLK; u += G) { mixer_unit<false>(args, L, u >> 6, u & 63, lds); __syncthreads(); }
            xcd_barrier(bar); }
        }
        if (PH(4)) { asm volatile("; PHASE_MARK P3b" ::: "memory");
            _Pragma("unroll 1") for (int rep = 0; rep < NREP(4); ++rep) {
            for (int u = vcu; u < NB * NBLK; u += G) { mixer_unit<true>(args, L, u >> 6, u & 63, lds); __syncthreads(); }
            xcd_barrier(bar); }
        }
        if (PH(5)) { asm volatile("; PHASE_MARK P4" ::: "memory");
            _Pragma("unroll 1") for (int rep = 0; rep < NREP(5); ++rep) {
            pg8::Gemm g{(const bf16*)(ws + WS_Y), (const bf16*)(ws + WS_WOUT) + (size_t)L * D * D, D}; pg8::StaticOrder S; S.init(T / 256, D / 256, G, (int)blockIdx.x);
            pg8::EpiResGate<XIN_BF> E{xin, XA, modl + 2 * D};
            pg8::gemm_phase<pg8::EpiResGate<XIN_BF>, pg8::StaticOrder>(lds, g, S, E);
            xcd_barrier(bar); }
        }
        x1 = XA;
    }
    if (MOE) {
        if (PH(6)) { asm volatile("; PHASE_MARK P5" ::: "memory");
            _Pragma("unroll 1") for (int rep = 0; rep < NREP(6); ++rep) {
            for (int tile = vcu; tile < NRT; tile += G) route_tile<X1_BF>(args, L, tile, x1, lds);
            xcd_barrier(bar); }
        }
        if (PH(7)) { asm volatile("; PHASE_MARK P6" ::: "memory");
            _Pragma("unroll 1") for (int rep = 0; rep < NREP(7); ++rep) {
            gather_phase(args, lds, vcu, G);
            xcd_barrier(bar); }
        }
        const int nM = *(const LAS int*)(lds + L_NM);
        if (PH(8)) { asm volatile("; PHASE_MARK P7" ::: "memory");
            _Pragma("unroll 1") for (int rep = 0; rep < NREP(8); ++rep) {
            pg8::Gemm g{(const bf16*)(ws + WS_XG), (const bf16*)(ws + WS_W1 + (size_t)L * NE * 2048 * D), D}; pg8::MoeOrder S; S.init(nM, 8, G, (int)blockIdx.x); S.tile_e = (const LAS int*)(lds + L_TILEE);
            pg8::EpiSwiglu E{(unsigned char*)(ws + WS_ACT), args.in[22] + (size_t)L * NE * 2048, 1.0f / (H_SCALE * W_SCALE), ACT_SCALE};
            pg8::gemm_phase<pg8::EpiSwiglu, pg8::MoeOrder, true>(lds, g, S, E);
            xcd_barrier(bar); }
        }
        if (PH(9)) { asm volatile("; PHASE_MARK P8" ::: "memory");
            _Pragma("unroll 1") for (int rep = 0; rep < NREP(9); ++rep) {
            pg8::Gemm g{(const bf16*)(ws + WS_ACT), (const bf16*)(ws + WS_W2 + (size_t)L * NE * D * FF), FF}; pg8::MoeOrder S; S.init(nM, 4, G, (int)blockIdx.x); S.tile_e = (const LAS int*)(lds + L_TILEE);
            pg8::EpiBf16 E{(bf16*)(ws + WS_XG), D, args.in[24] + (size_t)L * NE * D, D, 1.0f / (ACT_SCALE * W_SCALE)};
            pg8::gemm_phase<pg8::EpiBf16, pg8::MoeOrder, true>(lds, g, S, E);
            xcd_barrier(bar); }
        }
    }
    asm volatile("; PHASE_MARK P9" ::: "memory");
    if (PH(10)) { _Pragma("unroll 1") for (int rep = 0; rep < NREP(10); ++rep) { combine_rows<MOE, LAST, X1_BF>(args, L, x1, xnext, vcu, G); if (!LAST) xcd_barrier(bar); } }
}

__global__ void __launch_bounds__(NTHR, 2) fwd_kernel(Args args) {
    extern __shared__ __attribute__((aligned(16))) unsigned char lds_raw[];
    LAS unsigned char* lds = (LAS unsigned char*)lds_raw;
    const int tid = threadIdx.x;
    const int G = gridDim.x; const int bx = blockIdx.x; const int vcu = (G % 8 == 0) ? (bx % 8) * (G / 8) + bx / 8 : bx;
    unsigned char* ws = args.ws;
    for (int u = tid; u < (LDS_BYTES - LDSCTL_OFF) / 4; u += NTHR) ((LAS unsigned*)(lds + LDSCTL_OFF))[u] = 0u;
    __syncthreads();
    XcdBarrier bar = xcd_barrier_post((unsigned*)(ws + WS_CTL) + CW_BAR, (volatile LAS unsigned*)(lds + L_MISC) + 8);
    asm volatile("; PHASE_MARK P0" ::: "memory");
    _Pragma("unroll 1") for (int rep = 0; rep < NREP(0); ++rep) { if (PH(0)) pro_phase(args, lds, vcu, G); xcd_barrier(bar); }
    { shw_phase(args, lds, vcu, G); if (PH(1) & (RUN_MASK & 1)) { const float* mod0 = (const float*)(ws + WS_MOD); adaln_rows(args.in[0], (unsigned char*)(ws + WS_H), args.in[2], mod0, mod0 + D, vcu, G); } xcd_barrier(bar); }
    layer_body<0>(args, lds, bar, vcu, G, args.in[0], (bf16*)(ws + WS_XB));
    layer_body<1>(args, lds, bar, vcu, G, (const void*)(ws + WS_XB), nullptr);
}

extern "C" void kernel_launch(void* const* d_in, const int* in_sizes, int n_in, void* d_out, int out_size, void* d_ws, size_t ws_size, hipStream_t stream) {
    static int grid = 0;
    if (grid == 0) {
        if (n_in != 26 || in_sizes[0] != T * D || out_size != T * D || ws_size < WS_END) { fprintf(stderr, "kernel_launch: unexpected shapes (n_in %d, in0 %d, out %d, ws %zu < %zu); nothing launched\n", n_in, n_in > 0 ? in_sizes[0] : -1, out_size, ws_size, (size_t)WS_END); grid = -1; return; }
        int dev = 0, cus = 0, per_cu = 0;
        if (hipGetDevice(&dev) != hipSuccess || hipDeviceGetAttribute(&cus, hipDeviceAttributeMultiprocessorCount, dev) != hipSuccess) { grid = -1; return; }
        if (hipFuncSetAttribute((const void*)fwd_kernel, hipFuncAttributeMaxDynamicSharedMemorySize, LDS_BYTES) != hipSuccess) { fprintf(stderr, "kernel_launch: hipFuncSetAttribute failed\n"); grid = -1; return; }
        if (hipOccupancyMaxActiveBlocksPerMultiprocessor(&per_cu, (const void*)fwd_kernel, NTHR, LDS_BYTES) != hipSuccess || per_cu < 1) { fprintf(stderr, "kernel_launch: occupancy query says %d blocks per CU\n", per_cu); }
        (void)hipGetLastError();
        grid = cus;
    }
    if (grid < 0) return;
    if (hipMemsetAsync((char*)d_ws + WS_CTL, 0, CTL_ZERO_BYTES, stream) != hipSuccess) return;
    Args a{};
    for (int i = 0; i < 26; ++i) a.in[i] = (const float*)d_in[i];
    a.out = (float*)d_out; a.ws = (unsigned char*)d_ws; a.ph_lo = 0; a.ph_hi = 0;
    hipLaunchKernelGGL(fwd_kernel, dim3(grid), dim3(NTHR), LDS_BYTES, stream, a);
}
```

```cpp
#include <hip/hip_runtime.h>
#include <cstdio>
#include <cstdint>

#ifndef RUN_MASK
#define RUN_MASK 15
#endif
#ifndef PH_ENABLE
#define PH_ENABLE 0x7ff
#endif
#define PH(k) ((PH_ENABLE >> (k)) & 1)
#ifndef DUP_MASK
#define DUP_MASK 0
#endif
#define NREP(k) (1 + ((DUP_MASK >> (k)) & 1))
#ifndef MIX_MASK
#define MIX_MASK 7
#endif

namespace pg8 {
#define PG8_LAS __attribute__((address_space(3)))
typedef unsigned short bf16_t;
typedef short bf16x8 __attribute__((ext_vector_type(8)));
typedef float f32x4 __attribute__((ext_vector_type(4)));
typedef unsigned u32x4 __attribute__((ext_vector_type(4)));
typedef int i32x4 __attribute__((ext_vector_type(4)));
typedef int i32x8 __attribute__((ext_vector_type(8)));
constexpr int BM = 256, BK = 64, HALF = 128, HTB = HALF * BK * 2, STAGE_BYTES = 8 * HTB, NXCD = 8, WGM = 8;

__host__ __device__ __forceinline__ int lds_byte(int r, int c) { const int st = (r >> 4) * 2 + (c >> 5), rr = r & 15, cc = c & 31, ob = rr * 64 + cc * 2; return st * 1024 + (ob ^ (((ob >> 9) & 1) << 5)); }
__host__ __device__ __forceinline__ void stage_rc(int b, int& R, int& C) { const int st = b / 1024, sb = b % 1024, swz = sb ^ (((sb >> 9) & 1) << 5); R = (st >> 1) * 16 + swz / 64; C = (st & 1) * 32 + (swz % 64) / 2; }
__host__ __device__ __forceinline__ int perm32(int rho) { const int n = rho >> 4, i = rho & 15; return 8 * (i >> 2) + 4 * n + (i & 3); }

struct Unit { int pm, pn, pb, e; };
struct Gemm { const bf16_t* A; const bf16_t* Bt; int K; };

struct StaticOrder {
    int nM, nN, nwg, G, c;
    __device__ void init(int nM_, int nN_, int G_, int c_) { nM = nM_; nN = nN_; nwg = nM * nN; G = G_; c = c_; }
    __device__ __forceinline__ bool map(int i, Unit& u) const {
        const long L = (long)i * G + c; if (L >= nwg) return false;
        int wgid = (int)L; { const int q = nwg / NXCD, r = nwg % NXCD, xcd = wgid % NXCD, off = wgid / NXCD; wgid = (xcd < r ? xcd * (q + 1) : r * (q + 1) + (xcd - r) * q) + off; }
        const int nig = WGM * nN, gid = wgid / nig, fm = gid * WGM, gsz = (nM - fm) < WGM ? (nM - fm) : WGM;
        u.pm = fm + ((wgid % nig) % gsz); u.pn = (wgid % nig) / gsz; return true;
    }
    __device__ __forceinline__ bool next(int i, Unit& u) const { if (!map(i, u)) return false; u.pb = u.pn; u.e = 0; return true; }
};
struct MoeOrder : StaticOrder {
    const PG8_LAS int* tile_e;
    __device__ __forceinline__ bool next(int i, Unit& u) const { if (!map(i, u)) return false; u.e = tile_e[u.pm]; u.pb = u.e * nN + u.pn; return true; }
};

__device__ __forceinline__ unsigned cvt_pk_bf16(float lo, float hi) { unsigned r; asm volatile("v_cvt_pk_bf16_f32 %0, %1, %2" : "=v"(r) : "v"(lo), "v"(hi)); return r; }

__device__ __forceinline__ unsigned q_i8(float x) { const float y = __builtin_amdgcn_fmed3f(x, -127.0f, 127.0f) + 12582912.0f; return __builtin_bit_cast(unsigned, y); }
__device__ __forceinline__ unsigned pk4_i8(float a, float b, float c, float d) { return __builtin_amdgcn_perm(q_i8(b), q_i8(a), 0x0c0c0400u) | __builtin_amdgcn_perm(q_i8(d), q_i8(c), 0x04000c0cu); }
struct EpiBf16 {
    static constexpr bool PERM = true;
    bf16_t* O; int ldc; const float* bias; int bstride; float sc;
    template <class AT> __device__ __forceinline__ void operator()(const AT (&acc)[2][2][4][2], const Unit& u, int wr, int wc, int fr, int fq) const {
        const int row0 = u.pm * BM + wr * 64 + fr; const int col0 = u.pn * BM + wc * 32 + 8 * fq;
        f32x4 bv[2][2];
#pragma unroll
        for (int bj = 0; bj < 2; ++bj)
#pragma unroll
            for (int n = 0; n < 2; ++n) bv[bj][n] = bias ? *(const f32x4*)(bias + (size_t)u.e * bstride + col0 + bj * HALF + 4 * n) : (f32x4){0.f, 0.f, 0.f, 0.f};
#pragma unroll
        for (int ai = 0; ai < 2; ++ai)
#pragma unroll
            for (int m = 0; m < 4; ++m) { bf16_t* rowp = O + (size_t)(row0 + ai * HALF + m * 16) * ldc + col0;
#pragma unroll
                for (int bj = 0; bj < 2; ++bj) { const f32x4 v0 = __builtin_convertvector(acc[ai][bj][m][0], f32x4) * sc + bv[bj][0], v1 = __builtin_convertvector(acc[ai][bj][m][1], f32x4) * sc + bv[bj][1];
                    u32x4 w; w.x = cvt_pk_bf16(v0[0], v0[1]); w.y = cvt_pk_bf16(v0[2], v0[3]); w.z = cvt_pk_bf16(v1[0], v1[1]); w.w = cvt_pk_bf16(v1[2], v1[3]);
                    *(u32x4*)(rowp + bj * HALF) = w; } }
    }
};
struct EpiI8 {
    static constexpr bool PERM = true;
    unsigned char* O; int ldc; const float* bias; int bstride; float sc, osc;
    template <class AT> __device__ __forceinline__ void operator()(const AT (&acc)[2][2][4][2], const Unit& u, int wr, int wc, int fr, int fq) const {
        const int row0 = u.pm * BM + wr * 64 + fr; const int col0 = u.pn * BM + wc * 32 + 8 * fq;
        f32x4 bv[2][2]; const f32x4 s4 = {sc * osc, sc * osc, sc * osc, sc * osc};
#pragma unroll
        for (int bj = 0; bj < 2; ++bj)
#pragma unroll
            for (int n = 0; n < 2; ++n) bv[bj][n] = *(const f32x4*)(bias + (size_t)u.e * bstride + col0 + bj * HALF + 4 * n) * osc;
#pragma unroll
        for (int ai = 0; ai < 2; ++ai)
#pragma unroll
            for (int m = 0; m < 4; ++m) { unsigned char* rowp = O + (size_t)(row0 + ai * HALF + m * 16) * ldc + col0;
#pragma unroll
                for (int bj = 0; bj < 2; ++bj) { const f32x4 v0 = __builtin_elementwise_fma(__builtin_convertvector(acc[ai][bj][m][0], f32x4), s4, bv[bj][0]), v1 = __builtin_elementwise_fma(__builtin_convertvector(acc[ai][bj][m][1], f32x4), s4, bv[bj][1]);
                    typedef unsigned u32x2 __attribute__((ext_vector_type(2)));
                    *(u32x2*)(rowp + bj * HALF) = (u32x2){pk4_i8(v0[0], v0[1], v0[2], v0[3]), pk4_i8(v1[0], v1[1], v1[2], v1[3])}; } }
    }
};
typedef float f32x2 __attribute__((ext_vector_type(2)));
__device__ __forceinline__ unsigned pack4_lowbytes(unsigned w0, unsigned w1, unsigned w2, unsigned w3) {
    return __builtin_amdgcn_perm(w1, w0, 0x0c0c0400u) | __builtin_amdgcn_perm(w3, w2, 0x04000c0cu); }
struct EpiSwiglu {
    static constexpr bool PERM = true;
    unsigned char* O; const float* b1; float sc, osc;
    template <class AT> __device__ __forceinline__ void operator()(const AT (&acc)[2][2][4][2], const Unit& u, int wr, int wc, int fr, int fq) const {
        const int row0 = u.pm * BM + wr * 64 + fr; const int cg = u.pn * HALF + wc * 32 + 8 * fq;
        const float* bg = b1 + (size_t)u.e * 2048 + cg;
        f32x4 bgv[2], buv[2]; bgv[0] = *(const f32x4*)(bg); bgv[1] = *(const f32x4*)(bg + 4); buv[0] = *(const f32x4*)(bg + 1024); buv[1] = *(const f32x4*)(bg + 1028);
        const f32x2 sc2 = {sc, sc}, osc2 = {osc, osc}, k1 = {-1.702f * 1.4426950408889634f, -1.702f * 1.4426950408889634f}, one2 = {1.0f, 1.0f}, magic = {12582912.0f, 12582912.0f};
#pragma unroll
        for (int ai = 0; ai < 2; ++ai)
#pragma unroll
            for (int m = 0; m < 4; ++m) {
                unsigned wq[2];
#pragma unroll
                for (int hh = 0; hh < 2; ++hh) {
                    const f32x4 gf = __builtin_convertvector(acc[ai][0][m][hh], f32x4), uf = __builtin_convertvector(acc[ai][1][m][hh], f32x4);
                    unsigned bits[4];
#pragma unroll
                    for (int p = 0; p < 2; ++p) {
                        f32x2 g2 = __builtin_elementwise_fma((f32x2){gf[2 * p], gf[2 * p + 1]}, sc2, (f32x2){bgv[hh][2 * p], bgv[hh][2 * p + 1]});
                        f32x2 u2 = __builtin_elementwise_fma((f32x2){uf[2 * p], uf[2 * p + 1]}, sc2, (f32x2){buv[hh][2 * p], buv[hh][2 * p + 1]});
                        g2.x = fminf(g2.x, 7.0f); g2.y = fminf(g2.y, 7.0f);
                        u2.x = __builtin_amdgcn_fmed3f(u2.x, -7.0f, 7.0f); u2.y = __builtin_amdgcn_fmed3f(u2.y, -7.0f, 7.0f);
                        const f32x2 t = g2 * k1; f32x2 e; e.x = __builtin_amdgcn_exp2f(t.x); e.y = __builtin_amdgcn_exp2f(t.y);
                        const f32x2 d = e + one2; f32x2 r; r.x = __builtin_amdgcn_rcpf(d.x); r.y = __builtin_amdgcn_rcpf(d.y);
                        f32x2 o = __builtin_elementwise_fma(u2, osc2, osc2) * (g2 * r);
                        o.x = __builtin_amdgcn_fmed3f(o.x, -127.0f, 127.0f); o.y = __builtin_amdgcn_fmed3f(o.y, -127.0f, 127.0f);
                        o = o + magic;
                        const float ox = o.x, oy = o.y;
                        bits[2 * p] = __builtin_bit_cast(unsigned, ox); bits[2 * p + 1] = __builtin_bit_cast(unsigned, oy); }
                    wq[hh] = pack4_lowbytes(bits[0], bits[1], bits[2], bits[3]); }
                typedef unsigned u32x2 __attribute__((ext_vector_type(2)));
                *(u32x2*)(O + (size_t)(row0 + ai * HALF + m * 16) * 1024 + cg) = (u32x2){wq[0], wq[1]}; }
    }
};
template <bool XBF> struct EpiResGate {
    static constexpr bool PERM = true;
    const void* X; bf16_t* O; const float* gate;
    template <class AT> __device__ __forceinline__ void operator()(const AT (&acc)[2][2][4][2], const Unit& u, int wr, int wc, int fr, int fq) const {
        const int row0 = u.pm * BM + wr * 64 + fr, col0 = u.pn * BM + wc * 32 + 8 * fq; const int b = (u.pm * BM) >> 12;
        f32x4 gv[2][2];
#pragma unroll
        for (int bj = 0; bj < 2; ++bj)
#pragma unroll
            for (int n = 0; n < 2; ++n) gv[bj][n] = *(const f32x4*)(gate + b * 6144 + col0 + bj * HALF + 4 * n);
#pragma unroll
        for (int ai = 0; ai < 2; ++ai)
#pragma unroll
            for (int m = 0; m < 4; ++m) { const size_t off = (size_t)(row0 + ai * HALF + m * 16) * 1024 + col0;
#pragma unroll
                for (int bj = 0; bj < 2; ++bj) { f32x4 x0, x1;
                    if (XBF) { const u32x4 w = *(const u32x4*)((const bf16_t*)X + off + bj * HALF);
                        x0 = (f32x4){__builtin_bit_cast(float, w.x << 16), __builtin_bit_cast(float, w.x & 0xffff0000u), __builtin_bit_cast(float, w.y << 16), __builtin_bit_cast(float, w.y & 0xffff0000u)};
                        x1 = (f32x4){__builtin_bit_cast(float, w.z << 16), __builtin_bit_cast(float, w.z & 0xffff0000u), __builtin_bit_cast(float, w.w << 16), __builtin_bit_cast(float, w.w & 0xffff0000u)}; }
                    else { x0 = *(const f32x4*)((const float*)X + off + bj * HALF); x1 = *(const f32x4*)((const float*)X + off + bj * HALF + 4); }
                    const f32x4 v0 = x0 + gv[bj][0] * __builtin_convertvector(acc[ai][bj][m][0], f32x4), v1 = x1 + gv[bj][1] * __builtin_convertvector(acc[ai][bj][m][1], f32x4);
                    u32x4 w; w.x = cvt_pk_bf16(v0[0], v0[1]); w.y = cvt_pk_bf16(v0[2], v0[3]); w.z = cvt_pk_bf16(v1[0], v1[1]); w.w = cvt_pk_bf16(v1[2], v1[3]);
                    *(u32x4*)(O + off + bj * HALF) = w; }
                asm volatile("" ::: "memory"); }
    }
};
template <bool I8> struct AccSel { typedef f32x4 type; };
template <> struct AccSel<true> { typedef i32x4 type; };
__device__ __forceinline__ f32x4 mma16(bf16x8 b, bf16x8 a, f32x4 c) { return __builtin_amdgcn_mfma_f32_16x16x32_bf16(b, a, c, 0, 0, 0); }
__device__ __forceinline__ i32x4 mma16(bf16x8 b, bf16x8 a, i32x4 c) { return __builtin_amdgcn_mfma_i32_16x16x64_i8(__builtin_bit_cast(i32x4, b), __builtin_bit_cast(i32x4, a), c, 0, 0, 0); }
template <class Epi, class Sched, bool I8 = false>
__device__ __forceinline__ void gemm_phase(PG8_LAS unsigned char* lds, const Gemm g, const Sched& S, const Epi& E) {
    int tid_ = threadIdx.x; asm volatile("" : "+v"(tid_));
    const int tid = tid_, wid = __builtin_amdgcn_readfirstlane(tid >> 6), lane = tid & 63, wr = wid >> 2, wc = wid & 3, fr = lane & 15, fq = lane >> 4;
    const int K = I8 ? g.K / 2 : g.K, nt = K / BK;
    unsigned voffA[2], voffB[2];
#pragma unroll
    for (int i = 0; i < 2; ++i) { int R, C; stage_rc(tid * 16 + i * 8192, R, C); const int Rb = Epi::PERM ? ((R & ~31) + perm32(R & 31)) : R;
        voffA[i] = (unsigned)(R * K + C) * 2u; voffB[i] = (unsigned)(Rb * K + C) * 2u; }
    const size_t kstep = (size_t)(BK * 2);
    const size_t hstep = (size_t)HALF * K * 2;
    const size_t tstep = 2 * hstep;
    const unsigned ldsw = (unsigned)wid * 1024u;
    const int aoff = lds_byte(wr * 64 + fr, fq * 8), boff = lds_byte(wc * 32 + fr, fq * 8);
#define PG8_SA(b, h) (((b) * 2 + (h)) * HTB)
#define PG8_SB(b, h) ((4 + (b) * 2 + (h)) * HTB)
#define PG8_STAGE(bufoff, gbase, voff) do { _Pragma("unroll") for (int _i = 0; _i < 2; ++_i) \
        __builtin_amdgcn_global_load_lds((const unsigned*)((const char*)(gbase) + (voff)[_i]), (PG8_LAS unsigned*)(lds + (bufoff) + ldsw + _i * 8192), 16, 0, 0); } while (0)
#define PG8_LDA(dst, b, h) do { _Pragma("unroll") for (int m = 0; m < 4; ++m) _Pragma("unroll") for (int k = 0; k < 2; ++k) dst[m][k] = *(const PG8_LAS bf16x8*)(lds + PG8_SA(b, h) + aoff + m * 2048 + k * 1024); } while (0)
#define PG8_LDB(dst, b, h) do { _Pragma("unroll") for (int n = 0; n < 2; ++n) _Pragma("unroll") for (int k = 0; k < 2; ++k) dst[n][k] = *(const PG8_LAS bf16x8*)(lds + PG8_SB(b, h) + boff + n * 2048 + k * 1024); } while (0)
#define PG8_MMA(ai, bj, At, Bt) do { __builtin_amdgcn_s_setprio(1); _Pragma("unroll") for (int m = 0; m < 4; ++m) _Pragma("unroll") for (int n = 0; n < 2; ++n) _Pragma("unroll") for (int k = 0; k < 2; ++k) \
        acc[ai][bj][m][n] = mma16(Bt[n][k], At[m][k], acc[ai][bj][m][n]); __builtin_amdgcn_s_setprio(0); } while (0)
#define PG8_WAIT_V(n) asm volatile("s_waitcnt vmcnt(" #n ")" ::: "memory")
#define PG8_WAIT_L(n) asm volatile("s_waitcnt lgkmcnt(" #n ")" ::: "memory")
#define PG8_BAR __builtin_amdgcn_s_barrier()
#define PG8_SCHED __builtin_amdgcn_sched_barrier(0)
    Unit cur, nxt; int ui = 0;
    if (!S.next(0, cur)) return;
    typedef typename AccSel<I8>::type AccT;
    AccT acc[2][2][4][2];
#pragma unroll
    for (int a = 0; a < 2; ++a)
#pragma unroll
        for (int b = 0; b < 2; ++b)
#pragma unroll
            for (int m = 0; m < 4; ++m)
#pragma unroll
                for (int n = 0; n < 2; ++n) acc[a][b][m][n] = AccT{};
    bf16x8 At[4][2], B0[2][2], B1[2][2];
    const char* cA = (const char*)g.A + (size_t)cur.pm * tstep; const char* cB = (const char*)g.Bt + (size_t)cur.pb * tstep;
    PG8_STAGE(PG8_SB(0, 0), cB, voffB); PG8_STAGE(PG8_SB(0, 1), cB + hstep, voffB); PG8_STAGE(PG8_SA(0, 0), cA, voffA); PG8_STAGE(PG8_SA(0, 1), cA + hstep, voffA);
    if (wr == 1) PG8_BAR;
    PG8_WAIT_V(2); PG8_BAR;
    PG8_STAGE(PG8_SB(1, 0), cB + kstep, voffB); PG8_STAGE(PG8_SA(1, 0), cA + kstep, voffA); PG8_STAGE(PG8_SB(1, 1), cB + hstep + kstep, voffB);
    PG8_WAIT_V(6); PG8_BAR;
    for (;;) {
        const bool has_next = S.next(ui + 1, nxt);
        const char* nA = has_next ? (const char*)g.A + (size_t)nxt.pm * tstep : cA; const char* nB = has_next ? (const char*)g.Bt + (size_t)nxt.pb * tstep : cB;
#pragma unroll 1
        for (int t = 0; t < nt; t += 2) {
            const bool last = (t == nt - 2);
            const char* a1 = cA + (size_t)(t + 1) * kstep;
            const char* a2 = last ? nA : cA + (size_t)(t + 2) * kstep; const char* b2 = last ? nB : cB + (size_t)(t + 2) * kstep;
            const char* a3 = a2 + kstep; const char* b3 = b2 + kstep;
            PG8_LDB(B0, 0, 0); PG8_LDB(B1, 0, 1); PG8_SCHED; PG8_LDA(At, 0, 0); PG8_STAGE(PG8_SA(1, 1), a1 + hstep, voffA);
            PG8_WAIT_V(8); PG8_WAIT_L(0); PG8_BAR; PG8_MMA(0, 0, At, B0); PG8_MMA(0, 1, At, B1); PG8_BAR; PG8_SCHED;
            PG8_LDA(At, 0, 1); PG8_STAGE(PG8_SB(0, 0), b2, voffB); PG8_STAGE(PG8_SB(0, 1), b2 + hstep, voffB); PG8_STAGE(PG8_SA(0, 0), a2, voffA);
            PG8_WAIT_V(8); PG8_WAIT_L(0); PG8_BAR; PG8_MMA(1, 0, At, B0); PG8_MMA(1, 1, At, B1); PG8_BAR; PG8_SCHED;
            PG8_LDB(B0, 1, 0); PG8_LDB(B1, 1, 1); PG8_SCHED; PG8_LDA(At, 1, 0); PG8_STAGE(PG8_SA(0, 1), a2 + hstep, voffA);
            PG8_WAIT_V(8); PG8_WAIT_L(0); PG8_BAR; PG8_MMA(0, 0, At, B0); PG8_MMA(0, 1, At, B1); PG8_BAR; PG8_SCHED;
            PG8_LDA(At, 1, 1); PG8_STAGE(PG8_SB(1, 0), b3, voffB); PG8_STAGE(PG8_SB(1, 1), b3 + hstep, voffB); PG8_STAGE(PG8_SA(1, 0), a3, voffA);
            PG8_WAIT_V(8); PG8_WAIT_L(0); PG8_BAR; PG8_MMA(1, 0, At, B0); PG8_MMA(1, 1, At, B1); PG8_BAR; PG8_SCHED;
        }
        if (wr == 0) PG8_BAR;
        E(acc, cur, wr, wc, fr, fq);
        if (!has_next) break;
#pragma unroll
        for (int a = 0; a < 2; ++a)
#pragma unroll
            for (int b = 0; b < 2; ++b)
#pragma unroll
                for (int m = 0; m < 4; ++m)
#pragma unroll
                    for (int n = 0; n < 2; ++n) acc[a][b][m][n] = AccT{};
        cur = nxt; cA = nA; cB = nB; ++ui;
        if (wr == 1) PG8_BAR;
    }
    PG8_WAIT_V(0);
    PG8_BAR;
#undef PG8_SA
#undef PG8_SB
#undef PG8_STAGE
#undef PG8_LDA
#undef PG8_LDB
#undef PG8_MMA
#undef PG8_WAIT_V
#undef PG8_WAIT_L
#undef PG8_BAR
#undef PG8_SCHED
}
}

constexpr int NWAVES = 8, NTHR = 512;
constexpr int NB = 4, SEQ = 4096, D = 1024, T = NB * SEQ, DIN = 2304, NE = 32, TOPK = 4, DEPTH = 2, FF = 1024;
constexpr int OFF_ZB = 0, OFF_ZC = 256, OFF_ZV = 512, OFF_ZU = 768, OFF_ZSV = 1024, OFF_ZG = 1280, OFF_ZX = 1792;
constexpr int NBLK = SEQ / 64;
constexpr int NRT = T / 64;
constexpr int MAXTILES = T * TOPK / 256 + NE;
constexpr int MAXSLOTS = MAXTILES * 256;
constexpr float EPS = 1e-6f;
constexpr float W_SCALE = 960.0f, H_SCALE = 28.0f, ACT_SCALE = 12.0f, HIN_SCALE = 28.0f, YE_SCALE = 32.0f;

constexpr size_t al(size_t x) { return (x + 4095) & ~(size_t)4095; }
constexpr size_t WS_CTL = 0, CTL_ZERO_BYTES = 65536;
constexpr size_t WS_MOD = 65536;
constexpr size_t WS_GWT = al(WS_MOD + (size_t)DEPTH * NB * 6144 * 4);
constexpr size_t WS_SGW = al(WS_GWT + (size_t)DEPTH * 2 * 8 * 4096 * 2);
constexpr size_t WS_RWH = al(WS_SGW + (size_t)DEPTH * 4 * 16384 * 2);
constexpr size_t WS_RWL = al(WS_RWH + (size_t)DEPTH * NE * D * 2);
constexpr size_t WS_WIN = al(WS_RWL + (size_t)DEPTH * NE * D * 2);
constexpr size_t WS_WOUT = al(WS_WIN + (size_t)DEPTH * DIN * D * 2);
constexpr size_t WS_W1 = al(WS_WOUT + (size_t)DEPTH * D * D * 2);
constexpr size_t WS_W2 = al(WS_W1 + (size_t)DEPTH * NE * 2048 * D * 2);
constexpr size_t WS_H = al(WS_W2 + (size_t)DEPTH * NE * D * FF * 2);
constexpr size_t WS_Z = al(WS_H + (size_t)T * D * 2);
constexpr size_t WS_Y = al(WS_Z + (size_t)T * DIN * 2);
constexpr size_t WS_XA = al(WS_Y + (size_t)T * D * 2);
constexpr size_t WS_XB = al(WS_XA + (size_t)T * D * 4);
constexpr size_t WS_AGA = al(WS_XB + (size_t)T * D * 4);
constexpr size_t WS_AGH = al(WS_AGA + (size_t)NB * NBLK * 512 * 4);
constexpr size_t WS_TOPE = al(WS_AGH + (size_t)NB * NBLK * 512 * 4);
constexpr size_t WS_TOPW = al(WS_TOPE + (size_t)T * 4 * 4);
constexpr size_t WS_RANK = al(WS_TOPW + (size_t)T * 4 * 4);
constexpr size_t WS_SLOT = al(WS_RANK + (size_t)T * 4 * 4);
constexpr size_t WS_CNT = al(WS_SLOT + (size_t)T * 4 * 4);
constexpr size_t WS_SHW = al(WS_CNT + (size_t)NRT * NE * 4);
constexpr size_t WS_XG = al(WS_SHW + (size_t)DEPTH * NB * NE * 4);
constexpr size_t WS_ACT = al(WS_XG + (size_t)MAXSLOTS * D * 2);
constexpr size_t WS_END = al(WS_ACT + (size_t)MAXSLOTS * D * 2);
constexpr int CW_BAR = 1024;

constexpr int RING_BYTES = 131072;
constexpr int SCR_BYTES = 147456;
constexpr int LDSCTL_OFF = SCR_BYTES;
constexpr int L_MISC = LDSCTL_OFF;
constexpr int L_TILEE = LDSCTL_OFF + 256;
constexpr int L_NM = L_TILEE + MAXTILES * 4;
constexpr int LDS_BYTES = LDSCTL_OFF + 2048;
static_assert(L_NM + 4 <= LDS_BYTES, "LDS map");

#define GAS __attribute__((address_space(1)))
#define LAS __attribute__((address_space(3)))
typedef unsigned short bf16;
typedef unsigned v4u __attribute__((ext_vector_type(4)));
typedef unsigned v2u __attribute__((ext_vector_type(2)));
typedef float f32x4 __attribute__((ext_vector_type(4)));
typedef short bf16x8 __attribute__((ext_vector_type(8)));
#define LDS_WAIT() asm volatile("s_waitcnt lgkmcnt(0)" ::: "memory")
#define FRESH_TID() int tid_ = threadIdx.x; asm volatile("" : "+v"(tid_)); const int tid = tid_, lane = tid & 63, wave = __builtin_amdgcn_readfirstlane(tid >> 6); (void)tid; (void)lane; (void)wave
__device__ __forceinline__ unsigned f2bf(float f) { unsigned u = __builtin_bit_cast(unsigned, f); return (u + 0x7fffu + ((u >> 16) & 1u)) >> 16; }
__device__ __forceinline__ unsigned pk2(float lo, float hi) { return pg8::cvt_pk_bf16(lo, hi); }
__device__ __forceinline__ float bflo(unsigned w) { return __builtin_bit_cast(float, w << 16); }
__device__ __forceinline__ float bfhi(unsigned w) { return __builtin_bit_cast(float, w & 0xffff0000u); }
__device__ __forceinline__ float i8f(unsigned w, int k) { return (float)(int)(signed char)(w >> (8 * k)); }
template <bool BF> __device__ __forceinline__ void ld8(const void* p, size_t idx, float (&o)[8]) {
    if (BF) { const v4u w = *(const v4u*)((const bf16*)p + idx); o[0] = bflo(w.x); o[1] = bfhi(w.x); o[2] = bflo(w.y); o[3] = bfhi(w.y); o[4] = bflo(w.z); o[5] = bfhi(w.z); o[6] = bflo(w.w); o[7] = bfhi(w.w); }
    else { const f32x4 a = *(const f32x4*)((const float*)p + idx), b = *(const f32x4*)((const float*)p + idx + 4); o[0] = a[0]; o[1] = a[1]; o[2] = a[2]; o[3] = a[3]; o[4] = b[0]; o[5] = b[1]; o[6] = b[2]; o[7] = b[3]; } }
template <bool BF> __device__ __forceinline__ f32x4 ld4(const void* p, size_t idx) {
    if (BF) { const v2u w = *(const v2u*)((const bf16*)p + idx); return (f32x4){bflo(w.x), bfhi(w.x), bflo(w.y), bfhi(w.y)}; }
    else return *(const f32x4*)((const float*)p + idx); }
__device__ __forceinline__ float sigmoidf_(float x) { return __builtin_amdgcn_rcpf(1.0f + __builtin_amdgcn_exp2f(-1.4426950408889634f * x)); }
__device__ __forceinline__ float gelu_tanh(float x) { const float u2 = 1.5957691216057308f * (x + 0.044715f * x * x * x); return x * __builtin_amdgcn_rcpf(1.0f + __builtin_amdgcn_exp2f(-1.4426950408889634f * u2)); }
__device__ __forceinline__ float wave_sum(float v) {
#pragma unroll
    for (int o = 1; o < 64; o <<= 1) v += __shfl_xor(v, o);
    return v;
}
template <int CTRL> __device__ __forceinline__ float dpp_f(float old, float src) { return __builtin_bit_cast(float, __builtin_amdgcn_update_dpp(__builtin_bit_cast(int, old), __builtin_bit_cast(int, src), CTRL, 0xF, 0xF, false)); }
__device__ __forceinline__ float sum16(float v) {
    v += dpp_f<0xB1>(v, v); v += dpp_f<0x4E>(v, v); v += dpp_f<0x141>(v, v); v += dpp_f<0x140>(v, v); return v; }
__device__ __forceinline__ float bcast15(float v, int lane) { return __builtin_bit_cast(float, __builtin_amdgcn_ds_bpermute((lane | 15) << 2, __builtin_bit_cast(int, v))); }

#define XB_TMO      128
#define XB_XCNT(j)  (256  + 64 * (j))
#define XB_XSUB(j)  (1280 + 64 * (j))
#define XB_XGEN(j)  (2304 + 64 * (j))
#define XB_TOP      3328
#define XB_TOPGEN   3392
#define XCD_BAR_WORDS 3456
#define XB_SPIN_CAP (1u << 18)
__device__ __forceinline__ unsigned xb_ld(unsigned* p)              { return __hip_atomic_load(p, __ATOMIC_RELAXED, __HIP_MEMORY_SCOPE_AGENT); }
__device__ __forceinline__ unsigned xb_add(unsigned* p, unsigned v) { return __hip_atomic_fetch_add(p, v, __ATOMIC_RELAXED, __HIP_MEMORY_SCOPE_AGENT); }
__device__ __forceinline__ unsigned xb_xcc_id() { return (unsigned)__builtin_amdgcn_s_getreg((3 << 11) | 20) & 0xFu; }
#define XB_SPIN(cond, bar) do { unsigned _sp = 0; while (cond) { __builtin_amdgcn_s_sleep(1); \
    if ((++_sp & 255u) == 0u) { if (xb_ld(&(bar)[XB_TMO])) break; if (_sp > XB_SPIN_CAP) { atomicAdd(&(bar)[XB_TMO], 1u); break; } } } } while (0)
struct XcdBarrier { unsigned* bar; unsigned x; volatile LAS unsigned* st; };
__device__ __forceinline__ XcdBarrier xcd_barrier_post(unsigned* bar, volatile LAS unsigned* st) {
    XcdBarrier b; b.bar = bar; b.x = xb_xcc_id(); b.st = st;
    if (threadIdx.x == 0) (void)xb_add(&bar[XB_XCNT(b.x)], 1u);
    return b;
}
__device__ __forceinline__ void xcd_barrier_complete(unsigned* bar, unsigned x, unsigned& nloc, unsigned& nx) {
    const unsigned G = gridDim.x * gridDim.y * gridDim.z;
    unsigned sum, cnt, mine, sp = 0u;
    for (;;) {
        sum = 0u; cnt = 0u; mine = 0u;
#pragma unroll
        for (unsigned j = 0; j < 16; ++j) { const unsigned c = xb_ld(&bar[XB_XCNT(j)]); sum += c; cnt += (c > 0u) ? 1u : 0u; mine = (j == x) ? c : mine; }
        if (sum == G) break;
        __builtin_amdgcn_s_sleep(1);
        if ((++sp & 255u) == 0u) { if (xb_ld(&bar[XB_TMO])) break; if (sp > XB_SPIN_CAP) { atomicAdd(&bar[XB_TMO], 1u); break; } }
    }
    nloc = mine > 0u ? mine : 1u; nx = cnt > 0u ? cnt : 1u;
}
__device__ __forceinline__ void xcd_barrier(const XcdBarrier& b) {
    asm volatile("s_waitcnt vmcnt(0)" ::: "memory");
    __syncthreads();
    if (threadIdx.x == 0) {
        unsigned* bar = b.bar;
        __builtin_amdgcn_s_waitcnt(0);
        unsigned nloc = b.st[0], nx = b.st[1];
        if (nloc == 0u) { xcd_barrier_complete(bar, b.x, nloc, nx); b.st[0] = nloc; b.st[1] = nx; }
        const unsigned old = xb_add(&bar[XB_XSUB(b.x)], 1u);
        const unsigned gen = old / nloc;
        if (old + 1u == (gen + 1u) * nloc) {
            __builtin_amdgcn_fence(__ATOMIC_RELEASE, "agent");
            asm volatile("s_waitcnt vmcnt(0)" ::: "memory");
            const unsigned og = xb_add(&bar[XB_TOP], 1u);
            const unsigned tg = og / nx;
            if (og + 1u == (tg + 1u) * nx) xb_add(&bar[XB_TOPGEN], 1u);
            else XB_SPIN(xb_ld(&bar[XB_TOPGEN]) == tg, bar);
            __builtin_amdgcn_fence(__ATOMIC_ACQUIRE, "agent");
            xb_add(&bar[XB_XGEN(b.x)], 1u);
            asm volatile("s_waitcnt vmcnt(0)" ::: "memory");
        } else {
            XB_SPIN(xb_ld(&bar[XB_XGEN(b.x)]) == gen, bar);
            __builtin_amdgcn_fence(__ATOMIC_ACQUIRE, "agent");
            asm volatile("s_waitcnt vmcnt(0)" ::: "memory");
        }
    }
    __syncthreads();
}

struct TItem { const float* W; bf16* WT; int K, N, k0, n0, rowbase, fp8; };
__device__ __forceinline__ void ti_load(const TItem& d, f32x4 (&v)[16], int lane) {
    if (d.fp8) {
#pragma unroll
        for (int i = 0; i < 16; ++i) v[i] = __builtin_nontemporal_load((const f32x4*)(d.W + (size_t)(d.k0 + 8 * i + (lane >> 3)) * d.N + d.n0 + 4 * (lane & 7)));
    } else {
#pragma unroll
        for (int i = 0; i < 16; ++i) v[i] = __builtin_nontemporal_load((const f32x4*)(d.W + (size_t)(d.k0 + 4 * i + (lane >> 4)) * d.N + d.n0 + 4 * (lane & 15)));
    }
}
__device__ __forceinline__ void ti_store(const TItem& d, const f32x4 (&v)[16], LAS float* scr, int lane) {
    if (d.fp8) {
#pragma unroll
        for (int i = 0; i < 16; ++i) *(LAS f32x4*)(scr + (8 * (i & 1) + (lane >> 3)) * 288 + (i >> 1) * 36 + 4 * (lane & 7)) = v[i];
        LDS_WAIT(); asm volatile("" ::: "memory");
        const int c = lane & 7, nl = lane >> 3;
#pragma unroll
        for (int jj = 0; jj < 4; ++jj) { const int n = nl + 8 * jj; const LAS float* sp = scr + c * 36 + n; v4u o;
            o.x = pg8::pk4_i8(sp[0 * 288] * W_SCALE, sp[1 * 288] * W_SCALE, sp[2 * 288] * W_SCALE, sp[3 * 288] * W_SCALE);
            o.y = pg8::pk4_i8(sp[4 * 288] * W_SCALE, sp[5 * 288] * W_SCALE, sp[6 * 288] * W_SCALE, sp[7 * 288] * W_SCALE);
            o.z = pg8::pk4_i8(sp[8 * 288] * W_SCALE, sp[9 * 288] * W_SCALE, sp[10 * 288] * W_SCALE, sp[11 * 288] * W_SCALE);
            o.w = pg8::pk4_i8(sp[12 * 288] * W_SCALE, sp[13 * 288] * W_SCALE, sp[14 * 288] * W_SCALE, sp[15 * 288] * W_SCALE);
            *(v4u*)((unsigned char*)d.WT + (size_t)(d.rowbase + n) * d.K + d.k0 + 16 * c) = o; }
        LDS_WAIT(); asm volatile("" ::: "memory");
        return;
    }
#pragma unroll
    for (int i = 0; i < 16; ++i) { LAS float* s = scr + (4 * i + (lane >> 4)) * 65 + 4 * (lane & 15); s[0] = v[i][0]; s[1] = v[i][1]; s[2] = v[i][2]; s[3] = v[i][3]; }
    LDS_WAIT(); asm volatile("" ::: "memory");
    const int c = lane & 7;
#pragma unroll
    for (int j = 0; j < 8; ++j) { const int n = (lane >> 3) + 8 * j; const LAS float* s = scr + (8 * c) * 65 + n;
        v4u o; o.x = pk2(s[0 * 65], s[1 * 65]); o.y = pk2(s[2 * 65], s[3 * 65]); o.z = pk2(s[4 * 65], s[5 * 65]); o.w = pk2(s[6 * 65], s[7 * 65]);
        *(v4u*)(d.WT + (size_t)(d.rowbase + n) * d.K + d.k0 + 8 * c) = o; }
    LDS_WAIT(); asm volatile("" ::: "memory");
}

struct Args { const float* in[26]; float* out; unsigned char* ws; int ph_lo, ph_hi; };

__device__ __forceinline__ void pro_phase(const Args& args, LAS unsigned char* lds, int vcu, int G) {
    FRESH_TID();
    unsigned char* ws = args.ws;
    for (int u = vcu; u < DEPTH * 96; u += G) {
        const int l = u / 96, cbk = u % 96, col = cbk * 64 + lane;
        const float* wa = args.in[4] + (size_t)l * D * 6144; const float* cc = args.in[1];
        float a0 = 0.f, a1 = 0.f, a2 = 0.f, a3 = 0.f;
#pragma unroll 8
        for (int k = wave * 128; k < wave * 128 + 128; ++k) { const float w = wa[(size_t)k * 6144 + col]; a0 += cc[k] * w; a1 += cc[D + k] * w; a2 += cc[2 * D + k] * w; a3 += cc[3 * D + k] * w; }
        LAS float* red = (LAS float*)lds;
        red[(wave * 4 + 0) * 64 + lane] = a0; red[(wave * 4 + 1) * 64 + lane] = a1; red[(wave * 4 + 2) * 64 + lane] = a2; red[(wave * 4 + 3) * 64 + lane] = a3;
        __syncthreads();
        if (tid < 256) { const int b = tid >> 6, cl = tid & 63; float s = args.in[5][(size_t)l * 6144 + cbk * 64 + cl];
#pragma unroll
            for (int w = 0; w < 8; ++w) s += red[(w * 4 + b) * 64 + cl];
            ((float*)(ws + WS_MOD))[(size_t)(l * NB + b) * 6144 + cbk * 64 + cl] = s; }
        __syncthreads();
    }
    const int gt = vcu * NTHR + tid, NGT = G * NTHR;
    for (int i = gt; i < DEPTH * 2 * 8 * 4096; i += NGT) {
        const int ii = i & 63, j = (i >> 6) & 63, lgh = i >> 12;
        ((bf16*)(ws + WS_GWT))[i] = (bf16)f2bf(args.in[14][(size_t)lgh * 4096 + ii * 64 + j]); }
    for (int i = gt; i < DEPTH * 4 * 16384; i += NGT) {
        const int s = i & 127, t = (i >> 7) & 127;
        ((bf16*)(ws + WS_SGW))[i] = (bf16)(s <= t ? f2bf(args.in[8][i]) : 0u); }
    for (int i = gt; i < DEPTH * NE * D; i += NGT) {
        const int k = i & 1023, e = (i >> 10) & 31, l = i >> 15;
        const float w = args.in[19][((size_t)l * D + k) * NE + e]; const unsigned hi = f2bf(w); const float r = w - __builtin_bit_cast(float, hi << 16);
        ((bf16*)(ws + WS_RWH))[i] = (bf16)hi; ((bf16*)(ws + WS_RWL))[i] = (bf16)f2bf(r); }
    LAS float* scr = (LAS float*)(lds + wave * 18432);
    const int gw = vcu * NWAVES + wave, NGW = G * NWAVES;
    constexpr int I_IN = 16 * 36, I_OUT = 16 * 16, I_W1 = NE * 16 * 32, I_W2 = NE * 16 * 16, I_L = I_IN + I_OUT + I_W1 + I_W2;
    auto decode = [&](int it, TItem& d) {
        const int l = it / I_L; int r = it % I_L;
        if (r < I_IN) { const int kb = r / 72, nb = r % 72; d = TItem{args.in[6] + (size_t)l * D * DIN, (bf16*)(ws + WS_WIN + (size_t)l * DIN * D), D, DIN, kb * 128, nb * 32, nb * 32, 1}; return; } r -= I_IN;
        if (r < I_OUT) { const int kb = r / 16, nb = r % 16; d = TItem{args.in[18] + (size_t)l * D * D, (bf16*)(ws + WS_WOUT) + (size_t)l * D * D, D, D, kb * 64, nb * 64, nb * 64, 0}; return; } r -= I_OUT;
        if (r < I_W1) { const int e = r / 512, q = r % 512, kb = q / 64, nb = q % 64, n0 = nb * 32;
            const int rowbase = (n0 < 1024) ? (n0 >> 7) * 256 + (n0 & 127) : ((n0 - 1024) >> 7) * 256 + 128 + ((n0 - 1024) & 127);
            d = TItem{args.in[21] + ((size_t)l * NE + e) * D * 2048, (bf16*)(ws + WS_W1 + ((size_t)l * NE + e) * 2048 * D), D, 2048, kb * 128, n0, rowbase, 1}; return; } r -= I_W1;
        { const int e = r / 256, q = r % 256, kb = q / 32, nb = q % 32;
            d = TItem{args.in[23] + ((size_t)l * NE + e) * FF * D, (bf16*)(ws + WS_W2 + ((size_t)l * NE + e) * D * FF), FF, D, kb * 128, nb * 32, nb * 32, 1}; }
    };
    int it = gw; TItem d, dn; f32x4 v[16], vn[16];
    if (it < DEPTH * I_L) { decode(it, d); ti_load(d, v, lane); }
    while (it < DEPTH * I_L) {
        const int itn = it + NGW; const bool hn = itn < DEPTH * I_L;
        if (hn) { decode(itn, dn); ti_load(dn, vn, lane); }
        ti_store(d, v, scr, lane);
        if (hn) { d = dn;
#pragma unroll
            for (int i = 0; i < 16; ++i) v[i] = vn[i]; }
        it = itn;
    }
}

__device__ __forceinline__ void adaln_rows(const float* X, unsigned char* H, const float* g, const float* mod_shift, const float* mod_scale, int vcu, int G) {
    FRESH_TID(); const int gw = vcu * NWAVES + wave, NGW = G * NWAVES;
    for (int row = gw; row < T; row += NGW) {
        const int b = row >> 12; const float* xr = X + (size_t)row * D + 4 * lane;
        f32x4 v[4]; float s = 0.f;
#pragma unroll
        for (int j = 0; j < 4; ++j) { v[j] = *(const f32x4*)(xr + 256 * j); s += (v[j][0] * v[j][0] + v[j][1] * v[j][1]) + (v[j][2] * v[j][2] + v[j][3] * v[j][3]); }
        const float rstd = __builtin_amdgcn_rsqf(wave_sum(s) * (1.0f / D) + EPS);
#pragma unroll
        for (int j = 0; j < 4; ++j) { const int c = 4 * lane + 256 * j;
            const f32x4 gv = *(const f32x4*)(g + c), sc = *(const f32x4*)(mod_scale + b * 6144 + c), sh = *(const f32x4*)(mod_shift + b * 6144 + c);
            const f32x4 o = (v[j] * rstd * gv * (sc + 1.0f) + sh) * HIN_SCALE;
            *(unsigned*)(H + (size_t)row * D + c) = pg8::pk4_i8(o[0], o[1], o[2], o[3]); }
    }
}


__device__ __forceinline__ void shw_phase(const Args& args, LAS unsigned char* lds, int vcu, int G) {
    FRESH_TID();
    unsigned char* ws = args.ws; LAS float* RED = (LAS float*)lds;
    for (int u = vcu; u < DEPTH * NB; u += G) {
        const int l = u >> 2, b = u & 3, e = tid & 31, part = tid >> 5;
        const float* sh = (const float*)(ws + WS_MOD) + (size_t)(l * NB + b) * 6144 + 3 * D; const float* rw = args.in[19] + (size_t)l * D * NE; float s = 0.f;
#pragma unroll 16
        for (int k = part * 64; k < part * 64 + 64; ++k) s = fmaf(sh[k], rw[(size_t)k * NE + e], s);
        RED[part * 32 + e] = s;
        __syncthreads();
        if (tid < 32) { float t = args.in[20][(size_t)l * NE + tid];
#pragma unroll
            for (int p = 0; p < 16; ++p) t += RED[p * 32 + tid];
            ((float*)(ws + WS_SHW))[(l * NB + b) * NE + tid] = t; }
        __syncthreads();
    }
}

constexpr int L3_CARRY = 139264, L3_SS = 141312, L3_SS2 = 143360, L3_SPL = 144384;
template <bool FULL>
__device__ __forceinline__ void mixer_unit(const Args& args, int l, int b, int j, LAS unsigned char* lds) {
    FRESH_TID();
    unsigned char* ws = args.ws;
    const bf16* Z = (const bf16*)(ws + WS_Z); bf16* Y = (bf16*)(ws + WS_Y);
    float* aggA = (float*)(ws + WS_AGA); float* aggH = (float*)(ws + WS_AGH);
    const float* mixg = args.in[17] + (size_t)l * D;
    const int fr = lane & 15, fq = lane >> 4;
    const size_t rowb = (size_t)b * SEQ;
    const int t0 = 64 * j;
    LAS float* CARRY = (LAS float*)(lds + L3_CARRY); LAS float* SS = (LAS float*)(lds + L3_SS); LAS float* SS2 = (LAS float*)(lds + L3_SS2); LAS float* SPL = (LAS float*)(lds + L3_SPL);
    if ((MIX_MASK & 4) || !FULL) {
        {
            const float y = -args.in[16][(size_t)l * 512 + tid];
            SPL[tid] = fmaxf(y, 0.f) + log1pf(expf(-fabsf(y)));
            if (FULL) { float c = 0.f; const float* pa = aggA + (size_t)b * NBLK * 512 + tid; const float* ph = aggH + (size_t)b * NBLK * 512 + tid;
                int jj = 0;
                for (; jj + 16 <= j; jj += 16) { float av[16], hv[16];
#pragma unroll
                    for (int q = 0; q < 16; ++q) { av[q] = pa[(size_t)(jj + q) * 512]; hv[q] = ph[(size_t)(jj + q) * 512]; }
#pragma unroll
                    for (int q = 0; q < 16; ++q) c = fmaf(av[q], c, hv[q]); }
                { float av[16], hv[16];
#pragma unroll
                    for (int q = 0; q < 16; ++q) { const bool ok = jj + q < j; const int jq = ok ? jj + q : 0; av[q] = pa[(size_t)jq * 512]; hv[q] = ph[(size_t)jq * 512]; if (!ok) { av[q] = 1.f; hv[q] = 0.f; } }
#pragma unroll
                    for (int q = 0; q < 16; ++q) c = fmaf(av[q], c, hv[q]); }
                CARRY[tid] = c; }
        }
        __syncthreads();
        const int hd = wave;
        LAS float* XR = (LAS float*)(lds + wave * 17408);
        const float* cw = args.in[12] + (size_t)l * 4 * 512; const float* cbp = args.in[13] + (size_t)l * 512;
        bf16x8 Xa[4][2];
#pragma unroll
        for (int ks = 0; ks < 2; ++ks) {
            const int c8 = 64 * hd + 32 * ks + 8 * fq;
            float wv[4][8], bv[8];
#pragma unroll
            for (int k = 0; k < 4; ++k) { const f32x4 w0 = *(const f32x4*)(cw + k * 512 + c8), w1 = *(const f32x4*)(cw + k * 512 + c8 + 4);
#pragma unroll
                for (int e = 0; e < 4; ++e) { wv[k][e] = w0[e]; wv[k][4 + e] = w1[e]; } }
            { const f32x4 b0 = *(const f32x4*)(cbp + c8), b1 = *(const f32x4*)(cbp + c8 + 4);
#pragma unroll
                for (int e = 0; e < 4; ++e) { bv[e] = b0[e]; bv[4 + e] = b1[e]; } }
#pragma unroll
            for (int m = 0; m < 4; ++m) {
                const int t = t0 + 16 * m + fr;
                float a8[8];
#pragma unroll
                for (int e = 0; e < 8; ++e) a8[e] = bv[e];
#pragma unroll
                for (int k = 0; k < 4; ++k) { const int tt = t - 3 + k; const int tc = tt < 0 ? 0 : tt;
                    const v4u z = *(const v4u*)(Z + (rowb + tc) * DIN + OFF_ZX + c8); const float msk = tt < 0 ? 0.f : 1.f;
                    const unsigned zw[4] = {z.x, z.y, z.z, z.w};
#pragma unroll
                    for (int q = 0; q < 4; ++q) { a8[2 * q] += wv[k][2 * q] * (msk * bflo(zw[q])); a8[2 * q + 1] += wv[k][2 * q + 1] * (msk * bfhi(zw[q])); } }
                v4u pk; pk.x = pk2(a8[0], a8[1]); pk.y = pk2(a8[2], a8[3]); pk.z = pk2(a8[4], a8[5]); pk.w = pk2(a8[6], a8[7]);
                Xa[m][ks] = __builtin_bit_cast(bf16x8, pk);
                LAS float* xp = XR + (16 * m + fr) * 68 + 32 * ks + 8 * fq;
                *(LAS f32x4*)(xp) = (f32x4){a8[0], a8[1], a8[2], a8[3]}; *(LAS f32x4*)(xp + 4) = (f32x4){a8[4], a8[5], a8[6], a8[7]};
            }
        }
        LDS_WAIT(); asm volatile("" ::: "memory");
        const bf16* GwT = (const bf16*)(ws + WS_GWT) + (size_t)l * 2 * 8 * 4096;
        const float* gbp = args.in[15] + (size_t)l * 2 * 512;
        float ss[4] = {0.f, 0.f, 0.f, 0.f};
        bf16x8 Wn[2][2]; f32x4 gbr_n, gbi_n; v2u zg_n[4];
#define LRU_PREFETCH(nn) do { \
            _Pragma("unroll") for (int g_ = 0; g_ < 2; ++g_) _Pragma("unroll") for (int ks_ = 0; ks_ < 2; ++ks_) \
                Wn[g_][ks_] = __builtin_bit_cast(bf16x8, *(const v4u*)(GwT + ((size_t)(g_ * 8 + hd) * 64 + 16 * (nn) + fr) * 64 + 32 * ks_ + 8 * fq)); \
            gbr_n = *(const f32x4*)(gbp + hd * 64 + 16 * (nn) + 4 * fq); gbi_n = *(const f32x4*)(gbp + 512 + hd * 64 + 16 * (nn) + 4 * fq); \
            if (FULL) { _Pragma("unroll") for (int m_ = 0; m_ < 4; ++m_) zg_n[m_] = *(const v2u*)(Z + (rowb + t0 + 16 * m_ + fr) * DIN + OFF_ZG + 64 * hd + 16 * (nn) + 4 * fq); } } while (0)
        LRU_PREFETCH(0);
#pragma unroll 1
        for (int n = 0; n < 4; ++n) {
            const int cc = 16 * n + 4 * fq, c = 64 * hd + cc;
            bf16x8 Wc[2][2]; v2u zgc[4];
#pragma unroll
            for (int g = 0; g < 2; ++g)
#pragma unroll
                for (int ks = 0; ks < 2; ++ks) Wc[g][ks] = Wn[g][ks];
            const f32x4 gbr = gbr_n, gbi = gbi_n;
#pragma unroll
            for (int m = 0; m < 4; ++m) zgc[m] = zg_n[m];
            { const int nn = n < 3 ? n + 1 : 3; LRU_PREFETCH(nn); }
            f32x4 acc[2][4];
#pragma unroll
            for (int g = 0; g < 2; ++g)
#pragma unroll
                for (int m = 0; m < 4; ++m) { acc[g][m] = (f32x4){0.f, 0.f, 0.f, 0.f};
#pragma unroll
                    for (int ks = 0; ks < 2; ++ks) acc[g][m] = __builtin_amdgcn_mfma_f32_16x16x32_bf16(Wc[g][ks], Xa[m][ks], acc[g][m], 0, 0, 0); }
            const f32x4 sp = *(const LAS f32x4*)(SPL + c);
            float A[4][4], Bv[4][4];
#pragma unroll
            for (int m = 0; m < 4; ++m) { const f32x4 xr = *(const LAS f32x4*)(XR + (16 * m + fr) * 68 + cc);
#pragma unroll
                for (int e = 0; e < 4; ++e) { const float r = sigmoidf_(acc[0][m][e] + gbr[e]), ig = sigmoidf_(acc[1][m][e] + gbi[e]);
                    const float la = -8.0f * r * sp[e]; const float a = __builtin_amdgcn_exp2f(la * 1.4426950408889634f);
                    A[m][e] = a; Bv[m][e] = xr[e] * ig * __builtin_amdgcn_sqrtf(fmaxf(fmaf(-a, a, 1.0f), 0.f)); } }
#pragma unroll
            for (int m = 0; m < 4; ++m)
#pragma unroll
                for (int e = 0; e < 4; ++e) { float a = A[m][e], bb = Bv[m][e];
                    { const float ap = dpp_f<0x111>(1.0f, a), bp = dpp_f<0x111>(0.0f, bb); bb = fmaf(a, bp, bb); a *= ap; }
                    { const float ap = dpp_f<0x112>(1.0f, a), bp = dpp_f<0x112>(0.0f, bb); bb = fmaf(a, bp, bb); a *= ap; }
                    { const float ap = dpp_f<0x114>(1.0f, a), bp = dpp_f<0x114>(0.0f, bb); bb = fmaf(a, bp, bb); a *= ap; }
                    { const float ap = dpp_f<0x118>(1.0f, a), bp = dpp_f<0x118>(0.0f, bb); bb = fmaf(a, bp, bb); a *= ap; }
                    A[m][e] = a; Bv[m][e] = bb; }
            float hc[4], ac[4];
            if (FULL) { const f32x4 cv = *(const LAS f32x4*)(CARRY + c); hc[0] = cv[0]; hc[1] = cv[1]; hc[2] = cv[2]; hc[3] = cv[3]; }
            else { hc[0] = hc[1] = hc[2] = hc[3] = 0.f; }
            ac[0] = ac[1] = ac[2] = ac[3] = 1.f;
#pragma unroll
            for (int m = 0; m < 4; ++m) {
                float hcur[4];
#pragma unroll
                for (int e = 0; e < 4; ++e) { hcur[e] = fmaf(A[m][e], hc[e], Bv[m][e]); hc[e] = bcast15(hcur[e], lane);
                    if (!FULL) ac[e] = bcast15(A[m][e] * ac[e], lane); }
                if (FULL) { const v2u zg = zgc[m];
                    const float g4[4] = {bflo(zg.x), bfhi(zg.x), bflo(zg.y), bfhi(zg.y)};
                    f32x4 yq;
#pragma unroll
                    for (int e = 0; e < 4; ++e) { const float y = gelu_tanh(g4[e]) * hcur[e]; yq[e] = y; ss[m] = fmaf(y, y, ss[m]); }
                    *(LAS f32x4*)(XR + (16 * m + fr) * 68 + cc) = yq; }
            }
            if (!FULL && fr == 0) { const size_t o = ((size_t)b * NBLK + j) * 512 + c; *(f32x4*)(aggA + o) = (f32x4){ac[0], ac[1], ac[2], ac[3]}; *(f32x4*)(aggH + o) = (f32x4){hc[0], hc[1], hc[2], hc[3]}; }
        }
#undef LRU_PREFETCH
        if (FULL) {
#pragma unroll
            for (int m = 0; m < 4; ++m) { float s = ss[m]; s += __shfl_xor(s, 16); s += __shfl_xor(s, 32); if (fq == 0) SS[wave * 64 + 16 * m + fr] = s; }
            __syncthreads();
#pragma unroll
            for (int m = 0; m < 4; ++m) { float tot = 0.f;
#pragma unroll
                for (int w = 0; w < 8; ++w) tot += SS[w * 64 + 16 * m + fr];
                const float rstd = __builtin_amdgcn_rsqf(tot * (1.0f / 512.0f) + EPS);
#pragma unroll
                for (int n = 0; n < 4; ++n) { const int c = 512 + 64 * hd + 16 * n + 4 * fq; const f32x4 mg = *(const f32x4*)(mixg + c);
                    const f32x4 yq = *(const LAS f32x4*)(XR + (16 * m + fr) * 68 + 16 * n + 4 * fq);
                    v2u w; w.x = pk2(yq[0] * rstd * mg[0], yq[1] * rstd * mg[1]); w.y = pk2(yq[2] * rstd * mg[2], yq[3] * rstd * mg[3]);
                    *(v2u*)(Y + (rowb + t0 + 16 * m + fr) * D + c) = w; } }
        }
    } else if (FULL) {
        for (int i = tid; i < 64 * 64; i += NTHR) { const int r = i >> 6, c8 = (i & 63) * 8; *(v4u*)(Y + (rowb + t0 + r) * D + 512 + c8) = (v4u){0u, 0u, 0u, 0u}; }
    }
    if (!FULL) return;
    asm volatile("" ::: "memory");
    if (MIX_MASK & 1) {
        const int tg = tid >> 5, s8 = (tid & 31) * 8; const int tb = t0 + 4 * tg;
        const float* caw = args.in[7] + (size_t)l * 3 * 256;
        float w3[3][8];
#pragma unroll
        for (int k = 0; k < 3; ++k) { const f32x4 w0 = *(const f32x4*)(caw + k * 256 + s8), w1 = *(const f32x4*)(caw + k * 256 + s8 + 4);
#pragma unroll
            for (int e = 0; e < 4; ++e) { w3[k][e] = w0[e]; w3[k][4 + e] = w1[e]; } }
        float cv[6][8];
#pragma unroll
        for (int i = 0; i < 6; ++i) { const int tt = tb - 2 + i; const int tc = tt < 0 ? 0 : tt; const float msk = tt < 0 ? 0.f : 1.f;
            const v4u zc = *(const v4u*)(Z + (rowb + tc) * DIN + OFF_ZC + s8), zv = *(const v4u*)(Z + (rowb + tc) * DIN + OFF_ZV + s8);
            const unsigned a[4] = {zc.x, zc.y, zc.z, zc.w}, bq[4] = {zv.x, zv.y, zv.z, zv.w};
#pragma unroll
            for (int q = 0; q < 4; ++q) { cv[i][2 * q] = msk * bflo(a[q]) * bflo(bq[q]); cv[i][2 * q + 1] = msk * bfhi(a[q]) * bfhi(bq[q]); } }
        const f32x4 mg0 = *(const f32x4*)(mixg + s8), mg1 = *(const f32x4*)(mixg + s8 + 4);
#pragma unroll
        for (int i = 0; i < 4; ++i) {
            const v4u zb = *(const v4u*)(Z + (rowb + tb + i) * DIN + OFF_ZB + s8); const unsigned a[4] = {zb.x, zb.y, zb.z, zb.w};
            float y[8], s = 0.f;
#pragma unroll
            for (int e = 0; e < 8; ++e) { const float zbe = (e & 1) ? bfhi(a[e >> 1]) : bflo(a[e >> 1]);
                y[e] = zbe * (w3[0][e] * cv[i][e] + w3[1][e] * cv[i + 1][e] + w3[2][e] * cv[i + 2][e]); s = fmaf(y[e], y[e], s); }
#pragma unroll
            for (int o = 1; o < 32; o <<= 1) s += __shfl_xor(s, o);
            const float rstd = __builtin_amdgcn_rsqf(s * (1.0f / 256.0f) + EPS);
            v4u w; w.x = pk2(y[0] * rstd * mg0[0], y[1] * rstd * mg0[1]); w.y = pk2(y[2] * rstd * mg0[2], y[3] * rstd * mg0[3]);
            w.z = pk2(y[4] * rstd * mg1[0], y[5] * rstd * mg1[1]); w.w = pk2(y[6] * rstd * mg1[2], y[7] * rstd * mg1[3]);
            *(v4u*)(Y + (rowb + tb + i) * D + s8) = w; }
    } else {
        for (int i = tid; i < 64 * 32; i += NTHR) { const int r = i >> 5, c8 = (i & 31) * 8; *(v4u*)(Y + (rowb + t0 + r) * D + c8) = (v4u){0u, 0u, 0u, 0u}; }
    }
    asm volatile("" ::: "memory");
    if (MIX_MASK & 2) {
        __syncthreads();
        const int hf = j & 1, tcs = t0 - 64 * hf, slen = 64 * (hf + 1);
        LAS bf16* Vt = (LAS bf16*)lds;
        const float* lng = args.in[10] + (size_t)l * 256; const float* lnb = args.in[11] + (size_t)l * 256;
        {
            const int rr = lane >> 4, ci = lane & 15;
            float gq[16], bq[16];
#pragma unroll
            for (int q = 0; q < 4; ++q) { const f32x4 a = *(const f32x4*)(lng + 16 * ci + 4 * q), bb = *(const f32x4*)(lnb + 16 * ci + 4 * q);
#pragma unroll
                for (int e = 0; e < 4; ++e) { gq[4 * q + e] = a[e]; bq[4 * q + e] = bb[e]; } }
            v4u zz[4][2];
#pragma unroll
            for (int it = 0; it < 4; ++it) if (it * 32 < slen) { const int sr = 32 * it + 4 * wave + rr; const bf16* zp = Z + (rowb + tcs + sr) * DIN + OFF_ZSV + 16 * ci;
                zz[it][0] = *(const v4u*)(zp); zz[it][1] = *(const v4u*)(zp + 8); }
#pragma unroll
            for (int it = 0; it < 4; ++it) if (it * 32 < slen) { const int sr = 32 * it + 4 * wave + rr;
                float v[16]; float sm = 0.f;
#pragma unroll
                for (int hh = 0; hh < 2; ++hh) { const unsigned w4[4] = {zz[it][hh].x, zz[it][hh].y, zz[it][hh].z, zz[it][hh].w};
#pragma unroll
                    for (int q = 0; q < 4; ++q) { v[8 * hh + 2 * q] = gelu_tanh(bflo(w4[q])); v[8 * hh + 2 * q + 1] = gelu_tanh(bfhi(w4[q])); } }
#pragma unroll
                for (int e = 0; e < 16; ++e) sm += v[e];
                const float mean = sum16(sm) * (1.0f / 256.0f); float sq = 0.f;
#pragma unroll
                for (int e = 0; e < 16; ++e) { v[e] -= mean; sq = fmaf(v[e], v[e], sq); }
                const float rstd = __builtin_amdgcn_rsqf(sum16(sq) * (1.0f / 256.0f) + EPS);
#pragma unroll
                for (int e = 0; e < 16; ++e) Vt[(16 * ci + e) * 136 + sr] = (bf16)f2bf(v[e] * rstd * gq[e] + bq[e]);
            } }
        __syncthreads();
        const int h = wave >> 1, th = wave & 1;
        const bf16* SGW = (const bf16*)(ws + WS_SGW) + ((size_t)l * 4 + h) * 16384;
        f32x4 acc[2][4];
#pragma unroll
        for (int m = 0; m < 2; ++m)
#pragma unroll
            for (int n = 0; n < 4; ++n) acc[m][n] = (f32x4){0.f, 0.f, 0.f, 0.f};
#pragma unroll
        for (int ks = 0; ks < 4; ++ks) {
            if (ks * 32 < slen) {
                bf16x8 Wq[2];
#pragma unroll
                for (int m = 0; m < 2; ++m) Wq[m] = __builtin_bit_cast(bf16x8, *(const v4u*)(SGW + (size_t)(64 * hf + 32 * th + 16 * m + fr) * 128 + 32 * ks + 8 * fq));
#pragma unroll
                for (int n = 0; n < 4; ++n) { const bf16x8 Vp = *(const LAS bf16x8*)(Vt + (64 * h + 16 * n + fr) * 136 + 32 * ks + 8 * fq);
#pragma unroll
                    for (int m = 0; m < 2; ++m) acc[m][n] = __builtin_amdgcn_mfma_f32_16x16x32_bf16(Vp, Wq[m], acc[m][n], 0, 0, 0); }
            }
        }
        const float* sgb = args.in[9] + ((size_t)l * 4 + h) * 128;
        float ys[2][4][4], s2[2];
#pragma unroll
        for (int m = 0; m < 2; ++m) { const int tl = 32 * th + 16 * m + fr; const float bias = sgb[64 * hf + tl]; float s = 0.f;
#pragma unroll
            for (int n = 0; n < 4; ++n) { const v2u zu = *(const v2u*)(Z + (rowb + t0 + tl) * DIN + OFF_ZU + 64 * h + 16 * n + 4 * fq);
                const float u4[4] = {bflo(zu.x), bfhi(zu.x), bflo(zu.y), bfhi(zu.y)};
#pragma unroll
                for (int e = 0; e < 4; ++e) { const float y = gelu_tanh(u4[e]) * (acc[m][n][e] + bias); ys[m][n][e] = y; s = fmaf(y, y, s); } }
            s += __shfl_xor(s, 16); s += __shfl_xor(s, 32); s2[m] = s; if (fq == 0) SS2[h * 64 + tl] = s; }
        __syncthreads();
#pragma unroll
        for (int m = 0; m < 2; ++m) { const int tl = 32 * th + 16 * m + fr; const float tot = (SS2[tl] + SS2[64 + tl]) + (SS2[128 + tl] + SS2[192 + tl]);
            const float rstd = __builtin_amdgcn_rsqf(tot * (1.0f / 256.0f) + EPS);
#pragma unroll
            for (int n = 0; n < 4; ++n) { const int c = 256 + 64 * h + 16 * n + 4 * fq; const f32x4 mg = *(const f32x4*)(mixg + c);
                v2u w; w.x = pk2(ys[m][n][0] * rstd * mg[0], ys[m][n][1] * rstd * mg[1]); w.y = pk2(ys[m][n][2] * rstd * mg[2], ys[m][n][3] * rstd * mg[3]);
                *(v2u*)(Y + (rowb + t0 + tl) * D + c) = w; } }
        (void)s2;
    } else {
        for (int i = tid; i < 64 * 32; i += NTHR) { const int r = i >> 5, c8 = (i & 31) * 8; *(v4u*)(Y + (rowb + t0 + r) * D + 256 + c8) = (v4u){0u, 0u, 0u, 0u}; }
    }
}

template <bool XBF> __device__ __forceinline__ void route_tile(const Args& args, int l, int tile, const void* X1, LAS unsigned char* lds) {
    FRESH_TID();
    unsigned char* ws = args.ws;
    LAS float* GS = (LAS float*)lds; LAS float* SH = (LAS float*)(lds + 4096); LAS float* SHW = (LAS float*)(lds + 8192); LAS float* RED = (LAS float*)(lds + 8448);
    LAS float* PL = (LAS float*)(lds + 16384); LAS float* PSS = (LAS float*)(lds + 32768); LAS float* RSTD = (LAS float*)(lds + 33280); LAS int* HIST = (LAS int*)(lds + 33792);
    const int row0 = tile * 64, b = row0 >> 12; const int fr = lane & 15, fq = lane >> 4;
    const float* mod = (const float*)(ws + WS_MOD) + (size_t)(l * NB + b) * 6144;
    const float* g2 = args.in[3] + (size_t)l * D;
    for (int k = tid; k < D; k += NTHR) { GS[k] = g2[k] * (1.0f + mod[4 * D + k]); SH[k] = mod[3 * D + k]; }
    if (tid < 32) HIST[tid] = 0;
    __syncthreads();
    if (tid < 32) SHW[tid] = ((const float*)(ws + WS_SHW))[(l * NB + b) * NE + tid];
    const int st = wave >> 1, kh = wave & 1;
    const bf16* RWH = (const bf16*)(ws + WS_RWH) + (size_t)l * NE * D; const bf16* RWL = (const bf16*)(ws + WS_RWL) + (size_t)l * NE * D;
    f32x4 acc[2] = {(f32x4){0.f, 0.f, 0.f, 0.f}, (f32x4){0.f, 0.f, 0.f, 0.f}}; float ssq = 0.f;
    const size_t xrow = (size_t)(row0 + 16 * st + fr) * D;
#pragma unroll 8
    for (int kb = 0; kb < 16; ++kb) {
        const int k = 512 * kh + 32 * kb + 8 * fq;
        float xv[8]; ld8<XBF>(X1, xrow + k, xv);
        const f32x4 g0 = *(const LAS f32x4*)(GS + k), g1 = *(const LAS f32x4*)(GS + k + 4);
        float xs[8], hi[8], lo[8];
#pragma unroll
        for (int e = 0; e < 4; ++e) { xs[e] = xv[e] * g0[e]; xs[4 + e] = xv[4 + e] * g1[e]; ssq = fmaf(xv[e], xv[e], ssq); ssq = fmaf(xv[4 + e], xv[4 + e], ssq); }
        v4u qh, ql; unsigned hh[8], ll[8];
#pragma unroll
        for (int e = 0; e < 8; ++e) { hh[e] = f2bf(xs[e]); hi[e] = __builtin_bit_cast(float, hh[e] << 16); lo[e] = xs[e] - hi[e]; ll[e] = f2bf(lo[e]); }
        qh.x = hh[0] | (hh[1] << 16); qh.y = hh[2] | (hh[3] << 16); qh.z = hh[4] | (hh[5] << 16); qh.w = hh[6] | (hh[7] << 16);
        ql.x = ll[0] | (ll[1] << 16); ql.y = ll[2] | (ll[3] << 16); ql.z = ll[4] | (ll[5] << 16); ql.w = ll[6] | (ll[7] << 16);
        const bf16x8 Qh = __builtin_bit_cast(bf16x8, qh), Ql = __builtin_bit_cast(bf16x8, ql);
#pragma unroll
        for (int n = 0; n < 2; ++n) { const bf16x8 Ph = __builtin_bit_cast(bf16x8, *(const v4u*)(RWH + (size_t)(16 * n + fr) * D + k)), Pl = __builtin_bit_cast(bf16x8, *(const v4u*)(RWL + (size_t)(16 * n + fr) * D + k));
            acc[n] = __builtin_amdgcn_mfma_f32_16x16x32_bf16(Ph, Qh, acc[n], 0, 0, 0);
            acc[n] = __builtin_amdgcn_mfma_f32_16x16x32_bf16(Ph, Ql, acc[n], 0, 0, 0);
            acc[n] = __builtin_amdgcn_mfma_f32_16x16x32_bf16(Pl, Qh, acc[n], 0, 0, 0); }
    }
    ssq += __shfl_xor(ssq, 16); ssq += __shfl_xor(ssq, 32);
#pragma unroll
    for (int n = 0; n < 2; ++n) *(LAS f32x4*)(PL + (wave * 16 + fr) * 32 + 16 * n + 4 * fq) = acc[n];
    if (fq == 0) PSS[wave * 16 + fr] = ssq;
    __syncthreads();
    if (kh == 0) {
        const float tot = PSS[wave * 16 + fr] + PSS[(wave + 1) * 16 + fr]; const float rstd = __builtin_amdgcn_rsqf(tot * (1.0f / D) + EPS);
        if (fq == 0) RSTD[16 * st + fr] = rstd;
        float v[8]; int taken = 0;
#pragma unroll
        for (int n = 0; n < 2; ++n) { const f32x4 o = *(const LAS f32x4*)(PL + ((wave + 1) * 16 + fr) * 32 + 16 * n + 4 * fq); const f32x4 sw = *(const LAS f32x4*)(SHW + 16 * n + 4 * fq);
#pragma unroll
            for (int e = 0; e < 4; ++e) v[4 * n + e] = rstd * (acc[n][e] + o[e]) + sw[e]; }
        float selv[4]; int seli[4];
#pragma unroll
        for (int r = 0; r < 4; ++r) {
            float bv = -3.0e38f; int bi = 1 << 20;
#pragma unroll
            for (int q = 0; q < 8; ++q) { const int idx = 16 * (q >> 2) + 4 * fq + (q & 3); const bool ok = !((taken >> q) & 1) && (v[q] > bv); bv = ok ? v[q] : bv; bi = ok ? idx : bi; }
#pragma unroll
            for (int msk = 16; msk <= 32; msk <<= 1) { const float ov = __shfl_xor(bv, msk); const int oi = __shfl_xor(bi, msk); const bool tk = (ov > bv) || (ov == bv && oi < bi); bv = tk ? ov : bv; bi = tk ? oi : bi; }
            selv[r] = bv; seli[r] = bi;
            if (((bi >> 2) & 3) == fq) taken |= 1 << (4 * (bi >> 4) + (bi & 3));
        }
        const float e1 = __expf(selv[1] - selv[0]), e2 = __expf(selv[2] - selv[0]), e3 = __expf(selv[3] - selv[0]); const float inv = 1.0f / (1.0f + e1 + e2 + e3);
        const float wk = (fq == 0 ? 1.0f : fq == 1 ? e1 : fq == 2 ? e2 : e3) * inv; const int ek = fq == 0 ? seli[0] : fq == 1 ? seli[1] : fq == 2 ? seli[2] : seli[3];
        const int rank = __hip_atomic_fetch_add(HIST + ek, 1, __ATOMIC_RELAXED, __HIP_MEMORY_SCOPE_WORKGROUP);
        const size_t ai = (size_t)(row0 + 16 * st + fr) * 4 + fq;
        ((int*)(ws + WS_TOPE))[ai] = ek; ((float*)(ws + WS_TOPW))[ai] = wk; ((int*)(ws + WS_RANK))[ai] = rank;
    }
    __syncthreads();
    unsigned char* H8 = (unsigned char*)(ws + WS_H);
#pragma unroll
    for (int r0 = wave * 8; r0 < wave * 8 + 8; r0 += 4) {
        f32x4 xq[4][4];
#pragma unroll
        for (int i = 0; i < 4; ++i)
#pragma unroll
            for (int jj = 0; jj < 4; ++jj) xq[i][jj] = ld4<XBF>(X1, (size_t)(row0 + r0 + i) * D + 4 * lane + 256 * jj);
#pragma unroll
        for (int i = 0; i < 4; ++i) { const float rstd = RSTD[r0 + i] * H_SCALE;
#pragma unroll
            for (int jj = 0; jj < 4; ++jj) { const int c = 4 * lane + 256 * jj; const f32x4 gs = *(const LAS f32x4*)(GS + c), sh = *(const LAS f32x4*)(SH + c);
                const f32x4 o = xq[i][jj] * rstd * gs + sh * H_SCALE;
                *(unsigned*)(H8 + (size_t)(row0 + r0 + i) * D + c) = pg8::pk4_i8(o[0], o[1], o[2], o[3]); } } }
    if (tid < 32) ((int*)(ws + WS_CNT))[tile * 32 + tid] = HIST[tid];
    __syncthreads();
}

__device__ __forceinline__ void gather_phase(const Args& args, LAS unsigned char* lds, int vcu, int G) {
    FRESH_TID();
    unsigned char* ws = args.ws;
    LAS int* PART = (LAS int*)lds; LAS int* SEGS = (LAS int*)(lds + 2048); LAS int* BASE = (LAS int*)(lds + 2304); LAS int* SL = (LAS int*)(lds + 2560); LAS int* WK = (LAS int*)(lds + 4096);
    LAS int* TILEE = (LAS int*)(lds + L_TILEE); LAS int* NMp = (LAS int*)(lds + L_NM);
    const int* CNT = (const int*)(ws + WS_CNT);
    { const int e = tid & 31, q = tid >> 5; int s = 0;
#pragma unroll
        for (int t = 0; t < 16; ++t) s += CNT[(16 * q + t) * 32 + e];
        PART[q * 32 + e] = s; }
    __syncthreads();
    if (tid < 64) {
        int tot = 0;
        if (tid < 32) {
#pragma unroll
            for (int q = 0; q < 16; ++q) tot += PART[q * 32 + tid]; }
        const int nt = (tot + 255) >> 8; int inc = nt;
#pragma unroll
        for (int o = 1; o < 32; o <<= 1) { const int t = __shfl_up(inc, o); if (lane >= o) inc += t; }
        const int run = inc - nt;
        if (tid < 32) { SEGS[tid] = run * 256; for (int t = 0; t < nt; ++t) TILEE[run + t] = tid; }
        if (tid == 31) NMp[0] = inc;
    }
    __syncthreads();
    const unsigned char* H8 = (const unsigned char*)(ws + WS_H); unsigned char* XG = (unsigned char*)(ws + WS_XG);
    for (int tile = vcu; tile < NRT; tile += G) {
        { const int qt = tile >> 4, e = tid & 31, tq = tid >> 5, tt = 16 * qt + tq;
            WK[tq * 32 + e] = tt < tile ? CNT[tt * 32 + e] : 0; }
        __syncthreads();
        if (tid < 32) { const int qt = tile >> 4; int s = SEGS[tid];
            for (int q = 0; q < qt; ++q) s += PART[q * 32 + tid];
#pragma unroll
            for (int t = 0; t < 16; ++t) s += WK[t * 32 + tid];
            BASE[tid] = s; }
        __syncthreads();
        if (tid < 256) { const size_t ai = (size_t)tile * 256 + tid; const int e = ((const int*)(ws + WS_TOPE))[ai]; const int slot = BASE[e] + ((const int*)(ws + WS_RANK))[ai];
            ((int*)(ws + WS_SLOT))[ai] = slot; SL[tid] = slot; }
        __syncthreads();
        { v4u xr[8];
#pragma unroll
            for (int i = 0; i < 8; ++i) xr[i] = ((const v4u*)(H8 + (size_t)(tile * 64 + wave * 8 + i) * D))[lane];
#pragma unroll
            for (int i = 0; i < 8; ++i)
#pragma unroll
                for (int k = 0; k < 4; ++k) ((v4u*)(XG + (size_t)SL[wave * 32 + 4 * i + k] * D))[lane] = xr[i]; }
        __syncthreads();
    }
}

template <bool MOE, bool LAST, bool XBF>
__device__ __forceinline__ void combine_rows(const Args& args, int l, const void* X1, bf16* XN, int vcu, int G) {
    FRESH_TID(); const int gw = vcu * NWAVES + wave, NGW = G * NWAVES;
    unsigned char* ws = args.ws;
    const unsigned char* YE = (const unsigned char*)(ws + WS_XG); unsigned char* H = (unsigned char*)(ws + WS_H);
    int rpw = 1; while (rpw * NGW < T) rpw <<= 1;
    const int rbeg = gw * rpw, rend = (rbeg + rpw < T) ? rbeg + rpw : T;
    if (rbeg >= T) return;
    const int b = rbeg >> 12;
    const float* modl = (const float*)(ws + WS_MOD) + (size_t)(l * NB + b) * 6144;
    f32x4 gt[4], pa[4], pb[4];
#pragma unroll
    for (int q = 0; q < 4; ++q) { const int c = 8 * lane + 512 * (q >> 1) + 4 * (q & 1);
        gt[q] = MOE ? *(const f32x4*)(modl + 5 * D + c) : (f32x4){0.f, 0.f, 0.f, 0.f};
        if (LAST) { pa[q] = *(const f32x4*)(args.in[25] + c); pb[q] = (f32x4){0.f, 0.f, 0.f, 0.f}; }
        else { const float* modn = (const float*)(ws + WS_MOD) + (size_t)((l + 1) * NB + b) * 6144; const f32x4 g = *(const f32x4*)(args.in[2] + (size_t)(l + 1) * D + c), sc = *(const f32x4*)(modn + D + c);
            pa[q] = g * (sc + 1.0f); pb[q] = *(const f32x4*)(modn + c); } }
    int myslot = 0; float myw = 0.f;
    if (MOE && rpw * 4 <= 64 && lane < (rend - rbeg) * 4) { myslot = ((const int*)(ws + WS_SLOT))[(size_t)rbeg * 4 + lane]; myw = ((const float*)(ws + WS_TOPW))[(size_t)rbeg * 4 + lane]; }
#pragma unroll 2
    for (int row = rbeg; row < rend; ++row) {
        f32x4 v[4];
        { float t0[8], t1[8]; ld8<XBF>(X1, (size_t)row * D + 8 * lane, t0); ld8<XBF>(X1, (size_t)row * D + 512 + 8 * lane, t1);
            v[0] = (f32x4){t0[0], t0[1], t0[2], t0[3]}; v[1] = (f32x4){t0[4], t0[5], t0[6], t0[7]}; v[2] = (f32x4){t1[0], t1[1], t1[2], t1[3]}; v[3] = (f32x4){t1[4], t1[5], t1[6], t1[7]}; }
        if (MOE) {
            f32x4 a[4] = {(f32x4){0.f, 0.f, 0.f, 0.f}, (f32x4){0.f, 0.f, 0.f, 0.f}, (f32x4){0.f, 0.f, 0.f, 0.f}, (f32x4){0.f, 0.f, 0.f, 0.f}};
            v2u y[4][2]; float w[4];
#pragma unroll
            for (int k = 0; k < 4; ++k) { int slot;
                if (rpw * 4 <= 64) { slot = __builtin_amdgcn_readlane(myslot, (row - rbeg) * 4 + k); w[k] = __builtin_bit_cast(float, __builtin_amdgcn_readlane(__builtin_bit_cast(int, myw), (row - rbeg) * 4 + k)); }
                else { slot = ((const int*)(ws + WS_SLOT))[(size_t)row * 4 + k]; w[k] = ((const float*)(ws + WS_TOPW))[(size_t)row * 4 + k]; }
                slot = __builtin_amdgcn_readfirstlane(slot); w[k] *= (1.0f / YE_SCALE);
                const unsigned char* yr = YE + (size_t)slot * D + 8 * lane; y[k][0] = *(const v2u*)(yr); y[k][1] = *(const v2u*)(yr + 512); }
#pragma unroll
            for (int k = 0; k < 4; ++k)
#pragma unroll
                for (int hh = 0; hh < 2; ++hh) { const v2u t = y[k][hh];
                    a[2 * hh] += w[k] * (f32x4){i8f(t.x, 0), i8f(t.x, 1), i8f(t.x, 2), i8f(t.x, 3)}; a[2 * hh + 1] += w[k] * (f32x4){i8f(t.y, 0), i8f(t.y, 1), i8f(t.y, 2), i8f(t.y, 3)}; }
#pragma unroll
            for (int q = 0; q < 4; ++q) v[q] += gt[q] * a[q];
        }
        float s = 0.f;
#pragma unroll
        for (int q = 0; q < 4; ++q) s += (v[q][0] * v[q][0] + v[q][1] * v[q][1]) + (v[q][2] * v[q][2] + v[q][3] * v[q][3]);
        const float rstd = __builtin_amdgcn_rsqf(wave_sum(s) * (1.0f / D) + EPS);
        if (LAST) {
#pragma unroll
            for (int q = 0; q < 4; ++q) *(f32x4*)(args.out + (size_t)row * D + 8 * lane + 512 * (q >> 1) + 4 * (q & 1)) = v[q] * rstd * pa[q];
        } else {
#pragma unroll
            for (int hh = 0; hh < 2; ++hh) { v4u wv; wv.x = pk2(v[2 * hh][0], v[2 * hh][1]); wv.y = pk2(v[2 * hh][2], v[2 * hh][3]); wv.z = pk2(v[2 * hh + 1][0], v[2 * hh + 1][1]); wv.w = pk2(v[2 * hh + 1][2], v[2 * hh + 1][3]);
                *(v4u*)(XN + (size_t)row * D + 8 * lane + 512 * hh) = wv; }
#pragma unroll
            for (int hh = 0; hh < 2; ++hh) { const f32x4 o0 = (v[2 * hh] * rstd * pa[2 * hh] + pb[2 * hh]) * HIN_SCALE, o1 = (v[2 * hh + 1] * rstd * pa[2 * hh + 1] + pb[2 * hh + 1]) * HIN_SCALE;
                *(v2u*)(H + (size_t)row * D + 8 * lane + 512 * hh) = (v2u){pg8::pk4_i8(o0[0], o0[1], o0[2], o0[3]), pg8::pk4_i8(o1[0], o1[1], o1[2], o1[3])}; }
        }
    }
}

template <int L> __device__ __forceinline__ void layer_body(const Args& args, LAS unsigned char* lds, const XcdBarrier& bar, int vcu, int G, const void* xin, bf16* xnext) {
    unsigned char* ws = args.ws;
    constexpr bool MIX = (RUN_MASK >> (2 * L)) & 1, MOE = (RUN_MASK >> (2 * L + 1)) & 1, LAST = (L == DEPTH - 1);
    const float* modl = (const float*)(ws + WS_MOD) + (size_t)L * NB * 6144;
    constexpr bool XIN_BF = (L > 0), X1_BF = MIX ? true : XIN_BF;
    bf16* XA = (bf16*)(ws + WS_XA);
    const void* x1 = xin;
    if (MIX) {
        if (PH(2)) { asm volatile("; PHASE_MARK P2" ::: "memory");
            _Pragma("unroll 1") for (int rep = 0; rep < NREP(2); ++rep) {
            pg8::Gemm g{(const bf16*)(ws + WS_H), (const bf16*)(ws + WS_WIN + (size_t)L * DIN * D), D}; pg8::StaticOrder S; S.init(T / 256, DIN / 256, G, (int)blockIdx.x);
            pg8::EpiBf16 E{(bf16*)(ws + WS_Z), DIN, nullptr, 0, 1.0f / (HIN_SCALE * W_SCALE)};
            pg8::gemm_phase<pg8::EpiBf16, pg8::StaticOrder, true>(lds, g, S, E);
            xcd_barrier(bar); }
        }
        if (PH(3) & ((MIX_MASK >> 2) & 1)) { asm volatile("; PHASE_MARK P3a" ::: "memory");
            _Pragma("unroll 1") for (int rep = 0; rep < NREP(3); ++rep) {
            for (int u = vcu; u < NB * NBLK; u += G) { mixer_unit<false>(args, L, u >> 6, u & 63, lds); __syncthreads(); }
            xcd_barrier(bar); }
        }
        if (PH(4)) { asm volatile("; PHASE_MARK P3b" ::: "memory");
            _Pragma("unroll 1") for (int rep = 0; rep < NREP(4); ++rep) {
            for (int u = vcu; u < NB * NBLK; u += G) { mixer_unit<true>(args, L, u >> 6, u & 63, lds); __syncthreads(); }
            xcd_barrier(bar); }
        }
        if (PH(5)) { asm volatile("; PHASE_MARK P4" ::: "memory");
            _Pragma("unroll 1") for (int rep = 0; rep < NREP(5); ++rep) {
            pg8::Gemm g{(const bf16*)(ws + WS_Y), (const bf16*)(ws + WS_WOUT) + (size_t)L * D * D, D}; pg8::StaticOrder S; S.init(T / 256, D / 256, G, (int)blockIdx.x);
            pg8::EpiResGate<XIN_BF> E{xin, XA, modl + 2 * D};
            pg8::gemm_phase<pg8::EpiResGate<XIN_BF>, pg8::StaticOrder>(lds, g, S, E);
            xcd_barrier(bar); }
        }
        x1 = XA;
    }
    if (MOE) {
        if (PH(6)) { asm volatile("; PHASE_MARK P5" ::: "memory");
            _Pragma("unroll 1") for (int rep = 0; rep < NREP(6); ++rep) {
            for (int tile = vcu; tile < NRT; tile += G) route_tile<X1_BF>(args, L, tile, x1, lds);
            xcd_barrier(bar); }
        }
        if (PH(7)) { asm volatile("; PHASE_MARK P6" ::: "memory");
            _Pragma("unroll 1") for (int rep = 0; rep < NREP(7); ++rep) {
            gather_phase(args, lds, vcu, G);
            xcd_barrier(bar); }
        }
        const int nM = *(const LAS int*)(lds + L_NM);
        if (PH(8)) { asm volatile("; PHASE_MARK P7" ::: "memory");
            _Pragma("unroll 1") for (int rep = 0; rep < NREP(8); ++rep) {
            pg8::Gemm g{(const bf16*)(ws + WS_XG), (const bf16*)(ws + WS_W1 + (size_t)L * NE * 2048 * D), D}; pg8::MoeOrder S; S.init(nM, 8, G, (int)blockIdx.x); S.tile_e = (const LAS int*)(lds + L_TILEE);
            pg8::EpiSwiglu E{(unsigned char*)(ws + WS_ACT), args.in[22] + (size_t)L * NE * 2048, 1.0f / (H_SCALE * W_SCALE), ACT_SCALE};
            pg8::gemm_phase<pg8::EpiSwiglu, pg8::MoeOrder, true>(lds, g, S, E);
            xcd_barrier(bar); }
        }
        if (PH(9)) { asm volatile("; PHASE_MARK P8" ::: "memory");
            _Pragma("unroll 1") for (int rep = 0; rep < NREP(9); ++rep) {
            pg8::Gemm g{(const bf16*)(ws + WS_ACT), (const bf16*)(ws + WS_W2 + (size_t)L * NE * D * FF), FF}; pg8::MoeOrder S; S.init(nM, 4, G, (int)blockIdx.x); S.tile_e = (const LAS int*)(lds + L_TILEE);
            pg8::EpiI8 E{(unsigned char*)(ws + WS_XG), D, args.in[24] + (size_t)L * NE * D, D, 1.0f / (ACT_SCALE * W_SCALE), YE_SCALE};
            pg8::gemm_phase<pg8::EpiI8, pg8::MoeOrder, true>(lds, g, S, E);
            xcd_barrier(bar); }
        }
    }
    asm volatile("; PHASE_MARK P9" ::: "memory");
    if (PH(10)) { _Pragma("unroll 1") for (int rep = 0; rep < NREP(10); ++rep) { combine_rows<MOE, LAST, X1_BF>(args, L, x1, xnext, vcu, G); if (!LAST) xcd_barrier(bar); } }
}

__global__ void __launch_bounds__(NTHR, 2) fwd_kernel(Args args) {
    extern __shared__ __attribute__((aligned(16))) unsigned char lds_raw[];
    LAS unsigned char* lds = (LAS unsigned char*)lds_raw;
    const int tid = threadIdx.x;
    const int G = gridDim.x; const int bx = blockIdx.x; const int vcu = (G % 8 == 0) ? (bx % 8) * (G / 8) + bx / 8 : bx;
    unsigned char* ws = args.ws;
    for (int u = tid; u < (LDS_BYTES - LDSCTL_OFF) / 4; u += NTHR) ((LAS unsigned*)(lds + LDSCTL_OFF))[u] = 0u;
    __syncthreads();
    XcdBarrier bar = xcd_barrier_post((unsigned*)(ws + WS_CTL) + CW_BAR, (volatile LAS unsigned*)(lds + L_MISC) + 8);
    asm volatile("; PHASE_MARK P0" ::: "memory");
    _Pragma("unroll 1") for (int rep = 0; rep < NREP(0); ++rep) { if (PH(0)) pro_phase(args, lds, vcu, G); xcd_barrier(bar); }
    { shw_phase(args, lds, vcu, G); if (PH(1) & (RUN_MASK & 1)) { const float* mod0 = (const float*)(ws + WS_MOD); adaln_rows(args.in[0], (unsigned char*)(ws + WS_H), args.in[2], mod0, mod0 + D, vcu, G); } xcd_barrier(bar); }
    layer_body<0>(args, lds, bar, vcu, G, args.in[0], (bf16*)(ws + WS_XB));
    layer_body<1>(args, lds, bar, vcu, G, (const void*)(ws + WS_XB), nullptr);
}

extern "C" void kernel_launch(void* const* d_in, const int* in_sizes, int n_in, void* d_out, int out_size, void* d_ws, size_t ws_size, hipStream_t stream) {
    static int grid = 0;
    if (grid == 0) {
        if (n_in != 26 || in_sizes[0] != T * D || out_size != T * D || ws_size < WS_END) { fprintf(stderr, "kernel_launch: unexpected shapes (n_in %d, in0 %d, out %d, ws %zu < %zu); nothing launched\n", n_in, n_in > 0 ? in_sizes[0] : -1, out_size, ws_size, (size_t)WS_END); grid = -1; return; }
        int dev = 0, cus = 0, per_cu = 0;
        if (hipGetDevice(&dev) != hipSuccess || hipDeviceGetAttribute(&cus, hipDeviceAttributeMultiprocessorCount, dev) != hipSuccess) { grid = -1; return; }
        if (hipFuncSetAttribute((const void*)fwd_kernel, hipFuncAttributeMaxDynamicSharedMemorySize, LDS_BYTES) != hipSuccess) { fprintf(stderr, "kernel_launch: hipFuncSetAttribute failed\n"); grid = -1; return; }
        if (hipOccupancyMaxActiveBlocksPerMultiprocessor(&per_cu, (const void*)fwd_kernel, NTHR, LDS_BYTES) != hipSuccess || per_cu < 1) { fprintf(stderr, "kernel_launch: occupancy query says %d blocks per CU\n", per_cu); }
        (void)hipGetLastError();
        grid = cus;
    }
    if (grid < 0) return;
    if (hipMemsetAsync((char*)d_ws + WS_CTL, 0, CTL_ZERO_BYTES, stream) != hipSuccess) return;
    Args a{};
    for (int i = 0; i < 26; ++i) a.in[i] = (const float*)d_in[i];
    a.out = (float*)d_out; a.ws = (unsigned char*)d_ws; a.ph_lo = 0; a.ph_hi = 0;
    hipLaunchKernelGGL(fwd_kernel, dim3(grid), dim3(NTHR), LDS_BYTES, stream, a);
}
```

```cpp
#include <hip/hip_runtime.h>
#include <cstdio>
#include <cstdint>

#ifndef RUN_MASK
#define RUN_MASK 15
#endif
#ifndef PH_ENABLE
#define PH_ENABLE 0x7ff
#endif
#define PH(k) ((PH_ENABLE >> (k)) & 1)
#ifndef DUP_MASK
#define DUP_MASK 0
#endif
#define NREP(k) (1 + ((DUP_MASK >> (k)) & 1))
#ifndef MIX_MASK
#define MIX_MASK 7
#endif

namespace pg8 {
#define PG8_LAS __attribute__((address_space(3)))
typedef unsigned short bf16_t;
typedef short bf16x8 __attribute__((ext_vector_type(8)));
typedef float f32x4 __attribute__((ext_vector_type(4)));
typedef unsigned u32x4 __attribute__((ext_vector_type(4)));
typedef int i32x4 __attribute__((ext_vector_type(4)));
typedef int i32x8 __attribute__((ext_vector_type(8)));
constexpr int BM = 256, BK = 64, HALF = 128, HTB = HALF * BK * 2, STAGE_BYTES = 8 * HTB, NXCD = 8, WGM = 8;

__host__ __device__ __forceinline__ int lds_byte(int r, int c) { const int st = (r >> 4) * 2 + (c >> 5), rr = r & 15, cc = c & 31, ob = rr * 64 + cc * 2; return st * 1024 + (ob ^ (((ob >> 9) & 1) << 5)); }
__host__ __device__ __forceinline__ void stage_rc(int b, int& R, int& C) { const int st = b / 1024, sb = b % 1024, swz = sb ^ (((sb >> 9) & 1) << 5); R = (st >> 1) * 16 + swz / 64; C = (st & 1) * 32 + (swz % 64) / 2; }
__host__ __device__ __forceinline__ int perm32(int rho) { const int n = rho >> 4, i = rho & 15; return 8 * (i >> 2) + 4 * n + (i & 3); }

struct Unit { int pm, pn, pb, e; };
struct Gemm { const bf16_t* A; const bf16_t* Bt; int K; };

struct StaticOrder {
    int nM, nN, nwg, G, c;
    __device__ void init(int nM_, int nN_, int G_, int c_) { nM = nM_; nN = nN_; nwg = nM * nN; G = G_; c = c_; }
    __device__ __forceinline__ bool map(int i, Unit& u) const {
        const long L = (long)i * G + c; if (L >= nwg) return false;
        int wgid = (int)L; { const int q = nwg / NXCD, r = nwg % NXCD, xcd = wgid % NXCD, off = wgid / NXCD; wgid = (xcd < r ? xcd * (q + 1) : r * (q + 1) + (xcd - r) * q) + off; }
        const int nig = WGM * nN, gid = wgid / nig, fm = gid * WGM, gsz = (nM - fm) < WGM ? (nM - fm) : WGM;
        u.pm = fm + ((wgid % nig) % gsz); u.pn = (wgid % nig) / gsz; return true;
    }
    __device__ __forceinline__ bool next(int i, Unit& u) const { if (!map(i, u)) return false; u.pb = u.pn; u.e = 0; return true; }
};
struct MoeOrder : StaticOrder {
    const PG8_LAS int* tile_e; const PG8_LAS int* tile_pm;
    __device__ __forceinline__ bool next(int i, Unit& u) const { if (!map(i, u)) return false; const int t = u.pm; u.e = tile_e[t]; u.pm = tile_pm[t]; u.pb = u.e * nN + u.pn; return true; }
};

__device__ __forceinline__ unsigned cvt_pk_bf16(float lo, float hi) { unsigned r; asm volatile("v_cvt_pk_bf16_f32 %0, %1, %2" : "=v"(r) : "v"(lo), "v"(hi)); return r; }

__device__ __forceinline__ unsigned q_i8(float x) { const float y = __builtin_amdgcn_fmed3f(x, -127.0f, 127.0f) + 12582912.0f; return __builtin_bit_cast(unsigned, y); }
__device__ __forceinline__ unsigned pk4_i8(float a, float b, float c, float d) { return __builtin_amdgcn_perm(q_i8(b), q_i8(a), 0x0c0c0400u) | __builtin_amdgcn_perm(q_i8(d), q_i8(c), 0x04000c0cu); }
struct EpiBf16 {
    static constexpr bool PERM = true;
    bf16_t* O; int ldc; const float* bias; int bstride; float sc;
    template <class AT> __device__ __forceinline__ void operator()(const AT (&acc)[2][2][4][2], const Unit& u, int wr, int wc, int fr, int fq) const {
        const int row0 = u.pm * BM + wr * 64 + fr; const int col0 = u.pn * BM + wc * 32 + 8 * fq;
        f32x4 bv[2][2];
#pragma unroll
        for (int bj = 0; bj < 2; ++bj)
#pragma unroll
            for (int n = 0; n < 2; ++n) bv[bj][n] = bias ? *(const f32x4*)(bias + (size_t)u.e * bstride + col0 + bj * HALF + 4 * n) : (f32x4){0.f, 0.f, 0.f, 0.f};
#pragma unroll
        for (int ai = 0; ai < 2; ++ai)
#pragma unroll
            for (int m = 0; m < 4; ++m) { bf16_t* rowp = O + (size_t)(row0 + ai * HALF + m * 16) * ldc + col0;
#pragma unroll
                for (int bj = 0; bj < 2; ++bj) { const f32x4 v0 = __builtin_convertvector(acc[ai][bj][m][0], f32x4) * sc + bv[bj][0], v1 = __builtin_convertvector(acc[ai][bj][m][1], f32x4) * sc + bv[bj][1];
                    u32x4 w; w.x = cvt_pk_bf16(v0[0], v0[1]); w.y = cvt_pk_bf16(v0[2], v0[3]); w.z = cvt_pk_bf16(v1[0], v1[1]); w.w = cvt_pk_bf16(v1[2], v1[3]);
                    *(u32x4*)(rowp + bj * HALF) = w; } }
    }
};
struct EpiI8 {
    static constexpr bool PERM = true;
    unsigned char* O; int ldc; const float* bias; int bstride; float sc, osc;
    template <class AT> __device__ __forceinline__ void operator()(const AT (&acc)[2][2][4][2], const Unit& u, int wr, int wc, int fr, int fq) const {
        const int row0 = u.pm * BM + wr * 64 + fr; const int col0 = u.pn * BM + wc * 32 + 8 * fq;
        f32x4 bv[2][2]; const f32x4 s4 = {sc * osc, sc * osc, sc * osc, sc * osc};
#pragma unroll
        for (int bj = 0; bj < 2; ++bj)
#pragma unroll
            for (int n = 0; n < 2; ++n) bv[bj][n] = *(const f32x4*)(bias + (size_t)u.e * bstride + col0 + bj * HALF + 4 * n) * osc;
#pragma unroll
        for (int ai = 0; ai < 2; ++ai)
#pragma unroll
            for (int m = 0; m < 4; ++m) { unsigned char* rowp = O + (size_t)(row0 + ai * HALF + m * 16) * ldc + col0;
#pragma unroll
                for (int bj = 0; bj < 2; ++bj) { const f32x4 v0 = __builtin_elementwise_fma(__builtin_convertvector(acc[ai][bj][m][0], f32x4), s4, bv[bj][0]), v1 = __builtin_elementwise_fma(__builtin_convertvector(acc[ai][bj][m][1], f32x4), s4, bv[bj][1]);
                    typedef unsigned u32x2 __attribute__((ext_vector_type(2)));
                    *(u32x2*)(rowp + bj * HALF) = (u32x2){pk4_i8(v0[0], v0[1], v0[2], v0[3]), pk4_i8(v1[0], v1[1], v1[2], v1[3])}; } }
    }
};
typedef float f32x2 __attribute__((ext_vector_type(2)));
__device__ __forceinline__ unsigned pack4_lowbytes(unsigned w0, unsigned w1, unsigned w2, unsigned w3) {
    return __builtin_amdgcn_perm(w1, w0, 0x0c0c0400u) | __builtin_amdgcn_perm(w3, w2, 0x04000c0cu); }
struct EpiSwiglu {
    static constexpr bool PERM = true;
    unsigned char* O; const float* b1; float sc, osc;
    template <class AT> __device__ __forceinline__ void operator()(const AT (&acc)[2][2][4][2], const Unit& u, int wr, int wc, int fr, int fq) const {
        const int row0 = u.pm * BM + wr * 64 + fr; const int cg = u.pn * HALF + wc * 32 + 8 * fq;
        const float* bg = b1 + (size_t)u.e * 2048 + cg;
        f32x4 bgv[2], buv[2]; bgv[0] = *(const f32x4*)(bg); bgv[1] = *(const f32x4*)(bg + 4); buv[0] = *(const f32x4*)(bg + 1024); buv[1] = *(const f32x4*)(bg + 1028);
        const f32x2 sc2 = {sc, sc}, osc2 = {osc, osc}, k1 = {-1.702f * 1.4426950408889634f, -1.702f * 1.4426950408889634f}, one2 = {1.0f, 1.0f}, magic = {12582912.0f, 12582912.0f};
#pragma unroll
        for (int ai = 0; ai < 2; ++ai)
#pragma unroll
            for (int m = 0; m < 4; ++m) {
                unsigned wq[2];
#pragma unroll
                for (int hh = 0; hh < 2; ++hh) {
                    const f32x4 gf = __builtin_convertvector(acc[ai][0][m][hh], f32x4), uf = __builtin_convertvector(acc[ai][1][m][hh], f32x4);
                    unsigned bits[4];
#pragma unroll
                    for (int p = 0; p < 2; ++p) {
                        f32x2 g2 = __builtin_elementwise_fma((f32x2){gf[2 * p], gf[2 * p + 1]}, sc2, (f32x2){bgv[hh][2 * p], bgv[hh][2 * p + 1]});
                        f32x2 u2 = __builtin_elementwise_fma((f32x2){uf[2 * p], uf[2 * p + 1]}, sc2, (f32x2){buv[hh][2 * p], buv[hh][2 * p + 1]});
                        g2.x = fminf(g2.x, 7.0f); g2.y = fminf(g2.y, 7.0f);
                        u2.x = __builtin_amdgcn_fmed3f(u2.x, -7.0f, 7.0f); u2.y = __builtin_amdgcn_fmed3f(u2.y, -7.0f, 7.0f);
                        const f32x2 t = g2 * k1; f32x2 e; e.x = __builtin_amdgcn_exp2f(t.x); e.y = __builtin_amdgcn_exp2f(t.y);
                        const f32x2 d = e + one2; f32x2 r; r.x = __builtin_amdgcn_rcpf(d.x); r.y = __builtin_amdgcn_rcpf(d.y);
                        f32x2 o = __builtin_elementwise_fma(u2, osc2, osc2) * (g2 * r);
                        o.x = __builtin_amdgcn_fmed3f(o.x, -127.0f, 127.0f); o.y = __builtin_amdgcn_fmed3f(o.y, -127.0f, 127.0f);
                        o = o + magic;
                        const float ox = o.x, oy = o.y;
                        bits[2 * p] = __builtin_bit_cast(unsigned, ox); bits[2 * p + 1] = __builtin_bit_cast(unsigned, oy); }
                    wq[hh] = pack4_lowbytes(bits[0], bits[1], bits[2], bits[3]); }
                typedef unsigned u32x2 __attribute__((ext_vector_type(2)));
                *(u32x2*)(O + (size_t)(row0 + ai * HALF + m * 16) * 1024 + cg) = (u32x2){wq[0], wq[1]}; }
    }
};
template <bool XBF> struct EpiResGate {
    static constexpr bool PERM = true;
    const void* X; bf16_t* O; const float* gate;
    template <class AT> __device__ __forceinline__ void operator()(const AT (&acc)[2][2][4][2], const Unit& u, int wr, int wc, int fr, int fq) const {
        const int row0 = u.pm * BM + wr * 64 + fr, col0 = u.pn * BM + wc * 32 + 8 * fq; const int b = (u.pm * BM) >> 12;
        f32x4 gv[2][2];
#pragma unroll
        for (int bj = 0; bj < 2; ++bj)
#pragma unroll
            for (int n = 0; n < 2; ++n) gv[bj][n] = *(const f32x4*)(gate + b * 6144 + col0 + bj * HALF + 4 * n);
#pragma unroll
        for (int ai = 0; ai < 2; ++ai)
#pragma unroll
            for (int m = 0; m < 4; ++m) { const size_t off = (size_t)(row0 + ai * HALF + m * 16) * 1024 + col0;
#pragma unroll
                for (int bj = 0; bj < 2; ++bj) { f32x4 x0, x1;
                    if (XBF) { const u32x4 w = *(const u32x4*)((const bf16_t*)X + off + bj * HALF);
                        x0 = (f32x4){__builtin_bit_cast(float, w.x << 16), __builtin_bit_cast(float, w.x & 0xffff0000u), __builtin_bit_cast(float, w.y << 16), __builtin_bit_cast(float, w.y & 0xffff0000u)};
                        x1 = (f32x4){__builtin_bit_cast(float, w.z << 16), __builtin_bit_cast(float, w.z & 0xffff0000u), __builtin_bit_cast(float, w.w << 16), __builtin_bit_cast(float, w.w & 0xffff0000u)}; }
                    else { x0 = *(const f32x4*)((const float*)X + off + bj * HALF); x1 = *(const f32x4*)((const float*)X + off + bj * HALF + 4); }
                    const f32x4 v0 = x0 + gv[bj][0] * __builtin_convertvector(acc[ai][bj][m][0], f32x4), v1 = x1 + gv[bj][1] * __builtin_convertvector(acc[ai][bj][m][1], f32x4);
                    u32x4 w; w.x = cvt_pk_bf16(v0[0], v0[1]); w.y = cvt_pk_bf16(v0[2], v0[3]); w.z = cvt_pk_bf16(v1[0], v1[1]); w.w = cvt_pk_bf16(v1[2], v1[3]);
                    *(u32x4*)(O + off + bj * HALF) = w; }
                asm volatile("" ::: "memory"); }
    }
};
template <bool I8> struct AccSel { typedef f32x4 type; };
template <> struct AccSel<true> { typedef i32x4 type; };
__device__ __forceinline__ f32x4 mma16(bf16x8 b, bf16x8 a, f32x4 c) { return __builtin_amdgcn_mfma_f32_16x16x32_bf16(b, a, c, 0, 0, 0); }
__device__ __forceinline__ i32x4 mma16(bf16x8 b, bf16x8 a, i32x4 c) { return __builtin_amdgcn_mfma_i32_16x16x64_i8(__builtin_bit_cast(i32x4, b), __builtin_bit_cast(i32x4, a), c, 0, 0, 0); }
template <class Epi, class Sched, bool I8 = false, bool GATHER = false>
__device__ __forceinline__ void gemm_phase(PG8_LAS unsigned char* lds, const Gemm g, const Sched& S, const Epi& E, const PG8_LAS unsigned* RT = nullptr) {
    int tid_ = threadIdx.x; asm volatile("" : "+v"(tid_));
    const int tid = tid_, wid = __builtin_amdgcn_readfirstlane(tid >> 6), lane = tid & 63, wr = wid >> 2, wc = wid & 3, fr = lane & 15, fq = lane >> 4;
    const int K = I8 ? g.K / 2 : g.K, nt = K / BK;
    unsigned voffA[2], voffB[2]; int gR[2], gC = 0;
#pragma unroll
    for (int i = 0; i < 2; ++i) { int R, C; stage_rc(tid * 16 + i * 8192, R, C); const int Rb = Epi::PERM ? ((R & ~31) + perm32(R & 31)) : R;
        voffA[i] = (unsigned)(R * K + C) * 2u; voffB[i] = (unsigned)(Rb * K + C) * 2u; gR[i] = R; gC = C * 2; }
    unsigned cOff[2][2], nOff[2][2];
#define PG8_GOFF(dst, un) do { _Pragma("unroll") for (int h_ = 0; h_ < 2; ++h_) _Pragma("unroll") for (int i_ = 0; i_ < 2; ++i_) dst[h_][i_] = RT[(un) * 256 + h_ * 128 + gR[i_]] + (unsigned)gC; } while (0)
    const size_t kstep = (size_t)(BK * 2);
    const size_t hstep = (size_t)HALF * K * 2;
    const size_t tstep = 2 * hstep;
    const unsigned ldsw = (unsigned)wid * 1024u;
    const int aoff = lds_byte(wr * 64 + fr, fq * 8), boff = lds_byte(wc * 32 + fr, fq * 8);
#define PG8_SA(b, h) (((b) * 2 + (h)) * HTB)
#define PG8_SB(b, h) ((4 + (b) * 2 + (h)) * HTB)
#define PG8_STAGE(bufoff, gbase, voff) do { _Pragma("unroll") for (int _i = 0; _i < 2; ++_i) \
        __builtin_amdgcn_global_load_lds((const unsigned*)((const char*)(gbase) + (voff)[_i]), (PG8_LAS unsigned*)(lds + (bufoff) + ldsw + _i * 8192), 16, 0, 0); } while (0)
#define PG8_LDA(dst, b, h) do { _Pragma("unroll") for (int m = 0; m < 4; ++m) _Pragma("unroll") for (int k = 0; k < 2; ++k) dst[m][k] = *(const PG8_LAS bf16x8*)(lds + PG8_SA(b, h) + aoff + m * 2048 + k * 1024); } while (0)
#define PG8_LDB(dst, b, h) do { _Pragma("unroll") for (int n = 0; n < 2; ++n) _Pragma("unroll") for (int k = 0; k < 2; ++k) dst[n][k] = *(const PG8_LAS bf16x8*)(lds + PG8_SB(b, h) + boff + n * 2048 + k * 1024); } while (0)
#define PG8_MMA(ai, bj, At, Bt) do { __builtin_amdgcn_s_setprio(1); _Pragma("unroll") for (int m = 0; m < 4; ++m) _Pragma("unroll") for (int n = 0; n < 2; ++n) _Pragma("unroll") for (int k = 0; k < 2; ++k) \
        acc[ai][bj][m][n] = mma16(Bt[n][k], At[m][k], acc[ai][bj][m][n]); __builtin_amdgcn_s_setprio(0); } while (0)
#define PG8_WAIT_V(n) asm volatile("s_waitcnt vmcnt(" #n ")" ::: "memory")
#define PG8_WAIT_L(n) asm volatile("s_waitcnt lgkmcnt(" #n ")" ::: "memory")
#define PG8_BAR __builtin_amdgcn_s_barrier()
#define PG8_SCHED __builtin_amdgcn_sched_barrier(0)
    Unit cur, nxt; int ui = 0;
    if (!S.next(0, cur)) return;
    typedef typename AccSel<I8>::type AccT;
    AccT acc[2][2][4][2];
#pragma unroll
    for (int a = 0; a < 2; ++a)
#pragma unroll
        for (int b = 0; b < 2; ++b)
#pragma unroll
            for (int m = 0; m < 4; ++m)
#pragma unroll
                for (int n = 0; n < 2; ++n) acc[a][b][m][n] = AccT{};
    bf16x8 At[4][2], B0[2][2], B1[2][2];
    const char* cA = GATHER ? (const char*)g.A : (const char*)g.A + (size_t)cur.pm * tstep; const char* cB = (const char*)g.Bt + (size_t)cur.pb * tstep;
    if constexpr (GATHER) { PG8_GOFF(cOff, 0); PG8_WAIT_L(0); }
#define PG8_STAGE_A(bufoff, base, kbyte, half, offs) do { if constexpr (GATHER) PG8_STAGE(bufoff, (const char*)g.A + (kbyte), offs[half]); else PG8_STAGE(bufoff, (base) + (kbyte) + (half) * hstep, voffA); } while (0)
    PG8_STAGE(PG8_SB(0, 0), cB, voffB); PG8_STAGE(PG8_SB(0, 1), cB + hstep, voffB); PG8_STAGE_A(PG8_SA(0, 0), cA, 0, 0, cOff); PG8_STAGE_A(PG8_SA(0, 1), cA, 0, 1, cOff);
    if (wr == 1) PG8_BAR;
    PG8_WAIT_V(2); PG8_BAR;
    PG8_STAGE(PG8_SB(1, 0), cB + kstep, voffB); PG8_STAGE_A(PG8_SA(1, 0), cA, kstep, 0, cOff); PG8_STAGE(PG8_SB(1, 1), cB + hstep + kstep, voffB);
    PG8_WAIT_V(6); PG8_BAR;
    for (;;) {
        const bool has_next = S.next(ui + 1, nxt);
        const char* nA = (has_next && !GATHER) ? (const char*)g.A + (size_t)nxt.pm * tstep : cA; const char* nB = has_next ? (const char*)g.Bt + (size_t)nxt.pb * tstep : cB;
        if constexpr (GATHER) { if (has_next) PG8_GOFF(nOff, ui + 1); else {
#pragma unroll
            for (int h_ = 0; h_ < 2; ++h_)
#pragma unroll
                for (int i_ = 0; i_ < 2; ++i_) nOff[h_][i_] = cOff[h_][i_]; } }
#pragma unroll 1
        for (int t = 0; t < nt; t += 2) {
            const bool last = (t == nt - 2);
            const size_t k1 = (size_t)(t + 1) * kstep, k2 = last ? 0 : (size_t)(t + 2) * kstep, k3 = k2 + kstep;
            const char* a2b = last ? nA : cA; const char* b2 = last ? nB : cB + (size_t)(t + 2) * kstep; const char* b3 = b2 + kstep;
            unsigned o2[2][2];
#pragma unroll
            for (int h_ = 0; h_ < 2; ++h_)
#pragma unroll
                for (int i_ = 0; i_ < 2; ++i_) o2[h_][i_] = last ? nOff[h_][i_] : cOff[h_][i_];
            PG8_LDB(B0, 0, 0); PG8_LDB(B1, 0, 1); PG8_SCHED; PG8_LDA(At, 0, 0); PG8_STAGE_A(PG8_SA(1, 1), cA, k1, 1, cOff);
            PG8_WAIT_V(8); PG8_WAIT_L(0); PG8_BAR; PG8_MMA(0, 0, At, B0); PG8_MMA(0, 1, At, B1); PG8_BAR; PG8_SCHED;
            PG8_LDA(At, 0, 1); PG8_STAGE(PG8_SB(0, 0), b2, voffB); PG8_STAGE(PG8_SB(0, 1), b2 + hstep, voffB); PG8_STAGE_A(PG8_SA(0, 0), a2b, k2, 0, o2);
            PG8_WAIT_V(8); PG8_WAIT_L(0); PG8_BAR; PG8_MMA(1, 0, At, B0); PG8_MMA(1, 1, At, B1); PG8_BAR; PG8_SCHED;
            PG8_LDB(B0, 1, 0); PG8_LDB(B1, 1, 1); PG8_SCHED; PG8_LDA(At, 1, 0); PG8_STAGE_A(PG8_SA(0, 1), a2b, k2, 1, o2);
            PG8_WAIT_V(8); PG8_WAIT_L(0); PG8_BAR; PG8_MMA(0, 0, At, B0); PG8_MMA(0, 1, At, B1); PG8_BAR; PG8_SCHED;
            PG8_LDA(At, 1, 1); PG8_STAGE(PG8_SB(1, 0), b3, voffB); PG8_STAGE(PG8_SB(1, 1), b3 + hstep, voffB); PG8_STAGE_A(PG8_SA(1, 0), a2b, k3, 0, o2);
            PG8_WAIT_V(8); PG8_WAIT_L(0); PG8_BAR; PG8_MMA(1, 0, At, B0); PG8_MMA(1, 1, At, B1); PG8_BAR; PG8_SCHED;
        }
        if (wr == 0) PG8_BAR;
        E(acc, cur, wr, wc, fr, fq);
        if (!has_next) break;
#pragma unroll
        for (int a = 0; a < 2; ++a)
#pragma unroll
            for (int b = 0; b < 2; ++b)
#pragma unroll
                for (int m = 0; m < 4; ++m)
#pragma unroll
                    for (int n = 0; n < 2; ++n) acc[a][b][m][n] = AccT{};
        cur = nxt; cA = nA; cB = nB; ++ui;
        if constexpr (GATHER) {
#pragma unroll
            for (int h_ = 0; h_ < 2; ++h_)
#pragma unroll
                for (int i_ = 0; i_ < 2; ++i_) cOff[h_][i_] = nOff[h_][i_]; }
        if (wr == 1) PG8_BAR;
    }
    PG8_WAIT_V(0);
    PG8_BAR;
#undef PG8_GOFF
#undef PG8_STAGE_A
#undef PG8_SA
#undef PG8_SB
#undef PG8_STAGE
#undef PG8_LDA
#undef PG8_LDB
#undef PG8_MMA
#undef PG8_WAIT_V
#undef PG8_WAIT_L
#undef PG8_BAR
#undef PG8_SCHED
}
}

constexpr int NWAVES = 8, NTHR = 512;
constexpr int NB = 4, SEQ = 4096, D = 1024, T = NB * SEQ, DIN = 2304, NE = 32, TOPK = 4, DEPTH = 2, FF = 1024;
constexpr int OFF_ZB = 0, OFF_ZC = 256, OFF_ZV = 512, OFF_ZU = 768, OFF_ZSV = 1024, OFF_ZG = 1280, OFF_ZX = 1792;
constexpr int NBLK = SEQ / 64;
constexpr int NRT = T / 64;
constexpr int MAXTILES = T * TOPK / 256 + NE;
constexpr int CAP = T, CAPT = CAP / 256;
constexpr float EPS = 1e-6f;
constexpr float W_SCALE = 960.0f, H_SCALE = 28.0f, ACT_SCALE = 12.0f, HIN_SCALE = 28.0f, YE_SCALE = 32.0f;

constexpr size_t al(size_t x) { return (x + 4095) & ~(size_t)4095; }
constexpr size_t WS_CTL = 0, CTL_ZERO_BYTES = 65536;
constexpr size_t WS_MOD = 65536;
constexpr size_t WS_GWT = al(WS_MOD + (size_t)DEPTH * NB * 6144 * 4);
constexpr size_t WS_SGW = al(WS_GWT + (size_t)DEPTH * 2 * 8 * 4096 * 2);
constexpr size_t WS_RWH = al(WS_SGW + (size_t)DEPTH * 4 * 16384 * 2);
constexpr size_t WS_RWL = al(WS_RWH + (size_t)DEPTH * NE * D * 2);
constexpr size_t WS_WIN = al(WS_RWL + (size_t)DEPTH * NE * D * 2);
constexpr size_t WS_WOUT = al(WS_WIN + (size_t)DEPTH * DIN * D * 2);
constexpr size_t WS_W1 = al(WS_WOUT + (size_t)DEPTH * D * D * 2);
constexpr size_t WS_W2 = al(WS_W1 + (size_t)DEPTH * NE * 2048 * D * 2);
constexpr size_t WS_H = al(WS_W2 + (size_t)DEPTH * NE * D * FF * 2);
constexpr size_t WS_Z = al(WS_H + (size_t)T * D * 2);
constexpr size_t WS_Y = al(WS_Z + (size_t)T * DIN * 2);
constexpr size_t WS_XA = al(WS_Y + (size_t)T * D * 2);
constexpr size_t WS_XB = al(WS_XA + (size_t)T * D * 4);
constexpr size_t WS_AGA = al(WS_XB + (size_t)T * D * 4);
constexpr size_t WS_AGH = al(WS_AGA + (size_t)NB * NBLK * 512 * 4);
constexpr size_t WS_TOPW = al(WS_AGH + (size_t)NB * NBLK * 512 * 4);
constexpr size_t WS_SLOT = al(WS_TOPW + (size_t)T * 4 * 4);
constexpr size_t WS_SHW = al(WS_SLOT + (size_t)T * 4 * 4);
constexpr size_t WS_ROWTOK = al(WS_SHW + (size_t)DEPTH * NB * NE * 4);
constexpr size_t WS_ACT = al(WS_ROWTOK + (size_t)NE * CAP * 4);
constexpr size_t WS_YE = al(WS_ACT + (size_t)NE * CAP * D);
constexpr size_t WS_END = al(WS_YE + (size_t)NE * CAP * D);
constexpr int CW_BAR = 1024;
constexpr int CW_GCNT = 8192;

constexpr int RING_BYTES = 131072;
constexpr int SCR_BYTES = 147456;
constexpr int LDSCTL_OFF = SCR_BYTES;
constexpr int L_MISC = LDSCTL_OFF;
constexpr int L_TILEE = LDSCTL_OFF + 256;
constexpr int L_TILEPM = L_TILEE + MAXTILES * 4;
constexpr int L_CNTE = L_TILEPM + MAXTILES * 4;
constexpr int L_NM = L_CNTE + 128;
constexpr int L_RT = RING_BYTES;
constexpr int LDS_BYTES = LDSCTL_OFF + 4096;
static_assert(L_NM + 4 <= LDS_BYTES, "LDS map");

#define GAS __attribute__((address_space(1)))
#define LAS __attribute__((address_space(3)))
typedef unsigned short bf16;
typedef unsigned v4u __attribute__((ext_vector_type(4)));
typedef unsigned v2u __attribute__((ext_vector_type(2)));
typedef float f32x4 __attribute__((ext_vector_type(4)));
typedef short bf16x8 __attribute__((ext_vector_type(8)));
#define LDS_WAIT() asm volatile("s_waitcnt lgkmcnt(0)" ::: "memory")
#define FRESH_TID() int tid_ = threadIdx.x; asm volatile("" : "+v"(tid_)); const int tid = tid_, lane = tid & 63, wave = __builtin_amdgcn_readfirstlane(tid >> 6); (void)tid; (void)lane; (void)wave
__device__ __forceinline__ unsigned f2bf(float f) { unsigned u = __builtin_bit_cast(unsigned, f); return (u + 0x7fffu + ((u >> 16) & 1u)) >> 16; }
__device__ __forceinline__ unsigned pk2(float lo, float hi) { return pg8::cvt_pk_bf16(lo, hi); }
__device__ __forceinline__ float bflo(unsigned w) { return __builtin_bit_cast(float, w << 16); }
__device__ __forceinline__ float bfhi(unsigned w) { return __builtin_bit_cast(float, w & 0xffff0000u); }
__device__ __forceinline__ float i8f(unsigned w, int k) { return (float)(int)(signed char)(w >> (8 * k)); }
template <bool BF> __device__ __forceinline__ void ld8(const void* p, size_t idx, float (&o)[8]) {
    if (BF) { const v4u w = *(const v4u*)((const bf16*)p + idx); o[0] = bflo(w.x); o[1] = bfhi(w.x); o[2] = bflo(w.y); o[3] = bfhi(w.y); o[4] = bflo(w.z); o[5] = bfhi(w.z); o[6] = bflo(w.w); o[7] = bfhi(w.w); }
    else { const f32x4 a = *(const f32x4*)((const float*)p + idx), b = *(const f32x4*)((const float*)p + idx + 4); o[0] = a[0]; o[1] = a[1]; o[2] = a[2]; o[3] = a[3]; o[4] = b[0]; o[5] = b[1]; o[6] = b[2]; o[7] = b[3]; } }
template <bool BF> __device__ __forceinline__ f32x4 ld4(const void* p, size_t idx) {
    if (BF) { const v2u w = *(const v2u*)((const bf16*)p + idx); return (f32x4){bflo(w.x), bfhi(w.x), bflo(w.y), bfhi(w.y)}; }
    else return *(const f32x4*)((const float*)p + idx); }
__device__ __forceinline__ float sigmoidf_(float x) { return __builtin_amdgcn_rcpf(1.0f + __builtin_amdgcn_exp2f(-1.4426950408889634f * x)); }
__device__ __forceinline__ float gelu_tanh(float x) { const float u2 = 1.5957691216057308f * (x + 0.044715f * x * x * x); return x * __builtin_amdgcn_rcpf(1.0f + __builtin_amdgcn_exp2f(-1.4426950408889634f * u2)); }
__device__ __forceinline__ float wave_sum(float v) {
#pragma unroll
    for (int o = 1; o < 64; o <<= 1) v += __shfl_xor(v, o);
    return v;
}
template <int CTRL> __device__ __forceinline__ float dpp_f(float old, float src) { return __builtin_bit_cast(float, __builtin_amdgcn_update_dpp(__builtin_bit_cast(int, old), __builtin_bit_cast(int, src), CTRL, 0xF, 0xF, false)); }
__device__ __forceinline__ float sum16(float v) {
    v += dpp_f<0xB1>(v, v); v += dpp_f<0x4E>(v, v); v += dpp_f<0x141>(v, v); v += dpp_f<0x140>(v, v); return v; }
__device__ __forceinline__ float bcast15(float v, int lane) { return __builtin_bit_cast(float, __builtin_amdgcn_ds_bpermute((lane | 15) << 2, __builtin_bit_cast(int, v))); }

#define XB_TMO      128
#define XB_XCNT(j)  (256  + 64 * (j))
#define XB_XSUB(j)  (1280 + 64 * (j))
#define XB_XGEN(j)  (2304 + 64 * (j))
#define XB_TOP      3328
#define XB_TOPGEN   3392
#define XCD_BAR_WORDS 3456
#define XB_SPIN_CAP (1u << 18)
__device__ __forceinline__ unsigned xb_ld(unsigned* p)              { return __hip_atomic_load(p, __ATOMIC_RELAXED, __HIP_MEMORY_SCOPE_AGENT); }
__device__ __forceinline__ unsigned xb_add(unsigned* p, unsigned v) { return __hip_atomic_fetch_add(p, v, __ATOMIC_RELAXED, __HIP_MEMORY_SCOPE_AGENT); }
__device__ __forceinline__ unsigned xb_xcc_id() { return (unsigned)__builtin_amdgcn_s_getreg((3 << 11) | 20) & 0xFu; }
#define XB_SPIN(cond, bar) do { unsigned _sp = 0; while (cond) { __builtin_amdgcn_s_sleep(1); \
    if ((++_sp & 255u) == 0u) { if (xb_ld(&(bar)[XB_TMO])) break; if (_sp > XB_SPIN_CAP) { atomicAdd(&(bar)[XB_TMO], 1u); break; } } } } while (0)
struct XcdBarrier { unsigned* bar; unsigned x; volatile LAS unsigned* st; };
__device__ __forceinline__ XcdBarrier xcd_barrier_post(unsigned* bar, volatile LAS unsigned* st) {
    XcdBarrier b; b.bar = bar; b.x = xb_xcc_id(); b.st = st;
    if (threadIdx.x == 0) (void)xb_add(&bar[XB_XCNT(b.x)], 1u);
    return b;
}
__device__ __forceinline__ void xcd_barrier_complete(unsigned* bar, unsigned x, unsigned& nloc, unsigned& nx) {
    const unsigned G = gridDim.x * gridDim.y * gridDim.z;
    unsigned sum, cnt, mine, sp = 0u;
    for (;;) {
        sum = 0u; cnt = 0u; mine = 0u;
#pragma unroll
        for (unsigned j = 0; j < 16; ++j) { const unsigned c = xb_ld(&bar[XB_XCNT(j)]); sum += c; cnt += (c > 0u) ? 1u : 0u; mine = (j == x) ? c : mine; }
        if (sum == G) break;
        __builtin_amdgcn_s_sleep(1);
        if ((++sp & 255u) == 0u) { if (xb_ld(&bar[XB_TMO])) break; if (sp > XB_SPIN_CAP) { atomicAdd(&bar[XB_TMO], 1u); break; } }
    }
    nloc = mine > 0u ? mine : 1u; nx = cnt > 0u ? cnt : 1u;
}
__device__ __forceinline__ void xcd_barrier(const XcdBarrier& b) {
    asm volatile("s_waitcnt vmcnt(0)" ::: "memory");
    __syncthreads();
    if (threadIdx.x == 0) {
        unsigned* bar = b.bar;
        __builtin_amdgcn_s_waitcnt(0);
        unsigned nloc = b.st[0], nx = b.st[1];
        if (nloc == 0u) { xcd_barrier_complete(bar, b.x, nloc, nx); b.st[0] = nloc; b.st[1] = nx; }
        const unsigned old = xb_add(&bar[XB_XSUB(b.x)], 1u);
        const unsigned gen = old / nloc;
        if (old + 1u == (gen + 1u) * nloc) {
            __builtin_amdgcn_fence(__ATOMIC_RELEASE, "agent");
            asm volatile("s_waitcnt vmcnt(0)" ::: "memory");
            const unsigned og = xb_add(&bar[XB_TOP], 1u);
            const unsigned tg = og / nx;
            if (og + 1u == (tg + 1u) * nx) xb_add(&bar[XB_TOPGEN], 1u);
            else XB_SPIN(xb_ld(&bar[XB_TOPGEN]) == tg, bar);
            __builtin_amdgcn_fence(__ATOMIC_ACQUIRE, "agent");
            xb_add(&bar[XB_XGEN(b.x)], 1u);
            asm volatile("s_waitcnt vmcnt(0)" ::: "memory");
        } else {
            XB_SPIN(xb_ld(&bar[XB_XGEN(b.x)]) == gen, bar);
            __builtin_amdgcn_fence(__ATOMIC_ACQUIRE, "agent");
            asm volatile("s_waitcnt vmcnt(0)" ::: "memory");
        }
    }
    __syncthreads();
}

struct TItem { const float* W; bf16* WT; int K, N, k0, n0, rowbase, fp8; };
__device__ __forceinline__ void ti_load(const TItem& d, f32x4 (&v)[16], int lane) {
    if (d.fp8) {
#pragma unroll
        for (int i = 0; i < 16; ++i) v[i] = __builtin_nontemporal_load((const f32x4*)(d.W + (size_t)(d.k0 + 8 * i + (lane >> 3)) * d.N + d.n0 + 4 * (lane & 7)));
    } else {
#pragma unroll
        for (int i = 0; i < 16; ++i) v[i] = __builtin_nontemporal_load((const f32x4*)(d.W + (size_t)(d.k0 + 4 * i + (lane >> 4)) * d.N + d.n0 + 4 * (lane & 15)));
    }
}
__device__ __forceinline__ void ti_store(const TItem& d, const f32x4 (&v)[16], LAS float* scr, int lane) {
    if (d.fp8) {
#pragma unroll
        for (int i = 0; i < 16; ++i) *(LAS f32x4*)(scr + (8 * (i & 1) + (lane >> 3)) * 288 + (i >> 1) * 36 + 4 * (lane & 7)) = v[i];
        LDS_WAIT(); asm volatile("" ::: "memory");
        const int c = lane & 7, nl = lane >> 3;
#pragma unroll
        for (int jj = 0; jj < 4; ++jj) { const int n = nl + 8 * jj; const LAS float* sp = scr + c * 36 + n; v4u o;
            o.x = pg8::pk4_i8(sp[0 * 288] * W_SCALE, sp[1 * 288] * W_SCALE, sp[2 * 288] * W_SCALE, sp[3 * 288] * W_SCALE);
            o.y = pg8::pk4_i8(sp[4 * 288] * W_SCALE, sp[5 * 288] * W_SCALE, sp[6 * 288] * W_SCALE, sp[7 * 288] * W_SCALE);
            o.z = pg8::pk4_i8(sp[8 * 288] * W_SCALE, sp[9 * 288] * W_SCALE, sp[10 * 288] * W_SCALE, sp[11 * 288] * W_SCALE);
            o.w = pg8::pk4_i8(sp[12 * 288] * W_SCALE, sp[13 * 288] * W_SCALE, sp[14 * 288] * W_SCALE, sp[15 * 288] * W_SCALE);
            *(v4u*)((unsigned char*)d.WT + (size_t)(d.rowbase + n) * d.K + d.k0 + 16 * c) = o; }
        LDS_WAIT(); asm volatile("" ::: "memory");
        return;
    }
#pragma unroll
    for (int i = 0; i < 16; ++i) { LAS float* s = scr + (4 * i + (lane >> 4)) * 65 + 4 * (lane & 15); s[0] = v[i][0]; s[1] = v[i][1]; s[2] = v[i][2]; s[3] = v[i][3]; }
    LDS_WAIT(); asm volatile("" ::: "memory");
    const int c = lane & 7;
#pragma unroll
    for (int j = 0; j < 8; ++j) { const int n = (lane >> 3) + 8 * j; const LAS float* s = scr + (8 * c) * 65 + n;
        v4u o; o.x = pk2(s[0 * 65], s[1 * 65]); o.y = pk2(s[2 * 65], s[3 * 65]); o.z = pk2(s[4 * 65], s[5 * 65]); o.w = pk2(s[6 * 65], s[7 * 65]);
        *(v4u*)(d.WT + (size_t)(d.rowbase + n) * d.K + d.k0 + 8 * c) = o; }
    LDS_WAIT(); asm volatile("" ::: "memory");
}

struct Args { const float* in[26]; float* out; unsigned char* ws; int ph_lo, ph_hi; };

__device__ __forceinline__ void pro_phase(const Args& args, LAS unsigned char* lds, int vcu, int G) {
    FRESH_TID();
    unsigned char* ws = args.ws;
    for (int u = vcu; u < DEPTH * 96; u += G) {
        const int l = u / 96, cbk = u % 96, col = cbk * 64 + lane;
        const float* wa = args.in[4] + (size_t)l * D * 6144; const float* cc = args.in[1];
        float a0 = 0.f, a1 = 0.f, a2 = 0.f, a3 = 0.f;
#pragma unroll 8
        for (int k = wave * 128; k < wave * 128 + 128; ++k) { const float w = wa[(size_t)k * 6144 + col]; a0 += cc[k] * w; a1 += cc[D + k] * w; a2 += cc[2 * D + k] * w; a3 += cc[3 * D + k] * w; }
        LAS float* red = (LAS float*)lds;
        red[(wave * 4 + 0) * 64 + lane] = a0; red[(wave * 4 + 1) * 64 + lane] = a1; red[(wave * 4 + 2) * 64 + lane] = a2; red[(wave * 4 + 3) * 64 + lane] = a3;
        __syncthreads();
        if (tid < 256) { const int b = tid >> 6, cl = tid & 63; float s = args.in[5][(size_t)l * 6144 + cbk * 64 + cl];
#pragma unroll
            for (int w = 0; w < 8; ++w) s += red[(w * 4 + b) * 64 + cl];
            ((float*)(ws + WS_MOD))[(size_t)(l * NB + b) * 6144 + cbk * 64 + cl] = s; }
        __syncthreads();
    }
    const int gt = vcu * NTHR + tid, NGT = G * NTHR;
    for (int i = gt; i < DEPTH * 2 * 8 * 4096; i += NGT) {
        const int ii = i & 63, j = (i >> 6) & 63, lgh = i >> 12;
        ((bf16*)(ws + WS_GWT))[i] = (bf16)f2bf(args.in[14][(size_t)lgh * 4096 + ii * 64 + j]); }
    for (int i = gt; i < DEPTH * 4 * 16384; i += NGT) {
        const int s = i & 127, t = (i >> 7) & 127;
        ((bf16*)(ws + WS_SGW))[i] = (bf16)(s <= t ? f2bf(args.in[8][i]) : 0u); }
    for (int i = gt; i < DEPTH * NE * D; i += NGT) {
        const int k = i & 1023, e = (i >> 10) & 31, l = i >> 15;
        const float w = args.in[19][((size_t)l * D + k) * NE + e]; const unsigned hi = f2bf(w); const float r = w - __builtin_bit_cast(float, hi << 16);
        ((bf16*)(ws + WS_RWH))[i] = (bf16)hi; ((bf16*)(ws + WS_RWL))[i] = (bf16)f2bf(r); }
    LAS float* scr = (LAS float*)(lds + wave * 18432);
    const int gw = vcu * NWAVES + wave, NGW = G * NWAVES;
    constexpr int I_IN = 16 * 36, I_OUT = 16 * 16, I_W1 = NE * 16 * 32, I_W2 = NE * 16 * 16, I_L = I_IN + I_OUT + I_W1 + I_W2;
    auto decode = [&](int it, TItem& d) {
        const int l = it / I_L; int r = it % I_L;
        if (r < I_IN) { const int kb = r / 72, nb = r % 72; d = TItem{args.in[6] + (size_t)l * D * DIN, (bf16*)(ws + WS_WIN + (size_t)l * DIN * D), D, DIN, kb * 128, nb * 32, nb * 32, 1}; return; } r -= I_IN;
        if (r < I_OUT) { const int kb = r / 16, nb = r % 16; d = TItem{args.in[18] + (size_t)l * D * D, (bf16*)(ws + WS_WOUT) + (size_t)l * D * D, D, D, kb * 64, nb * 64, nb * 64, 0}; return; } r -= I_OUT;
        if (r < I_W1) { const int e = r / 512, q = r % 512, kb = q / 64, nb = q % 64, n0 = nb * 32;
            const int rowbase = (n0 < 1024) ? (n0 >> 7) * 256 + (n0 & 127) : ((n0 - 1024) >> 7) * 256 + 128 + ((n0 - 1024) & 127);
            d = TItem{args.in[21] + ((size_t)l * NE + e) * D * 2048, (bf16*)(ws + WS_W1 + ((size_t)l * NE + e) * 2048 * D), D, 2048, kb * 128, n0, rowbase, 1}; return; } r -= I_W1;
        { const int e = r / 256, q = r % 256, kb = q / 32, nb = q % 32;
            d = TItem{args.in[23] + ((size_t)l * NE + e) * FF * D, (bf16*)(ws + WS_W2 + ((size_t)l * NE + e) * D * FF), FF, D, kb * 128, nb * 32, nb * 32, 1}; }
    };
    int it = gw; TItem d, dn; f32x4 v[16], vn[16];
    if (it < DEPTH * I_L) { decode(it, d); ti_load(d, v, lane); }
    while (it < DEPTH * I_L) {
        const int itn = it + NGW; const bool hn = itn < DEPTH * I_L;
        if (hn) { decode(itn, dn); ti_load(dn, vn, lane); }
        ti_store(d, v, scr, lane);
        if (hn) { d = dn;
#pragma unroll
            for (int i = 0; i < 16; ++i) v[i] = vn[i]; }
        it = itn;
    }
}

__device__ __forceinline__ void adaln_rows(const float* X, unsigned char* H, const float* g, const float* mod_shift, const float* mod_scale, int vcu, int G) {
    FRESH_TID(); const int gw = vcu * NWAVES + wave, NGW = G * NWAVES;
    for (int row = gw; row < T; row += NGW) {
        const int b = row >> 12; const float* xr = X + (size_t)row * D + 4 * lane;
        f32x4 v[4]; float s = 0.f;
#pragma unroll
        for (int j = 0; j < 4; ++j) { v[j] = *(const f32x4*)(xr + 256 * j); s += (v[j][0] * v[j][0] + v[j][1] * v[j][1]) + (v[j][2] * v[j][2] + v[j][3] * v[j][3]); }
        const float rstd = __builtin_amdgcn_rsqf(wave_sum(s) * (1.0f / D) + EPS);
#pragma unroll
        for (int j = 0; j < 4; ++j) { const int c = 4 * lane + 256 * j;
            const f32x4 gv = *(const f32x4*)(g + c), sc = *(const f32x4*)(mod_scale + b * 6144 + c), sh = *(const f32x4*)(mod_shift + b * 6144 + c);
            const f32x4 o = (v[j] * rstd * gv * (sc + 1.0f) + sh) * HIN_SCALE;
            *(unsigned*)(H + (size_t)row * D + c) = pg8::pk4_i8(o[0], o[1], o[2], o[3]); }
    }
}


__device__ __forceinline__ void shw_phase(const Args& args, LAS unsigned char* lds, int vcu, int G) {
    FRESH_TID();
    unsigned char* ws = args.ws; LAS float* RED = (LAS float*)lds;
    for (int u = vcu; u < DEPTH * NB; u += G) {
        const int l = u >> 2, b = u & 3, e = tid & 31, part = tid >> 5;
        const float* sh = (const float*)(ws + WS_MOD) + (size_t)(l * NB + b) * 6144 + 3 * D; const float* rw = args.in[19] + (size_t)l * D * NE; float s = 0.f;
#pragma unroll 16
        for (int k = part * 64; k < part * 64 + 64; ++k) s = fmaf(sh[k], rw[(size_t)k * NE + e], s);
        RED[part * 32 + e] = s;
        __syncthreads();
        if (tid < 32) { float t = args.in[20][(size_t)l * NE + tid];
#pragma unroll
            for (int p = 0; p < 16; ++p) t += RED[p * 32 + tid];
            ((float*)(ws + WS_SHW))[(l * NB + b) * NE + tid] = t; }
        __syncthreads();
    }
}

constexpr int L3_CARRY = 139264, L3_SS = 141312, L3_SS2 = 143360, L3_SPL = 144384;
template <bool FULL>
__device__ __forceinline__ void mixer_unit(const Args& args, int l, int b, int j, LAS unsigned char* lds) {
    FRESH_TID();
    unsigned char* ws = args.ws;
    const bf16* Z = (const bf16*)(ws + WS_Z); bf16* Y = (bf16*)(ws + WS_Y);
    float* aggA = (float*)(ws + WS_AGA); float* aggH = (float*)(ws + WS_AGH);
    const float* mixg = args.in[17] + (size_t)l * D;
    const int fr = lane & 15, fq = lane >> 4;
    const size_t rowb = (size_t)b * SEQ;
    const int t0 = 64 * j;
    LAS float* CARRY = (LAS float*)(lds + L3_CARRY); LAS float* SS = (LAS float*)(lds + L3_SS); LAS float* SS2 = (LAS float*)(lds + L3_SS2); LAS float* SPL = (LAS float*)(lds + L3_SPL);
    if ((MIX_MASK & 4) || !FULL) {
        {
            const float y = -args.in[16][(size_t)l * 512 + tid];
            SPL[tid] = fmaxf(y, 0.f) + log1pf(expf(-fabsf(y)));
            if (FULL) { float c = 0.f; const float* pa = aggA + (size_t)b * NBLK * 512 + tid; const float* ph = aggH + (size_t)b * NBLK * 512 + tid;
                int jj = 0;
                for (; jj + 16 <= j; jj += 16) { float av[16], hv[16];
#pragma unroll
                    for (int q = 0; q < 16; ++q) { av[q] = pa[(size_t)(jj + q) * 512]; hv[q] = ph[(size_t)(jj + q) * 512]; }
#pragma unroll
                    for (int q = 0; q < 16; ++q) c = fmaf(av[q], c, hv[q]); }
                { float av[16], hv[16];
#pragma unroll
                    for (int q = 0; q < 16; ++q) { const bool ok = jj + q < j; const int jq = ok ? jj + q : 0; av[q] = pa[(size_t)jq * 512]; hv[q] = ph[(size_t)jq * 512]; if (!ok) { av[q] = 1.f; hv[q] = 0.f; } }
#pragma unroll
                    for (int q = 0; q < 16; ++q) c = fmaf(av[q], c, hv[q]); }
                CARRY[tid] = c; }
        }
        __syncthreads();
        const int hd = wave;
        LAS float* XR = (LAS float*)(lds + wave * 17408);
        const float* cw = args.in[12] + (size_t)l * 4 * 512; const float* cbp = args.in[13] + (size_t)l * 512;
        bf16x8 Xa[4][2];
#pragma unroll
        for (int ks = 0; ks < 2; ++ks) {
            const int c8 = 64 * hd + 32 * ks + 8 * fq;
            float wv[4][8], bv[8];
#pragma unroll
            for (int k = 0; k < 4; ++k) { const f32x4 w0 = *(const f32x4*)(cw + k * 512 + c8), w1 = *(const f32x4*)(cw + k * 512 + c8 + 4);
#pragma unroll
                for (int e = 0; e < 4; ++e) { wv[k][e] = w0[e]; wv[k][4 + e] = w1[e]; } }
            { const f32x4 b0 = *(const f32x4*)(cbp + c8), b1 = *(const f32x4*)(cbp + c8 + 4);
#pragma unroll
                for (int e = 0; e < 4; ++e) { bv[e] = b0[e]; bv[4 + e] = b1[e]; } }
#pragma unroll
            for (int m = 0; m < 4; ++m) {
                const int t = t0 + 16 * m + fr;
                float a8[8];
#pragma unroll
                for (int e = 0; e < 8; ++e) a8[e] = bv[e];
#pragma unroll
                for (int k = 0; k < 4; ++k) { const int tt = t - 3 + k; const int tc = tt < 0 ? 0 : tt;
                    const v4u z = *(const v4u*)(Z + (rowb + tc) * DIN + OFF_ZX + c8); const float msk = tt < 0 ? 0.f : 1.f;
                    const unsigned zw[4] = {z.x, z.y, z.z, z.w};
#pragma unroll
                    for (int q = 0; q < 4; ++q) { a8[2 * q] += wv[k][2 * q] * (msk * bflo(zw[q])); a8[2 * q + 1] += wv[k][2 * q + 1] * (msk * bfhi(zw[q])); } }
                v4u pk; pk.x = pk2(a8[0], a8[1]); pk.y = pk2(a8[2], a8[3]); pk.z = pk2(a8[4], a8[5]); pk.w = pk2(a8[6], a8[7]);
                Xa[m][ks] = __builtin_bit_cast(bf16x8, pk);
                LAS float* xp = XR + (16 * m + fr) * 68 + 32 * ks + 8 * fq;
                *(LAS f32x4*)(xp) = (f32x4){a8[0], a8[1], a8[2], a8[3]}; *(LAS f32x4*)(xp + 4) = (f32x4){a8[4], a8[5], a8[6], a8[7]};
            }
        }
        LDS_WAIT(); asm volatile("" ::: "memory");
        const bf16* GwT = (const bf16*)(ws + WS_GWT) + (size_t)l * 2 * 8 * 4096;
        const float* gbp = args.in[15] + (size_t)l * 2 * 512;
        float ss[4] = {0.f, 0.f, 0.f, 0.f};
        bf16x8 Wn[2][2]; f32x4 gbr_n, gbi_n; v2u zg_n[4];
#define LRU_PREFETCH(nn) do { \
            _Pragma("unroll") for (int g_ = 0; g_ < 2; ++g_) _Pragma("unroll") for (int ks_ = 0; ks_ < 2; ++ks_) \
                Wn[g_][ks_] = __builtin_bit_cast(bf16x8, *(const v4u*)(GwT + ((size_t)(g_ * 8 + hd) * 64 + 16 * (nn) + fr) * 64 + 32 * ks_ + 8 * fq)); \
            gbr_n = *(const f32x4*)(gbp + hd * 64 + 16 * (nn) + 4 * fq); gbi_n = *(const f32x4*)(gbp + 512 + hd * 64 + 16 * (nn) + 4 * fq); \
            if (FULL) { _Pragma("unroll") for (int m_ = 0; m_ < 4; ++m_) zg_n[m_] = *(const v2u*)(Z + (rowb + t0 + 16 * m_ + fr) * DIN + OFF_ZG + 64 * hd + 16 * (nn) + 4 * fq); } } while (0)
        LRU_PREFETCH(0);
#pragma unroll 1
        for (int n = 0; n < 4; ++n) {
            const int cc = 16 * n + 4 * fq, c = 64 * hd + cc;
            bf16x8 Wc[2][2]; v2u zgc[4];
#pragma unroll
            for (int g = 0; g < 2; ++g)
#pragma unroll
                for (int ks = 0; ks < 2; ++ks) Wc[g][ks] = Wn[g][ks];
            const f32x4 gbr = gbr_n, gbi = gbi_n;
#pragma unroll
            for (int m = 0; m < 4; ++m) zgc[m] = zg_n[m];
            { const int nn = n < 3 ? n + 1 : 3; LRU_PREFETCH(nn); }
            f32x4 acc[2][4];
#pragma unroll
            for (int g = 0; g < 2; ++g)
#pragma unroll
                for (int m = 0; m < 4; ++m) { acc[g][m] = (f32x4){0.f, 0.f, 0.f, 0.f};
#pragma unroll
                    for (int ks = 0; ks < 2; ++ks) acc[g][m] = __builtin_amdgcn_mfma_f32_16x16x32_bf16(Wc[g][ks], Xa[m][ks], acc[g][m], 0, 0, 0); }
            const f32x4 sp = *(const LAS f32x4*)(SPL + c);
            float A[4][4], Bv[4][4];
#pragma unroll
            for (int m = 0; m < 4; ++m) { const f32x4 xr = *(const LAS f32x4*)(XR + (16 * m + fr) * 68 + cc);
#pragma unroll
                for (int e = 0; e < 4; ++e) { const float r = sigmoidf_(acc[0][m][e] + gbr[e]), ig = sigmoidf_(acc[1][m][e] + gbi[e]);
                    const float la = -8.0f * r * sp[e]; const float a = __builtin_amdgcn_exp2f(la * 1.4426950408889634f);
                    A[m][e] = a; Bv[m][e] = xr[e] * ig * __builtin_amdgcn_sqrtf(fmaxf(fmaf(-a, a, 1.0f), 0.f)); } }
#pragma unroll
            for (int m = 0; m < 4; ++m)
#pragma unroll
                for (int e = 0; e < 4; ++e) { float a = A[m][e], bb = Bv[m][e];
                    { const float ap = dpp_f<0x111>(1.0f, a), bp = dpp_f<0x111>(0.0f, bb); bb = fmaf(a, bp, bb); a *= ap; }
                    { const float ap = dpp_f<0x112>(1.0f, a), bp = dpp_f<0x112>(0.0f, bb); bb = fmaf(a, bp, bb); a *= ap; }
                    { const float ap = dpp_f<0x114>(1.0f, a), bp = dpp_f<0x114>(0.0f, bb); bb = fmaf(a, bp, bb); a *= ap; }
                    { const float ap = dpp_f<0x118>(1.0f, a), bp = dpp_f<0x118>(0.0f, bb); bb = fmaf(a, bp, bb); a *= ap; }
                    A[m][e] = a; Bv[m][e] = bb; }
            float hc[4], ac[4];
            if (FULL) { const f32x4 cv = *(const LAS f32x4*)(CARRY + c); hc[0] = cv[0]; hc[1] = cv[1]; hc[2] = cv[2]; hc[3] = cv[3]; }
            else { hc[0] = hc[1] = hc[2] = hc[3] = 0.f; }
            ac[0] = ac[1] = ac[2] = ac[3] = 1.f;
#pragma unroll
            for (int m = 0; m < 4; ++m) {
                float hcur[4];
#pragma unroll
                for (int e = 0; e < 4; ++e) { hcur[e] = fmaf(A[m][e], hc[e], Bv[m][e]); hc[e] = bcast15(hcur[e], lane);
                    if (!FULL) ac[e] = bcast15(A[m][e] * ac[e], lane); }
                if (FULL) { const v2u zg = zgc[m];
                    const float g4[4] = {bflo(zg.x), bfhi(zg.x), bflo(zg.y), bfhi(zg.y)};
                    f32x4 yq;
#pragma unroll
                    for (int e = 0; e < 4; ++e) { const float y = gelu_tanh(g4[e]) * hcur[e]; yq[e] = y; ss[m] = fmaf(y, y, ss[m]); }
                    *(LAS f32x4*)(XR + (16 * m + fr) * 68 + cc) = yq; }
            }
            if (!FULL && fr == 0) { const size_t o = ((size_t)b * NBLK + j) * 512 + c; *(f32x4*)(aggA + o) = (f32x4){ac[0], ac[1], ac[2], ac[3]}; *(f32x4*)(aggH + o) = (f32x4){hc[0], hc[1], hc[2], hc[3]}; }
        }
#undef LRU_PREFETCH
        if (FULL) {
#pragma unroll
            for (int m = 0; m < 4; ++m) { float s = ss[m]; s += __shfl_xor(s, 16); s += __shfl_xor(s, 32); if (fq == 0) SS[wave * 64 + 16 * m + fr] = s; }
            __syncthreads();
#pragma unroll
            for (int m = 0; m < 4; ++m) { float tot = 0.f;
#pragma unroll
                for (int w = 0; w < 8; ++w) tot += SS[w * 64 + 16 * m + fr];
                const float rstd = __builtin_amdgcn_rsqf(tot * (1.0f / 512.0f) + EPS);
#pragma unroll
                for (int n = 0; n < 4; ++n) { const int c = 512 + 64 * hd + 16 * n + 4 * fq; const f32x4 mg = *(const f32x4*)(mixg + c);
                    const f32x4 yq = *(const LAS f32x4*)(XR + (16 * m + fr) * 68 + 16 * n + 4 * fq);
                    v2u w; w.x = pk2(yq[0] * rstd * mg[0], yq[1] * rstd * mg[1]); w.y = pk2(yq[2] * rstd * mg[2], yq[3] * rstd * mg[3]);
                    *(v2u*)(Y + (rowb + t0 + 16 * m + fr) * D + c) = w; } }
        }
    } else if (FULL) {
        for (int i = tid; i < 64 * 64; i += NTHR) { const int r = i >> 6, c8 = (i & 63) * 8; *(v4u*)(Y + (rowb + t0 + r) * D + 512 + c8) = (v4u){0u, 0u, 0u, 0u}; }
    }
    if (!FULL) return;
    asm volatile("" ::: "memory");
    if (MIX_MASK & 1) {
        const int tg = tid >> 5, s8 = (tid & 31) * 8; const int tb = t0 + 4 * tg;
        const float* caw = args.in[7] + (size_t)l * 3 * 256;
        float w3[3][8];
#pragma unroll
        for (int k = 0; k < 3; ++k) { const f32x4 w0 = *(const f32x4*)(caw + k * 256 + s8), w1 = *(const f32x4*)(caw + k * 256 + s8 + 4);
#pragma unroll
            for (int e = 0; e < 4; ++e) { w3[k][e] = w0[e]; w3[k][4 + e] = w1[e]; } }
        float cv[6][8];
#pragma unroll
        for (int i = 0; i < 6; ++i) { const int tt = tb - 2 + i; const int tc = tt < 0 ? 0 : tt; const float msk = tt < 0 ? 0.f : 1.f;
            const v4u zc = *(const v4u*)(Z + (rowb + tc) * DIN + OFF_ZC + s8), zv = *(const v4u*)(Z + (rowb + tc) * DIN + OFF_ZV + s8);
            const unsigned a[4] = {zc.x, zc.y, zc.z, zc.w}, bq[4] = {zv.x, zv.y, zv.z, zv.w};
#pragma unroll
            for (int q = 0; q < 4; ++q) { cv[i][2 * q] = msk * bflo(a[q]) * bflo(bq[q]); cv[i][2 * q + 1] = msk * bfhi(a[q]) * bfhi(bq[q]); } }
        const f32x4 mg0 = *(const f32x4*)(mixg + s8), mg1 = *(const f32x4*)(mixg + s8 + 4);
#pragma unroll
        for (int i = 0; i < 4; ++i) {
            const v4u zb = *(const v4u*)(Z + (rowb + tb + i) * DIN + OFF_ZB + s8); const unsigned a[4] = {zb.x, zb.y, zb.z, zb.w};
            float y[8], s = 0.f;
#pragma unroll
            for (int e = 0; e < 8; ++e) { const float zbe = (e & 1) ? bfhi(a[e >> 1]) : bflo(a[e >> 1]);
                y[e] = zbe * (w3[0][e] * cv[i][e] + w3[1][e] * cv[i + 1][e] + w3[2][e] * cv[i + 2][e]); s = fmaf(y[e], y[e], s); }
#pragma unroll
            for (int o = 1; o < 32; o <<= 1) s += __shfl_xor(s, o);
            const float rstd = __builtin_amdgcn_rsqf(s * (1.0f / 256.0f) + EPS);
            v4u w; w.x = pk2(y[0] * rstd * mg0[0], y[1] * rstd * mg0[1]); w.y = pk2(y[2] * rstd * mg0[2], y[3] * rstd * mg0[3]);
            w.z = pk2(y[4] * rstd * mg1[0], y[5] * rstd * mg1[1]); w.w = pk2(y[6] * rstd * mg1[2], y[7] * rstd * mg1[3]);
            *(v4u*)(Y + (rowb + tb + i) * D + s8) = w; }
    } else {
        for (int i = tid; i < 64 * 32; i += NTHR) { const int r = i >> 5, c8 = (i & 31) * 8; *(v4u*)(Y + (rowb + t0 + r) * D + c8) = (v4u){0u, 0u, 0u, 0u}; }
    }
    asm volatile("" ::: "memory");
    if (MIX_MASK & 2) {
        __syncthreads();
        const int hf = j & 1, tcs = t0 - 64 * hf, slen = 64 * (hf + 1);
        LAS bf16* Vt = (LAS bf16*)lds;
        const float* lng = args.in[10] + (size_t)l * 256; const float* lnb = args.in[11] + (size_t)l * 256;
        {
            const int rr = lane >> 4, ci = lane & 15;
            float gq[16], bq[16];
#pragma unroll
            for (int q = 0; q < 4; ++q) { const f32x4 a = *(const f32x4*)(lng + 16 * ci + 4 * q), bb = *(const f32x4*)(lnb + 16 * ci + 4 * q);
#pragma unroll
                for (int e = 0; e < 4; ++e) { gq[4 * q + e] = a[e]; bq[4 * q + e] = bb[e]; } }
            v4u zz[4][2];
#pragma unroll
            for (int it = 0; it < 4; ++it) if (it * 32 < slen) { const int sr = 32 * it + 4 * wave + rr; const bf16* zp = Z + (rowb + tcs + sr) * DIN + OFF_ZSV + 16 * ci;
                zz[it][0] = *(const v4u*)(zp); zz[it][1] = *(const v4u*)(zp + 8); }
#pragma unroll
            for (int it = 0; it < 4; ++it) if (it * 32 < slen) { const int sr = 32 * it + 4 * wave + rr;
                float v[16]; float sm = 0.f;
#pragma unroll
                for (int hh = 0; hh < 2; ++hh) { const unsigned w4[4] = {zz[it][hh].x, zz[it][hh].y, zz[it][hh].z, zz[it][hh].w};
#pragma unroll
                    for (int q = 0; q < 4; ++q) { v[8 * hh + 2 * q] = gelu_tanh(bflo(w4[q])); v[8 * hh + 2 * q + 1] = gelu_tanh(bfhi(w4[q])); } }
#pragma unroll
                for (int e = 0; e < 16; ++e) sm += v[e];
                const float mean = sum16(sm) * (1.0f / 256.0f); float sq = 0.f;
#pragma unroll
                for (int e = 0; e < 16; ++e) { v[e] -= mean; sq = fmaf(v[e], v[e], sq); }
                const float rstd = __builtin_amdgcn_rsqf(sum16(sq) * (1.0f / 256.0f) + EPS);
#pragma unroll
                for (int e = 0; e < 16; ++e) Vt[(16 * ci + e) * 136 + sr] = (bf16)f2bf(v[e] * rstd * gq[e] + bq[e]);
            } }
        __syncthreads();
        const int h = wave >> 1, th = wave & 1;
        const bf16* SGW = (const bf16*)(ws + WS_SGW) + ((size_t)l * 4 + h) * 16384;
        f32x4 acc[2][4];
#pragma unroll
        for (int m = 0; m < 2; ++m)
#pragma unroll
            for (int n = 0; n < 4; ++n) acc[m][n] = (f32x4){0.f, 0.f, 0.f, 0.f};
#pragma unroll
        for (int ks = 0; ks < 4; ++ks) {
            if (ks * 32 < slen) {
                bf16x8 Wq[2];
#pragma unroll
                for (int m = 0; m < 2; ++m) Wq[m] = __builtin_bit_cast(bf16x8, *(const v4u*)(SGW + (size_t)(64 * hf + 32 * th + 16 * m + fr) * 128 + 32 * ks + 8 * fq));
#pragma unroll
                for (int n = 0; n < 4; ++n) { const bf16x8 Vp = *(const LAS bf16x8*)(Vt + (64 * h + 16 * n + fr) * 136 + 32 * ks + 8 * fq);
#pragma unroll
                    for (int m = 0; m < 2; ++m) acc[m][n] = __builtin_amdgcn_mfma_f32_16x16x32_bf16(Vp, Wq[m], acc[m][n], 0, 0, 0); }
            }
        }
        const float* sgb = args.in[9] + ((size_t)l * 4 + h) * 128;
        float ys[2][4][4], s2[2];
#pragma unroll
        for (int m = 0; m < 2; ++m) { const int tl = 32 * th + 16 * m + fr; const float bias = sgb[64 * hf + tl]; float s = 0.f;
#pragma unroll
            for (int n = 0; n < 4; ++n) { const v2u zu = *(const v2u*)(Z + (rowb + t0 + tl) * DIN + OFF_ZU + 64 * h + 16 * n + 4 * fq);
                const float u4[4] = {bflo(zu.x), bfhi(zu.x), bflo(zu.y), bfhi(zu.y)};
#pragma unroll
                for (int e = 0; e < 4; ++e) { const float y = gelu_tanh(u4[e]) * (acc[m][n][e] + bias); ys[m][n][e] = y; s = fmaf(y, y, s); } }
            s += __shfl_xor(s, 16); s += __shfl_xor(s, 32); s2[m] = s; if (fq == 0) SS2[h * 64 + tl] = s; }
        __syncthreads();
#pragma unroll
        for (int m = 0; m < 2; ++m) { const int tl = 32 * th + 16 * m + fr; const float tot = (SS2[tl] + SS2[64 + tl]) + (SS2[128 + tl] + SS2[192 + tl]);
            const float rstd = __builtin_amdgcn_rsqf(tot * (1.0f / 256.0f) + EPS);
#pragma unroll
            for (int n = 0; n < 4; ++n) { const int c = 256 + 64 * h + 16 * n + 4 * fq; const f32x4 mg = *(const f32x4*)(mixg + c);
                v2u w; w.x = pk2(ys[m][n][0] * rstd * mg[0], ys[m][n][1] * rstd * mg[1]); w.y = pk2(ys[m][n][2] * rstd * mg[2], ys[m][n][3] * rstd * mg[3]);
                *(v2u*)(Y + (rowb + t0 + tl) * D + c) = w; } }
        (void)s2;
    } else {
        for (int i = tid; i < 64 * 32; i += NTHR) { const int r = i >> 5, c8 = (i & 31) * 8; *(v4u*)(Y + (rowb + t0 + r) * D + 256 + c8) = (v4u){0u, 0u, 0u, 0u}; }
    }
}

template <bool XBF> __device__ __forceinline__ void route_tile(const Args& args, int l, int tile, const void* X1, LAS unsigned char* lds) {
    FRESH_TID();
    unsigned char* ws = args.ws;
    LAS float* GS = (LAS float*)lds; LAS float* SH = (LAS float*)(lds + 4096); LAS float* SHW = (LAS float*)(lds + 8192); LAS float* RED = (LAS float*)(lds + 8448);
    LAS float* PL = (LAS float*)(lds + 16384); LAS float* PSS = (LAS float*)(lds + 32768); LAS float* RSTD = (LAS float*)(lds + 33280); LAS int* HIST = (LAS int*)(lds + 33792); LAS int* BASE = (LAS int*)(lds + 33920);
    const int row0 = tile * 64, b = row0 >> 12; const int fr = lane & 15, fq = lane >> 4;
    const float* mod = (const float*)(ws + WS_MOD) + (size_t)(l * NB + b) * 6144;
    const float* g2 = args.in[3] + (size_t)l * D;
    for (int k = tid; k < D; k += NTHR) { GS[k] = g2[k] * (1.0f + mod[4 * D + k]); SH[k] = mod[3 * D + k]; }
    if (tid < 32) HIST[tid] = 0;
    __syncthreads();
    if (tid < 32) SHW[tid] = ((const float*)(ws + WS_SHW))[(l * NB + b) * NE + tid];
    const int st = wave >> 1, kh = wave & 1;
    const bf16* RWH = (const bf16*)(ws + WS_RWH) + (size_t)l * NE * D; const bf16* RWL = (const bf16*)(ws + WS_RWL) + (size_t)l * NE * D;
    f32x4 acc[2] = {(f32x4){0.f, 0.f, 0.f, 0.f}, (f32x4){0.f, 0.f, 0.f, 0.f}}; float ssq = 0.f;
    const size_t xrow = (size_t)(row0 + 16 * st + fr) * D;
#pragma unroll 8
    for (int kb = 0; kb < 16; ++kb) {
        const int k = 512 * kh + 32 * kb + 8 * fq;
        float xv[8]; ld8<XBF>(X1, xrow + k, xv);
        const f32x4 g0 = *(const LAS f32x4*)(GS + k), g1 = *(const LAS f32x4*)(GS + k + 4);
        float xs[8], hi[8], lo[8];
#pragma unroll
        for (int e = 0; e < 4; ++e) { xs[e] = xv[e] * g0[e]; xs[4 + e] = xv[4 + e] * g1[e]; ssq = fmaf(xv[e], xv[e], ssq); ssq = fmaf(xv[4 + e], xv[4 + e], ssq); }
        v4u qh, ql; unsigned hh[8], ll[8];
#pragma unroll
        for (int e = 0; e < 8; ++e) { hh[e] = f2bf(xs[e]); hi[e] = __builtin_bit_cast(float, hh[e] << 16); lo[e] = xs[e] - hi[e]; ll[e] = f2bf(lo[e]); }
        qh.x = hh[0] | (hh[1] << 16); qh.y = hh[2] | (hh[3] << 16); qh.z = hh[4] | (hh[5] << 16); qh.w = hh[6] | (hh[7] << 16);
        ql.x = ll[0] | (ll[1] << 16); ql.y = ll[2] | (ll[3] << 16); ql.z = ll[4] | (ll[5] << 16); ql.w = ll[6] | (ll[7] << 16);
        const bf16x8 Qh = __builtin_bit_cast(bf16x8, qh), Ql = __builtin_bit_cast(bf16x8, ql);
#pragma unroll
        for (int n = 0; n < 2; ++n) { const bf16x8 Ph = __builtin_bit_cast(bf16x8, *(const v4u*)(RWH + (size_t)(16 * n + fr) * D + k)), Pl = __builtin_bit_cast(bf16x8, *(const v4u*)(RWL + (size_t)(16 * n + fr) * D + k));
            acc[n] = __builtin_amdgcn_mfma_f32_16x16x32_bf16(Ph, Qh, acc[n], 0, 0, 0);
            acc[n] = __builtin_amdgcn_mfma_f32_16x16x32_bf16(Ph, Ql, acc[n], 0, 0, 0);
            acc[n] = __builtin_amdgcn_mfma_f32_16x16x32_bf16(Pl, Qh, acc[n], 0, 0, 0); }
    }
    ssq += __shfl_xor(ssq, 16); ssq += __shfl_xor(ssq, 32);
#pragma unroll
    for (int n = 0; n < 2; ++n) *(LAS f32x4*)(PL + (wave * 16 + fr) * 32 + 16 * n + 4 * fq) = acc[n];
    if (fq == 0) PSS[wave * 16 + fr] = ssq;
    __syncthreads();
    int ek = 0, rank = 0; float wk = 0.f;
    if (kh == 0) {
        const float tot = PSS[wave * 16 + fr] + PSS[(wave + 1) * 16 + fr]; const float rstd = __builtin_amdgcn_rsqf(tot * (1.0f / D) + EPS);
        if (fq == 0) RSTD[16 * st + fr] = rstd;
        float v[8]; int taken = 0;
#pragma unroll
        for (int n = 0; n < 2; ++n) { const f32x4 o = *(const LAS f32x4*)(PL + ((wave + 1) * 16 + fr) * 32 + 16 * n + 4 * fq); const f32x4 sw = *(const LAS f32x4*)(SHW + 16 * n + 4 * fq);
#pragma unroll
            for (int e = 0; e < 4; ++e) v[4 * n + e] = rstd * (acc[n][e] + o[e]) + sw[e]; }
        float selv[4]; int seli[4];
#pragma unroll
        for (int r = 0; r < 4; ++r) {
            float bv = -3.0e38f; int bi = 1 << 20;
#pragma unroll
            for (int q = 0; q < 8; ++q) { const int idx = 16 * (q >> 2) + 4 * fq + (q & 3); const bool ok = !((taken >> q) & 1) && (v[q] > bv); bv = ok ? v[q] : bv; bi = ok ? idx : bi; }
#pragma unroll
            for (int msk = 16; msk <= 32; msk <<= 1) { const float ov = __shfl_xor(bv, msk); const int oi = __shfl_xor(bi, msk); const bool tk = (ov > bv) || (ov == bv && oi < bi); bv = tk ? ov : bv; bi = tk ? oi : bi; }
            selv[r] = bv; seli[r] = bi;
            if (((bi >> 2) & 3) == fq) taken |= 1 << (4 * (bi >> 4) + (bi & 3));
        }
        const float e1 = __expf(selv[1] - selv[0]), e2 = __expf(selv[2] - selv[0]), e3 = __expf(selv[3] - selv[0]); const float inv = 1.0f / (1.0f + e1 + e2 + e3);
        wk = (fq == 0 ? 1.0f : fq == 1 ? e1 : fq == 2 ? e2 : e3) * inv; ek = fq == 0 ? seli[0] : fq == 1 ? seli[1] : fq == 2 ? seli[2] : seli[3];
        rank = __hip_atomic_fetch_add(HIST + ek, 1, __ATOMIC_RELAXED, __HIP_MEMORY_SCOPE_WORKGROUP);
    }
    __syncthreads();
    if (tid < 32) { const int hcnt = HIST[tid]; int base = 0;
        if (hcnt) base = (int)__hip_atomic_fetch_add((unsigned*)(ws + WS_CTL) + CW_GCNT + (l * 32 + tid) * 32, (unsigned)hcnt, __ATOMIC_RELAXED, __HIP_MEMORY_SCOPE_AGENT);
        BASE[tid] = base; }
    __syncthreads();
    if (kh == 0) { const int tok = row0 + 16 * st + fr; const size_t ai = (size_t)tok * 4 + fq; const int slot = ek * CAP + BASE[ek] + rank;
        ((int*)(ws + WS_SLOT))[ai] = slot; ((float*)(ws + WS_TOPW))[ai] = wk; ((int*)(ws + WS_ROWTOK))[slot] = tok; }
    unsigned char* H8 = (unsigned char*)(ws + WS_H);
#pragma unroll
    for (int r0 = wave * 8; r0 < wave * 8 + 8; r0 += 4) {
        f32x4 xq[4][4];
#pragma unroll
        for (int i = 0; i < 4; ++i)
#pragma unroll
            for (int jj = 0; jj < 4; ++jj) xq[i][jj] = ld4<XBF>(X1, (size_t)(row0 + r0 + i) * D + 4 * lane + 256 * jj);
#pragma unroll
        for (int i = 0; i < 4; ++i) { const float rstd = RSTD[r0 + i] * H_SCALE;
#pragma unroll
            for (int jj = 0; jj < 4; ++jj) { const int c = 4 * lane + 256 * jj; const f32x4 gs = *(const LAS f32x4*)(GS + c), sh = *(const LAS f32x4*)(SH + c);
                const f32x4 o = xq[i][jj] * rstd * gs + sh * H_SCALE;
                *(unsigned*)(H8 + (size_t)(row0 + r0 + i) * D + c) = pg8::pk4_i8(o[0], o[1], o[2], o[3]); } } }
    __syncthreads();
}

__device__ __forceinline__ void moe_tables(const Args& args, int l, LAS unsigned char* lds, int G) {
    FRESH_TID();
    unsigned char* ws = args.ws;
    LAS int* TILEE = (LAS int*)(lds + L_TILEE); LAS int* TILEPM = (LAS int*)(lds + L_TILEPM); LAS int* CNTE = (LAS int*)(lds + L_CNTE); LAS int* NMp = (LAS int*)(lds + L_NM);
    LAS unsigned* RT = (LAS unsigned*)(lds + L_RT);
    if (tid < 64) {
        int cnt = 0; if (tid < 32) cnt = (int)__hip_atomic_load((unsigned*)(ws + WS_CTL) + CW_GCNT + (l * 32 + tid) * 32, __ATOMIC_RELAXED, __HIP_MEMORY_SCOPE_AGENT);
        const int nt = (cnt + 255) >> 8; int inc = nt;
#pragma unroll
        for (int o = 1; o < 32; o <<= 1) { const int t = __shfl_up(inc, o); if (lane >= o) inc += t; }
        const int run = inc - nt;
        if (tid < 32) { CNTE[tid] = cnt; for (int t = 0; t < nt; ++t) { TILEE[run + t] = tid; TILEPM[run + t] = tid * CAPT + t; } }
        if (tid == 31) NMp[0] = inc;
    }
    __syncthreads();
    pg8::MoeOrder S; S.init(NMp[0], 8, G, (int)blockIdx.x); S.tile_e = TILEE; S.tile_pm = TILEPM;
    const int* ROWTOK = (const int*)(ws + WS_ROWTOK);
    for (int i0 = 0; i0 < 16; i0 += 2) { pg8::Unit u0; if (!S.next(i0, u0)) break;
        const int i = i0 + (tid >> 8), r = tid & 255; pg8::Unit u;
        if (S.next(i, u)) { const bool valid = (u.pm - u.e * CAPT) * 256 + r < CNTE[u.e]; const int tok = valid ? ROWTOK[(size_t)u.pm * 256 + r] : 0; RT[i * 256 + r] = (unsigned)tok * (unsigned)D; } }
    __syncthreads();
}

template <bool MOE, bool LAST, bool XBF>
__device__ __forceinline__ void combine_rows(const Args& args, int l, const void* X1, bf16* XN, int vcu, int G) {
    FRESH_TID(); const int gw = vcu * NWAVES + wave, NGW = G * NWAVES;
    unsigned char* ws = args.ws;
    const unsigned char* YE = (const unsigned char*)(ws + WS_YE); unsigned char* H = (unsigned char*)(ws + WS_H);
    int rpw = 1; while (rpw * NGW < T) rpw <<= 1;
    const int rbeg = gw * rpw, rend = (rbeg + rpw < T) ? rbeg + rpw : T;
    if (rbeg >= T) return;
    const int b = rbeg >> 12;
    const float* modl = (const float*)(ws + WS_MOD) + (size_t)(l * NB + b) * 6144;
    f32x4 gt[4], pa[4], pb[4];
#pragma unroll
    for (int q = 0; q < 4; ++q) { const int c = 8 * lane + 512 * (q >> 1) + 4 * (q & 1);
        gt[q] = MOE ? *(const f32x4*)(modl + 5 * D + c) : (f32x4){0.f, 0.f, 0.f, 0.f};
        if (LAST) { pa[q] = *(const f32x4*)(args.in[25] + c); pb[q] = (f32x4){0.f, 0.f, 0.f, 0.f}; }
        else { const float* modn = (const float*)(ws + WS_MOD) + (size_t)((l + 1) * NB + b) * 6144; const f32x4 g = *(const f32x4*)(args.in[2] + (size_t)(l + 1) * D + c), sc = *(const f32x4*)(modn + D + c);
            pa[q] = g * (sc + 1.0f); pb[q] = *(const f32x4*)(modn + c); } }
    int myslot = 0; float myw = 0.f;
    if (MOE && rpw * 4 <= 64 && lane < (rend - rbeg) * 4) { myslot = ((const int*)(ws + WS_SLOT))[(size_t)rbeg * 4 + lane]; myw = ((const float*)(ws + WS_TOPW))[(size_t)rbeg * 4 + lane]; }
#pragma unroll 2
    for (int row = rbeg; row < rend; ++row) {
        f32x4 v[4];
        { float t0[8], t1[8]; ld8<XBF>(X1, (size_t)row * D + 8 * lane, t0); ld8<XBF>(X1, (size_t)row * D + 512 + 8 * lane, t1);
            v[0] = (f32x4){t0[0], t0[1], t0[2], t0[3]}; v[1] = (f32x4){t0[4], t0[5], t0[6], t0[7]}; v[2] = (f32x4){t1[0], t1[1], t1[2], t1[3]}; v[3] = (f32x4){t1[4], t1[5], t1[6], t1[7]}; }
        if (MOE) {
            f32x4 a[4] = {(f32x4){0.f, 0.f, 0.f, 0.f}, (f32x4){0.f, 0.f, 0.f, 0.f}, (f32x4){0.f, 0.f, 0.f, 0.f}, (f32x4){0.f, 0.f, 0.f, 0.f}};
            v2u y[4][2]; float w[4];
#pragma unroll
            for (int k = 0; k < 4; ++k) { int slot;
                if (rpw * 4 <= 64) { slot = __builtin_amdgcn_readlane(myslot, (row - rbeg) * 4 + k); w[k] = __builtin_bit_cast(float, __builtin_amdgcn_readlane(__builtin_bit_cast(int, myw), (row - rbeg) * 4 + k)); }
                else { slot = ((const int*)(ws + WS_SLOT))[(size_t)row * 4 + k]; w[k] = ((const float*)(ws + WS_TOPW))[(size_t)row * 4 + k]; }
                slot = __builtin_amdgcn_readfirstlane(slot); w[k] *= (1.0f / YE_SCALE);
                const unsigned char* yr = YE + (size_t)slot * D + 8 * lane; y[k][0] = *(const v2u*)(yr); y[k][1] = *(const v2u*)(yr + 512); }
#pragma unroll
            for (int k = 0; k < 4; ++k)
#pragma unroll
                for (int hh = 0; hh < 2; ++hh) { const v2u t = y[k][hh];
                    a[2 * hh] += w[k] * (f32x4){i8f(t.x, 0), i8f(t.x, 1), i8f(t.x, 2), i8f(t.x, 3)}; a[2 * hh + 1] += w[k] * (f32x4){i8f(t.y, 0), i8f(t.y, 1), i8f(t.y, 2), i8f(t.y, 3)}; }
#pragma unroll
            for (int q = 0; q < 4; ++q) v[q] += gt[q] * a[q];
        }
        float s = 0.f;
#pragma unroll
        for (int q = 0; q < 4; ++q) s += (v[q][0] * v[q][0] + v[q][1] * v[q][1]) + (v[q][2] * v[q][2] + v[q][3] * v[q][3]);
        const float rstd = __builtin_amdgcn_rsqf(wave_sum(s) * (1.0f / D) + EPS);
        if (LAST) {
#pragma unroll
            for (int q = 0; q < 4; ++q) *(f32x4*)(args.out + (size_t)row * D + 8 * lane + 512 * (q >> 1) + 4 * (q & 1)) = v[q] * rstd * pa[q];
        } else {
#pragma unroll
            for (int hh = 0; hh < 2; ++hh) { v4u wv; wv.x = pk2(v[2 * hh][0], v[2 * hh][1]); wv.y = pk2(v[2 * hh][2], v[2 * hh][3]); wv.z = pk2(v[2 * hh + 1][0], v[2 * hh + 1][1]); wv.w = pk2(v[2 * hh + 1][2], v[2 * hh + 1][3]);
                *(v4u*)(XN + (size_t)row * D + 8 * lane + 512 * hh) = wv; }
#pragma unroll
            for (int hh = 0; hh < 2; ++hh) { const f32x4 o0 = (v[2 * hh] * rstd * pa[2 * hh] + pb[2 * hh]) * HIN_SCALE, o1 = (v[2 * hh + 1] * rstd * pa[2 * hh + 1] + pb[2 * hh + 1]) * HIN_SCALE;
                *(v2u*)(H + (size_t)row * D + 8 * lane + 512 * hh) = (v2u){pg8::pk4_i8(o0[0], o0[1], o0[2], o0[3]), pg8::pk4_i8(o1[0], o1[1], o1[2], o1[3])}; }
        }
    }
}

template <int L> __device__ __forceinline__ void layer_body(const Args& args, LAS unsigned char* lds, const XcdBarrier& bar, int vcu, int G, const void* xin, bf16* xnext) {
    unsigned char* ws = args.ws;
    constexpr bool MIX = (RUN_MASK >> (2 * L)) & 1, MOE = (RUN_MASK >> (2 * L + 1)) & 1, LAST = (L == DEPTH - 1);
    const float* modl = (const float*)(ws + WS_MOD) + (size_t)L * NB * 6144;
    constexpr bool XIN_BF = (L > 0), X1_BF = MIX ? true : XIN_BF;
    bf16* XA = (bf16*)(ws + WS_XA);
    const void* x1 = xin;
    if (MIX) {
        if (PH(2)) { asm volatile("; PHASE_MARK P2" ::: "memory");
            _Pragma("unroll 1") for (int rep = 0; rep < NREP(2); ++rep) {
            pg8::Gemm g{(const bf16*)(ws + WS_H), (const bf16*)(ws + WS_WIN + (size_t)L * DIN * D), D}; pg8::StaticOrder S; S.init(T / 256, DIN / 256, G, (int)blockIdx.x);
            pg8::EpiBf16 E{(bf16*)(ws + WS_Z), DIN, nullptr, 0, 1.0f / (HIN_SCALE * W_SCALE)};
            pg8::gemm_phase<pg8::EpiBf16, pg8::StaticOrder, true>(lds, g, S, E);
            xcd_barrier(bar); }
        }
        if (PH(3) & ((MIX_MASK >> 2) & 1)) { asm volatile("; PHASE_MARK P3a" ::: "memory");
            _Pragma("unroll 1") for (int rep = 0; rep < NREP(3); ++rep) {
            for (int u = vcu; u < NB * NBLK; u += G) { mixer_unit<false>(args, L, u >> 6, u & 63, lds); __syncthreads(); }
            xcd_barrier(bar); }
        }
        if (PH(4)) { asm volatile("; PHASE_MARK P3b" ::: "memory");
            _Pragma("unroll 1") for (int rep = 0; rep < NREP(4); ++rep) {
            for (int u = vcu; u < NB * NBLK; u += G) { mixer_unit<true>(args, L, u >> 6, u & 63, lds); __syncthreads(); }
            xcd_barrier(bar); }
        }
        if (PH(5)) { asm volatile("; PHASE_MARK P4" ::: "memory");
            _Pragma("unroll 1") for (int rep = 0; rep < NREP(5); ++rep) {
            pg8::Gemm g{(const bf16*)(ws + WS_Y), (const bf16*)(ws + WS_WOUT) + (size_t)L * D * D, D}; pg8::StaticOrder S; S.init(T / 256, D / 256, G, (int)blockIdx.x);
            pg8::EpiResGate<XIN_BF> E{xin, XA, modl + 2 * D};
            pg8::gemm_phase<pg8::EpiResGate<XIN_BF>, pg8::StaticOrder>(lds, g, S, E);
            xcd_barrier(bar); }
        }
        x1 = XA;
    }
    if (MOE) {
        if (PH(6)) { asm volatile("; PHASE_MARK P5" ::: "memory");
            _Pragma("unroll 1") for (int rep = 0; rep < NREP(6); ++rep) {
            for (int tile = vcu; tile < NRT; tile += G) route_tile<X1_BF>(args, L, tile, x1, lds);
            xcd_barrier(bar); }
        }
        moe_tables(args, L, lds, G);
        const int nM = *(const LAS int*)(lds + L_NM);
        if (PH(8)) { asm volatile("; PHASE_MARK P7" ::: "memory");
            _Pragma("unroll 1") for (int rep = 0; rep < NREP(8); ++rep) {
            pg8::Gemm g{(const bf16*)(ws + WS_H), (const bf16*)(ws + WS_W1 + (size_t)L * NE * 2048 * D), D}; pg8::MoeOrder S; S.init(nM, 8, G, (int)blockIdx.x); S.tile_e = (const LAS int*)(lds + L_TILEE); S.tile_pm = (const LAS int*)(lds + L_TILEPM);
            pg8::EpiSwiglu E{(unsigned char*)(ws + WS_ACT), args.in[22] + (size_t)L * NE * 2048, 1.0f / (H_SCALE * W_SCALE), ACT_SCALE};
            pg8::gemm_phase<pg8::EpiSwiglu, pg8::MoeOrder, true, true>(lds, g, S, E, (const LAS unsigned*)(lds + L_RT));
            xcd_barrier(bar); }
        }
        if (PH(9)) { asm volatile("; PHASE_MARK P8" ::: "memory");
            _Pragma("unroll 1") for (int rep = 0; rep < NREP(9); ++rep) {
            pg8::Gemm g{(const bf16*)(ws + WS_ACT), (const bf16*)(ws + WS_W2 + (size_t)L * NE * D * FF), FF}; pg8::MoeOrder S; S.init(nM, 4, G, (int)blockIdx.x); S.tile_e = (const LAS int*)(lds + L_TILEE); S.tile_pm = (const LAS int*)(lds + L_TILEPM);
            pg8::EpiI8 E{(unsigned char*)(ws + WS_YE), D, args.in[24] + (size_t)L * NE * D, D, 1.0f / (ACT_SCALE * W_SCALE), YE_SCALE};
            pg8::gemm_phase<pg8::EpiI8, pg8::MoeOrder, true>(lds, g, S, E);
            xcd_barrier(bar); }
        }
    }
    asm volatile("; PHASE_MARK P9" ::: "memory");
    if (PH(10)) { _Pragma("unroll 1") for (int rep = 0; rep < NREP(10); ++rep) { combine_rows<MOE, LAST, X1_BF>(args, L, x1, xnext, vcu, G); if (!LAST) xcd_barrier(bar); } }
}

__global__ void __launch_bounds__(NTHR, 2) fwd_kernel(Args args) {
    extern __shared__ __attribute__((aligned(16))) unsigned char lds_raw[];
    LAS unsigned char* lds = (LAS unsigned char*)lds_raw;
    const int tid = threadIdx.x;
    const int G = gridDim.x; const int bx = blockIdx.x; const int vcu = (G % 8 == 0) ? (bx % 8) * (G / 8) + bx / 8 : bx;
    unsigned char* ws = args.ws;
    for (int u = tid; u < (LDS_BYTES - LDSCTL_OFF) / 4; u += NTHR) ((LAS unsigned*)(lds + LDSCTL_OFF))[u] = 0u;
    __syncthreads();
    XcdBarrier bar = xcd_barrier_post((unsigned*)(ws + WS_CTL) + CW_BAR, (volatile LAS unsigned*)(lds + L_MISC) + 8);
    asm volatile("; PHASE_MARK P0" ::: "memory");
    _Pragma("unroll 1") for (int rep = 0; rep < NREP(0); ++rep) { if (PH(0)) pro_phase(args, lds, vcu, G); xcd_barrier(bar); }
    { shw_phase(args, lds, vcu, G); if (PH(1) & (RUN_MASK & 1)) { const float* mod0 = (const float*)(ws + WS_MOD); adaln_rows(args.in[0], (unsigned char*)(ws + WS_H), args.in[2], mod0, mod0 + D, vcu, G); } xcd_barrier(bar); }
    layer_body<0>(args, lds, bar, vcu, G, args.in[0], (bf16*)(ws + WS_XB));
    layer_body<1>(args, lds, bar, vcu, G, (const void*)(ws + WS_XB), nullptr);
}

extern "C" void kernel_launch(void* const* d_in, const int* in_sizes, int n_in, void* d_out, int out_size, void* d_ws, size_t ws_size, hipStream_t stream) {
    static int grid = 0;
    if (grid == 0) {
        if (n_in != 26 || in_sizes[0] != T * D || out_size != T * D || ws_size < WS_END) { fprintf(stderr, "kernel_launch: unexpected shapes (n_in %d, in0 %d, out %d, ws %zu < %zu); nothing launched\n", n_in, n_in > 0 ? in_sizes[0] : -1, out_size, ws_size, (size_t)WS_END); grid = -1; return; }
        int dev = 0, cus = 0, per_cu = 0;
        if (hipGetDevice(&dev) != hipSuccess || hipDeviceGetAttribute(&cus, hipDeviceAttributeMultiprocessorCount, dev) != hipSuccess) { grid = -1; return; }
        if (hipFuncSetAttribute((const void*)fwd_kernel, hipFuncAttributeMaxDynamicSharedMemorySize, LDS_BYTES) != hipSuccess) { fprintf(stderr, "kernel_launch: hipFuncSetAttribute failed\n"); grid = -1; return; }
        if (hipOccupancyMaxActiveBlocksPerMultiprocessor(&per_cu, (const void*)fwd_kernel, NTHR, LDS_BYTES) != hipSuccess || per_cu < 1) { fprintf(stderr, "kernel_launch: occupancy query says %d blocks per CU\n", per_cu); }
        (void)hipGetLastError();
        grid = cus;
    }
    if (grid < 0) return;
    if (hipMemsetAsync((char*)d_ws + WS_CTL, 0, CTL_ZERO_BYTES, stream) != hipSuccess) return;
    Args a{};
    for (int i = 0; i < 26; ++i) a.in[i] = (const float*)d_in[i];
    a.out = (float*)d_out; a.ws = (unsigned char*)d_ws; a.ph_lo = 0; a.ph_hi = 0;
    hipLaunchKernelGGL(fwd_kernel, dim3(grid), dim3(NTHR), LDS_BYTES, stream, a);
}
```

```cpp
#include <hip/hip_runtime.h>
#include <cstdio>
#include <cstdint>

#ifndef RUN_MASK
#define RUN_MASK 15
#endif
#ifndef PH_ENABLE
#define PH_ENABLE 0x7ff
#endif
#define PH(k) ((PH_ENABLE >> (k)) & 1)
#ifndef DUP_MASK
#define DUP_MASK 0
#endif
#define NREP(k) (1 + ((DUP_MASK >> (k)) & 1))
#ifndef MIX_MASK
#define MIX_MASK 7
#endif

namespace pg8 {
#define PG8_LAS __attribute__((address_space(3)))
typedef unsigned short bf16_t;
typedef short bf16x8 __attribute__((ext_vector_type(8)));
typedef float f32x4 __attribute__((ext_vector_type(4)));
typedef unsigned u32x4 __attribute__((ext_vector_type(4)));
typedef int i32x4 __attribute__((ext_vector_type(4)));
typedef int i32x8 __attribute__((ext_vector_type(8)));
constexpr int BM = 256, BK = 64, HALF = 128, HTB = HALF * BK * 2, STAGE_BYTES = 8 * HTB, NXCD = 8, WGM = 8;

__host__ __device__ __forceinline__ int lds_byte(int r, int c) { const int st = (r >> 4) * 2 + (c >> 5), rr = r & 15, cc = c & 31, ob = rr * 64 + cc * 2; return st * 1024 + (ob ^ (((ob >> 9) & 1) << 5)); }
__host__ __device__ __forceinline__ void stage_rc(int b, int& R, int& C) { const int st = b / 1024, sb = b % 1024, swz = sb ^ (((sb >> 9) & 1) << 5); R = (st >> 1) * 16 + swz / 64; C = (st & 1) * 32 + (swz % 64) / 2; }
__host__ __device__ __forceinline__ int perm32(int rho) { const int n = rho >> 4, i = rho & 15; return 8 * (i >> 2) + 4 * n + (i & 3); }

struct Unit { int pm, pn, pb, e; };
struct Gemm { const bf16_t* A; const bf16_t* Bt; int K; };

struct StaticOrder {
    int nM, nN, nwg, G, c;
    __device__ void init(int nM_, int nN_, int G_, int c_) { nM = nM_; nN = nN_; nwg = nM * nN; G = G_; c = c_; }
    __device__ __forceinline__ bool map(int i, Unit& u) const {
        const long L = (long)i * G + c; if (L >= nwg) return false;
        int wgid = (int)L; { const int q = nwg / NXCD, r = nwg % NXCD, xcd = wgid % NXCD, off = wgid / NXCD; wgid = (xcd < r ? xcd * (q + 1) : r * (q + 1) + (xcd - r) * q) + off; }
        const int nig = WGM * nN, gid = wgid / nig, fm = gid * WGM, gsz = (nM - fm) < WGM ? (nM - fm) : WGM;
        u.pm = fm + ((wgid % nig) % gsz); u.pn = (wgid % nig) / gsz; return true;
    }
    __device__ __forceinline__ bool next(int i, Unit& u) const { if (!map(i, u)) return false; u.pb = u.pn; u.e = 0; return true; }
};
struct MoeOrder : StaticOrder {
    const PG8_LAS int* tile_e; const PG8_LAS int* tile_pm;
    __device__ __forceinline__ bool next(int i, Unit& u) const { if (!map(i, u)) return false; const int t = u.pm; u.e = tile_e[t]; u.pm = tile_pm[t]; u.pb = u.e * nN + u.pn; return true; }
};

typedef unsigned u32x2w __attribute__((ext_vector_type(2)));
#ifndef WT_MASK
#define WT_MASK 4
#endif
template <int LV> __device__ __forceinline__ void st16_wt(void* p, u32x4 v) { if ((WT_MASK >> (LV - 1)) & 1) asm volatile("global_store_dwordx4 %0, %1, off sc1\n\ts_nop 0" :: "v"(p), "v"(v) : "memory"); else *(u32x4*)p = v; }
template <int LV> __device__ __forceinline__ void st8_wt(void* p, u32x2w v) { if ((WT_MASK >> (LV - 1)) & 1) asm volatile("global_store_dwordx2 %0, %1, off sc1" :: "v"(p), "v"(v) : "memory"); else *(u32x2w*)p = v; }
template <int LV> __device__ __forceinline__ void st4_wt(void* p, unsigned v) { if ((WT_MASK >> (LV - 1)) & 1) asm volatile("global_store_dword %0, %1, off sc1" :: "v"(p), "v"(v) : "memory"); else *(unsigned*)p = v; }
__device__ __forceinline__ unsigned cvt_pk_bf16(float lo, float hi) { unsigned r; asm volatile("v_cvt_pk_bf16_f32 %0, %1, %2" : "=v"(r) : "v"(lo), "v"(hi)); return r; }

__device__ __forceinline__ unsigned q_i8(float x) { const float y = __builtin_amdgcn_fmed3f(x, -127.0f, 127.0f) + 12582912.0f; return __builtin_bit_cast(unsigned, y); }
__device__ __forceinline__ unsigned pk4_i8(float a, float b, float c, float d) { return __builtin_amdgcn_perm(q_i8(b), q_i8(a), 0x0c0c0400u) | __builtin_amdgcn_perm(q_i8(d), q_i8(c), 0x04000c0cu); }
struct EpiBf16 {
    static constexpr bool PERM = true;
    bf16_t* O; int ldc; const float* bias; int bstride; float sc;
    template <class AT> __device__ __forceinline__ void operator()(const AT (&acc)[2][2][4][2], const Unit& u, int wr, int wc, int fr, int fq) const {
        const int row0 = u.pm * BM + wr * 64 + fr; const int col0 = u.pn * BM + wc * 32 + 8 * fq;
        f32x4 bv[2][2];
#pragma unroll
        for (int bj = 0; bj < 2; ++bj)
#pragma unroll
            for (int n = 0; n < 2; ++n) bv[bj][n] = bias ? *(const f32x4*)(bias + (size_t)u.e * bstride + col0 + bj * HALF + 4 * n) : (f32x4){0.f, 0.f, 0.f, 0.f};
#pragma unroll
        for (int ai = 0; ai < 2; ++ai)
#pragma unroll
            for (int m = 0; m < 4; ++m) { bf16_t* rowp = O + (size_t)(row0 + ai * HALF + m * 16) * ldc + col0;
#pragma unroll
                for (int bj = 0; bj < 2; ++bj) { const f32x4 v0 = __builtin_convertvector(acc[ai][bj][m][0], f32x4) * sc + bv[bj][0], v1 = __builtin_convertvector(acc[ai][bj][m][1], f32x4) * sc + bv[bj][1];
                    u32x4 w; w.x = cvt_pk_bf16(v0[0], v0[1]); w.y = cvt_pk_bf16(v0[2], v0[3]); w.z = cvt_pk_bf16(v1[0], v1[1]); w.w = cvt_pk_bf16(v1[2], v1[3]);
                    st16_wt<1>(rowp + bj * HALF, w); } }
    }
};
struct EpiI8 {
    static constexpr bool PERM = true;
    unsigned char* O; int ldc; const float* bias; int bstride; float sc, osc;
    template <class AT> __device__ __forceinline__ void operator()(const AT (&acc)[2][2][4][2], const Unit& u, int wr, int wc, int fr, int fq) const {
        const int row0 = u.pm * BM + wr * 64 + fr; const int col0 = u.pn * BM + wc * 32 + 8 * fq;
        f32x4 bv[2][2]; const f32x4 s4 = {sc * osc, sc * osc, sc * osc, sc * osc};
#pragma unroll
        for (int bj = 0; bj < 2; ++bj)
#pragma unroll
            for (int n = 0; n < 2; ++n) bv[bj][n] = *(const f32x4*)(bias + (size_t)u.e * bstride + col0 + bj * HALF + 4 * n) * osc;
#pragma unroll
        for (int ai = 0; ai < 2; ++ai)
#pragma unroll
            for (int m = 0; m < 4; ++m) { unsigned char* rowp = O + (size_t)(row0 + ai * HALF + m * 16) * ldc + col0;
#pragma unroll
                for (int bj = 0; bj < 2; ++bj) { const f32x4 v0 = __builtin_elementwise_fma(__builtin_convertvector(acc[ai][bj][m][0], f32x4), s4, bv[bj][0]), v1 = __builtin_elementwise_fma(__builtin_convertvector(acc[ai][bj][m][1], f32x4), s4, bv[bj][1]);
                    typedef unsigned u32x2 __attribute__((ext_vector_type(2)));
                    st8_wt<1>(rowp + bj * HALF, (u32x2w){pk4_i8(v0[0], v0[1], v0[2], v0[3]), pk4_i8(v1[0], v1[1], v1[2], v1[3])}); } }
    }
};
typedef float f32x2 __attribute__((ext_vector_type(2)));
__device__ __forceinline__ unsigned pack4_lowbytes(unsigned w0, unsigned w1, unsigned w2, unsigned w3) {
    return __builtin_amdgcn_perm(w1, w0, 0x0c0c0400u) | __builtin_amdgcn_perm(w3, w2, 0x04000c0cu); }
struct EpiSwiglu {
    static constexpr bool PERM = true;
    unsigned char* O; const float* b1; float sc, osc;
    template <class AT> __device__ __forceinline__ void operator()(const AT (&acc)[2][2][4][2], const Unit& u, int wr, int wc, int fr, int fq) const {
        const int row0 = u.pm * BM + wr * 64 + fr; const int cg = u.pn * HALF + wc * 32 + 8 * fq;
        const float* bg = b1 + (size_t)u.e * 2048 + cg;
        f32x4 bgv[2], buv[2]; bgv[0] = *(const f32x4*)(bg); bgv[1] = *(const f32x4*)(bg + 4); buv[0] = *(const f32x4*)(bg + 1024); buv[1] = *(const f32x4*)(bg + 1028);
        const f32x2 sc2 = {sc, sc}, osc2 = {osc, osc}, k1 = {-1.702f * 1.4426950408889634f, -1.702f * 1.4426950408889634f}, one2 = {1.0f, 1.0f}, magic = {12582912.0f, 12582912.0f};
#pragma unroll
        for (int ai = 0; ai < 2; ++ai)
#pragma unroll
            for (int m = 0; m < 4; ++m) {
                unsigned wq[2];
#pragma unroll
                for (int hh = 0; hh < 2; ++hh) {
                    const f32x4 gf = __builtin_convertvector(acc[ai][0][m][hh], f32x4), uf = __builtin_convertvector(acc[ai][1][m][hh], f32x4);
                    unsigned bits[4];
#pragma unroll
                    for (int p = 0; p < 2; ++p) {
                        f32x2 g2 = __builtin_elementwise_fma((f32x2){gf[2 * p], gf[2 * p + 1]}, sc2, (f32x2){bgv[hh][2 * p], bgv[hh][2 * p + 1]});
                        f32x2 u2 = __builtin_elementwise_fma((f32x2){uf[2 * p], uf[2 * p + 1]}, sc2, (f32x2){buv[hh][2 * p], buv[hh][2 * p + 1]});
                        g2.x = fminf(g2.x, 7.0f); g2.y = fminf(g2.y, 7.0f);
                        u2.x = __builtin_amdgcn_fmed3f(u2.x, -7.0f, 7.0f); u2.y = __builtin_amdgcn_fmed3f(u2.y, -7.0f, 7.0f);
                        const f32x2 t = g2 * k1; f32x2 e; e.x = __builtin_amdgcn_exp2f(t.x); e.y = __builtin_amdgcn_exp2f(t.y);
                        const f32x2 d = e + one2; f32x2 r; r.x = __builtin_amdgcn_rcpf(d.x); r.y = __builtin_amdgcn_rcpf(d.y);
                        f32x2 o = __builtin_elementwise_fma(u2, osc2, osc2) * (g2 * r);
                        o.x = __builtin_amdgcn_fmed3f(o.x, -127.0f, 127.0f); o.y = __builtin_amdgcn_fmed3f(o.y, -127.0f, 127.0f);
                        o = o + magic;
                        const float ox = o.x, oy = o.y;
                        bits[2 * p] = __builtin_bit_cast(unsigned, ox); bits[2 * p + 1] = __builtin_bit_cast(unsigned, oy); }
                    wq[hh] = pack4_lowbytes(bits[0], bits[1], bits[2], bits[3]); }
                typedef unsigned u32x2 __attribute__((ext_vector_type(2)));
                st8_wt<1>(O + (size_t)(row0 + ai * HALF + m * 16) * 1024 + cg, (u32x2w){wq[0], wq[1]}); }
    }
};
template <bool XBF> struct EpiResGate {
    static constexpr bool PERM = true;
    const void* X; bf16_t* O; const float* gate;
    template <class AT> __device__ __forceinline__ void operator()(const AT (&acc)[2][2][4][2], const Unit& u, int wr, int wc, int fr, int fq) const {
        const int row0 = u.pm * BM + wr * 64 + fr, col0 = u.pn * BM + wc * 32 + 8 * fq; const int b = (u.pm * BM) >> 12;
        f32x4 gv[2][2];
#pragma unroll
        for (int bj = 0; bj < 2; ++bj)
#pragma unroll
            for (int n = 0; n < 2; ++n) gv[bj][n] = *(const f32x4*)(gate + b * 6144 + col0 + bj * HALF + 4 * n);
#pragma unroll
        for (int ai = 0; ai < 2; ++ai)
#pragma unroll
            for (int m = 0; m < 4; ++m) { const size_t off = (size_t)(row0 + ai * HALF + m * 16) * 1024 + col0;
#pragma unroll
                for (int bj = 0; bj < 2; ++bj) { f32x4 x0, x1;
                    if (XBF) { const u32x4 w = *(const u32x4*)((const bf16_t*)X + off + bj * HALF);
                        x0 = (f32x4){__builtin_bit_cast(float, w.x << 16), __builtin_bit_cast(float, w.x & 0xffff0000u), __builtin_bit_cast(float, w.y << 16), __builtin_bit_cast(float, w.y & 0xffff0000u)};
                        x1 = (f32x4){__builtin_bit_cast(float, w.z << 16), __builtin_bit_cast(float, w.z & 0xffff0000u), __builtin_bit_cast(float, w.w << 16), __builtin_bit_cast(float, w.w & 0xffff0000u)}; }
                    else { x0 = *(const f32x4*)((const float*)X + off + bj * HALF); x1 = *(const f32x4*)((const float*)X + off + bj * HALF + 4); }
                    const f32x4 v0 = x0 + gv[bj][0] * __builtin_convertvector(acc[ai][bj][m][0], f32x4), v1 = x1 + gv[bj][1] * __builtin_convertvector(acc[ai][bj][m][1], f32x4);
                    u32x4 w; w.x = cvt_pk_bf16(v0[0], v0[1]); w.y = cvt_pk_bf16(v0[2], v0[3]); w.z = cvt_pk_bf16(v1[0], v1[1]); w.w = cvt_pk_bf16(v1[2], v1[3]);
                    st16_wt<1>(O + off + bj * HALF, w); }
                asm volatile("" ::: "memory"); }
    }
};
template <bool I8> struct AccSel { typedef f32x4 type; };
template <> struct AccSel<true> { typedef i32x4 type; };
__device__ __forceinline__ f32x4 mma16(bf16x8 b, bf16x8 a, f32x4 c) { return __builtin_amdgcn_mfma_f32_16x16x32_bf16(b, a, c, 0, 0, 0); }
__device__ __forceinline__ i32x4 mma16(bf16x8 b, bf16x8 a, i32x4 c) { return __builtin_amdgcn_mfma_i32_16x16x64_i8(__builtin_bit_cast(i32x4, b), __builtin_bit_cast(i32x4, a), c, 0, 0, 0); }
template <class Epi, class Sched, bool I8 = false, bool GATHER = false>
__device__ __forceinline__ void gemm_phase(PG8_LAS unsigned char* lds, const Gemm g, const Sched& S, const Epi& E, const PG8_LAS unsigned* RT = nullptr) {
    int tid_ = threadIdx.x; asm volatile("" : "+v"(tid_));
    const int tid = tid_, wid = __builtin_amdgcn_readfirstlane(tid >> 6), lane = tid & 63, wr = wid >> 2, wc = wid & 3, fr = lane & 15, fq = lane >> 4;
    const int K = I8 ? g.K / 2 : g.K, nt = K / BK;
    unsigned voffA[2], voffB[2]; int gR[2], gC = 0;
#pragma unroll
    for (int i = 0; i < 2; ++i) { int R, C; stage_rc(tid * 16 + i * 8192, R, C); const int Rb = Epi::PERM ? ((R & ~31) + perm32(R & 31)) : R;
        voffA[i] = (unsigned)(R * K + C) * 2u; voffB[i] = (unsigned)(Rb * K + C) * 2u; gR[i] = R; gC = C * 2; }
    unsigned cOff[2][2], nOff[2][2];
#define PG8_GOFF(dst, un) do { _Pragma("unroll") for (int h_ = 0; h_ < 2; ++h_) _Pragma("unroll") for (int i_ = 0; i_ < 2; ++i_) dst[h_][i_] = RT[(un) * 256 + h_ * 128 + gR[i_]] + (unsigned)gC; } while (0)
    const size_t kstep = (size_t)(BK * 2);
    const size_t hstep = (size_t)HALF * K * 2;
    const size_t tstep = 2 * hstep;
    const unsigned ldsw = (unsigned)wid * 1024u;
    const int aoff = lds_byte(wr * 64 + fr, fq * 8), boff = lds_byte(wc * 32 + fr, fq * 8);
#define PG8_SA(b, h) (((b) * 2 + (h)) * HTB)
#define PG8_SB(b, h) ((4 + (b) * 2 + (h)) * HTB)
#define PG8_STAGE(bufoff, gbase, voff) do { _Pragma("unroll") for (int _i = 0; _i < 2; ++_i) \
        __builtin_amdgcn_global_load_lds((const unsigned*)((const char*)(gbase) + (voff)[_i]), (PG8_LAS unsigned*)(lds + (bufoff) + ldsw + _i * 8192), 16, 0, 0); } while (0)
#define PG8_LDA(dst, b, h) do { _Pragma("unroll") for (int m = 0; m < 4; ++m) _Pragma("unroll") for (int k = 0; k < 2; ++k) dst[m][k] = *(const PG8_LAS bf16x8*)(lds + PG8_SA(b, h) + aoff + m * 2048 + k * 1024); } while (0)
#define PG8_LDB(dst, b, h) do { _Pragma("unroll") for (int n = 0; n < 2; ++n) _Pragma("unroll") for (int k = 0; k < 2; ++k) dst[n][k] = *(const PG8_LAS bf16x8*)(lds + PG8_SB(b, h) + boff + n * 2048 + k * 1024); } while (0)
#define PG8_MMA(ai, bj, At, Bt) do { __builtin_amdgcn_s_setprio(1); _Pragma("unroll") for (int m = 0; m < 4; ++m) _Pragma("unroll") for (int n = 0; n < 2; ++n) _Pragma("unroll") for (int k = 0; k < 2; ++k) \
        acc[ai][bj][m][n] = mma16(Bt[n][k], At[m][k], acc[ai][bj][m][n]); __builtin_amdgcn_s_setprio(0); } while (0)
#define PG8_WAIT_V(n) asm volatile("s_waitcnt vmcnt(" #n ")" ::: "memory")
#define PG8_WAIT_L(n) asm volatile("s_waitcnt lgkmcnt(" #n ")" ::: "memory")
#define PG8_BAR __builtin_amdgcn_s_barrier()
#define PG8_SCHED __builtin_amdgcn_sched_barrier(0)
    Unit cur, nxt; int ui = 0;
    if (!S.next(0, cur)) return;
    typedef typename AccSel<I8>::type AccT;
    AccT acc[2][2][4][2];
#pragma unroll
    for (int a = 0; a < 2; ++a)
#pragma unroll
        for (int b = 0; b < 2; ++b)
#pragma unroll
            for (int m = 0; m < 4; ++m)
#pragma unroll
                for (int n = 0; n < 2; ++n) acc[a][b][m][n] = AccT{};
    bf16x8 At[4][2], B0[2][2], B1[2][2];
    const char* cA = GATHER ? (const char*)g.A : (const char*)g.A + (size_t)cur.pm * tstep; const char* cB = (const char*)g.Bt + (size_t)cur.pb * tstep;
    if constexpr (GATHER) { PG8_GOFF(cOff, 0); PG8_WAIT_L(0); }
#define PG8_STAGE_A(bufoff, base, kbyte, half, offs) do { if constexpr (GATHER) PG8_STAGE(bufoff, (const char*)g.A + (kbyte), offs[half]); else PG8_STAGE(bufoff, (base) + (kbyte) + (half) * hstep, voffA); } while (0)
    PG8_STAGE(PG8_SB(0, 0), cB, voffB); PG8_STAGE(PG8_SB(0, 1), cB + hstep, voffB); PG8_STAGE_A(PG8_SA(0, 0), cA, 0, 0, cOff); PG8_STAGE_A(PG8_SA(0, 1), cA, 0, 1, cOff);
    if (wr == 1) PG8_BAR;
    PG8_WAIT_V(2); PG8_BAR;
    PG8_STAGE(PG8_SB(1, 0), cB + kstep, voffB); PG8_STAGE_A(PG8_SA(1, 0), cA, kstep, 0, cOff); PG8_STAGE(PG8_SB(1, 1), cB + hstep + kstep, voffB);
    PG8_WAIT_V(6); PG8_BAR;
    for (;;) {
        const bool has_next = S.next(ui + 1, nxt);
        const char* nA = (has_next && !GATHER) ? (const char*)g.A + (size_t)nxt.pm * tstep : cA; const char* nB = has_next ? (const char*)g.Bt + (size_t)nxt.pb * tstep : cB;
        if constexpr (GATHER) { if (has_next) PG8_GOFF(nOff, ui + 1); else {
#pragma unroll
            for (int h_ = 0; h_ < 2; ++h_)
#pragma unroll
                for (int i_ = 0; i_ < 2; ++i_) nOff[h_][i_] = cOff[h_][i_]; } }
#pragma unroll 1
        for (int t = 0; t < nt; t += 2) {
            const bool last = (t == nt - 2);
            const size_t k1 = (size_t)(t + 1) * kstep, k2 = last ? 0 : (size_t)(t + 2) * kstep, k3 = k2 + kstep;
            const char* a2b = last ? nA : cA; const char* b2 = last ? nB : cB + (size_t)(t + 2) * kstep; const char* b3 = b2 + kstep;
            unsigned o2[2][2];
#pragma unroll
            for (int h_ = 0; h_ < 2; ++h_)
#pragma unroll
                for (int i_ = 0; i_ < 2; ++i_) o2[h_][i_] = last ? nOff[h_][i_] : cOff[h_][i_];
            PG8_LDB(B0, 0, 0); PG8_LDB(B1, 0, 1); PG8_SCHED; PG8_LDA(At, 0, 0); PG8_STAGE_A(PG8_SA(1, 1), cA, k1, 1, cOff);
            PG8_WAIT_V(8); PG8_WAIT_L(0); PG8_BAR; PG8_MMA(0, 0, At, B0); PG8_MMA(0, 1, At, B1); PG8_BAR; PG8_SCHED;
            PG8_LDA(At, 0, 1); PG8_STAGE(PG8_SB(0, 0), b2, voffB); PG8_STAGE(PG8_SB(0, 1), b2 + hstep, voffB); PG8_STAGE_A(PG8_SA(0, 0), a2b, k2, 0, o2);
            PG8_WAIT_V(8); PG8_WAIT_L(0); PG8_BAR; PG8_MMA(1, 0, At, B0); PG8_MMA(1, 1, At, B1); PG8_BAR; PG8_SCHED;
            PG8_LDB(B0, 1, 0); PG8_LDB(B1, 1, 1); PG8_SCHED; PG8_LDA(At, 1, 0); PG8_STAGE_A(PG8_SA(0, 1), a2b, k2, 1, o2);
            PG8_WAIT_V(8); PG8_WAIT_L(0); PG8_BAR; PG8_MMA(0, 0, At, B0); PG8_MMA(0, 1, At, B1); PG8_BAR; PG8_SCHED;
            PG8_LDA(At, 1, 1); PG8_STAGE(PG8_SB(1, 0), b3, voffB); PG8_STAGE(PG8_SB(1, 1), b3 + hstep, voffB); PG8_STAGE_A(PG8_SA(1, 0), a2b, k3, 0, o2);
            PG8_WAIT_V(8); PG8_WAIT_L(0); PG8_BAR; PG8_MMA(1, 0, At, B0); PG8_MMA(1, 1, At, B1); PG8_BAR; PG8_SCHED;
        }
        if (wr == 0) PG8_BAR;
        E(acc, cur, wr, wc, fr, fq);
        if (!has_next) break;
#pragma unroll
        for (int a = 0; a < 2; ++a)
#pragma unroll
            for (int b = 0; b < 2; ++b)
#pragma unroll
                for (int m = 0; m < 4; ++m)
#pragma unroll
                    for (int n = 0; n < 2; ++n) acc[a][b][m][n] = AccT{};
        cur = nxt; cA = nA; cB = nB; ++ui;
        if constexpr (GATHER) {
#pragma unroll
            for (int h_ = 0; h_ < 2; ++h_)
#pragma unroll
                for (int i_ = 0; i_ < 2; ++i_) cOff[h_][i_] = nOff[h_][i_]; }
        if (wr == 1) PG8_BAR;
    }
    PG8_WAIT_V(0);
    PG8_BAR;
#undef PG8_GOFF
#undef PG8_STAGE_A
#undef PG8_SA
#undef PG8_SB
#undef PG8_STAGE
#undef PG8_LDA
#undef PG8_LDB
#undef PG8_MMA
#undef PG8_WAIT_V
#undef PG8_WAIT_L
#undef PG8_BAR
#undef PG8_SCHED
}
}

constexpr int NWAVES = 8, NTHR = 512;
constexpr int NB = 4, SEQ = 4096, D = 1024, T = NB * SEQ, DIN = 2304, NE = 32, TOPK = 4, DEPTH = 2, FF = 1024;
constexpr int OFF_ZB = 0, OFF_ZC = 256, OFF_ZV = 512, OFF_ZU = 768, OFF_ZSV = 1024, OFF_ZG = 1280, OFF_ZX = 1792;
constexpr int NBLK = SEQ / 64;
constexpr int NRT = T / 64;
constexpr int MAXTILES = T * TOPK / 256 + NE;
constexpr int CAP = T, CAPT = CAP / 256;
constexpr float EPS = 1e-6f;
constexpr float W_SCALE = 960.0f, H_SCALE = 28.0f, ACT_SCALE = 12.0f, HIN_SCALE = 28.0f, YE_SCALE = 32.0f;

constexpr size_t al(size_t x) { return (x + 4095) & ~(size_t)4095; }
constexpr size_t WS_CTL = 0, CTL_ZERO_BYTES = 65536;
constexpr size_t WS_MOD = 65536;
constexpr size_t WS_GWT = al(WS_MOD + (size_t)DEPTH * NB * 6144 * 4);
constexpr size_t WS_SGW = al(WS_GWT + (size_t)DEPTH * 2 * 8 * 4096 * 2);
constexpr size_t WS_RWH = al(WS_SGW + (size_t)DEPTH * 4 * 16384 * 2);
constexpr size_t WS_RWL = al(WS_RWH + (size_t)DEPTH * NE * D * 2);
constexpr size_t WS_WIN = al(WS_RWL + (size_t)DEPTH * NE * D * 2);
constexpr size_t WS_WOUT = al(WS_WIN + (size_t)DEPTH * DIN * D * 2);
constexpr size_t WS_W1 = al(WS_WOUT + (size_t)DEPTH * D * D * 2);
constexpr size_t WS_W2 = al(WS_W1 + (size_t)DEPTH * NE * 2048 * D * 2);
constexpr size_t WS_H = al(WS_W2 + (size_t)DEPTH * NE * D * FF * 2);
constexpr size_t WS_Z = al(WS_H + (size_t)T * D * 2);
constexpr size_t WS_Y = al(WS_Z + (size_t)T * DIN * 2);
constexpr size_t WS_XA = al(WS_Y + (size_t)T * D * 2);
constexpr size_t WS_XB = al(WS_XA + (size_t)T * D * 4);
constexpr size_t WS_AGA = al(WS_XB + (size_t)T * D * 4);
constexpr size_t WS_AGH = al(WS_AGA + (size_t)NB * NBLK * 512 * 4);
constexpr size_t WS_TOPW = al(WS_AGH + (size_t)NB * NBLK * 512 * 4);
constexpr size_t WS_SLOT = al(WS_TOPW + (size_t)T * 4 * 4);
constexpr size_t WS_SHW = al(WS_SLOT + (size_t)T * 4 * 4);
constexpr size_t WS_ROWTOK = al(WS_SHW + (size_t)DEPTH * NB * NE * 4);
constexpr size_t WS_ACT = al(WS_ROWTOK + (size_t)NE * CAP * 4);
constexpr size_t WS_YE = al(WS_ACT + (size_t)NE * CAP * D);
constexpr size_t WS_END = al(WS_YE + (size_t)NE * CAP * D);
constexpr int CW_BAR = 1024;
constexpr int CW_GCNT = 8192;

constexpr int RING_BYTES = 131072;
constexpr int SCR_BYTES = 147456;
constexpr int LDSCTL_OFF = SCR_BYTES;
constexpr int L_MISC = LDSCTL_OFF;
constexpr int L_TILEE = LDSCTL_OFF + 256;
constexpr int L_TILEPM = L_TILEE + MAXTILES * 4;
constexpr int L_CNTE = L_TILEPM + MAXTILES * 4;
constexpr int L_NM = L_CNTE + 128;
constexpr int L_RT = RING_BYTES;
constexpr int LDS_BYTES = LDSCTL_OFF + 4096;
static_assert(L_NM + 4 <= LDS_BYTES, "LDS map");

#define GAS __attribute__((address_space(1)))
#define LAS __attribute__((address_space(3)))
typedef unsigned short bf16;
typedef unsigned v4u __attribute__((ext_vector_type(4)));
typedef unsigned v2u __attribute__((ext_vector_type(2)));
typedef float f32x4 __attribute__((ext_vector_type(4)));
typedef short bf16x8 __attribute__((ext_vector_type(8)));
#define LDS_WAIT() asm volatile("s_waitcnt lgkmcnt(0)" ::: "memory")
#define FRESH_TID() int tid_ = threadIdx.x; asm volatile("" : "+v"(tid_)); const int tid = tid_, lane = tid & 63, wave = __builtin_amdgcn_readfirstlane(tid >> 6); (void)tid; (void)lane; (void)wave
__device__ __forceinline__ unsigned f2bf(float f) { unsigned u = __builtin_bit_cast(unsigned, f); return (u + 0x7fffu + ((u >> 16) & 1u)) >> 16; }
__device__ __forceinline__ unsigned pk2(float lo, float hi) { return pg8::cvt_pk_bf16(lo, hi); }
__device__ __forceinline__ float bflo(unsigned w) { return __builtin_bit_cast(float, w << 16); }
__device__ __forceinline__ float bfhi(unsigned w) { return __builtin_bit_cast(float, w & 0xffff0000u); }
__device__ __forceinline__ float i8f(unsigned w, int k) { return (float)(int)(signed char)(w >> (8 * k)); }
template <bool BF> __device__ __forceinline__ void ld8(const void* p, size_t idx, float (&o)[8]) {
    if (BF) { const v4u w = *(const v4u*)((const bf16*)p + idx); o[0] = bflo(w.x); o[1] = bfhi(w.x); o[2] = bflo(w.y); o[3] = bfhi(w.y); o[4] = bflo(w.z); o[5] = bfhi(w.z); o[6] = bflo(w.w); o[7] = bfhi(w.w); }
    else { const f32x4 a = *(const f32x4*)((const float*)p + idx), b = *(const f32x4*)((const float*)p + idx + 4); o[0] = a[0]; o[1] = a[1]; o[2] = a[2]; o[3] = a[3]; o[4] = b[0]; o[5] = b[1]; o[6] = b[2]; o[7] = b[3]; } }
template <bool BF> __device__ __forceinline__ f32x4 ld4(const void* p, size_t idx) {
    if (BF) { const v2u w = *(const v2u*)((const bf16*)p + idx); return (f32x4){bflo(w.x), bfhi(w.x), bflo(w.y), bfhi(w.y)}; }
    else return *(const f32x4*)((const float*)p + idx); }
__device__ __forceinline__ float sigmoidf_(float x) { return __builtin_amdgcn_rcpf(1.0f + __builtin_amdgcn_exp2f(-1.4426950408889634f * x)); }
__device__ __forceinline__ float gelu_tanh(float x) { const float u2 = 1.5957691216057308f * (x + 0.044715f * x * x * x); return x * __builtin_amdgcn_rcpf(1.0f + __builtin_amdgcn_exp2f(-1.4426950408889634f * u2)); }
__device__ __forceinline__ float wave_sum(float v) {
#pragma unroll
    for (int o = 1; o < 64; o <<= 1) v += __shfl_xor(v, o);
    return v;
}
template <int CTRL> __device__ __forceinline__ float dpp_f(float old, float src) { return __builtin_bit_cast(float, __builtin_amdgcn_update_dpp(__builtin_bit_cast(int, old), __builtin_bit_cast(int, src), CTRL, 0xF, 0xF, false)); }
__device__ __forceinline__ float sum16(float v) {
    v += dpp_f<0xB1>(v, v); v += dpp_f<0x4E>(v, v); v += dpp_f<0x141>(v, v); v += dpp_f<0x140>(v, v); return v; }
__device__ __forceinline__ float bcast15(float v, int lane) { return __builtin_bit_cast(float, __builtin_amdgcn_ds_bpermute((lane | 15) << 2, __builtin_bit_cast(int, v))); }

#define XB_TMO      128
#define XB_XCNT(j)  (256  + 64 * (j))
#define XB_XSUB(j)  (1280 + 64 * (j))
#define XB_XGEN(j)  (2304 + 64 * (j))
#define XB_TOP      3328
#define XB_TOPGEN   3392
#define XCD_BAR_WORDS 3456
#define XB_SPIN_CAP (1u << 18)
__device__ __forceinline__ unsigned xb_ld(unsigned* p)              { return __hip_atomic_load(p, __ATOMIC_RELAXED, __HIP_MEMORY_SCOPE_AGENT); }
__device__ __forceinline__ unsigned xb_add(unsigned* p, unsigned v) { return __hip_atomic_fetch_add(p, v, __ATOMIC_RELAXED, __HIP_MEMORY_SCOPE_AGENT); }
__device__ __forceinline__ unsigned xb_xcc_id() { return (unsigned)__builtin_amdgcn_s_getreg((3 << 11) | 20) & 0xFu; }
#define XB_SPIN(cond, bar) do { unsigned _sp = 0; while (cond) { __builtin_amdgcn_s_sleep(1); \
    if ((++_sp & 255u) == 0u) { if (xb_ld(&(bar)[XB_TMO])) break; if (_sp > XB_SPIN_CAP) { atomicAdd(&(bar)[XB_TMO], 1u); break; } } } } while (0)
struct XcdBarrier { unsigned* bar; unsigned x; volatile LAS unsigned* st; };
__device__ __forceinline__ XcdBarrier xcd_barrier_post(unsigned* bar, volatile LAS unsigned* st) {
    XcdBarrier b; b.bar = bar; b.x = xb_xcc_id(); b.st = st;
    if (threadIdx.x == 0) (void)xb_add(&bar[XB_XCNT(b.x)], 1u);
    return b;
}
__device__ __forceinline__ void xcd_barrier_complete(unsigned* bar, unsigned x, unsigned& nloc, unsigned& nx) {
    const unsigned G = gridDim.x * gridDim.y * gridDim.z;
    unsigned sum, cnt, mine, sp = 0u;
    for (;;) {
        sum = 0u; cnt = 0u; mine = 0u;
#pragma unroll
        for (unsigned j = 0; j < 16; ++j) { const unsigned c = xb_ld(&bar[XB_XCNT(j)]); sum += c; cnt += (c > 0u) ? 1u : 0u; mine = (j == x) ? c : mine; }
        if (sum == G) break;
        __builtin_amdgcn_s_sleep(1);
        if ((++sp & 255u) == 0u) { if (xb_ld(&bar[XB_TMO])) break; if (sp > XB_SPIN_CAP) { atomicAdd(&bar[XB_TMO], 1u); break; } }
    }
    nloc = mine > 0u ? mine : 1u; nx = cnt > 0u ? cnt : 1u;
}
__device__ __forceinline__ void xcd_barrier(const XcdBarrier& b) {
    asm volatile("s_waitcnt vmcnt(0)" ::: "memory");
    __syncthreads();
    if (threadIdx.x == 0) {
        unsigned* bar = b.bar;
        __builtin_amdgcn_s_waitcnt(0);
        unsigned nloc = b.st[0], nx = b.st[1];
        if (nloc == 0u) { xcd_barrier_complete(bar, b.x, nloc, nx); b.st[0] = nloc; b.st[1] = nx; }
        const unsigned old = xb_add(&bar[XB_XSUB(b.x)], 1u);
        const unsigned gen = old / nloc;
        if (old + 1u == (gen + 1u) * nloc) {
            __builtin_amdgcn_fence(__ATOMIC_RELEASE, "agent");
            asm volatile("s_waitcnt vmcnt(0)" ::: "memory");
            const unsigned og = xb_add(&bar[XB_TOP], 1u);
            const unsigned tg = og / nx;
            if (og + 1u == (tg + 1u) * nx) xb_add(&bar[XB_TOPGEN], 1u);
            else XB_SPIN(xb_ld(&bar[XB_TOPGEN]) == tg, bar);
            __builtin_amdgcn_fence(__ATOMIC_ACQUIRE, "agent");
            xb_add(&bar[XB_XGEN(b.x)], 1u);
            asm volatile("s_waitcnt vmcnt(0)" ::: "memory");
        } else {
            XB_SPIN(xb_ld(&bar[XB_XGEN(b.x)]) == gen, bar);
            __builtin_amdgcn_fence(__ATOMIC_ACQUIRE, "agent");
            asm volatile("s_waitcnt vmcnt(0)" ::: "memory");
        }
    }
    __syncthreads();
}

struct TItem { const float* W; bf16* WT; int K, N, k0, n0, rowbase, fp8; };
__device__ __forceinline__ void ti_load(const TItem& d, f32x4 (&v)[16], int lane) {
    if (d.fp8) {
#pragma unroll
        for (int i = 0; i < 16; ++i) v[i] = __builtin_nontemporal_load((const f32x4*)(d.W + (size_t)(d.k0 + 8 * i + (lane >> 3)) * d.N + d.n0 + 4 * (lane & 7)));
    } else {
#pragma unroll
        for (int i = 0; i < 16; ++i) v[i] = __builtin_nontemporal_load((const f32x4*)(d.W + (size_t)(d.k0 + 4 * i + (lane >> 4)) * d.N + d.n0 + 4 * (lane & 15)));
    }
}
__device__ __forceinline__ void ti_store(const TItem& d, const f32x4 (&v)[16], LAS float* scr, int lane) {
    if (d.fp8) {
#pragma unroll
        for (int i = 0; i < 16; ++i) *(LAS f32x4*)(scr + (8 * (i & 1) + (lane >> 3)) * 288 + (i >> 1) * 36 + 4 * (lane & 7)) = v[i];
        LDS_WAIT(); asm volatile("" ::: "memory");
        const int c = lane & 7, nl = lane >> 3;
#pragma unroll
        for (int jj = 0; jj < 4; ++jj) { const int n = nl + 8 * jj; const LAS float* sp = scr + c * 36 + n; v4u o;
            o.x = pg8::pk4_i8(sp[0 * 288] * W_SCALE, sp[1 * 288] * W_SCALE, sp[2 * 288] * W_SCALE, sp[3 * 288] * W_SCALE);
            o.y = pg8::pk4_i8(sp[4 * 288] * W_SCALE, sp[5 * 288] * W_SCALE, sp[6 * 288] * W_SCALE, sp[7 * 288] * W_SCALE);
            o.z = pg8::pk4_i8(sp[8 * 288] * W_SCALE, sp[9 * 288] * W_SCALE, sp[10 * 288] * W_SCALE, sp[11 * 288] * W_SCALE);
            o.w = pg8::pk4_i8(sp[12 * 288] * W_SCALE, sp[13 * 288] * W_SCALE, sp[14 * 288] * W_SCALE, sp[15 * 288] * W_SCALE);
            pg8::st16_wt<3>((unsigned char*)d.WT + (size_t)(d.rowbase + n) * d.K + d.k0 + 16 * c, o); }
        LDS_WAIT(); asm volatile("" ::: "memory");
        return;
    }
#pragma unroll
    for (int i = 0; i < 16; ++i) { LAS float* s = scr + (4 * i + (lane >> 4)) * 65 + 4 * (lane & 15); s[0] = v[i][0]; s[1] = v[i][1]; s[2] = v[i][2]; s[3] = v[i][3]; }
    LDS_WAIT(); asm volatile("" ::: "memory");
    const int c = lane & 7;
#pragma unroll
    for (int j = 0; j < 8; ++j) { const int n = (lane >> 3) + 8 * j; const LAS float* s = scr + (8 * c) * 65 + n;
        v4u o; o.x = pk2(s[0 * 65], s[1 * 65]); o.y = pk2(s[2 * 65], s[3 * 65]); o.z = pk2(s[4 * 65], s[5 * 65]); o.w = pk2(s[6 * 65], s[7 * 65]);
        pg8::st16_wt<3>(d.WT + (size_t)(d.rowbase + n) * d.K + d.k0 + 8 * c, o); }
    LDS_WAIT(); asm volatile("" ::: "memory");
}

struct Args { const float* in[26]; float* out; unsigned char* ws; int ph_lo, ph_hi; };

__device__ __forceinline__ void pro_phase(const Args& args, LAS unsigned char* lds, int vcu, int G) {
    FRESH_TID();
    unsigned char* ws = args.ws;
    for (int u = vcu; u < DEPTH * 96; u += G) {
        const int l = u / 96, cbk = u % 96, col = cbk * 64 + lane;
        const float* wa = args.in[4] + (size_t)l * D * 6144; const float* cc = args.in[1];
        float a0 = 0.f, a1 = 0.f, a2 = 0.f, a3 = 0.f;
#pragma unroll 8
        for (int k = wave * 128; k < wave * 128 + 128; ++k) { const float w = wa[(size_t)k * 6144 + col]; a0 += cc[k] * w; a1 += cc[D + k] * w; a2 += cc[2 * D + k] * w; a3 += cc[3 * D + k] * w; }
        LAS float* red = (LAS float*)lds;
        red[(wave * 4 + 0) * 64 + lane] = a0; red[(wave * 4 + 1) * 64 + lane] = a1; red[(wave * 4 + 2) * 64 + lane] = a2; red[(wave * 4 + 3) * 64 + lane] = a3;
        __syncthreads();
        if (tid < 256) { const int b = tid >> 6, cl = tid & 63; float s = args.in[5][(size_t)l * 6144 + cbk * 64 + cl];
#pragma unroll
            for (int w = 0; w < 8; ++w) s += red[(w * 4 + b) * 64 + cl];
            ((float*)(ws + WS_MOD))[(size_t)(l * NB + b) * 6144 + cbk * 64 + cl] = s; }
        __syncthreads();
    }
    const int gt = vcu * NTHR + tid, NGT = G * NTHR;
    for (int i = gt; i < DEPTH * 2 * 8 * 4096; i += NGT) {
        const int ii = i & 63, j = (i >> 6) & 63, lgh = i >> 12;
        ((bf16*)(ws + WS_GWT))[i] = (bf16)f2bf(args.in[14][(size_t)lgh * 4096 + ii * 64 + j]); }
    for (int i = gt; i < DEPTH * 4 * 16384; i += NGT) {
        const int s = i & 127, t = (i >> 7) & 127;
        ((bf16*)(ws + WS_SGW))[i] = (bf16)(s <= t ? f2bf(args.in[8][i]) : 0u); }
    for (int i = gt; i < DEPTH * NE * D; i += NGT) {
        const int k = i & 1023, e = (i >> 10) & 31, l = i >> 15;
        const float w = args.in[19][((size_t)l * D + k) * NE + e]; const unsigned hi = f2bf(w); const float r = w - __builtin_bit_cast(float, hi << 16);
        ((bf16*)(ws + WS_RWH))[i] = (bf16)hi; ((bf16*)(ws + WS_RWL))[i] = (bf16)f2bf(r); }
    LAS float* scr = (LAS float*)(lds + wave * 18432);
    const int gw = vcu * NWAVES + wave, NGW = G * NWAVES;
    constexpr int I_IN = 16 * 36, I_OUT = 16 * 16, I_W1 = NE * 16 * 32, I_W2 = NE * 16 * 16, I_L = I_IN + I_OUT + I_W1 + I_W2;
    auto decode = [&](int it, TItem& d) {
        const int l = it / I_L; int r = it % I_L;
        if (r < I_IN) { const int kb = r / 72, nb = r % 72; d = TItem{args.in[6] + (size_t)l * D * DIN, (bf16*)(ws + WS_WIN + (size_t)l * DIN * D), D, DIN, kb * 128, nb * 32, nb * 32, 1}; return; } r -= I_IN;
        if (r < I_OUT) { const int kb = r / 16, nb = r % 16; d = TItem{args.in[18] + (size_t)l * D * D, (bf16*)(ws + WS_WOUT) + (size_t)l * D * D, D, D, kb * 64, nb * 64, nb * 64, 0}; return; } r -= I_OUT;
        if (r < I_W1) { const int e = r / 512, q = r % 512, kb = q / 64, nb = q % 64, n0 = nb * 32;
            const int rowbase = (n0 < 1024) ? (n0 >> 7) * 256 + (n0 & 127) : ((n0 - 1024) >> 7) * 256 + 128 + ((n0 - 1024) & 127);
            d = TItem{args.in[21] + ((size_t)l * NE + e) * D * 2048, (bf16*)(ws + WS_W1 + ((size_t)l * NE + e) * 2048 * D), D, 2048, kb * 128, n0, rowbase, 1}; return; } r -= I_W1;
        { const int e = r / 256, q = r % 256, kb = q / 32, nb = q % 32;
            d = TItem{args.in[23] + ((size_t)l * NE + e) * FF * D, (bf16*)(ws + WS_W2 + ((size_t)l * NE + e) * D * FF), FF, D, kb * 128, nb * 32, nb * 32, 1}; }
    };
    int it = gw; TItem d, dn; f32x4 v[16], vn[16];
    if (it < DEPTH * I_L) { decode(it, d); ti_load(d, v, lane); }
    while (it < DEPTH * I_L) {
        const int itn = it + NGW; const bool hn = itn < DEPTH * I_L;
        if (hn) { decode(itn, dn); ti_load(dn, vn, lane); }
        ti_store(d, v, scr, lane);
        if (hn) { d = dn;
#pragma unroll
            for (int i = 0; i < 16; ++i) v[i] = vn[i]; }
        it = itn;
    }
}

__device__ __forceinline__ void adaln_rows(const float* X, unsigned char* H, const float* g, const float* mod_shift, const float* mod_scale, int vcu, int G) {
    FRESH_TID(); const int gw = vcu * NWAVES + wave, NGW = G * NWAVES;
    for (int row = gw; row < T; row += NGW) {
        const int b = row >> 12; const float* xr = X + (size_t)row * D + 4 * lane;
        f32x4 v[4]; float s = 0.f;
#pragma unroll
        for (int j = 0; j < 4; ++j) { v[j] = *(const f32x4*)(xr + 256 * j); s += (v[j][0] * v[j][0] + v[j][1] * v[j][1]) + (v[j][2] * v[j][2] + v[j][3] * v[j][3]); }
        const float rstd = __builtin_amdgcn_rsqf(wave_sum(s) * (1.0f / D) + EPS);
#pragma unroll
        for (int j = 0; j < 4; ++j) { const int c = 4 * lane + 256 * j;
            const f32x4 gv = *(const f32x4*)(g + c), sc = *(const f32x4*)(mod_scale + b * 6144 + c), sh = *(const f32x4*)(mod_shift + b * 6144 + c);
            const f32x4 o = (v[j] * rstd * gv * (sc + 1.0f) + sh) * HIN_SCALE;
            pg8::st4_wt<2>(H + (size_t)row * D + c, pg8::pk4_i8(o[0], o[1], o[2], o[3])); }
    }
}


__device__ __forceinline__ void shw_phase(const Args& args, LAS unsigned char* lds, int vcu, int G) {
    FRESH_TID();
    unsigned char* ws = args.ws; LAS float* RED = (LAS float*)lds;
    for (int u = vcu; u < DEPTH * NB; u += G) {
        const int l = u >> 2, b = u & 3, e = tid & 31, part = tid >> 5;
        const float* sh = (const float*)(ws + WS_MOD) + (size_t)(l * NB + b) * 6144 + 3 * D; const float* rw = args.in[19] + (size_t)l * D * NE; float s = 0.f;
#pragma unroll 16
        for (int k = part * 64; k < part * 64 + 64; ++k) s = fmaf(sh[k], rw[(size_t)k * NE + e], s);
        RED[part * 32 + e] = s;
        __syncthreads();
        if (tid < 32) { float t = args.in[20][(size_t)l * NE + tid];
#pragma unroll
            for (int p = 0; p < 16; ++p) t += RED[p * 32 + tid];
            ((float*)(ws + WS_SHW))[(l * NB + b) * NE + tid] = t; }
        __syncthreads();
    }
}

constexpr int L3_CARRY = 139264, L3_SS = 141312, L3_SS2 = 143360, L3_SPL = 144384;
template <bool FULL>
__device__ __forceinline__ void mixer_unit(const Args& args, int l, int b, int j, LAS unsigned char* lds) {
    FRESH_TID();
    unsigned char* ws = args.ws;
    const bf16* Z = (const bf16*)(ws + WS_Z); bf16* Y = (bf16*)(ws + WS_Y);
    float* aggA = (float*)(ws + WS_AGA); float* aggH = (float*)(ws + WS_AGH);
    const float* mixg = args.in[17] + (size_t)l * D;
    const int fr = lane & 15, fq = lane >> 4;
    const size_t rowb = (size_t)b * SEQ;
    const int t0 = 64 * j;
    LAS float* CARRY = (LAS float*)(lds + L3_CARRY); LAS float* SS = (LAS float*)(lds + L3_SS); LAS float* SS2 = (LAS float*)(lds + L3_SS2); LAS float* SPL = (LAS float*)(lds + L3_SPL);
    if ((MIX_MASK & 4) || !FULL) {
        {
            const float y = -args.in[16][(size_t)l * 512 + tid];
            SPL[tid] = fmaxf(y, 0.f) + log1pf(expf(-fabsf(y)));
            if (FULL) { float c = 0.f; const float* pa = aggA + (size_t)b * NBLK * 512 + tid; const float* ph = aggH + (size_t)b * NBLK * 512 + tid;
                int jj = 0;
                for (; jj + 16 <= j; jj += 16) { float av[16], hv[16];
#pragma unroll
                    for (int q = 0; q < 16; ++q) { av[q] = pa[(size_t)(jj + q) * 512]; hv[q] = ph[(size_t)(jj + q) * 512]; }
#pragma unroll
                    for (int q = 0; q < 16; ++q) c = fmaf(av[q], c, hv[q]); }
                { float av[16], hv[16];
#pragma unroll
                    for (int q = 0; q < 16; ++q) { const bool ok = jj + q < j; const int jq = ok ? jj + q : 0; av[q] = pa[(size_t)jq * 512]; hv[q] = ph[(size_t)jq * 512]; if (!ok) { av[q] = 1.f; hv[q] = 0.f; } }
#pragma unroll
                    for (int q = 0; q < 16; ++q) c = fmaf(av[q], c, hv[q]); }
                CARRY[tid] = c; }
        }
        __syncthreads();
        const int hd = wave;
        LAS float* XR = (LAS float*)(lds + wave * 17408);
        const float* cw = args.in[12] + (size_t)l * 4 * 512; const float* cbp = args.in[13] + (size_t)l * 512;
        bf16x8 Xa[4][2];
#pragma unroll
        for (int ks = 0; ks < 2; ++ks) {
            const int c8 = 64 * hd + 32 * ks + 8 * fq;
            float wv[4][8], bv[8];
#pragma unroll
            for (int k = 0; k < 4; ++k) { const f32x4 w0 = *(const f32x4*)(cw + k * 512 + c8), w1 = *(const f32x4*)(cw + k * 512 + c8 + 4);
#pragma unroll
                for (int e = 0; e < 4; ++e) { wv[k][e] = w0[e]; wv[k][4 + e] = w1[e]; } }
            { const f32x4 b0 = *(const f32x4*)(cbp + c8), b1 = *(const f32x4*)(cbp + c8 + 4);
#pragma unroll
                for (int e = 0; e < 4; ++e) { bv[e] = b0[e]; bv[4 + e] = b1[e]; } }
#pragma unroll
            for (int m = 0; m < 4; ++m) {
                const int t = t0 + 16 * m + fr;
                float a8[8];
#pragma unroll
                for (int e = 0; e < 8; ++e) a8[e] = bv[e];
#pragma unroll
                for (int k = 0; k < 4; ++k) { const int tt = t - 3 + k; const int tc = tt < 0 ? 0 : tt;
                    const v4u z = *(const v4u*)(Z + (rowb + tc) * DIN + OFF_ZX + c8); const float msk = tt < 0 ? 0.f : 1.f;
                    const unsigned zw[4] = {z.x, z.y, z.z, z.w};
#pragma unroll
                    for (int q = 0; q < 4; ++q) { a8[2 * q] += wv[k][2 * q] * (msk * bflo(zw[q])); a8[2 * q + 1] += wv[k][2 * q + 1] * (msk * bfhi(zw[q])); } }
                v4u pk; pk.x = pk2(a8[0], a8[1]); pk.y = pk2(a8[2], a8[3]); pk.z = pk2(a8[4], a8[5]); pk.w = pk2(a8[6], a8[7]);
                Xa[m][ks] = __builtin_bit_cast(bf16x8, pk);
                LAS float* xp = XR + (16 * m + fr) * 68 + 32 * ks + 8 * fq;
                *(LAS f32x4*)(xp) = (f32x4){a8[0], a8[1], a8[2], a8[3]}; *(LAS f32x4*)(xp + 4) = (f32x4){a8[4], a8[5], a8[6], a8[7]};
            }
        }
        LDS_WAIT(); asm volatile("" ::: "memory");
        const bf16* GwT = (const bf16*)(ws + WS_GWT) + (size_t)l * 2 * 8 * 4096;
        const float* gbp = args.in[15] + (size_t)l * 2 * 512;
        float ss[4] = {0.f, 0.f, 0.f, 0.f};
        bf16x8 Wn[2][2]; f32x4 gbr_n, gbi_n; v2u zg_n[4];
#define LRU_PREFETCH(nn) do { \
            _Pragma("unroll") for (int g_ = 0; g_ < 2; ++g_) _Pragma("unroll") for (int ks_ = 0; ks_ < 2; ++ks_) \
                Wn[g_][ks_] = __builtin_bit_cast(bf16x8, *(const v4u*)(GwT + ((size_t)(g_ * 8 + hd) * 64 + 16 * (nn) + fr) * 64 + 32 * ks_ + 8 * fq)); \
            gbr_n = *(const f32x4*)(gbp + hd * 64 + 16 * (nn) + 4 * fq); gbi_n = *(const f32x4*)(gbp + 512 + hd * 64 + 16 * (nn) + 4 * fq); \
            if (FULL) { _Pragma("unroll") for (int m_ = 0; m_ < 4; ++m_) zg_n[m_] = *(const v2u*)(Z + (rowb + t0 + 16 * m_ + fr) * DIN + OFF_ZG + 64 * hd + 16 * (nn) + 4 * fq); } } while (0)
        LRU_PREFETCH(0);
#pragma unroll 1
        for (int n = 0; n < 4; ++n) {
            const int cc = 16 * n + 4 * fq, c = 64 * hd + cc;
            bf16x8 Wc[2][2]; v2u zgc[4];
#pragma unroll
            for (int g = 0; g < 2; ++g)
#pragma unroll
                for (int ks = 0; ks < 2; ++ks) Wc[g][ks] = Wn[g][ks];
            const f32x4 gbr = gbr_n, gbi = gbi_n;
#pragma unroll
            for (int m = 0; m < 4; ++m) zgc[m] = zg_n[m];
            { const int nn = n < 3 ? n + 1 : 3; LRU_PREFETCH(nn); }
            f32x4 acc[2][4];
#pragma unroll
            for (int g = 0; g < 2; ++g)
#pragma unroll
                for (int m = 0; m < 4; ++m) { acc[g][m] = (f32x4){0.f, 0.f, 0.f, 0.f};
#pragma unroll
                    for (int ks = 0; ks < 2; ++ks) acc[g][m] = __builtin_amdgcn_mfma_f32_16x16x32_bf16(Wc[g][ks], Xa[m][ks], acc[g][m], 0, 0, 0); }
            const f32x4 sp = *(const LAS f32x4*)(SPL + c);
            float A[4][4], Bv[4][4];
#pragma unroll
            for (int m = 0; m < 4; ++m) { const f32x4 xr = *(const LAS f32x4*)(XR + (16 * m + fr) * 68 + cc);
#pragma unroll
                for (int e = 0; e < 4; ++e) { const float r = sigmoidf_(acc[0][m][e] + gbr[e]), ig = sigmoidf_(acc[1][m][e] + gbi[e]);
                    const float la = -8.0f * r * sp[e]; const float a = __builtin_amdgcn_exp2f(la * 1.4426950408889634f);
                    A[m][e] = a; Bv[m][e] = xr[e] * ig * __builtin_amdgcn_sqrtf(fmaxf(fmaf(-a, a, 1.0f), 0.f)); } }
#pragma unroll
            for (int m = 0; m < 4; ++m)
#pragma unroll
                for (int e = 0; e < 4; ++e) { float a = A[m][e], bb = Bv[m][e];
                    { const float ap = dpp_f<0x111>(1.0f, a), bp = dpp_f<0x111>(0.0f, bb); bb = fmaf(a, bp, bb); a *= ap; }
                    { const float ap = dpp_f<0x112>(1.0f, a), bp = dpp_f<0x112>(0.0f, bb); bb = fmaf(a, bp, bb); a *= ap; }
                    { const float ap = dpp_f<0x114>(1.0f, a), bp = dpp_f<0x114>(0.0f, bb); bb = fmaf(a, bp, bb); a *= ap; }
                    { const float ap = dpp_f<0x118>(1.0f, a), bp = dpp_f<0x118>(0.0f, bb); bb = fmaf(a, bp, bb); a *= ap; }
                    A[m][e] = a; Bv[m][e] = bb; }
            float hc[4], ac[4];
            if (FULL) { const f32x4 cv = *(const LAS f32x4*)(CARRY + c); hc[0] = cv[0]; hc[1] = cv[1]; hc[2] = cv[2]; hc[3] = cv[3]; }
            else { hc[0] = hc[1] = hc[2] = hc[3] = 0.f; }
            ac[0] = ac[1] = ac[2] = ac[3] = 1.f;
#pragma unroll
            for (int m = 0; m < 4; ++m) {
                float hcur[4];
#pragma unroll
                for (int e = 0; e < 4; ++e) { hcur[e] = fmaf(A[m][e], hc[e], Bv[m][e]); hc[e] = bcast15(hcur[e], lane);
                    if (!FULL) ac[e] = bcast15(A[m][e] * ac[e], lane); }
                if (FULL) { const v2u zg = zgc[m];
                    const float g4[4] = {bflo(zg.x), bfhi(zg.x), bflo(zg.y), bfhi(zg.y)};
                    f32x4 yq;
#pragma unroll
                    for (int e = 0; e < 4; ++e) { const float y = gelu_tanh(g4[e]) * hcur[e]; yq[e] = y; ss[m] = fmaf(y, y, ss[m]); }
                    *(LAS f32x4*)(XR + (16 * m + fr) * 68 + cc) = yq; }
            }
            if (!FULL && fr == 0) { const size_t o = ((size_t)b * NBLK + j) * 512 + c; *(f32x4*)(aggA + o) = (f32x4){ac[0], ac[1], ac[2], ac[3]}; *(f32x4*)(aggH + o) = (f32x4){hc[0], hc[1], hc[2], hc[3]}; }
        }
#undef LRU_PREFETCH
        if (FULL) {
#pragma unroll
            for (int m = 0; m < 4; ++m) { float s = ss[m]; s += __shfl_xor(s, 16); s += __shfl_xor(s, 32); if (fq == 0) SS[wave * 64 + 16 * m + fr] = s; }
            __syncthreads();
#pragma unroll
            for (int m = 0; m < 4; ++m) { float tot = 0.f;
#pragma unroll
                for (int w = 0; w < 8; ++w) tot += SS[w * 64 + 16 * m + fr];
                const float rstd = __builtin_amdgcn_rsqf(tot * (1.0f / 512.0f) + EPS);
#pragma unroll
                for (int n = 0; n < 4; ++n) { const int c = 512 + 64 * hd + 16 * n + 4 * fq; const f32x4 mg = *(const f32x4*)(mixg + c);
                    const f32x4 yq = *(const LAS f32x4*)(XR + (16 * m + fr) * 68 + 16 * n + 4 * fq);
                    v2u w; w.x = pk2(yq[0] * rstd * mg[0], yq[1] * rstd * mg[1]); w.y = pk2(yq[2] * rstd * mg[2], yq[3] * rstd * mg[3]);
                    pg8::st8_wt<2>(Y + (rowb + t0 + 16 * m + fr) * D + c, w); } }
        }
    } else if (FULL) {
        for (int i = tid; i < 64 * 64; i += NTHR) { const int r = i >> 6, c8 = (i & 63) * 8; *(v4u*)(Y + (rowb + t0 + r) * D + 512 + c8) = (v4u){0u, 0u, 0u, 0u}; }
    }
    if (!FULL) return;
    asm volatile("" ::: "memory");
    if (MIX_MASK & 1) {
        const int tg = tid >> 5, s8 = (tid & 31) * 8; const int tb = t0 + 4 * tg;
        const float* caw = args.in[7] + (size_t)l * 3 * 256;
        float w3[3][8];
#pragma unroll
        for (int k = 0; k < 3; ++k) { const f32x4 w0 = *(const f32x4*)(caw + k * 256 + s8), w1 = *(const f32x4*)(caw + k * 256 + s8 + 4);
#pragma unroll
            for (int e = 0; e < 4; ++e) { w3[k][e] = w0[e]; w3[k][4 + e] = w1[e]; } }
        float cv[6][8];
#pragma unroll
        for (int i = 0; i < 6; ++i) { const int tt = tb - 2 + i; const int tc = tt < 0 ? 0 : tt; const float msk = tt < 0 ? 0.f : 1.f;
            const v4u zc = *(const v4u*)(Z + (rowb + tc) * DIN + OFF_ZC + s8), zv = *(const v4u*)(Z + (rowb + tc) * DIN + OFF_ZV + s8);
            const unsigned a[4] = {zc.x, zc.y, zc.z, zc.w}, bq[4] = {zv.x, zv.y, zv.z, zv.w};
#pragma unroll
            for (int q = 0; q < 4; ++q) { cv[i][2 * q] = msk * bflo(a[q]) * bflo(bq[q]); cv[i][2 * q + 1] = msk * bfhi(a[q]) * bfhi(bq[q]); } }
        const f32x4 mg0 = *(const f32x4*)(mixg + s8), mg1 = *(const f32x4*)(mixg + s8 + 4);
#pragma unroll
        for (int i = 0; i < 4; ++i) {
            const v4u zb = *(const v4u*)(Z + (rowb + tb + i) * DIN + OFF_ZB + s8); const unsigned a[4] = {zb.x, zb.y, zb.z, zb.w};
            float y[8], s = 0.f;
#pragma unroll
            for (int e = 0; e < 8; ++e) { const float zbe = (e & 1) ? bfhi(a[e >> 1]) : bflo(a[e >> 1]);
                y[e] = zbe * (w3[0][e] * cv[i][e] + w3[1][e] * cv[i + 1][e] + w3[2][e] * cv[i + 2][e]); s = fmaf(y[e], y[e], s); }
#pragma unroll
            for (int o = 1; o < 32; o <<= 1) s += __shfl_xor(s, o);
            const float rstd = __builtin_amdgcn_rsqf(s * (1.0f / 256.0f) + EPS);
            v4u w; w.x = pk2(y[0] * rstd * mg0[0], y[1] * rstd * mg0[1]); w.y = pk2(y[2] * rstd * mg0[2], y[3] * rstd * mg0[3]);
            w.z = pk2(y[4] * rstd * mg1[0], y[5] * rstd * mg1[1]); w.w = pk2(y[6] * rstd * mg1[2], y[7] * rstd * mg1[3]);
            pg8::st16_wt<2>(Y + (rowb + tb + i) * D + s8, w); }
    } else {
        for (int i = tid; i < 64 * 32; i += NTHR) { const int r = i >> 5, c8 = (i & 31) * 8; *(v4u*)(Y + (rowb + t0 + r) * D + c8) = (v4u){0u, 0u, 0u, 0u}; }
    }
    asm volatile("" ::: "memory");
    if (MIX_MASK & 2) {
        __syncthreads();
        const int hf = j & 1, tcs = t0 - 64 * hf, slen = 64 * (hf + 1);
        LAS bf16* Vt = (LAS bf16*)lds;
        const float* lng = args.in[10] + (size_t)l * 256; const float* lnb = args.in[11] + (size_t)l * 256;
        {
            const int rr = lane >> 4, ci = lane & 15;
            float gq[16], bq[16];
#pragma unroll
            for (int q = 0; q < 4; ++q) { const f32x4 a = *(const f32x4*)(lng + 16 * ci + 4 * q), bb = *(const f32x4*)(lnb + 16 * ci + 4 * q);
#pragma unroll
                for (int e = 0; e < 4; ++e) { gq[4 * q + e] = a[e]; bq[4 * q + e] = bb[e]; } }
            v4u zz[4][2];
#pragma unroll
            for (int it = 0; it < 4; ++it) if (it * 32 < slen) { const int sr = 32 * it + 4 * wave + rr; const bf16* zp = Z + (rowb + tcs + sr) * DIN + OFF_ZSV + 16 * ci;
                zz[it][0] = *(const v4u*)(zp); zz[it][1] = *(const v4u*)(zp + 8); }
#pragma unroll
            for (int it = 0; it < 4; ++it) if (it * 32 < slen) { const int sr = 32 * it + 4 * wave + rr;
                float v[16]; float sm = 0.f;
#pragma unroll
                for (int hh = 0; hh < 2; ++hh) { const unsigned w4[4] = {zz[it][hh].x, zz[it][hh].y, zz[it][hh].z, zz[it][hh].w};
#pragma unroll
                    for (int q = 0; q < 4; ++q) { v[8 * hh + 2 * q] = gelu_tanh(bflo(w4[q])); v[8 * hh + 2 * q + 1] = gelu_tanh(bfhi(w4[q])); } }
#pragma unroll
                for (int e = 0; e < 16; ++e) sm += v[e];
                const float mean = sum16(sm) * (1.0f / 256.0f); float sq = 0.f;
#pragma unroll
                for (int e = 0; e < 16; ++e) { v[e] -= mean; sq = fmaf(v[e], v[e], sq); }
                const float rstd = __builtin_amdgcn_rsqf(sum16(sq) * (1.0f / 256.0f) + EPS);
#pragma unroll
                for (int e = 0; e < 16; e += 2) { const unsigned w = pk2(v[e] * rstd * gq[e] + bq[e], v[e + 1] * rstd * gq[e + 1] + bq[e + 1]); Vt[(16 * ci + e) * 136 + sr] = (bf16)w; Vt[(16 * ci + e + 1) * 136 + sr] = (bf16)(w >> 16); }
            } }
        __syncthreads();
        const int h = wave >> 1, th = wave & 1;
        const bf16* SGW = (const bf16*)(ws + WS_SGW) + ((size_t)l * 4 + h) * 16384;
        f32x4 acc[2][4];
#pragma unroll
        for (int m = 0; m < 2; ++m)
#pragma unroll
            for (int n = 0; n < 4; ++n) acc[m][n] = (f32x4){0.f, 0.f, 0.f, 0.f};
#pragma unroll
        for (int ks = 0; ks < 4; ++ks) {
            if (ks * 32 < slen) {
                bf16x8 Wq[2];
#pragma unroll
                for (int m = 0; m < 2; ++m) Wq[m] = __builtin_bit_cast(bf16x8, *(const v4u*)(SGW + (size_t)(64 * hf + 32 * th + 16 * m + fr) * 128 + 32 * ks + 8 * fq));
#pragma unroll
                for (int n = 0; n < 4; ++n) { const bf16x8 Vp = *(const LAS bf16x8*)(Vt + (64 * h + 16 * n + fr) * 136 + 32 * ks + 8 * fq);
#pragma unroll
                    for (int m = 0; m < 2; ++m) acc[m][n] = __builtin_amdgcn_mfma_f32_16x16x32_bf16(Vp, Wq[m], acc[m][n], 0, 0, 0); }
            }
        }
        const float* sgb = args.in[9] + ((size_t)l * 4 + h) * 128;
        float ys[2][4][4], s2[2];
#pragma unroll
        for (int m = 0; m < 2; ++m) { const int tl = 32 * th + 16 * m + fr; const float bias = sgb[64 * hf + tl]; float s = 0.f;
#pragma unroll
            for (int n = 0; n < 4; ++n) { const v2u zu = *(const v2u*)(Z + (rowb + t0 + tl) * DIN + OFF_ZU + 64 * h + 16 * n + 4 * fq);
                const float u4[4] = {bflo(zu.x), bfhi(zu.x), bflo(zu.y), bfhi(zu.y)};
#pragma unroll
                for (int e = 0; e < 4; ++e) { const float y = gelu_tanh(u4[e]) * (acc[m][n][e] + bias); ys[m][n][e] = y; s = fmaf(y, y, s); } }
            s += __shfl_xor(s, 16); s += __shfl_xor(s, 32); s2[m] = s; if (fq == 0) SS2[h * 64 + tl] = s; }
        __syncthreads();
#pragma unroll
        for (int m = 0; m < 2; ++m) { const int tl = 32 * th + 16 * m + fr; const float tot = (SS2[tl] + SS2[64 + tl]) + (SS2[128 + tl] + SS2[192 + tl]);
            const float rstd = __builtin_amdgcn_rsqf(tot * (1.0f / 256.0f) + EPS);
#pragma unroll
            for (int n = 0; n < 4; ++n) { const int c = 256 + 64 * h + 16 * n + 4 * fq; const f32x4 mg = *(const f32x4*)(mixg + c);
                v2u w; w.x = pk2(ys[m][n][0] * rstd * mg[0], ys[m][n][1] * rstd * mg[1]); w.y = pk2(ys[m][n][2] * rstd * mg[2], ys[m][n][3] * rstd * mg[3]);
                pg8::st8_wt<2>(Y + (rowb + t0 + tl) * D + c, w); } }
        (void)s2;
    } else {
        for (int i = tid; i < 64 * 32; i += NTHR) { const int r = i >> 5, c8 = (i & 31) * 8; *(v4u*)(Y + (rowb + t0 + r) * D + 256 + c8) = (v4u){0u, 0u, 0u, 0u}; }
    }
}

template <bool XBF> __device__ __forceinline__ void route_tile(const Args& args, int l, int tile, const void* X1, LAS unsigned char* lds) {
    FRESH_TID();
    unsigned char* ws = args.ws;
    LAS float* GS = (LAS float*)lds; LAS float* SH = (LAS float*)(lds + 4096); LAS float* SHW = (LAS float*)(lds + 8192); LAS float* RED = (LAS float*)(lds + 8448);
    LAS float* PL = (LAS float*)(lds + 16384); LAS float* PSS = (LAS float*)(lds + 32768); LAS float* RSTD = (LAS float*)(lds + 33280); LAS int* HIST = (LAS int*)(lds + 33792); LAS int* BASE = (LAS int*)(lds + 33920);
    const int row0 = tile * 64, b = row0 >> 12; const int fr = lane & 15, fq = lane >> 4;
    const float* mod = (const float*)(ws + WS_MOD) + (size_t)(l * NB + b) * 6144;
    const float* g2 = args.in[3] + (size_t)l * D;
    const int st = wave >> 1, kh = wave & 1;
    const size_t xrow = (size_t)(row0 + 16 * st + fr) * D;
    v4u xraw[16];
#pragma unroll
    for (int kb = 0; kb < 16; ++kb) { const int k = 512 * kh + 32 * kb + 8 * fq;
        if (XBF) xraw[kb] = *(const v4u*)((const bf16*)X1 + xrow + k);
        else { const f32x4 a = *(const f32x4*)((const float*)X1 + xrow + k), c4 = *(const f32x4*)((const float*)X1 + xrow + k + 4); xraw[kb] = (v4u){pk2(a[0], a[1]), pk2(a[2], a[3]), pk2(c4[0], c4[1]), pk2(c4[2], c4[3])}; } }
    for (int k = tid; k < D; k += NTHR) { GS[k] = g2[k] * (1.0f + mod[4 * D + k]); SH[k] = mod[3 * D + k]; }
    if (tid < 32) { HIST[tid] = 0; SHW[tid] = ((const float*)(ws + WS_SHW))[(l * NB + b) * NE + tid]; }
    __syncthreads();
    const bf16* RWH = (const bf16*)(ws + WS_RWH) + (size_t)l * NE * D; const bf16* RWL = (const bf16*)(ws + WS_RWL) + (size_t)l * NE * D;
    f32x4 acc[2] = {(f32x4){0.f, 0.f, 0.f, 0.f}, (f32x4){0.f, 0.f, 0.f, 0.f}}; float ssq = 0.f;
#pragma unroll
    for (int kb = 0; kb < 16; ++kb) {
        const int k = 512 * kh + 32 * kb + 8 * fq;
        const float xv[8] = {bflo(xraw[kb].x), bfhi(xraw[kb].x), bflo(xraw[kb].y), bfhi(xraw[kb].y), bflo(xraw[kb].z), bfhi(xraw[kb].z), bflo(xraw[kb].w), bfhi(xraw[kb].w)};
        const f32x4 g0 = *(const LAS f32x4*)(GS + k), g1 = *(const LAS f32x4*)(GS + k + 4);
        float xs[8];
#pragma unroll
        for (int e = 0; e < 4; ++e) { xs[e] = xv[e] * g0[e]; xs[4 + e] = xv[4 + e] * g1[e]; ssq = fmaf(xv[e], xv[e], ssq); ssq = fmaf(xv[4 + e], xv[4 + e], ssq); }
        v4u qh, ql;
        qh.x = pk2(xs[0], xs[1]); qh.y = pk2(xs[2], xs[3]); qh.z = pk2(xs[4], xs[5]); qh.w = pk2(xs[6], xs[7]);
        ql.x = pk2(xs[0] - bflo(qh.x), xs[1] - bfhi(qh.x)); ql.y = pk2(xs[2] - bflo(qh.y), xs[3] - bfhi(qh.y));
        ql.z = pk2(xs[4] - bflo(qh.z), xs[5] - bfhi(qh.z)); ql.w = pk2(xs[6] - bflo(qh.w), xs[7] - bfhi(qh.w));
        const bf16x8 Qh = __builtin_bit_cast(bf16x8, qh), Ql = __builtin_bit_cast(bf16x8, ql);
#pragma unroll
        for (int n = 0; n < 2; ++n) { const bf16x8 Ph = __builtin_bit_cast(bf16x8, *(const v4u*)(RWH + (size_t)(16 * n + fr) * D + k)), Pl = __builtin_bit_cast(bf16x8, *(const v4u*)(RWL + (size_t)(16 * n + fr) * D + k));
            acc[n] = __builtin_amdgcn_mfma_f32_16x16x32_bf16(Ph, Qh, acc[n], 0, 0, 0);
            acc[n] = __builtin_amdgcn_mfma_f32_16x16x32_bf16(Ph, Ql, acc[n], 0, 0, 0);
            acc[n] = __builtin_amdgcn_mfma_f32_16x16x32_bf16(Pl, Qh, acc[n], 0, 0, 0); }
    }
    ssq += __shfl_xor(ssq, 16); ssq += __shfl_xor(ssq, 32);
#pragma unroll
    for (int n = 0; n < 2; ++n) *(LAS f32x4*)(PL + (wave * 16 + fr) * 32 + 16 * n + 4 * fq) = acc[n];
    if (fq == 0) PSS[wave * 16 + fr] = ssq;
    __syncthreads();
    int ek = 0, rank = 0; float wk = 0.f;
    if (kh == 0) {
        const float tot = PSS[wave * 16 + fr] + PSS[(wave + 1) * 16 + fr]; const float rstd = __builtin_amdgcn_rsqf(tot * (1.0f / D) + EPS);
        if (fq == 0) RSTD[16 * st + fr] = rstd;
        float v[8]; int taken = 0;
#pragma unroll
        for (int n = 0; n < 2; ++n) { const f32x4 o = *(const LAS f32x4*)(PL + ((wave + 1) * 16 + fr) * 32 + 16 * n + 4 * fq); const f32x4 sw = *(const LAS f32x4*)(SHW + 16 * n + 4 * fq);
#pragma unroll
            for (int e = 0; e < 4; ++e) v[4 * n + e] = rstd * (acc[n][e] + o[e]) + sw[e]; }
        float selv[4]; int seli[4];
#pragma unroll
        for (int r = 0; r < 4; ++r) {
            float bv = -3.0e38f; int bi = 1 << 20;
#pragma unroll
            for (int q = 0; q < 8; ++q) { const int idx = 16 * (q >> 2) + 4 * fq + (q & 3); const bool ok = !((taken >> q) & 1) && (v[q] > bv); bv = ok ? v[q] : bv; bi = ok ? idx : bi; }
#pragma unroll
            for (int msk = 16; msk <= 32; msk <<= 1) { const float ov = __shfl_xor(bv, msk); const int oi = __shfl_xor(bi, msk); const bool tk = (ov > bv) || (ov == bv && oi < bi); bv = tk ? ov : bv; bi = tk ? oi : bi; }
            selv[r] = bv; seli[r] = bi;
            if (((bi >> 2) & 3) == fq) taken |= 1 << (4 * (bi >> 4) + (bi & 3));
        }
        const float e1 = __expf(selv[1] - selv[0]), e2 = __expf(selv[2] - selv[0]), e3 = __expf(selv[3] - selv[0]); const float inv = 1.0f / (1.0f + e1 + e2 + e3);
        wk = (fq == 0 ? 1.0f : fq == 1 ? e1 : fq == 2 ? e2 : e3) * inv; ek = fq == 0 ? seli[0] : fq == 1 ? seli[1] : fq == 2 ? seli[2] : seli[3];
        rank = __hip_atomic_fetch_add(HIST + ek, 1, __ATOMIC_RELAXED, __HIP_MEMORY_SCOPE_WORKGROUP);
    }
    __syncthreads();
    if (tid < 32) { const int hcnt = HIST[tid]; int base = 0;
        if (hcnt) base = (int)__hip_atomic_fetch_add((unsigned*)(ws + WS_CTL) + CW_GCNT + (l * 32 + tid) * 32, (unsigned)hcnt, __ATOMIC_RELAXED, __HIP_MEMORY_SCOPE_AGENT);
        BASE[tid] = base; }
    __syncthreads();
    if (kh == 0) { const int tok = row0 + 16 * st + fr; const size_t ai = (size_t)tok * 4 + fq; const int slot = ek * CAP + BASE[ek] + rank;
        ((int*)(ws + WS_SLOT))[ai] = slot; ((float*)(ws + WS_TOPW))[ai] = wk; ((int*)(ws + WS_ROWTOK))[slot] = tok; }
    unsigned char* H8 = (unsigned char*)(ws + WS_H);
    { const float rs = RSTD[16 * st + fr] * H_SCALE;
#pragma unroll
        for (int kb = 0; kb < 16; ++kb) { const int k = 512 * kh + 32 * kb + 8 * fq;
            const f32x4 g0 = *(const LAS f32x4*)(GS + k), g1 = *(const LAS f32x4*)(GS + k + 4), s0 = *(const LAS f32x4*)(SH + k), s1 = *(const LAS f32x4*)(SH + k + 4);
            const f32x4 x0 = {bflo(xraw[kb].x), bfhi(xraw[kb].x), bflo(xraw[kb].y), bfhi(xraw[kb].y)}, x1 = {bflo(xraw[kb].z), bfhi(xraw[kb].z), bflo(xraw[kb].w), bfhi(xraw[kb].w)};
            const f32x4 o0 = x0 * g0 * rs + s0 * H_SCALE, o1 = x1 * g1 * rs + s1 * H_SCALE;
            pg8::st8_wt<2>(H8 + xrow + k, (v2u){pg8::pk4_i8(o0[0], o0[1], o0[2], o0[3]), pg8::pk4_i8(o1[0], o1[1], o1[2], o1[3])}); } }
    __syncthreads();
}

__device__ __forceinline__ void moe_tables(const Args& args, int l, LAS unsigned char* lds, int G) {
    FRESH_TID();
    unsigned char* ws = args.ws;
    LAS int* TILEE = (LAS int*)(lds + L_TILEE); LAS int* TILEPM = (LAS int*)(lds + L_TILEPM); LAS int* CNTE = (LAS int*)(lds + L_CNTE); LAS int* NMp = (LAS int*)(lds + L_NM);
    LAS unsigned* RT = (LAS unsigned*)(lds + L_RT);
    if (tid < 64) {
        int cnt = 0; if (tid < 32) cnt = (int)__hip_atomic_load((unsigned*)(ws + WS_CTL) + CW_GCNT + (l * 32 + tid) * 32, __ATOMIC_RELAXED, __HIP_MEMORY_SCOPE_AGENT);
        const int nt = (cnt + 255) >> 8; int inc = nt;
#pragma unroll
        for (int o = 1; o < 32; o <<= 1) { const int t = __shfl_up(inc, o); if (lane >= o) inc += t; }
        const int run = inc - nt;
        if (tid < 32) { CNTE[tid] = cnt; for (int t = 0; t < nt; ++t) { TILEE[run + t] = tid; TILEPM[run + t] = tid * CAPT + t; } }
        if (tid == 31) NMp[0] = inc;
    }
    __syncthreads();
    pg8::MoeOrder S; S.init(NMp[0], 8, G, (int)blockIdx.x); S.tile_e = TILEE; S.tile_pm = TILEPM;
    const int* ROWTOK = (const int*)(ws + WS_ROWTOK);
    for (int i0 = 0; i0 < 16; i0 += 2) { pg8::Unit u0; if (!S.next(i0, u0)) break;
        const int i = i0 + (tid >> 8), r = tid & 255; pg8::Unit u;
        if (S.next(i, u)) { const bool valid = (u.pm - u.e * CAPT) * 256 + r < CNTE[u.e]; const int tok = valid ? ROWTOK[(size_t)u.pm * 256 + r] : 0; RT[i * 256 + r] = (unsigned)tok * (unsigned)D; } }
    __syncthreads();
}

template <bool MOE, bool LAST, bool XBF>
__device__ __forceinline__ void combine_rows(const Args& args, int l, const void* X1, bf16* XN, int vcu, int G) {
    FRESH_TID(); const int gw = vcu * NWAVES + wave, NGW = G * NWAVES;
    unsigned char* ws = args.ws;
    const unsigned char* YE = (const unsigned char*)(ws + WS_YE); unsigned char* H = (unsigned char*)(ws + WS_H);
    int rpw = 1; while (rpw * NGW < T) rpw <<= 1;
    const int rbeg = gw * rpw, rend = (rbeg + rpw < T) ? rbeg + rpw : T;
    if (rbeg >= T) return;
    const int b = rbeg >> 12;
    const float* modl = (const float*)(ws + WS_MOD) + (size_t)(l * NB + b) * 6144;
    f32x4 gt[4], pa[4], pb[4];
#pragma unroll
    for (int q = 0; q < 4; ++q) { const int c = 8 * lane + 512 * (q >> 1) + 4 * (q & 1);
        gt[q] = MOE ? *(const f32x4*)(modl + 5 * D + c) : (f32x4){0.f, 0.f, 0.f, 0.f};
        if (LAST) { pa[q] = *(const f32x4*)(args.in[25] + c); pb[q] = (f32x4){0.f, 0.f, 0.f, 0.f}; }
        else { const float* modn = (const float*)(ws + WS_MOD) + (size_t)((l + 1) * NB + b) * 6144; const f32x4 g = *(const f32x4*)(args.in[2] + (size_t)(l + 1) * D + c), sc = *(const f32x4*)(modn + D + c);
            pa[q] = g * (sc + 1.0f); pb[q] = *(const f32x4*)(modn + c); } }
    int myslot = 0; float myw = 0.f;
    if (MOE && rpw * 4 <= 64 && lane < (rend - rbeg) * 4) { myslot = ((const int*)(ws + WS_SLOT))[(size_t)rbeg * 4 + lane]; myw = ((const float*)(ws + WS_TOPW))[(size_t)rbeg * 4 + lane]; }
#pragma unroll 2
    for (int row = rbeg; row < rend; ++row) {
        f32x4 v[4];
        { float t0[8], t1[8]; ld8<XBF>(X1, (size_t)row * D + 8 * lane, t0); ld8<XBF>(X1, (size_t)row * D + 512 + 8 * lane, t1);
            v[0] = (f32x4){t0[0], t0[1], t0[2], t0[3]}; v[1] = (f32x4){t0[4], t0[5], t0[6], t0[7]}; v[2] = (f32x4){t1[0], t1[1], t1[2], t1[3]}; v[3] = (f32x4){t1[4], t1[5], t1[6], t1[7]}; }
        if (MOE) {
            f32x4 a[4] = {(f32x4){0.f, 0.f, 0.f, 0.f}, (f32x4){0.f, 0.f, 0.f, 0.f}, (f32x4){0.f, 0.f, 0.f, 0.f}, (f32x4){0.f, 0.f, 0.f, 0.f}};
            v2u y[4][2]; float w[4];
#pragma unroll
            for (int k = 0; k < 4; ++k) { int slot;
                if (rpw * 4 <= 64) { slot = __builtin_amdgcn_readlane(myslot, (row - rbeg) * 4 + k); w[k] = __builtin_bit_cast(float, __builtin_amdgcn_readlane(__builtin_bit_cast(int, myw), (row - rbeg) * 4 + k)); }
                else { slot = ((const int*)(ws + WS_SLOT))[(size_t)row * 4 + k]; w[k] = ((const float*)(ws + WS_TOPW))[(size_t)row * 4 + k]; }
                slot = __builtin_amdgcn_readfirstlane(slot); w[k] *= (1.0f / YE_SCALE);
                const unsigned char* yr = YE + (size_t)slot * D + 8 * lane; y[k][0] = *(const v2u*)(yr); y[k][1] = *(const v2u*)(yr + 512); }
#pragma unroll
            for (int k = 0; k < 4; ++k)
#pragma unroll
                for (int hh = 0; hh < 2; ++hh) { const v2u t = y[k][hh];
                    a[2 * hh] += w[k] * (f32x4){i8f(t.x, 0), i8f(t.x, 1), i8f(t.x, 2), i8f(t.x, 3)}; a[2 * hh + 1] += w[k] * (f32x4){i8f(t.y, 0), i8f(t.y, 1), i8f(t.y, 2), i8f(t.y, 3)}; }
#pragma unroll
            for (int q = 0; q < 4; ++q) v[q] += gt[q] * a[q];
        }
        float s = 0.f;
#pragma unroll
        for (int q = 0; q < 4; ++q) s += (v[q][0] * v[q][0] + v[q][1] * v[q][1]) + (v[q][2] * v[q][2] + v[q][3] * v[q][3]);
        const float rstd = __builtin_amdgcn_rsqf(wave_sum(s) * (1.0f / D) + EPS);
        if (LAST) {
#pragma unroll
            for (int q = 0; q < 4; ++q) *(f32x4*)(args.out + (size_t)row * D + 8 * lane + 512 * (q >> 1) + 4 * (q & 1)) = v[q] * rstd * pa[q];
        } else {
#pragma unroll
            for (int hh = 0; hh < 2; ++hh) { v4u wv; wv.x = pk2(v[2 * hh][0], v[2 * hh][1]); wv.y = pk2(v[2 * hh][2], v[2 * hh][3]); wv.z = pk2(v[2 * hh + 1][0], v[2 * hh + 1][1]); wv.w = pk2(v[2 * hh + 1][2], v[2 * hh + 1][3]);
                pg8::st16_wt<2>(XN + (size_t)row * D + 8 * lane + 512 * hh, wv); }
#pragma unroll
            for (int hh = 0; hh < 2; ++hh) { const f32x4 o0 = (v[2 * hh] * rstd * pa[2 * hh] + pb[2 * hh]) * HIN_SCALE, o1 = (v[2 * hh + 1] * rstd * pa[2 * hh + 1] + pb[2 * hh + 1]) * HIN_SCALE;
                pg8::st8_wt<2>(H + (size_t)row * D + 8 * lane + 512 * hh, (v2u){pg8::pk4_i8(o0[0], o0[1], o0[2], o0[3]), pg8::pk4_i8(o1[0], o1[1], o1[2], o1[3])}); }
        }
    }
}

template <int L> __device__ __forceinline__ void layer_body(const Args& args, LAS unsigned char* lds, const XcdBarrier& bar, int vcu, int G, const void* xin, bf16* xnext) {
    unsigned char* ws = args.ws;
    constexpr bool MIX = (RUN_MASK >> (2 * L)) & 1, MOE = (RUN_MASK >> (2 * L + 1)) & 1, LAST = (L == DEPTH - 1);
    const float* modl = (const float*)(ws + WS_MOD) + (size_t)L * NB * 6144;
    constexpr bool XIN_BF = (L > 0), X1_BF = MIX ? true : XIN_BF;
    bf16* XA = (bf16*)(ws + WS_XA);
    const void* x1 = xin;
    if (MIX) {
        if (PH(2)) { asm volatile("; PHASE_MARK P2" ::: "memory");
            _Pragma("unroll 1") for (int rep = 0; rep < NREP(2); ++rep) {
            pg8::Gemm g{(const bf16*)(ws + WS_H), (const bf16*)(ws + WS_WIN + (size_t)L * DIN * D), D}; pg8::StaticOrder S; S.init(T / 256, DIN / 256, G, (int)blockIdx.x);
            pg8::EpiBf16 E{(bf16*)(ws + WS_Z), DIN, nullptr, 0, 1.0f / (HIN_SCALE * W_SCALE)};
            pg8::gemm_phase<pg8::EpiBf16, pg8::StaticOrder, true>(lds, g, S, E);
            xcd_barrier(bar); }
        }
        if (PH(3) & ((MIX_MASK >> 2) & 1)) { asm volatile("; PHASE_MARK P3a" ::: "memory");
            _Pragma("unroll 1") for (int rep = 0; rep < NREP(3); ++rep) {
            for (int u = vcu; u < NB * NBLK; u += G) { mixer_unit<false>(args, L, u >> 6, u & 63, lds); __syncthreads(); }
            xcd_barrier(bar); }
        }
        if (PH(4)) { asm volatile("; PHASE_MARK P3b" ::: "memory");
            _Pragma("unroll 1") for (int rep = 0; rep < NREP(4); ++rep) {
            for (int u = vcu; u < NB * NBLK; u += G) { mixer_unit<true>(args, L, u >> 6, u & 63, lds); __syncthreads(); }
            xcd_barrier(bar); }
        }
        if (PH(5)) { asm volatile("; PHASE_MARK P4" ::: "memory");
            _Pragma("unroll 1") for (int rep = 0; rep < NREP(5); ++rep) {
            pg8::Gemm g{(const bf16*)(ws + WS_Y), (const bf16*)(ws + WS_WOUT) + (size_t)L * D * D, D}; pg8::StaticOrder S; S.init(T / 256, D / 256, G, (int)blockIdx.x);
            pg8::EpiResGate<XIN_BF> E{xin, XA, modl + 2 * D};
            pg8::gemm_phase<pg8::EpiResGate<XIN_BF>, pg8::StaticOrder>(lds, g, S, E);
            xcd_barrier(bar); }
        }
        x1 = XA;
    }
    if (MOE) {
        if (PH(6)) { asm volatile("; PHASE_MARK P5" ::: "memory");
            _Pragma("unroll 1") for (int rep = 0; rep < NREP(6); ++rep) {
            for (int tile = vcu; tile < NRT; tile += G) route_tile<X1_BF>(args, L, tile, x1, lds);
            xcd_barrier(bar); }
        }
        moe_tables(args, L, lds, G);
        const int nM = *(const LAS int*)(lds + L_NM);
        if (PH(8)) { asm volatile("; PHASE_MARK P7" ::: "memory");
            _Pragma("unroll 1") for (int rep = 0; rep < NREP(8); ++rep) {
            pg8::Gemm g{(const bf16*)(ws + WS_H), (const bf16*)(ws + WS_W1 + (size_t)L * NE * 2048 * D), D}; pg8::MoeOrder S; S.init(nM, 8, G, (int)blockIdx.x); S.tile_e = (const LAS int*)(lds + L_TILEE); S.tile_pm = (const LAS int*)(lds + L_TILEPM);
            pg8::EpiSwiglu E{(unsigned char*)(ws + WS_ACT), args.in[22] + (size_t)L * NE * 2048, 1.0f / (H_SCALE * W_SCALE), ACT_SCALE};
            pg8::gemm_phase<pg8::EpiSwiglu, pg8::MoeOrder, true, true>(lds, g, S, E, (const LAS unsigned*)(lds + L_RT));
            xcd_barrier(bar); }
        }
        if (PH(9)) { asm volatile("; PHASE_MARK P8" ::: "memory");
            _Pragma("unroll 1") for (int rep = 0; rep < NREP(9); ++rep) {
            pg8::Gemm g{(const bf16*)(ws + WS_ACT), (const bf16*)(ws + WS_W2 + (size_t)L * NE * D * FF), FF}; pg8::MoeOrder S; S.init(nM, 4, G, (int)blockIdx.x); S.tile_e = (const LAS int*)(lds + L_TILEE); S.tile_pm = (const LAS int*)(lds + L_TILEPM);
            pg8::EpiI8 E{(unsigned char*)(ws + WS_YE), D, args.in[24] + (size_t)L * NE * D, D, 1.0f / (ACT_SCALE * W_SCALE), YE_SCALE};
            pg8::gemm_phase<pg8::EpiI8, pg8::MoeOrder, true>(lds, g, S, E);
            xcd_barrier(bar); }
        }
    }
    asm volatile("; PHASE_MARK P9" ::: "memory");
    if (PH(10)) { _Pragma("unroll 1") for (int rep = 0; rep < NREP(10); ++rep) { combine_rows<MOE, LAST, X1_BF>(args, L, x1, xnext, vcu, G); if (!LAST) xcd_barrier(bar); } }
}

__global__ void __launch_bounds__(NTHR, 2) fwd_kernel(Args args) {
    extern __shared__ __attribute__((aligned(16))) unsigned char lds_raw[];
    LAS unsigned char* lds = (LAS unsigned char*)lds_raw;
    const int tid = threadIdx.x;
    const int G = gridDim.x; const int bx = blockIdx.x; const int vcu = (G % 8 == 0) ? (bx % 8) * (G / 8) + bx / 8 : bx;
    unsigned char* ws = args.ws;
    for (int u = tid; u < (LDS_BYTES - LDSCTL_OFF) / 4; u += NTHR) ((LAS unsigned*)(lds + LDSCTL_OFF))[u] = 0u;
    __syncthreads();
    XcdBarrier bar = xcd_barrier_post((unsigned*)(ws + WS_CTL) + CW_BAR, (volatile LAS unsigned*)(lds + L_MISC) + 8);
    asm volatile("; PHASE_MARK P0" ::: "memory");
    _Pragma("unroll 1") for (int rep = 0; rep < NREP(0); ++rep) { if (PH(0)) pro_phase(args, lds, vcu, G); xcd_barrier(bar); }
    { shw_phase(args, lds, vcu, G); if (PH(1) & (RUN_MASK & 1)) { const float* mod0 = (const float*)(ws + WS_MOD); adaln_rows(args.in[0], (unsigned char*)(ws + WS_H), args.in[2], mod0, mod0 + D, vcu, G); } xcd_barrier(bar); }
    layer_body<0>(args, lds, bar, vcu, G, args.in[0], (bf16*)(ws + WS_XB));
    layer_body<1>(args, lds, bar, vcu, G, (const void*)(ws + WS_XB), nullptr);
}

extern "C" void kernel_launch(void* const* d_in, const int* in_sizes, int n_in, void* d_out, int out_size, void* d_ws, size_t ws_size, hipStream_t stream) {
    static int grid = 0;
    if (grid == 0) {
        if (n_in != 26 || in_sizes[0] != T * D || out_size != T * D || ws_size < WS_END) { fprintf(stderr, "kernel_launch: unexpected shapes (n_in %d, in0 %d, out %d, ws %zu < %zu); nothing launched\n", n_in, n_in > 0 ? in_sizes[0] : -1, out_size, ws_size, (size_t)WS_END); grid = -1; return; }
        int dev = 0, cus = 0, per_cu = 0;
        if (hipGetDevice(&dev) != hipSuccess || hipDeviceGetAttribute(&cus, hipDeviceAttributeMultiprocessorCount, dev) != hipSuccess) { grid = -1; return; }
        if (hipFuncSetAttribute((const void*)fwd_kernel, hipFuncAttributeMaxDynamicSharedMemorySize, LDS_BYTES) != hipSuccess) { fprintf(stderr, "kernel_launch: hipFuncSetAttribute failed\n"); grid = -1; return; }
        if (hipOccupancyMaxActiveBlocksPerMultiprocessor(&per_cu, (const void*)fwd_kernel, NTHR, LDS_BYTES) != hipSuccess || per_cu < 1) { fprintf(stderr, "kernel_launch: occupancy query says %d blocks per CU\n", per_cu); }
        (void)hipGetLastError();
        grid = cus;
    }
    if (grid < 0) return;
    if (hipMemsetAsync((char*)d_ws + WS_CTL, 0, CTL_ZERO_BYTES, stream) != hipSuccess) return;
    Args a{};
    for (int i = 0; i < 26; ++i) a.in[i] = (const float*)d_in[i];
    a.out = (float*)d_out; a.ws = (unsigned char*)d_ws; a.ph_lo = 0; a.ph_hi = 0;
    hipLaunchKernelGGL(fwd_kernel, dim3(grid), dim3(NTHR), LDS_BYTES, stream, a);
}
```
